# Optimizing an MI355X kernel written in HIP

```python
import math
import jax
import jax.numpy as jnp
from jax import lax
import numpy as np

D_MODEL = 1024
BATCH = 16
SEQ = 2048
DEPTH = 2

N_MIXERS = 2
N_ATTN_LAYERS = (DEPTH + N_MIXERS - 1) // N_MIXERS
N_MLSTM_LAYERS = DEPTH // N_MIXERS
DA_HEADS = 8
DA_HEAD_DIM = 64
DA_WIDTH = DA_HEADS * 2 * DA_HEAD_DIM
DA_QBLOCK = 128
N_BUCKETS = 32
MAX_DISTANCE = 128
ML_INNER = 2 * D_MODEL
ML_HEADS = 4
ML_HEAD_DIM = ML_INNER // ML_HEADS
ML_CONV = 5
ML_QKV_BLOCK = 4
ML_CHUNK = 128
N_GROUPS = 4
EXPERTS_PER_GROUP = 8
N_EXPERTS = N_GROUPS * EXPERTS_PER_GROUP
TOP_K_IN_GROUP = 2
D_EXPERT = D_MODEL // 4
EPS = 1e-6

kernel_name = 'hybrid_diffattn_mlstm_hmoe_encoder'


def rmsnorm(x, g):
    xf = x.astype(jnp.float32)
    y = xf * lax.rsqrt(jnp.mean(xf * xf, axis=-1, keepdims=True) + EPS)
    return (y * g.astype(jnp.float32)).astype(x.dtype)


def t5_bucket(rel):
    nb = N_BUCKETS // 2
    max_exact = nb // 2
    ret = jnp.where(rel > 0, nb, 0)
    n = jnp.abs(rel)
    nf = jnp.maximum(n, 1).astype(jnp.float32)
    large = max_exact + (jnp.log(nf / max_exact) / math.log(MAX_DISTANCE / max_exact)
                         * (nb - max_exact)).astype(jnp.int32)
    large = jnp.minimum(large, nb - 1)
    return ret + jnp.where(n < max_exact, n, large)


def diff_attention(h, w_in, w_out, q_gain, k_gain, lam_q1, lam_k1, lam_q2, lam_k2, subln_g, rel_table, layer_idx):
    B, S, _ = h.shape
    H, dh = DA_HEADS, DA_HEAD_DIM
    q, k, v = jnp.split(h @ w_in, 3, axis=-1)
    q = rmsnorm(q.reshape(B, S, H, 2, dh), q_gain)
    k = rmsnorm(k.reshape(B, S, H, 2, dh), k_gain)
    q = q.transpose(3, 0, 2, 1, 4) * dh ** -0.5
    k = k.transpose(3, 0, 2, 1, 4)
    v = v.reshape(B, S, H, 2 * dh).transpose(0, 2, 1, 3)
    lam_init = 0.8 - 0.6 * math.exp(-0.3 * layer_idx)
    lam = (jnp.exp(jnp.sum(lam_q1 * lam_k1).astype(jnp.float32))
           - jnp.exp(jnp.sum(lam_q2 * lam_k2).astype(jnp.float32)) + lam_init)
    kpos = jnp.arange(S)

    def block(i):
        start = i * DA_QBLOCK
        qb = lax.dynamic_slice_in_dim(q, start, DA_QBLOCK, axis=3)
        qpos = start + jnp.arange(DA_QBLOCK)
        bias = rel_table[t5_bucket(kpos[None, :] - qpos[:, None])]
        bias = bias.transpose(2, 0, 1).astype(jnp.float32)
        s = jnp.einsum('mbhqd,mbhkd->mbhqk', qb, k).astype(jnp.float32) + bias
        a = jax.nn.softmax(s, axis=-1)
        attn = a[0] - lam * a[1]
        return jnp.einsum('bhqk,bhkd->bhqd', attn.astype(v.dtype), v)

    o = lax.map(block, jnp.arange(S // DA_QBLOCK))
    o = o.transpose(1, 0, 3, 2, 4).reshape(B, S, H, 2 * dh)
    o = rmsnorm(o, subln_g) * (1.0 - lam_init)
    return o.reshape(B, S, DA_WIDTH) @ w_out


def conv_centred(x, w, b):
    pad = w.shape[0] // 2
    y = lax.conv_general_dilated(x, w[:, None, :], window_strides=(1,), padding=[(pad, pad)],
                                 dimension_numbers=('NWC', 'WIO', 'NWC'),
                                 feature_group_count=x.shape[-1])
    return y + b


def blockdiag(x, w):
    B, S, C = x.shape
    nb, blk, _ = w.shape
    return jnp.einsum('bsni,nio->bsno', x.reshape(B, S, nb, blk), w).reshape(B, S, C)


def mlstm_scan(q, k, v, i_pre, f_pre):
    B, S, H, dk = q.shape
    dv = v.shape[-1]
    L = ML_CHUNK
    NC = S // L
    f32 = jnp.float32

    def to_chunks(t):
        t = t.reshape((B, NC, L, H) + t.shape[3:])
        return jnp.moveaxis(t, (1, 3), (0, 2))

    qc = to_chunks(q.astype(f32))
    kc = to_chunks(k.astype(f32) * dk ** -0.5)
    vc = to_chunks(v.astype(f32))
    lfc = to_chunks(jax.nn.log_sigmoid(f_pre.astype(f32)))
    igc = to_chunks(i_pre.astype(f32))
    causal = jnp.tril(jnp.ones((L, L), dtype=bool))

    def step(carry, xs):
        C, n, m = carry
        qb, kb, vb, lf, ii = xs
        b = jnp.cumsum(lf, axis=-1)
        dmat = jnp.where(causal, b[..., :, None] - b[..., None, :] + ii[..., None, :], -jnp.inf)
        inter = b + m[..., None]
        m_t = jnp.maximum(inter, jnp.max(dmat, axis=-1))
        w_intra = jnp.exp(dmat - m_t[..., None])
        w_inter = jnp.exp(inter - m_t)
        s = jnp.einsum('bhtd,bhsd->bhts', qb, kb) * w_intra
        num = (w_inter[..., None] * jnp.einsum('bhtk,bhkv->bhtv', qb, C)
               + jnp.einsum('bhts,bhsv->bhtv', s, vb))
        den = w_inter * jnp.einsum('bhtk,bhk->bht', qb, n) + jnp.sum(s, axis=-1)
        h = num / jnp.maximum(jnp.abs(den), jnp.exp(-m_t))[..., None]
        bL = b[..., -1]
        g = bL[..., None] - b + ii
        m_new = jnp.maximum(bL + m, jnp.max(g, axis=-1))
        decay = jnp.exp(bL + m - m_new)
        kw = kb * jnp.exp(g - m_new[..., None])[..., None]
        C_new = decay[..., None, None] * C + jnp.einsum('bhsk,bhsv->bhkv', kw, vb)
        n_new = decay[..., None] * n + jnp.sum(kw, axis=2)
        return (C_new, n_new, m_new), h

    init = (jnp.zeros((B, H, dk, dv), f32), jnp.zeros((B, H, dk), f32), jnp.zeros((B, H), f32))
    _, hs = lax.scan(step, init, (qc, kc, vc, lfc, igc))
    return hs.transpose(1, 0, 3, 2, 4).reshape(B, S, H, dv)


def mlstm_mixer(h, w_in, conv_w, conv_b, wq, wk, wv, gate_w, gate_b, outnorm_g, skip, w_out):
    B, S, _ = h.shape
    H, dv = ML_HEADS, ML_HEAD_DIM
    xm, z = jnp.split(h @ w_in, 2, axis=-1)
    xc = jax.nn.silu(conv_centred(xm, conv_w, conv_b))
    q = blockdiag(xc, wq)
    k = blockdiag(xc, wk)
    v = blockdiag(xm, wv)
    pre = (jnp.einsum('bsc,dcg->dbsg', q, gate_w[:, 0]) + jnp.einsum('bsc,dcg->dbsg', k, gate_w[:, 1])
           + jnp.einsum('bsc,dcg->dbsg', v, gate_w[:, 2]) + gate_b[:, None, None, :])
    heads = lambda t: t.reshape(B, S, H, dv)
    flip = lambda t: jnp.flip(t, axis=1)
    qh, kh, vh = heads(q), heads(k), heads(v)
    h_fwd = mlstm_scan(qh, kh, vh, pre[0, ..., :H], pre[0, ..., H:])
    h_bwd = flip(mlstm_scan(flip(qh), flip(kh), flip(vh), flip(pre[1, ..., :H]), flip(pre[1, ..., H:])))
    hh = rmsnorm((h_fwd + h_bwd).astype(h.dtype), outnorm_g)
    y = (hh.reshape(B, S, ML_INNER) + skip * xc) * jax.nn.silu(z)
    return y @ w_out


def hier_moe(h, w_group, w_router, w1, w3, w2):
    B, S, D = h.shape
    t = h.reshape(B * S, D)
    g_logits = (t @ w_group).astype(jnp.float32)
    g_prob = jax.nn.softmax(g_logits, axis=-1)
    g_sel = jnp.argmax(g_logits, axis=-1)
    p_g = jnp.take_along_axis(g_prob, g_sel[:, None], axis=-1)
    e_logits = (t @ w_router).astype(jnp.float32).reshape(-1, N_GROUPS, EXPERTS_PER_GROUP)
    e_logits = jnp.take_along_axis(e_logits, g_sel[:, None, None], axis=1)[:, 0]
    top_p, top_i = lax.top_k(jax.nn.softmax(e_logits, axis=-1), TOP_K_IN_GROUP)
    weights = p_g * top_p / jnp.sum(top_p, axis=-1, keepdims=True)
    expert_id = g_sel[:, None] * EXPERTS_PER_GROUP + top_i
    gates = jnp.sum(jax.nn.one_hot(expert_id, N_EXPERTS, dtype=jnp.float32) * weights[..., None], axis=1)

    def expert(acc, xs):
        a, b_, c_, gcol = xs
        y = (jax.nn.silu(t @ a) * (t @ b_)) @ c_
        return acc + gcol[:, None].astype(t.dtype) * y, None

    y, _ = lax.scan(expert, jnp.zeros_like(t), (w1, w3, w2, gates.T))
    return y.reshape(B, S, D)


def setup_inputs(seed: int = 0) -> dict:
    key = jax.random.key(seed)
    ks = iter(jax.random.split(key, 48))
    nrm = lambda shape, scale: scale * jax.random.normal(next(ks), shape, jnp.float32)
    NA, NM = N_ATTN_LAYERS, N_MLSTM_LAYERS
    H, dh = DA_HEADS, DA_HEAD_DIM
    MH, dv = ML_HEADS, ML_HEAD_DIM
    nblk = ML_INNER // ML_QKV_BLOCK
    f_bias = jnp.linspace(3.0, 6.0, MH, dtype=jnp.float32)
    ml_gate_b = jnp.concatenate([nrm((NM, 2, MH), 0.1), f_bias + nrm((NM, 2, MH), 0.1)], axis=-1)
    return {
        'x': nrm((BATCH, SEQ, D_MODEL), 1.0),
        'c': nrm((BATCH, D_MODEL), 1.0),
        'rel_table': nrm((N_BUCKETS, H), 0.5),
        'ada_w': nrm((DEPTH, D_MODEL, 6 * D_MODEL), 0.5 * D_MODEL ** -0.5),
        'ada_b': nrm((DEPTH, 6 * D_MODEL), 0.02),
        'norm_mix_g': 1.0 + nrm((DEPTH, D_MODEL), 0.02),
        'norm_ffn_g': 1.0 + nrm((DEPTH, D_MODEL), 0.02),
        'da_w_in': nrm((NA, D_MODEL, 3 * DA_WIDTH), D_MODEL ** -0.5),
        'da_w_out': nrm((NA, DA_WIDTH, D_MODEL), DA_WIDTH ** -0.5),
        'da_q_gain': 1.0 + nrm((NA, dh), 0.02),
        'da_k_gain': 1.0 + nrm((NA, dh), 0.02),
        'da_lam_q1': nrm((NA, dh), 0.1),
        'da_lam_k1': nrm((NA, dh), 0.1),
        'da_lam_q2': nrm((NA, dh), 0.1),
        'da_lam_k2': nrm((NA, dh), 0.1),
        'da_subln_g': 1.0 + nrm((NA, 2 * dh), 0.02),
        'ml_w_in': nrm((NM, D_MODEL, 2 * ML_INNER), D_MODEL ** -0.5),
        'ml_conv_w': nrm((NM, ML_CONV, ML_INNER), ML_CONV ** -0.5),
        'ml_conv_b': nrm((NM, ML_INNER), 0.01),
        'ml_wq': nrm((NM, nblk, ML_QKV_BLOCK, ML_QKV_BLOCK), ML_QKV_BLOCK ** -0.5),
        'ml_wk': nrm((NM, nblk, ML_QKV_BLOCK, ML_QKV_BLOCK), ML_QKV_BLOCK ** -0.5),
        'ml_wv': nrm((NM, nblk, ML_QKV_BLOCK, ML_QKV_BLOCK), ML_QKV_BLOCK ** -0.5),
        'ml_gate_w': nrm((NM, 2, 3, ML_INNER, 2 * MH), (3 * ML_INNER) ** -0.5),
        'ml_gate_b': ml_gate_b,
        'ml_outnorm_g': 1.0 + nrm((NM, MH, dv), 0.02),
        'ml_skip': 1.0 + nrm((NM, ML_INNER), 0.02),
        'ml_w_out': nrm((NM, ML_INNER, D_MODEL), ML_INNER ** -0.5),
        'moe_w_group': nrm((DEPTH, D_MODEL, N_GROUPS), D_MODEL ** -0.5),
        'moe_w_router': nrm((DEPTH, D_MODEL, N_EXPERTS), D_MODEL ** -0.5),
        'moe_w1': nrm((DEPTH, N_EXPERTS, D_MODEL, D_EXPERT), D_MODEL ** -0.5),
        'moe_w3': nrm((DEPTH, N_EXPERTS, D_MODEL, D_EXPERT), D_MODEL ** -0.5),
        'moe_w2': nrm((DEPTH, N_EXPERTS, D_EXPERT, D_MODEL), D_EXPERT ** -0.5),
    }


def reference(x, c, rel_table, ada_w, ada_b, norm_mix_g, norm_ffn_g,
              da_w_in, da_w_out, da_q_gain, da_k_gain, da_lam_q1, da_lam_k1, da_lam_q2, da_lam_k2, da_subln_g,
              ml_w_in, ml_conv_w, ml_conv_b, ml_wq, ml_wk, ml_wv, ml_gate_w, ml_gate_b, ml_outnorm_g, ml_skip, ml_w_out,
              moe_w_group, moe_w_router, moe_w1, moe_w3, moe_w2):
    c_act = jax.nn.silu(c)
    for i in range(DEPTH):
        mod = (c_act @ ada_w[i] + ada_b[i])[:, None, :]
        sh1, sc1, g1, sh2, sc2, g2 = jnp.split(mod, 6, axis=-1)
        hm = rmsnorm(x, norm_mix_g[i]) * (1.0 + sc1) + sh1
        j = i // N_MIXERS
        if i % N_MIXERS == 0:
            y = diff_attention(hm, da_w_in[j], da_w_out[j], da_q_gain[j], da_k_gain[j],
                               da_lam_q1[j], da_lam_k1[j], da_lam_q2[j], da_lam_k2[j], da_subln_g[j],
                               rel_table, i)
        else:
            y = mlstm_mixer(hm, ml_w_in[j], ml_conv_w[j], ml_conv_b[j], ml_wq[j], ml_wk[j], ml_wv[j],
                            ml_gate_w[j], ml_gate_b[j], ml_outnorm_g[j], ml_skip[j], ml_w_out[j])
        x = x + g1 * y
        hf = rmsnorm(x, norm_ffn_g[i]) * (1.0 + sc2) + sh2
        x = x + g2 * hier_moe(hf, moe_w_group[i], moe_w_router[i], moe_w1[i], moe_w3[i], moe_w2[i])
    return x
```

```cpp
#include <hip/hip_runtime.h>
#include <cstdio>
#include <cstdint>

#ifndef MK_ONE_LAUNCH
#define MK_ONE_LAUNCH 0
#endif

#define GAS __attribute__((address_space(1)))
#define LAS __attribute__((address_space(3)))
typedef unsigned short bf16;
typedef short bf16x8 __attribute__((ext_vector_type(8)));
typedef float f32x4 __attribute__((ext_vector_type(4)));
typedef float f32x16 __attribute__((ext_vector_type(16)));
typedef float f32x2 __attribute__((ext_vector_type(2)));
typedef unsigned u32x4 __attribute__((ext_vector_type(4)));
typedef unsigned u32x2 __attribute__((ext_vector_type(2)));

constexpr int NB = 16, SEQ = 2048, DM = 1024, NT = NB * SEQ;
constexpr int DA_H = 8;
constexpr int ML_IN = 2048, ML_H = 4, ML_DH = 512;
constexpr int NEXP = 32, DEXP = 256;
constexpr float EPS = 1e-6f;
constexpr float LOG2E = 1.4426950408889634f;
constexpr int RB = 4;
constexpr int NROUND = NB / RB;
constexpr int RT = RB * SEQ;
constexpr int WLD = 2304;
constexpr int MAXSLOT = 2 * NT + NEXP * 256;

constexpr size_t MiB = 1u << 20;
constexpr size_t WS_CTL = 0, CTL_ZERO_BYTES = 1 * MiB;
constexpr size_t WS_MODS = 2 * MiB;
constexpr size_t WS_TAB2 = 3 * MiB;
constexpr size_t WS_SCAL = 3 * MiB + 128 * 1024;
constexpr size_t WS_GWT = 3 * MiB + 256 * 1024;
constexpr size_t WS_RE = 4 * MiB;
constexpr size_t WS_RW = 4 * MiB + 256 * 1024;
constexpr size_t WS_RP = 4 * MiB + 512 * 1024;
constexpr size_t WS_PRE = 5 * MiB;
constexpr size_t WS_FG = 5 * MiB + 512 * 1024;
constexpr size_t WS_DEN = 6 * MiB;
constexpr size_t WS_WINT = 8 * MiB;
constexpr size_t WS_WOT = 14 * MiB;
constexpr size_t WS_MLWINT = 16 * MiB;
constexpr size_t WS_MLWOUTT = 24 * MiB;
constexpr size_t WS_W13T = 28 * MiB;
constexpr size_t WS_W2T = 60 * MiB;
constexpr size_t WS_BIG = 76 * MiB;
constexpr size_t WS_HM = WS_BIG + 0 * MiB;
constexpr size_t WS_QK = WS_BIG + 64 * MiB;
constexpr size_t WS_VT = WS_BIG + 192 * MiB;
constexpr size_t WS_O = WS_BIG + 256 * MiB;
constexpr size_t WS_HF = WS_BIG + 0 * MiB;
constexpr size_t WS_HS = WS_BIG + 64 * MiB;
constexpr size_t WS_HH = WS_BIG + 208 * MiB;
constexpr size_t WS_YS = WS_BIG + 244 * MiB;
constexpr size_t WS_Y = WS_BIG + 0 * MiB;
constexpr size_t WS_W = WS_BIG + 128 * MiB;
constexpr size_t WS_HMR = WS_BIG + 128 * MiB;
constexpr size_t WS_XMH = WS_BIG + 272 * MiB;
constexpr size_t WS_XC = WS_BIG + 304 * MiB;
constexpr size_t WS_Q = WS_BIG + 336 * MiB;
constexpr size_t WS_K = WS_BIG + 368 * MiB;
constexpr size_t WS_VTR = WS_BIG + 400 * MiB;
constexpr size_t WS_END = WS_BIG + 432 * MiB;
static_assert(WS_END <= 512 * MiB, "ws map");
static_assert((size_t)MAXSLOT * 1024 * 2 <= 144 * MiB && (size_t)MAXSLOT * 256 * 2 <= 36 * MiB, "slot buffers");
constexpr int CW_CNT = 64;
constexpr int CW_BAR = 4096;

constexpr int RING_BYTES = 131072;
constexpr int MISC_OFF = RING_BYTES;
constexpr int LDS_BYTES = RING_BYTES + 16384;

__device__ __forceinline__ unsigned f2bf(float f) { unsigned u = __builtin_bit_cast(unsigned, f); return (u + 0x7fffu + ((u >> 16) & 1u)) >> 16; }
__device__ __forceinline__ unsigned pk2(float lo, float hi) { return f2bf(lo) | (f2bf(hi) << 16); }
__device__ __forceinline__ float bf2f(unsigned short b) { return __builtin_bit_cast(float, ((unsigned)b) << 16); }
__device__ __forceinline__ float bflo(unsigned w) { return __builtin_bit_cast(float, w << 16); }
__device__ __forceinline__ float bfhi(unsigned w) { return __builtin_bit_cast(float, w & 0xffff0000u); }
__device__ __forceinline__ float wave_sum(float v) {
#pragma unroll
    for (int o = 1; o < 64; o <<= 1) v += __shfl_xor(v, o);
    return v;
}
__device__ __forceinline__ float silu_f(float v) { return v / (1.0f + __expf(-v)); }
#define LDS_WAIT() asm volatile("s_waitcnt lgkmcnt(0)" ::: "memory")
#define VM_WAIT() asm volatile("s_waitcnt vmcnt(0)" ::: "memory")
__device__ __forceinline__ int opaque_v(int x) { asm volatile("" : "+v"(x)); return x; }
__device__ __forceinline__ int lane_id() { return (int)__builtin_amdgcn_mbcnt_hi(~0u, __builtin_amdgcn_mbcnt_lo(~0u, 0u)); }

namespace pg8 {
constexpr int BM = 256, BK = 64, HALF = 128, HTB = HALF * BK * 2, STAGE_BYTES = 8 * HTB;
static_assert(STAGE_BYTES == RING_BYTES, "stage region");
__host__ __device__ __forceinline__ int lds_byte(int r, int c) { const int st = (r >> 4) * 2 + (c >> 5), rr = r & 15, cc = c & 31, ob = rr * 64 + cc * 2; return st * 1024 + (ob ^ (((ob >> 9) & 1) << 5)); }
__host__ __device__ __forceinline__ void stage_rc(int b, int& R, int& C) { const int st = b / 1024, sb = b % 1024, swz = sb ^ (((sb >> 9) & 1) << 5); R = (st >> 1) * 16 + swz / 64; C = (st & 1) * 32 + (swz % 64) / 2; }
__host__ __device__ __forceinline__ int perm32(int rho) { const int n = rho >> 4, i = rho & 15; return 8 * (i >> 2) + 4 * n + (i & 3); }

struct Unit { const char* A; const char* B; int r0, c0, a0, a1, nt, flags; };

__device__ __forceinline__ unsigned cvt_pk_bf16(float lo, float hi) { unsigned r; asm volatile("v_cvt_pk_bf16_f32 %0, %1, %2" : "=v"(r) : "v"(lo), "v"(hi)); return r; }

template <class Epi, class Sched, bool ALIGN_EPI>
__device__ __forceinline__ void gemm_phase(LAS unsigned char* lds, const int tid, const int lda, const int ldb, const Sched& S, const Epi& E) {
    const int wid = __builtin_amdgcn_readfirstlane(tid >> 6), lane = tid & 63, wr = wid >> 2, wc = wid & 3, fr = lane & 15, fq = lane >> 4;
    unsigned voffA[2], voffB[2];
#pragma unroll
    for (int i = 0; i < 2; ++i) { int R, C; stage_rc(tid * 16 + i * 8192, R, C); const int Rb = Epi::PERM ? ((R & ~31) + perm32(R & 31)) : R;
        voffA[i] = (unsigned)(R * lda + C) * 2u; voffB[i] = (unsigned)(Rb * ldb + C) * 2u; }
    const size_t kstep = (size_t)(BK * 2);
    const size_t hstepA = (size_t)HALF * lda * 2, hstepB = (size_t)HALF * ldb * 2;
    const unsigned ldsw = (unsigned)wid * 1024u;
    const int aoff = lds_byte(wr * 64 + fr, fq * 8), boff = lds_byte(wc * 32 + fr, fq * 8);
#define PG8_SA(b, h) (((b) * 2 + (h)) * HTB)
#define PG8_SB(b, h) ((4 + (b) * 2 + (h)) * HTB)
#define PG8_STAGE(bufoff, gbase, voff) do { _Pragma("unroll") for (int _i = 0; _i < 2; ++_i) \
        __builtin_amdgcn_global_load_lds((const unsigned*)((const char*)(gbase) + (voff)[_i]), (LAS unsigned*)(lds + (bufoff) + ldsw + _i * 8192), 16, 0, 0); } while (0)
#define PG8_LDA(dst, b, h) do { _Pragma("unroll") for (int m = 0; m < 4; ++m) _Pragma("unroll") for (int k = 0; k < 2; ++k) dst[m][k] = *(const LAS bf16x8*)(lds + PG8_SA(b, h) + aoff + m * 2048 + k * 1024); } while (0)
#define PG8_LDB(dst, b, h) do { _Pragma("unroll") for (int n = 0; n < 2; ++n) _Pragma("unroll") for (int k = 0; k < 2; ++k) dst[n][k] = *(const LAS bf16x8*)(lds + PG8_SB(b, h) + boff + n * 2048 + k * 1024); } while (0)
#define PG8_MMA(ai, bj, At, Bt) do { __builtin_amdgcn_s_setprio(1); _Pragma("unroll") for (int m = 0; m < 4; ++m) _Pragma("unroll") for (int n = 0; n < 2; ++n) _Pragma("unroll") for (int k = 0; k < 2; ++k) \
        acc[ai][bj][m][n] = __builtin_amdgcn_mfma_f32_16x16x32_bf16(Bt[n][k], At[m][k], acc[ai][bj][m][n], 0, 0, 0); __builtin_amdgcn_s_setprio(0); } while (0)
#define PG8_WAIT_V(n) asm volatile("s_waitcnt vmcnt(" #n ")" ::: "memory")
#define PG8_WAIT_L(n) asm volatile("s_waitcnt lgkmcnt(" #n ")" ::: "memory")
#define PG8_BAR __builtin_amdgcn_s_barrier()
#define PG8_SCHED __builtin_amdgcn_sched_barrier(0)
    Unit cur, nxt; int ui = 0;
    if (!S.next(0, cur)) return;
    f32x4 acc[2][2][4][2];
#pragma unroll
    for (int a = 0; a < 2; ++a)
#pragma unroll
        for (int b = 0; b < 2; ++b)
#pragma unroll
            for (int m = 0; m < 4; ++m)
#pragma unroll
                for (int n = 0; n < 2; ++n) acc[a][b][m][n] = (f32x4){0.f, 0.f, 0.f, 0.f};
    bf16x8 At[4][2], B0[2][2], B1[2][2];
    const char* cA = cur.A; const char* cB = cur.B;
    {
        const char* b0 = cB + (size_t)S.kb(cur, 0) * kstep; const char* b1 = cB + (size_t)S.kb(cur, 1) * kstep;
        PG8_STAGE(PG8_SB(0, 0), b0, voffB); PG8_STAGE(PG8_SB(0, 1), b0 + hstepB, voffB); PG8_STAGE(PG8_SA(0, 0), cA, voffA); PG8_STAGE(PG8_SA(0, 1), cA + hstepA, voffA);
        if (wr == 1) PG8_BAR;
        PG8_WAIT_V(2); PG8_BAR;
        PG8_STAGE(PG8_SB(1, 0), b1, voffB); PG8_STAGE(PG8_SA(1, 0), cA + kstep, voffA); PG8_STAGE(PG8_SB(1, 1), b1 + hstepB, voffB);
        PG8_WAIT_V(6); PG8_BAR;
    }
    for (;;) {
        const bool has_next = S.next(ui + 1, nxt);
        const Unit& nu = has_next ? nxt : cur;
        const char* nA = nu.A; const char* nB = nu.B;
        const int nt = cur.nt;
        for (int t = 0; t < nt; t += 2) {
            const bool last = (t == nt - 2);
            const char* a1 = cA + (size_t)(t + 1) * kstep;
            const char* a2 = last ? nA : cA + (size_t)(t + 2) * kstep;
            const char* a3 = a2 + kstep;
            const char* b2 = last ? nB + (size_t)S.kb(nu, 0) * kstep : cB + (size_t)S.kb(cur, t + 2) * kstep;
            const char* b3 = last ? nB + (size_t)S.kb(nu, 1) * kstep : cB + (size_t)S.kb(cur, t + 3) * kstep;
            PG8_LDB(B0, 0, 0); PG8_LDB(B1, 0, 1); PG8_SCHED; PG8_LDA(At, 0, 0); PG8_STAGE(PG8_SA(1, 1), a1 + hstepA, voffA);
            PG8_WAIT_V(8); PG8_WAIT_L(0); PG8_BAR; PG8_MMA(0, 0, At, B0); PG8_MMA(0, 1, At, B1); PG8_BAR; PG8_SCHED;
            PG8_LDA(At, 0, 1); PG8_STAGE(PG8_SB(0, 0), b2, voffB); PG8_STAGE(PG8_SB(0, 1), b2 + hstepB, voffB); PG8_STAGE(PG8_SA(0, 0), a2, voffA);
            PG8_WAIT_V(8); PG8_WAIT_L(0); PG8_BAR; PG8_MMA(1, 0, At, B0); PG8_MMA(1, 1, At, B1); PG8_BAR; PG8_SCHED;
            PG8_LDB(B0, 1, 0); PG8_LDB(B1, 1, 1); PG8_SCHED; PG8_LDA(At, 1, 0); PG8_STAGE(PG8_SA(0, 1), a2 + hstepA, voffA);
            PG8_WAIT_V(8); PG8_WAIT_L(0); PG8_BAR; PG8_MMA(0, 0, At, B0); PG8_MMA(0, 1, At, B1); PG8_BAR; PG8_SCHED;
            PG8_LDA(At, 1, 1); PG8_STAGE(PG8_SB(1, 0), b3, voffB); PG8_STAGE(PG8_SB(1, 1), b3 + hstepB, voffB); PG8_STAGE(PG8_SA(1, 0), a3, voffA);
            PG8_WAIT_V(8); PG8_WAIT_L(0); PG8_BAR; PG8_MMA(1, 0, At, B0); PG8_MMA(1, 1, At, B1); PG8_BAR; PG8_SCHED;
        }
        if constexpr (ALIGN_EPI) { if (wr == 0) PG8_BAR; }
        E(acc, cur, wr, wc, fr, fq);
        if (!has_next) break;
#pragma unroll
        for (int a = 0; a < 2; ++a)
#pragma unroll
            for (int b = 0; b < 2; ++b)
#pragma unroll
                for (int m = 0; m < 4; ++m)
#pragma unroll
                    for (int n = 0; n < 2; ++n) acc[a][b][m][n] = (f32x4){0.f, 0.f, 0.f, 0.f};
        cur = nxt; cA = nA; cB = nB; ++ui;
        if constexpr (ALIGN_EPI) { if (wr == 1) PG8_BAR; }
    }
    PG8_WAIT_V(0);
    if constexpr (!ALIGN_EPI) { if (wr == 0) PG8_BAR; }
    PG8_BAR;
#undef PG8_SA
#undef PG8_SB
#undef PG8_STAGE
#undef PG8_LDA
#undef PG8_LDB
#undef PG8_MMA
#undef PG8_WAIT_V
#undef PG8_WAIT_L
#undef PG8_BAR
#undef PG8_SCHED
}

struct PlainOrder {
    const char* A; const char* B; int lda, ldb, nM, nN, G, c, nt;
    __device__ __forceinline__ bool next(int i, Unit& u) const {
        const int L = i * G + c; if (L >= nM * nN) return false;
        const int pm = L / nN, pn = L - pm * nN;
        u.A = A + (size_t)pm * 256 * lda * 2; u.B = B + (size_t)pn * 256 * ldb * 2; u.r0 = pm * 256; u.c0 = pn * 256; u.a0 = 0; u.a1 = 0; u.nt = nt; u.flags = 3; return true;
    }
    __device__ __forceinline__ int kb(const Unit&, int t) const { return t; }
};
struct EpiBf16 {
    static constexpr bool PERM = true;
    bf16* O; int ldc; int split_cols; bf16* O2; int ldc2;
    __device__ __forceinline__ void operator()(const f32x4 (&acc)[2][2][4][2], const Unit& u, int wr, int wc, int fr_, int fq_) const {
        (void)fr_; (void)fq_; const int ln_ = opaque_v(lane_id()); const int fr = ln_ & 15, fq = ln_ >> 4;
        bf16* base = O; int ld = ldc; int colt = u.c0;
        if (split_cols > 0 && colt >= split_cols) { base = O2; ld = ldc2; colt -= split_cols; }
        const int row0 = u.r0 + wr * 64 + fr, col0 = colt + wc * 32 + 8 * fq;
#pragma unroll
        for (int ai = 0; ai < 2; ++ai)
#pragma unroll
            for (int m = 0; m < 4; ++m) { bf16* rowp = base + (size_t)(row0 + ai * HALF + m * 16) * ld + col0;
#pragma unroll
                for (int bj = 0; bj < 2; ++bj) { const f32x4 v0 = acc[ai][bj][m][0], v1 = acc[ai][bj][m][1];
                    u32x4 w; w.x = cvt_pk_bf16(v0[0], v0[1]); w.y = cvt_pk_bf16(v0[2], v0[3]); w.z = cvt_pk_bf16(v1[0], v1[1]); w.w = cvt_pk_bf16(v1[2], v1[3]);
                    *(u32x4*)(rowp + bj * HALF) = w; } }
    }
};
struct EpiResid {
    static constexpr bool PERM = false;
    const float* xin; float* out; const float* gate;
    __device__ __forceinline__ void operator()(const f32x4 (&acc)[2][2][4][2], const Unit& u, int wr, int wc, int fr_, int fq_) const {
        (void)fr_; (void)fq_; const int ln_ = opaque_v(lane_id()); const int fr = ln_ & 15, fq = ln_ >> 4;
        const int row0 = u.r0 + wr * 64 + fr, col0 = u.c0 + wc * 32 + 4 * fq;
        const float* g = gate + (size_t)(u.r0 / SEQ) * 6144 + col0;
        f32x4 gv[2][2];
#pragma unroll
        for (int bj = 0; bj < 2; ++bj)
#pragma unroll
            for (int n = 0; n < 2; ++n) gv[bj][n] = *(const f32x4*)(g + bj * HALF + n * 16);
#pragma unroll
        for (int ai = 0; ai < 2; ++ai)
#pragma unroll
            for (int m = 0; m < 4; ++m) { const size_t off = (size_t)(row0 + ai * HALF + m * 16) * DM + col0;
#pragma unroll
                for (int bj = 0; bj < 2; ++bj)
#pragma unroll
                    for (int n = 0; n < 2; ++n) { const f32x4 xv = *(const f32x4*)(xin + off + bj * HALF + n * 16);
                        *(f32x4*)(out + off + bj * HALF + n * 16) = xv + gv[bj][n] * acc[ai][bj][m][n]; }
                if (m & 1) asm volatile("" ::: "memory"); }
    }
};
}

#define XB_TMO      128
#define XB_XCNT(j)  (256  + 64 * (j))
#define XB_XSUB(j)  (1280 + 64 * (j))
#define XB_XGEN(j)  (2304 + 64 * (j))
#define XB_TOP      3328
#define XB_TOPGEN   3392
#define XCD_BAR_WORDS 3456
#define XB_SPIN_CAP (1u << 18)
__device__ __forceinline__ unsigned xb_ld(unsigned* p)              { return __hip_atomic_load(p, __ATOMIC_RELAXED, __HIP_MEMORY_SCOPE_AGENT); }
__device__ __forceinline__ unsigned xb_add(unsigned* p, unsigned v) { return __hip_atomic_fetch_add(p, v, __ATOMIC_RELAXED, __HIP_MEMORY_SCOPE_AGENT); }
__device__ __forceinline__ unsigned xb_xcc_id() { return (unsigned)__builtin_amdgcn_s_getreg((3 << 11) | 20) & 0xFu; }
#define XB_SPIN(cond, bar) do { unsigned _sp = 0; while (cond) { __builtin_amdgcn_s_sleep(1); \
    if ((++_sp & 255u) == 0u) { if (xb_ld(&(bar)[XB_TMO])) break; if (_sp > XB_SPIN_CAP) { atomicAdd(&(bar)[XB_TMO], 1u); break; } } } } while (0)
struct XcdBarrier { unsigned* bar; unsigned x; volatile LAS unsigned* st; };
__device__ __forceinline__ XcdBarrier xcd_barrier_post(unsigned* bar, volatile LAS unsigned* st) {
    XcdBarrier b; b.bar = bar; b.x = xb_xcc_id(); b.st = st;
    if (threadIdx.x == 0) (void)xb_add(&bar[XB_XCNT(b.x)], 1u);
    return b;
}
__device__ __forceinline__ void xcd_barrier_complete(unsigned* bar, unsigned x, unsigned& nloc, unsigned& nx) {
    const unsigned G = gridDim.x * gridDim.y * gridDim.z;
    unsigned sum, cnt, mine, sp = 0u;
    for (;;) {
        sum = 0u; cnt = 0u; mine = 0u;
#pragma unroll
        for (unsigned j = 0; j < 16; ++j) { const unsigned c = xb_ld(&bar[XB_XCNT(j)]); sum += c; cnt += (c > 0u) ? 1u : 0u; mine = (j == x) ? c : mine; }
        if (sum == G) break;
        __builtin_amdgcn_s_sleep(1);
        if ((++sp & 255u) == 0u) { if (xb_ld(&bar[XB_TMO])) break; if (sp > XB_SPIN_CAP) { atomicAdd(&bar[XB_TMO], 1u); break; } }
    }
    nloc = mine > 0u ? mine : 1u; nx = cnt > 0u ? cnt : 1u;
}
__device__ __forceinline__ void xcd_barrier(const XcdBarrier& b) {
    asm volatile("s_waitcnt vmcnt(0)" ::: "memory");
    __syncthreads();
    if (threadIdx.x == 0) {
        unsigned* bar = b.bar;
        __builtin_amdgcn_s_waitcnt(0);
        unsigned nloc = b.st[0], nx = b.st[1];
        if (nloc == 0u) { xcd_barrier_complete(bar, b.x, nloc, nx); b.st[0] = nloc; b.st[1] = nx; }
        const unsigned old = xb_add(&bar[XB_XSUB(b.x)], 1u);
        const unsigned gen = old / nloc;
        if (old + 1u == (gen + 1u) * nloc) {
            __builtin_amdgcn_fence(__ATOMIC_RELEASE, "agent");
            asm volatile("s_waitcnt vmcnt(0)" ::: "memory");
            const unsigned og = xb_add(&bar[XB_TOP], 1u);
            const unsigned tg = og / nx;
            if (og + 1u == (tg + 1u) * nx) xb_add(&bar[XB_TOPGEN], 1u);
            else XB_SPIN(xb_ld(&bar[XB_TOPGEN]) == tg, bar);
            __builtin_amdgcn_fence(__ATOMIC_ACQUIRE, "agent");
            xb_add(&bar[XB_XGEN(b.x)], 1u);
            asm volatile("s_waitcnt vmcnt(0)" ::: "memory");
        } else {
            XB_SPIN(xb_ld(&bar[XB_XGEN(b.x)]) == gen, bar);
            __builtin_amdgcn_fence(__ATOMIC_ACQUIRE, "agent");
            asm volatile("s_waitcnt vmcnt(0)" ::: "memory");
        }
    }
    __syncthreads();
}

struct Args { const float* in[32]; float* out; unsigned char* ws; int ph_lo, ph_hi; };
enum { IN_X = 0, IN_C, IN_REL, IN_ADAW, IN_ADAB, IN_NMG, IN_NFG, IN_DAWIN, IN_DAWOUT, IN_QG, IN_KG, IN_LQ1, IN_LK1, IN_LQ2, IN_LK2, IN_SUBLN,
       IN_MLWIN, IN_CONVW, IN_CONVB, IN_WQ, IN_WK, IN_WV, IN_GATEW, IN_GATEB, IN_ONG, IN_SKIP, IN_MLWOUT, IN_WGRP, IN_WRT, IN_W1, IN_W3, IN_W2 };

struct Ctx {
    const Args* a; unsigned char* ws; LAS unsigned char* lds; int tid, lane, wave, G, vcu;
    __device__ __forceinline__ const float* in(int i) const { return a->in[i]; }
    template <class Tp> __device__ __forceinline__ Tp* w(size_t off) const { return (Tp*)(ws + off); }
    __device__ __forceinline__ const float* mods(int layer, int which) const { return (const float*)(ws + WS_MODS) + (size_t)layer * 16 * 6144 + which * 1024; }
};

__device__ __forceinline__ Ctx fresh(const Ctx& C) {
    Ctx P = C; int t = C.tid; asm volatile("" : "+v"(t)); P.tid = t; P.lane = t & 63; P.wave = __builtin_amdgcn_readfirstlane(t >> 6);
    unsigned char* w = C.ws; asm volatile("" : "+s"(w)); P.ws = w; int g = __builtin_amdgcn_readfirstlane(C.G), v = __builtin_amdgcn_readfirstlane(C.vcu); asm volatile("" : "+s"(g), "+s"(v)); P.G = g; P.vcu = v;
    return P;
}
__device__ __forceinline__ void transpose_item(const float* W, int K, int N, bf16* WT, int ldt, int dst_row0, LAS float* scr, int kb, int nb, int lane) {
    const int k0 = 64 * kb, n0 = 32 * nb;
#pragma unroll 8
    for (int i = 0; i < 32; ++i) { const int kk = 2 * i + (lane >> 5); scr[kk * 33 + (lane & 31)] = W[(size_t)(k0 + kk) * N + n0 + (lane & 31)]; }
    LDS_WAIT(); asm volatile("" ::: "memory");
    const int c = lane & 7;
#pragma unroll
    for (int j = 0; j < 4; ++j) { const int n = (lane >> 3) + 8 * j; const LAS float* s = scr + (8 * c) * 33 + n;
        u32x4 o; o.x = pk2(s[0 * 33], s[1 * 33]); o.y = pk2(s[2 * 33], s[3 * 33]); o.z = pk2(s[4 * 33], s[5 * 33]); o.w = pk2(s[6 * 33], s[7 * 33]);
        *(u32x4*)(WT + (size_t)(dst_row0 + n) * ldt + k0 + 8 * c) = o; }
    LDS_WAIT(); asm volatile("" ::: "memory");
}
__device__ __forceinline__ void moe_weight_items(const Ctx& C, int layer, LAS float* scr) {
    const int gw = C.vcu * 8 + C.wave, NGW = C.G * 8;
    const float* w1 = C.in(IN_W1) + (size_t)layer * NEXP * DM * DEXP; const float* w3 = C.in(IN_W3) + (size_t)layer * NEXP * DM * DEXP; const float* w2 = C.in(IN_W2) + (size_t)layer * NEXP * DEXP * DM;
    bf16* W13T = C.w<bf16>(WS_W13T); bf16* W2T = C.w<bf16>(WS_W2T);
    constexpr int I13 = 16 * 8, I2 = 4 * 32;
    for (int it = gw; it < NEXP * (2 * I13 + I2); it += NGW) {
        const int e = it / (2 * I13 + I2); int r = it - e * (2 * I13 + I2);
        if (r < 2 * I13) { const int which = r / I13; r -= which * I13; const int kb = r / 8, nb = r % 8; const int n0 = 32 * nb;
            const int dst = (n0 / 128) * 256 + which * 128 + (n0 % 128);
            transpose_item((which ? w3 : w1) + (size_t)e * DM * DEXP, DM, DEXP, W13T + (size_t)e * 512 * DM, DM, dst, scr, kb, nb, C.lane); }
        else { r -= 2 * I13; const int kb = r / 32, nb = r % 32;
            transpose_item(w2 + (size_t)e * DEXP * DM, DEXP, DM, W2T + (size_t)e * DM * DEXP, DEXP, 32 * nb, scr, kb, nb, C.lane); }
    }
}
__device__ __forceinline__ void plain_weight_items(const Ctx& C, const float* W, int K, int N, bf16* WT, LAS float* scr) {
    const int gw = C.vcu * 8 + C.wave, NGW = C.G * 8; const int nblk = N / 32;
    for (int it = gw; it < (K / 64) * nblk; it += NGW) { const int kb = it / nblk, nb = it % nblk; transpose_item(W, K, N, WT, K, 32 * nb, scr, kb, nb, C.lane); }
}
__device__ __forceinline__ int t5_bucket(int rel) {
    const int n = rel < 0 ? -rel : rel; int b;
    if (n < 8) b = n; else b = 8 + (n >= 12) + (n >= 16) + (n >= 23) + (n >= 32) + (n >= 46) + (n >= 64) + (n >= 91);
    return b + (rel > 0 ? 16 : 0);
}
__device__ __forceinline__ void p_prologue(const Ctx& C) {
    {
        LAS float* cact = (LAS float*)C.lds;
        LAS float* red = (LAS float*)(C.lds + 65536);
        const float* c = C.in(IN_C);
        for (int i = C.tid; i < 16 * 1024; i += 512) cact[i] = silu_f(c[i]);
        __syncthreads();
        for (int task = C.vcu; task < 192; task += C.G) {
            const int layer = task / 96, n0 = (task % 96) * 64, nl = C.tid & 63, kc = C.tid >> 6;
            const float* W = C.in(IN_ADAW) + (size_t)layer * DM * 6144 + n0 + nl;
            float acc[16];
#pragma unroll
            for (int b = 0; b < 16; ++b) acc[b] = 0.f;
            for (int k = kc * 128; k < kc * 128 + 128; ++k) { const float wv = W[(size_t)k * 6144];
#pragma unroll
                for (int b = 0; b < 16; ++b) acc[b] += cact[b * 1024 + k] * wv; }
#pragma unroll
            for (int b = 0; b < 16; ++b) red[(kc * 16 + b) * 64 + nl] = acc[b];
            __syncthreads();
            for (int o = C.tid; o < 16 * 64; o += 512) { const int b = o >> 6, n = o & 63; float s = 0.f;
#pragma unroll
                for (int q = 0; q < 8; ++q) s += red[(q * 16 + b) * 64 + n];
                C.w<float>(WS_MODS)[(size_t)layer * 16 * 6144 + (size_t)b * 6144 + n0 + n] = s + C.in(IN_ADAB)[layer * 6144 + n0 + n]; }
            __syncthreads();
        }
    }
    {
        const int gt = C.vcu * 512 + C.tid, NGT = C.G * 512;
        float mq = 0.f, mk = 0.f;
        for (int i = 0; i < 64; ++i) { mq = fmaxf(mq, fabsf(C.in(IN_QG)[i])); mk = fmaxf(mk, fabsf(C.in(IN_KG)[i])); }
        for (int i = gt; i < 8 * 4096; i += NGT) { const int h = i >> 12, idx = i & 4095; if (idx < 4095) {
            float mb = -1e30f; for (int b = 0; b < 32; ++b) mb = fmaxf(mb, C.in(IN_REL)[b * 8 + h]);
            const float cshift = 8.0f * mq * mk + mb;
            C.w<float>(WS_TAB2)[i] = (C.in(IN_REL)[t5_bucket(idx - 2047) * 8 + h] - cshift) * LOG2E; } else C.w<float>(WS_TAB2)[i] = 0.f; }
        if (gt == 0) { float s1 = 0.f, s2 = 0.f; for (int i = 0; i < 64; ++i) { s1 += C.in(IN_LQ1)[i] * C.in(IN_LK1)[i]; s2 += C.in(IN_LQ2)[i] * C.in(IN_LK2)[i]; }
            C.w<float>(WS_SCAL)[0] = __expf(s1) - __expf(s2) + 0.2f; }
        for (int i = gt; i < 16 * 6144; i += NGT) { const int n = i / 6144, k = i % 6144, d = n >> 3, g = n & 7, m = k / 2048, c = k % 2048;
            C.w<bf16>(WS_GWT)[i] = (bf16)f2bf(C.in(IN_GATEW)[(((size_t)d * 3 + m) * 2048 + c) * 8 + g]); }
    }
    LAS float* scr = (LAS float*)(C.lds + C.wave * 16384);
    plain_weight_items(C, C.in(IN_DAWIN), DM, 3 * DM, C.w<bf16>(WS_WINT), scr);
    plain_weight_items(C, C.in(IN_DAWOUT), DM, DM, C.w<bf16>(WS_WOT), scr);
    plain_weight_items(C, C.in(IN_MLWIN), DM, 2 * ML_IN, C.w<bf16>(WS_MLWINT), scr);
    plain_weight_items(C, C.in(IN_MLWOUT), ML_IN, DM, C.w<bf16>(WS_MLWOUTT), scr);
    moe_weight_items(C, 0, scr);
}

__device__ __forceinline__ void normmod_row(const float* xrow, const float* g, const float* sc, const float* sh, bf16* orow, int lane) {
    const f32x4* xr = (const f32x4*)xrow + lane; f32x4 v[4]; float s = 0.f;
#pragma unroll
    for (int j = 0; j < 4; ++j) { v[j] = xr[64 * j]; s += (v[j].x * v[j].x + v[j].y * v[j].y) + (v[j].z * v[j].z + v[j].w * v[j].w); }
    const float rstd = 1.0f / sqrtf(wave_sum(s) * (1.0f / DM) + EPS);
    u32x2* o8 = (u32x2*)orow + lane;
#pragma unroll
    for (int j = 0; j < 4; ++j) { const f32x4 gv = ((const f32x4*)g)[lane + 64 * j], scv = ((const f32x4*)sc)[lane + 64 * j], shv = ((const f32x4*)sh)[lane + 64 * j];
        const f32x4 y = (v[j] * rstd * gv) * (scv + 1.0f) + shv; u32x2 w; w.x = pk2(y.x, y.y); w.y = pk2(y.z, y.w); o8[64 * j] = w; }
}
__device__ __forceinline__ void p_normmod(const Ctx& C, const float* xsrc, int layer, int row_lo, int row_hi, bf16* dst) {
    const int gw = C.vcu * 8 + C.wave, NGW = C.G * 8;
    const float* g = C.in(IN_NMG) + layer * DM;
    for (int r = row_lo + gw; r < row_hi; r += NGW) { const int b = r / SEQ;
        normmod_row(xsrc + (size_t)r * DM, g, C.mods(layer, 1) + (size_t)b * 6144, C.mods(layer, 0) + (size_t)b * 6144, dst + (size_t)(r - row_lo) * DM, C.lane); }
}

constexpr int AT_KS = 144, AT_VS = 136;
constexpr int AT_K_OFF = 0, AT_K_BYTES = 2 * 64 * AT_KS;
constexpr int AT_V_OFF = AT_K_BYTES, AT_V_BYTES = 128 * AT_VS;
constexpr int AT_TAB_OFF = AT_V_OFF + AT_V_BYTES;
constexpr int AT_EX_OFF = 0, AT_EX_PITCH = 132;
static_assert(AT_TAB_OFF % 16 == 0 && AT_TAB_OFF + 16384 <= RING_BYTES && 4 * 32 * AT_EX_PITCH * 4 <= RING_BYTES, "attention LDS");
__device__ __forceinline__ void attn_unit(const Ctx& C, int b, int h, int qt) {
    LAS unsigned char* lds = C.lds;
    const int tid = C.tid, lane = C.lane, wid = C.wave, mp = wid >> 2, rb = wid & 3, r32 = lane & 31, hi = lane >> 5;
    const bf16* QK = C.w<bf16>(WS_QK); const bf16* VT = C.w<bf16>(WS_VT);
    const size_t tok0 = (size_t)b * SEQ; const int q0 = qt * 128;
    LAS float* tab = (LAS float*)(lds + AT_TAB_OFF);
    __syncthreads();
    { const float* t2 = C.w<float>(WS_TAB2) + h * 4096; for (int i = tid; i < 4096; i += 512) tab[i] = t2[i]; }
    bf16x8 qf[4];
    {
        const bf16* qrow = QK + (tok0 + q0 + rb * 32 + r32) * 2048 + h * 128 + mp * 64 + hi * 8;
        float qv[4][8]; float ss = 0.f;
#pragma unroll
        for (int ks = 0; ks < 4; ++ks) { const u32x4 w = *(const u32x4*)(qrow + ks * 16);
            qv[ks][0] = bflo(w.x); qv[ks][1] = bfhi(w.x); qv[ks][2] = bflo(w.y); qv[ks][3] = bfhi(w.y); qv[ks][4] = bflo(w.z); qv[ks][5] = bfhi(w.z); qv[ks][6] = bflo(w.w); qv[ks][7] = bfhi(w.w);
#pragma unroll
            for (int j = 0; j < 8; ++j) ss += qv[ks][j] * qv[ks][j]; }
        ss += __shfl_xor(ss, 32);
        const float rs = (1.0f / sqrtf(ss * (1.0f / 64.0f) + EPS)) * (0.125f * LOG2E);
        const float* qg = C.in(IN_QG);
#pragma unroll
        for (int ks = 0; ks < 4; ++ks) { u32x4 w; const float* gg = qg + ks * 16 + hi * 8;
            w.x = pk2(qv[ks][0] * rs * gg[0], qv[ks][1] * rs * gg[1]); w.y = pk2(qv[ks][2] * rs * gg[2], qv[ks][3] * rs * gg[3]);
            w.z = pk2(qv[ks][4] * rs * gg[4], qv[ks][5] * rs * gg[5]); w.w = pk2(qv[ks][6] * rs * gg[6], qv[ks][7] * rs * gg[7]);
            qf[ks] = __builtin_bit_cast(bf16x8, w); }
    }
    const int kkey = tid >> 4, kcc = tid & 15, vdv = tid >> 3, vkc = tid & 7;
    const bf16* ksrc = QK + (tok0 + kkey) * 2048 + 1024 + h * 128 + kcc * 8;
    const bf16* vsrc = VT + (size_t)(h * 128 + vdv) * NT + tok0 + vkc * 8;
    float kgain[8];
#pragma unroll
    for (int j = 0; j < 8; ++j) kgain[j] = C.in(IN_KG)[(kcc & 7) * 8 + j];
    u32x4 kst[2], vst[2];
#define AT_LOAD(t) do { const int k0_ = (t) * 64; kst[0] = *(const u32x4*)(ksrc + (size_t)k0_ * 2048); kst[1] = *(const u32x4*)(ksrc + (size_t)(k0_ + 32) * 2048); \
        vst[0] = *(const u32x4*)(vsrc + k0_); vst[1] = *(const u32x4*)(vsrc + (size_t)64 * NT + k0_); } while (0)
    AT_LOAD(0);
    f32x16 o[4];
#pragma unroll
    for (int i = 0; i < 4; ++i) o[i] = (f32x16){0.f, 0.f, 0.f, 0.f, 0.f, 0.f, 0.f, 0.f, 0.f, 0.f, 0.f, 0.f, 0.f, 0.f, 0.f, 0.f};
    float lsum = 0.f;
    const LAS unsigned char* kfp = lds + AT_K_OFF + (mp * 64 + r32) * AT_KS + hi * 16;
    const LAS unsigned char* vfp = lds + AT_V_OFF + r32 * AT_VS + hi * 8;
    for (int t = 0; t < 32; ++t) {
        __syncthreads();
#pragma unroll
        for (int i = 0; i < 2; ++i) { const u32x4 w = kst[i]; float v[8] = {bflo(w.x), bfhi(w.x), bflo(w.y), bfhi(w.y), bflo(w.z), bfhi(w.z), bflo(w.w), bfhi(w.w)};
            float ss = 0.f;
#pragma unroll
            for (int j = 0; j < 8; ++j) ss += v[j] * v[j];
            ss += __shfl_xor(ss, 1); ss += __shfl_xor(ss, 2); ss += __shfl_xor(ss, 4);
            const float rs = 1.0f / sqrtf(ss * (1.0f / 64.0f) + EPS);
            u32x4 ow; ow.x = pk2(v[0] * rs * kgain[0], v[1] * rs * kgain[1]); ow.y = pk2(v[2] * rs * kgain[2], v[3] * rs * kgain[3]);
            ow.z = pk2(v[4] * rs * kgain[4], v[5] * rs * kgain[5]); ow.w = pk2(v[6] * rs * kgain[6], v[7] * rs * kgain[7]);
            *(LAS u32x4*)(lds + AT_K_OFF + ((kcc >> 3) * 64 + kkey + 32 * i) * AT_KS + (kcc & 7) * 16) = ow;
            LAS u32x2* vd = (LAS u32x2*)(lds + AT_V_OFF + (vdv + 64 * i) * AT_VS + vkc * 16);
            vd[0] = (u32x2){vst[i].x, vst[i].y}; vd[1] = (u32x2){vst[i].z, vst[i].w}; }
        if (t + 1 < 32) AT_LOAD(t + 1);
        __syncthreads();
        const int k0 = t * 64;
        bf16x8 pf[4];
#pragma unroll
        for (int kb = 0; kb < 2; ++kb) {
            f32x16 s = (f32x16){0.f, 0.f, 0.f, 0.f, 0.f, 0.f, 0.f, 0.f, 0.f, 0.f, 0.f, 0.f, 0.f, 0.f, 0.f, 0.f};
#pragma unroll
            for (int ks = 0; ks < 4; ++ks) { const bf16x8 kf = *(const LAS bf16x8*)(kfp + kb * 32 * AT_KS + ks * 32); s = __builtin_amdgcn_mfma_f32_32x32x16_bf16(kf, qf[ks], s, 0, 0, 0); }
            const LAS float* tp = tab + (k0 + 32 * kb + 4 * hi - (q0 + 32 * rb + r32) + 2047);
            float p[16];
#pragma unroll
            for (int r = 0; r < 16; ++r) { p[r] = __builtin_amdgcn_exp2f(s[r] + tp[(r & 3) + 8 * (r >> 2)]); lsum += p[r]; }
#pragma unroll
            for (int sh = 0; sh < 2; ++sh) { u32x4 w; w.x = pk2(p[8 * sh + 0], p[8 * sh + 1]); w.y = pk2(p[8 * sh + 2], p[8 * sh + 3]); w.z = pk2(p[8 * sh + 4], p[8 * sh + 5]); w.w = pk2(p[8 * sh + 6], p[8 * sh + 7]);
                pf[2 * kb + sh] = __builtin_bit_cast(bf16x8, w); }
        }
#pragma unroll
        for (int dvb = 0; dvb < 4; ++dvb)
#pragma unroll
            for (int s4 = 0; s4 < 4; ++s4) { const u32x2 lo = *(const LAS u32x2*)(vfp + dvb * 32 * AT_VS + s4 * 32), hi2 = *(const LAS u32x2*)(vfp + dvb * 32 * AT_VS + s4 * 32 + 16);
                const u32x4 w = (u32x4){lo.x, lo.y, hi2.x, hi2.y};
                o[dvb] = __builtin_amdgcn_mfma_f32_32x32x16_bf16(__builtin_bit_cast(bf16x8, w), pf[s4], o[dvb], 0, 0, 0); }
    }
#undef AT_LOAD
    lsum += __shfl_xor(lsum, 32);
    const float lam = C.w<float>(WS_SCAL)[0];
    const float sc = (mp == 0 ? 1.0f : lam) / lsum;
    __syncthreads();
    LAS float* ex = (LAS float*)(lds + AT_EX_OFF) + (rb * 32 + r32) * AT_EX_PITCH;
    if (mp == 1) {
#pragma unroll
        for (int dvb = 0; dvb < 4; ++dvb)
#pragma unroll
            for (int g = 0; g < 4; ++g) *(LAS f32x4*)(ex + dvb * 32 + 8 * g + 4 * hi) = (f32x4){o[dvb][4 * g] * sc, o[dvb][4 * g + 1] * sc, o[dvb][4 * g + 2] * sc, o[dvb][4 * g + 3] * sc};
    }
    __syncthreads();
    if (mp == 0) {
        float ss = 0.f;
#pragma unroll
        for (int dvb = 0; dvb < 4; ++dvb)
#pragma unroll
            for (int g = 0; g < 4; ++g) { const f32x4 e = *(const LAS f32x4*)(ex + dvb * 32 + 8 * g + 4 * hi);
#pragma unroll
                for (int i = 0; i < 4; ++i) { const float v = o[dvb][4 * g + i] * sc - e[i]; o[dvb][4 * g + i] = v; ss += v * v; } }
        ss += __shfl_xor(ss, 32);
        const float rs = (1.0f / sqrtf(ss * (1.0f / 128.0f) + EPS)) * 0.8f;
        bf16* orow = C.w<bf16>(WS_O) + (tok0 + q0 + rb * 32 + r32) * DM + h * 128;
        const float* sg = C.in(IN_SUBLN);
#pragma unroll
        for (int dvb = 0; dvb < 4; ++dvb)
#pragma unroll
            for (int g = 0; g < 4; ++g) { const int dv = dvb * 32 + 8 * g + 4 * hi; const f32x4 gv = *(const f32x4*)(sg + dv);
                u32x2 w; w.x = pk2(o[dvb][4 * g] * rs * gv.x, o[dvb][4 * g + 1] * rs * gv.y); w.y = pk2(o[dvb][4 * g + 2] * rs * gv.z, o[dvb][4 * g + 3] * rs * gv.w);
                *(u32x2*)(orow + dv) = w; }
    }
}
__device__ __forceinline__ void p_attention(const Ctx& C) {
    for (int u = C.vcu; u < NB * DA_H * 16; u += C.G) { const int qt = u & 15, bh = u >> 4; attn_unit(C, bh >> 3, bh & 7, qt); }
    __syncthreads();
}

__device__ __forceinline__ void p_route(const Ctx& C, int layer) {
    const float* x = C.a->out; const int lane = C.lane, tok = lane & 15, kq = lane >> 4;
    const float* g = C.in(IN_NFG) + layer * DM;
    const float* wr_ = C.in(IN_WRT) + (size_t)layer * DM * 32; const float* wg_ = C.in(IN_WGRP) + (size_t)layer * DM * 4;
    unsigned* cnt = C.w<unsigned>(WS_CTL) + CW_CNT + layer * 64;
    LAS float* lg = (LAS float*)(C.lds) + C.wave * (16 * 48);
    bf16* HF = C.w<bf16>(WS_HF);
    for (int wt = C.vcu * 8 + C.wave; wt < NT / 16; wt += C.G * 8) {
        const int t0 = wt * 16, b = t0 / SEQ;
        const float* xrow = x + (size_t)(t0 + tok) * DM + 4 * kq;
        float ss = 0.f;
        for (int kk = 0; kk < 64; ++kk) { const f32x4 v = *(const f32x4*)(xrow + 16 * kk); ss += (v.x * v.x + v.y * v.y) + (v.z * v.z + v.w * v.w); }
        ss += __shfl_xor(ss, 16); ss += __shfl_xor(ss, 32);
        const float rstd = 1.0f / sqrtf(ss * (1.0f / DM) + EPS);
        const float* sc = C.mods(layer, 4) + (size_t)b * 6144 + 4 * kq; const float* sh = C.mods(layer, 3) + (size_t)b * 6144 + 4 * kq;
        f32x4 a0 = (f32x4){0.f, 0.f, 0.f, 0.f}, a1 = a0, a2 = a0;
        bf16* hrow = HF + (size_t)(t0 + tok) * DM + 4 * kq;
        for (int kk = 0; kk < 64; ++kk) {
            const f32x4 v = *(const f32x4*)(xrow + 16 * kk), gv = *(const f32x4*)(g + 16 * kk + 4 * kq), scv = *(const f32x4*)(sc + 16 * kk), shv = *(const f32x4*)(sh + 16 * kk);
            const f32x4 hf = (v * rstd * gv) * (scv + 1.0f) + shv;
            u32x2 w; w.x = pk2(hf.x, hf.y); w.y = pk2(hf.z, hf.w); *(u32x2*)(hrow + 16 * kk) = w;
#pragma unroll
            for (int i = 0; i < 4; ++i) { const int k = 16 * kk + 4 * kq + i;
                const float b0 = wr_[k * 32 + tok], b1 = wr_[k * 32 + 16 + tok], b2 = tok < 4 ? wg_[k * 4 + tok] : 0.f;
                a0 = __builtin_amdgcn_mfma_f32_16x16x4f32(hf[i], b0, a0, 0, 0, 0); a1 = __builtin_amdgcn_mfma_f32_16x16x4f32(hf[i], b1, a1, 0, 0, 0); a2 = __builtin_amdgcn_mfma_f32_16x16x4f32(hf[i], b2, a2, 0, 0, 0); }
        }
#pragma unroll
        for (int r = 0; r < 4; ++r) { lg[(4 * kq + r) * 48 + tok] = a0[r]; lg[(4 * kq + r) * 48 + 16 + tok] = a1[r]; lg[(4 * kq + r) * 48 + 32 + tok] = a2[r]; }
        LDS_WAIT(); asm volatile("" ::: "memory");
        if (lane < 16) {
            const LAS float* L = lg + lane * 48;
            int gs = 0; float gm = L[32];
#pragma unroll
            for (int j = 1; j < 4; ++j) { const float v = L[32 + j]; if (v > gm) { gm = v; gs = j; } }
            float gsum = 0.f;
#pragma unroll
            for (int j = 0; j < 4; ++j) gsum += __expf(L[32 + j] - gm);
            const float pg = 1.0f / gsum;
            int ia = 0; float la = L[gs * 8];
#pragma unroll
            for (int j = 1; j < 8; ++j) { const float v = L[gs * 8 + j]; if (v > la) { la = v; ia = j; } }
            int ib = -1; float lb = -3.0e38f;
#pragma unroll
            for (int j = 0; j < 8; ++j) { const float v = L[gs * 8 + j]; if (j != ia && v > lb) { lb = v; ib = j; } }
            const float wa = pg / (1.0f + __expf(lb - la)), wb = pg - wa;
            const int ea = gs * 8 + ia, eb = gs * 8 + ib, t = t0 + lane;
            const unsigned pa = atomicAdd(cnt + ea, 1u), pb = atomicAdd(cnt + eb, 1u);
            C.w<int>(WS_RE)[2 * t] = ea; C.w<int>(WS_RE)[2 * t + 1] = eb; C.w<float>(WS_RW)[2 * t] = wa; C.w<float>(WS_RW)[2 * t + 1] = wb;
            C.w<int>(WS_RP)[2 * t] = (int)pa; C.w<int>(WS_RP)[2 * t + 1] = (int)pb;
        }
        LDS_WAIT(); asm volatile("" ::: "memory");
    }
}
struct MoeTab { LAS int* off; LAS int* tile_e; LAS int* ntile; };
__device__ __forceinline__ MoeTab moe_tables(const Ctx& C, int layer) {
    MoeTab T; T.off = (LAS int*)(C.lds + MISC_OFF + 256); T.tile_e = T.off + 64; T.ntile = T.off + 48;
    __syncthreads();
    if (C.tid == 0) { const unsigned* cnt = C.w<unsigned>(WS_CTL) + CW_CNT + layer * 64; int o = 0, nt = 0;
        for (int e = 0; e < NEXP; ++e) { const int c = (int)__hip_atomic_load(cnt + e, __ATOMIC_RELAXED, __HIP_MEMORY_SCOPE_AGENT); T.off[e] = o; const int tiles = (c + 255) >> 8; for (int j = 0; j < tiles; ++j) T.tile_e[nt + j] = e; nt += tiles; o += tiles * 256; }
        T.off[32] = o; T.ntile[0] = nt; }
    __syncthreads();
    return T;
}
__device__ __forceinline__ void p_permute(const Ctx& C, int layer) {
    const MoeTab T = moe_tables(C, layer);
    const bf16* HF = C.w<bf16>(WS_HF); bf16* HS = C.w<bf16>(WS_HS);
    int* RP = C.w<int>(WS_RP); const int* RE = C.w<int>(WS_RE);
    for (int p = C.vcu * 8 + C.wave; p < 2 * NT; p += C.G * 8) {
        const int e = RE[p], pos = RP[p], slot = T.off[e] + pos, t = p >> 1;
        const u32x4* s = (const u32x4*)(HF + (size_t)t * DM) + C.lane; u32x4* d = (u32x4*)(HS + (size_t)slot * DM) + C.lane;
        const u32x4 v0 = s[0], v1 = s[64]; d[0] = v0; d[64] = v1;
        asm volatile("" ::: "memory");
        if (C.lane == 0) RP[p] = slot;
    }
}
template <int NPN> struct MoeOrder {
    MoeTab T; const char* A; const char* B; int lda_bytes; size_t b_expert_bytes; int b_tile_bytes; int G, c, nt;
    __device__ __forceinline__ bool next(int i, pg8::Unit& u) const {
        const int L = i * G + c; const int rt = L / NPN, pn = L - rt * NPN; if (rt >= T.ntile[0]) return false;
        const int e = T.tile_e[rt];
        u.A = A + (size_t)rt * 256 * lda_bytes; u.B = B + (size_t)e * b_expert_bytes + (size_t)pn * b_tile_bytes; u.r0 = rt * 256; u.c0 = pn * 256; u.a0 = e; u.a1 = pn; u.nt = nt; u.flags = 3; return true;
    }
    __device__ __forceinline__ int kb(const pg8::Unit&, int t) const { return t; }
};
struct EpiSwiGLU {
    static constexpr bool PERM = true;
    bf16* H;
    __device__ __forceinline__ void operator()(const f32x4 (&acc)[2][2][4][2], const pg8::Unit& u, int wr, int wc, int fr_, int fq_) const {
        (void)fr_; (void)fq_; const int ln_ = opaque_v(lane_id()); const int fr = ln_ & 15, fq = ln_ >> 4;
        const int row0 = u.r0 + wr * 64 + fr, col0 = u.a1 * 128 + wc * 32 + 8 * fq;
#pragma unroll
        for (int ai = 0; ai < 2; ++ai)
#pragma unroll
            for (int m = 0; m < 4; ++m) { float r[8];
#pragma unroll
                for (int n = 0; n < 2; ++n)
#pragma unroll
                    for (int i = 0; i < 4; ++i) { const float a = acc[ai][0][m][n][i], b = acc[ai][1][m][n][i]; r[4 * n + i] = silu_f(a) * b; }
                u32x4 w; w.x = pk2(r[0], r[1]); w.y = pk2(r[2], r[3]); w.z = pk2(r[4], r[5]); w.w = pk2(r[6], r[7]);
                *(u32x4*)(H + (size_t)(row0 + ai * 128 + m * 16) * DEXP + col0) = w; }
    }
};
__device__ __forceinline__ void p_combine(const Ctx& C, int layer) {
    float* x = C.a->out; const bf16* YS = C.w<bf16>(WS_YS); const int* RP = C.w<int>(WS_RP); const float* RW = C.w<float>(WS_RW);
    for (int t = C.vcu * 8 + C.wave; t < NT; t += C.G * 8) {
        const int s0 = RP[2 * t], s1 = RP[2 * t + 1]; const float w0 = RW[2 * t], w1 = RW[2 * t + 1];
        const float* g2 = C.mods(layer, 5) + (size_t)(t / SEQ) * 6144;
        const u32x4* y0 = (const u32x4*)(YS + (size_t)s0 * DM) + C.lane; const u32x4* y1 = (const u32x4*)(YS + (size_t)s1 * DM) + C.lane;
        float* xr = x + (size_t)t * DM + 8 * C.lane;
#pragma unroll
        for (int j = 0; j < 2; ++j) { const u32x4 a = y0[64 * j], b = y1[64 * j]; const f32x4 ga = *(const f32x4*)(g2 + 512 * j + 8 * C.lane), gb = *(const f32x4*)(g2 + 512 * j + 8 * C.lane + 4);
            f32x4 xa = *(f32x4*)(xr + 512 * j), xb = *(f32x4*)(xr + 512 * j + 4);
            xa.x += ga.x * (w0 * bflo(a.x) + w1 * bflo(b.x)); xa.y += ga.y * (w0 * bfhi(a.x) + w1 * bfhi(b.x)); xa.z += ga.z * (w0 * bflo(a.y) + w1 * bflo(b.y)); xa.w += ga.w * (w0 * bfhi(a.y) + w1 * bfhi(b.y));
            xb.x += gb.x * (w0 * bflo(a.z) + w1 * bflo(b.z)); xb.y += gb.y * (w0 * bfhi(a.z) + w1 * bfhi(b.z)); xb.z += gb.z * (w0 * bflo(a.w) + w1 * bflo(b.w)); xb.w += gb.w * (w0 * bfhi(a.w) + w1 * bfhi(b.w));
            *(f32x4*)(xr + 512 * j) = xa; *(f32x4*)(xr + 512 * j + 4) = xb; }
    }
}

constexpr int CV_XM = 0;
constexpr int CV_QKV = 18432;
constexpr int CV_QKV_P = 1552;
constexpr int CV_VT = CV_QKV + 32 * CV_QKV_P;
constexpr int CV_RED = CV_VT + 256 * 80;
static_assert(CV_RED + 16384 <= RING_BYTES && CV_VT % 16 == 0 && CV_RED % 16 == 0, "conv LDS");
__device__ __forceinline__ void conv_unit(const Ctx& C, int round, int bl, int ti) {
    LAS unsigned char* lds = C.lds; const int tid = C.tid, lane = C.lane, wid = C.wave;
    const int s0 = ti * 32; const size_t rrow0 = (size_t)bl * SEQ;
    const bf16* XM = C.w<bf16>(WS_XMH); bf16* XC = C.w<bf16>(WS_XC); bf16* Q = C.w<bf16>(WS_Q); bf16* K = C.w<bf16>(WS_K); bf16* VTR = C.w<bf16>(WS_VTR);
    const bf16* GWT = C.w<bf16>(WS_GWT);
    f32x4 gacc[2]; gacc[0] = (f32x4){0.f, 0.f, 0.f, 0.f}; gacc[1] = gacc[0];
    const int nblk = tid & 63, tg = tid >> 6;
    for (int ch = 0; ch < 8; ++ch) {
        const int c0 = ch * 256;
        __syncthreads();
        for (int i = tid; i < 36 * 32; i += 512) { const int r = i >> 5, cc = i & 31, s = s0 - 2 + r; u32x4 v = (u32x4){0u, 0u, 0u, 0u};
            if (s >= 0 && s < SEQ) v = *(const u32x4*)(XM + (rrow0 + s) * ML_IN + c0 + cc * 8);
            *(LAS u32x4*)(lds + CV_XM + r * 512 + cc * 16) = v; }
        __syncthreads();
        {
            const int c = c0 + 4 * nblk;
            float cw[5][4], cb[4], wq[4][4], wk[4][4], wv[4][4];
            const float* convw = C.in(IN_CONVW); const float* convb = C.in(IN_CONVB);
#pragma unroll
            for (int j = 0; j < 5; ++j) { const f32x4 v = *(const f32x4*)(convw + j * ML_IN + c); cw[j][0] = v.x; cw[j][1] = v.y; cw[j][2] = v.z; cw[j][3] = v.w; }
            { const f32x4 v = *(const f32x4*)(convb + c); cb[0] = v.x; cb[1] = v.y; cb[2] = v.z; cb[3] = v.w; }
            const int nb = c >> 2;
#pragma unroll
            for (int i = 0; i < 4; ++i) { const f32x4 a = *(const f32x4*)(C.in(IN_WQ) + nb * 16 + i * 4), b = *(const f32x4*)(C.in(IN_WK) + nb * 16 + i * 4), d = *(const f32x4*)(C.in(IN_WV) + nb * 16 + i * 4);
                wq[i][0] = a.x; wq[i][1] = a.y; wq[i][2] = a.z; wq[i][3] = a.w; wk[i][0] = b.x; wk[i][1] = b.y; wk[i][2] = b.z; wk[i][3] = b.w; wv[i][0] = d.x; wv[i][1] = d.y; wv[i][2] = d.z; wv[i][3] = d.w; }
            float xw[8][4];
#pragma unroll
            for (int r = 0; r < 8; ++r) { const u32x2 v = *(const LAS u32x2*)(lds + CV_XM + (4 * tg + r) * 512 + nblk * 8); xw[r][0] = bflo(v.x); xw[r][1] = bfhi(v.x); xw[r][2] = bflo(v.y); xw[r][3] = bfhi(v.y); }
#pragma unroll
            for (int tt = 0; tt < 4; ++tt) {
                const int tl = 4 * tg + tt;
                float xc[4], qv[4], kv[4], vv[4];
#pragma unroll
                for (int i = 0; i < 4; ++i) { float a = cb[i];
#pragma unroll
                    for (int j = 0; j < 5; ++j) a += cw[j][i] * xw[tt + j][i];
                    xc[i] = silu_f(a); }
#pragma unroll
                for (int o = 0; o < 4; ++o) { float a = 0.f, b = 0.f, d = 0.f;
#pragma unroll
                    for (int i = 0; i < 4; ++i) { a += xc[i] * wq[i][o]; b += xc[i] * wk[i][o]; d += xw[tt + 2][i] * wv[i][o]; }
                    qv[o] = a; kv[o] = b; vv[o] = d; }
                const size_t grow = (rrow0 + s0 + tl) * ML_IN + c;
                const u32x2 xcw = (u32x2){pk2(xc[0], xc[1]), pk2(xc[2], xc[3])}, qw = (u32x2){pk2(qv[0], qv[1]), pk2(qv[2], qv[3])}, kw = (u32x2){pk2(kv[0], kv[1]), pk2(kv[2], kv[3])}, vw = (u32x2){pk2(vv[0], vv[1]), pk2(vv[2], vv[3])};
                *(u32x2*)(XC + grow) = xcw; *(u32x2*)(Q + grow) = qw; *(u32x2*)(K + grow) = kw;
                LAS unsigned char* qrow = lds + CV_QKV + tl * CV_QKV_P + nblk * 8;
                *(LAS u32x2*)(qrow) = qw; *(LAS u32x2*)(qrow + 512) = kw; *(LAS u32x2*)(qrow + 1024) = vw;
                LAS unsigned short* vt = (LAS unsigned short*)(lds + CV_VT) + (4 * nblk) * 40 + tl;
                vt[0] = (unsigned short)(vw.x & 0xffffu); vt[40] = (unsigned short)(vw.x >> 16); vt[80] = (unsigned short)(vw.y & 0xffffu); vt[120] = (unsigned short)(vw.y >> 16);
            }
        }
        __syncthreads();
        for (int i = tid; i < 256 * 4; i += 512) { const int cr = i >> 2, cc = i & 3; const int cg = c0 + cr, head = cg >> 9, dv = cg & 511;
            const LAS u32x2* s = (const LAS u32x2*)(lds + CV_VT + cr * 80 + cc * 16); const u32x2 a = s[0], b2 = s[1];
            *(u32x4*)(VTR + ((size_t)(bl * 4 + head) * 512 + dv) * SEQ + s0 + cc * 8) = (u32x4){a.x, a.y, b2.x, b2.y}; }
#pragma unroll
        for (int ks = 0; ks < 3; ++ks) { const int kk = 96 * wid + 32 * ks + 8 * (lane >> 4);
            const int m = kk >> 8, cl = kk & 255;
            const bf16x8 bfr = *(const bf16x8*)(GWT + (size_t)(lane & 15) * 6144 + m * 2048 + c0 + cl);
#pragma unroll
            for (int tgp = 0; tgp < 2; ++tgp) { const bf16x8 afr = *(const LAS bf16x8*)(lds + CV_QKV + (16 * tgp + (lane & 15)) * CV_QKV_P + kk * 2);
                gacc[tgp] = __builtin_amdgcn_mfma_f32_16x16x32_bf16(afr, bfr, gacc[tgp], 0, 0, 0); } }
    }
    __syncthreads();
    LAS float* red = (LAS float*)(lds + CV_RED);
#pragma unroll
    for (int tgp = 0; tgp < 2; ++tgp)
#pragma unroll
        for (int r = 0; r < 4; ++r) red[(wid * 32 + 16 * tgp + 4 * (lane >> 4) + r) * 16 + (lane & 15)] = gacc[tgp][r];
    __syncthreads();
    { const int tkn = tid >> 4, n = tid & 15; float s = C.in(IN_GATEB)[n];
#pragma unroll
        for (int w = 0; w < 8; ++w) s += red[(w * 32 + tkn) * 16 + n];
        C.w<float>(WS_PRE)[(rrow0 + s0 + tkn) * 16 + n] = s; }
    (void)round;
}
__device__ __forceinline__ void p_conv(const Ctx& C, int round) {
    for (int u = C.vcu; u < RB * 64; u += C.G) conv_unit(C, round, u >> 6, u & 63);
    __syncthreads();
}
__device__ __forceinline__ void p_cumsum(const Ctx& C) {
    float* FG = C.w<float>(WS_FG); const float* PRE = C.w<float>(WS_PRE); float* DEN = C.w<float>(WS_DEN);
    for (int i = C.vcu * 512 + C.tid; i < 2 * 16 * 2048; i += C.G * 512) DEN[i] = 0.f;
    const int gw = C.vcu * 8 + C.wave;
    if (gw < 32) {
        const int dir = gw & 1, bh = gw >> 1, bl = bh >> 2, hd = bh & 3, lane = C.lane;
        const float* p = PRE + (size_t)bl * SEQ * 16 + dir * 8;
        float lf[32], ii[32]; float tot = 0.f;
#pragma unroll
        for (int j = 0; j < 32; ++j) { const int s = lane * 32 + j; const float f = p[(size_t)s * 16 + 4 + hd]; ii[j] = p[(size_t)s * 16 + hd];
            lf[j] = fminf(f, 0.f) - log1pf(__expf(-fabsf(f))); tot += lf[j]; }
        float inc = tot;
#pragma unroll
        for (int o = 1; o < 64; o <<= 1) { const float v = __shfl_up(inc, o); if (lane >= o) inc += v; }
        const float all = __shfl(inc, 63);
        float* F = FG + (size_t)(dir * 2) * 16 * 2048 + (size_t)bh * 2048; float* Gp = F + 16 * 2048;
        if (dir == 0) { float run = inc - tot;
#pragma unroll
            for (int j = 0; j < 32; ++j) { run += lf[j]; const int s = lane * 32 + j; F[s] = run * LOG2E; Gp[s] = (ii[j] - run) * LOG2E - 4.5f; } }
        else { float run = all - (inc - tot);
#pragma unroll
            for (int j = 0; j < 32; ++j) { const int s = lane * 32 + j; F[s] = run * LOG2E; Gp[s] = (ii[j] - run) * LOG2E - 4.5f; run -= lf[j]; } }
    }
}
struct DecayOrder {
    const char* Qb; const char* Kb; int G, c;
    __device__ __forceinline__ bool next(int ii, pg8::Unit& u) const {
        const int L = ii * G + c; if (L >= 16 * 64) return false;
        const int bh = L >> 6, i = (L >> 3) & 7, j = L & 7, bl = bh >> 2, hd = bh & 3;
        u.A = Qb + ((size_t)(bl * SEQ + 256 * i) * ML_IN + hd * 512) * 2; u.B = Kb + ((size_t)(bl * SEQ + 256 * j) * ML_IN + hd * 512) * 2; u.r0 = 256 * i; u.c0 = 256 * j; u.a0 = bh; u.a1 = (i << 4) | j; u.nt = ML_DH / 64; u.flags = 3; return true;
    }
    __device__ __forceinline__ int kb(const pg8::Unit&, int t) const { return t; }
};
struct EpiDecay {
    static constexpr bool PERM = true;
    bf16* W; const float* FG; float* DEN;
    __device__ __forceinline__ void pass(const f32x4 (&acc)[2][2][4][2], const pg8::Unit& u, int wr, int wc, int fr, int fq, int dir, int dmin, int dmax, int cblk) const {
        const int bh = u.a0; const float* F = FG + (size_t)(dir * 2) * 16 * 2048 + (size_t)bh * 2048; const float* Gp = F + 16 * 2048;
        const int rl0 = opaque_v(wr * 64 + fr), cl0 = opaque_v(wc * 32 + 8 * fq);
        f32x4 gv[2][2];
#pragma unroll
        for (int bj = 0; bj < 2; ++bj)
#pragma unroll
            for (int n = 0; n < 2; ++n) gv[bj][n] = *(const f32x4*)(Gp + u.c0 + cl0 + bj * 128 + 4 * n);
        bf16* wbase = W + ((size_t)bh * SEQ + u.r0) * WLD + cblk * 256 + cl0;
        float* den = DEN + (size_t)dir * 16 * 2048 + (size_t)bh * 2048 + u.r0;
        const float* Fr = F + u.r0;
#pragma unroll
        for (int ai = 0; ai < 2; ++ai)
#pragma unroll
            for (int m = 0; m < 4; ++m) { const int rl = rl0 + ai * 128 + m * 16; const float fv = Fr[rl]; float rs = 0.f;
#pragma unroll
                for (int bj = 0; bj < 2; ++bj) { float r[8];
#pragma unroll
                    for (int n = 0; n < 2; ++n)
#pragma unroll
                        for (int i = 0; i < 4; ++i) { const int d = cl0 + bj * 128 + 4 * n + i - rl; float wv = acc[ai][bj][m][n][i] * __builtin_amdgcn_exp2f(fv + gv[bj][n][i]);
                            wv = (d >= dmin && d <= dmax) ? wv : 0.f; r[4 * n + i] = wv; rs += wv; }
                    u32x4 w; w.x = pk2(r[0], r[1]); w.y = pk2(r[2], r[3]); w.z = pk2(r[4], r[5]); w.w = pk2(r[6], r[7]);
                    *(u32x4*)(wbase + (size_t)rl * WLD + bj * 128) = w; }
                rs += __shfl_xor(rs, 16); rs += __shfl_xor(rs, 32);
                if (fq == 0) atomicAdd(den + rl, rs); }
    }
    __device__ __forceinline__ void operator()(const f32x4 (&acc)[2][2][4][2], const pg8::Unit& u, int wr, int wc, int fr_, int fq_) const {
        (void)fr_; (void)fq_; const int ln_ = opaque_v(lane_id()); const int fr = ln_ & 15, fq = ln_ >> 4;
        const int i = u.a1 >> 4, j = u.a1 & 15;
        const int npass = (i == j) ? 2 : 1;
        for (int p = 0; p < npass; ++p) {
            int dir, dmin, dmax, cblk;
            if (j < i) { dir = 0; dmin = -100000; dmax = 100000; cblk = j; }
            else if (j > i) { dir = 1; dmin = -100000; dmax = 100000; cblk = j + 1; }
            else if (p == 0) { dir = 0; dmin = -100000; dmax = 0; cblk = i; }
            else { dir = 1; dmin = 0; dmax = 100000; cblk = i + 1; }
            pass(acc, u, wr, wc, fr, fq, dir, dmin, dmax, cblk);
        }
    }
};
struct HOrder {
    const char* Wb; const char* Vb; int G, c;
    __device__ __forceinline__ bool next(int ii, pg8::Unit& u) const {
        const int L = (ii >> 1) * G + c, part = ii & 1; if (L >= 16 * 16) return false;
        const int bh = L >> 4, i = (L >> 1) & 7, jn = L & 1;
        const int kt0 = part ? 4 * (i + 1) : 0;
        u.A = Wb + (((size_t)bh * SEQ + 256 * i) * WLD + (size_t)kt0 * 64) * 2;
        u.B = Vb + (((size_t)bh * 512 + 256 * jn) * SEQ + (size_t)(part ? 4 * i : 0) * 64) * 2;
        u.r0 = 256 * i; u.c0 = 256 * jn; u.a0 = bh; u.a1 = part; u.nt = part ? 36 - 4 * (i + 1) : 4 * (i + 1); u.flags = 3; return true;
    }
    __device__ __forceinline__ int kb(const pg8::Unit&, int t) const { return t; }
};
struct EpiH {
    static constexpr bool PERM = true;
    bf16* HF; bf16* HB; const float* DEN;
    __device__ __forceinline__ void operator()(const f32x4 (&acc)[2][2][4][2], const pg8::Unit& u, int wr, int wc, int fr_, int fq_) const {
        (void)fr_; (void)fq_; const int ln_ = opaque_v(lane_id()); const int fr = ln_ & 15, fq = ln_ >> 4;
        const int bh = u.a0, bl = bh >> 2, hd = bh & 3, part = u.a1; const float* dn = DEN + (size_t)part * 16 * 2048 + (size_t)bh * 2048 + u.r0;
        const int rl0 = wr * 64 + fr, col0 = hd * 512 + u.c0 + wc * 32 + 8 * fq;
        bf16* Hh = part ? HB : HF;
#pragma unroll
        for (int ai = 0; ai < 2; ++ai)
#pragma unroll
            for (int m = 0; m < 4; ++m) { const int rl = rl0 + ai * 128 + m * 16; const float rv = 1.0f / fmaxf(fabsf(dn[rl]), 1.0f);
                bf16* rowp = Hh + ((size_t)bl * SEQ + u.r0 + rl) * ML_IN + col0;
#pragma unroll
                for (int bj = 0; bj < 2; ++bj) { const f32x4 v0 = acc[ai][bj][m][0] * rv, v1 = acc[ai][bj][m][1] * rv;
                    u32x4 w; w.x = pk2(v0[0], v0[1]); w.y = pk2(v0[2], v0[3]); w.z = pk2(v1[0], v1[1]); w.w = pk2(v1[2], v1[3]);
                    *(u32x4*)(rowp + bj * 128) = w; } }
    }
};
__device__ __forceinline__ void p_ynorm(const Ctx& C, int round) {
    const bf16* HF = C.w<bf16>(WS_Q); const bf16* HB = C.w<bf16>(WS_K); const bf16* XC = C.w<bf16>(WS_XC); bf16* Y = C.w<bf16>(WS_Y) + (size_t)round * RT * ML_IN;
    const float* og = C.in(IN_ONG); const float* skip = C.in(IN_SKIP);
    for (int r = C.vcu * 8 + C.wave; r < RT; r += C.G * 8) {
        const size_t off = (size_t)r * ML_IN + 8 * C.lane;
#pragma unroll
        for (int hd = 0; hd < 4; ++hd) {
            const u32x4 hw = *(const u32x4*)(HF + off + hd * 512), hw2 = *(const u32x4*)(HB + off + hd * 512), xw = *(const u32x4*)(XC + off + hd * 512), zw = *(const u32x4*)(Y + off + hd * 512);
            float hv[8] = {bflo(hw.x) + bflo(hw2.x), bfhi(hw.x) + bfhi(hw2.x), bflo(hw.y) + bflo(hw2.y), bfhi(hw.y) + bfhi(hw2.y), bflo(hw.z) + bflo(hw2.z), bfhi(hw.z) + bfhi(hw2.z), bflo(hw.w) + bflo(hw2.w), bfhi(hw.w) + bfhi(hw2.w)};
            const float xv[8] = {bflo(xw.x), bfhi(xw.x), bflo(xw.y), bfhi(xw.y), bflo(xw.z), bfhi(xw.z), bflo(xw.w), bfhi(xw.w)};
            const float zv[8] = {bflo(zw.x), bfhi(zw.x), bflo(zw.y), bfhi(zw.y), bflo(zw.z), bfhi(zw.z), bflo(zw.w), bfhi(zw.w)};
            float ss = 0.f;
#pragma unroll
            for (int j = 0; j < 8; ++j) ss += hv[j] * hv[j];
            const float rs = 1.0f / sqrtf(wave_sum(ss) * (1.0f / 512.0f) + EPS);
            const float* gg = og + hd * 512 + 8 * C.lane; const float* sk = skip + hd * 512 + 8 * C.lane; float yv[8];
#pragma unroll
            for (int j = 0; j < 8; ++j) yv[j] = (hv[j] * rs * gg[j] + sk[j] * xv[j]) * silu_f(zv[j]);
            u32x4 w; w.x = pk2(yv[0], yv[1]); w.y = pk2(yv[2], yv[3]); w.z = pk2(yv[4], yv[5]); w.w = pk2(yv[6], yv[7]);
            *(u32x4*)(Y + off + hd * 512) = w;
        }
    }
}

constexpr int PH_PRO = 0, PH_NORM0 = 1, PH_QKV = 2, PH_ATTN = 3, PH_OUT0 = 4, PH_ROUTE0 = 5, PH_PERM0 = 6, PH_UP0 = 7, PH_DOWN0 = 8, PH_COMB0 = 9,
              PH_NORM1 = 10, PH_RND = 11  , PH_OUT1 = PH_RND + 6 * NROUND, PH_ROUTE1 = PH_OUT1 + 1, PH_PERM1 = PH_OUT1 + 2,
              PH_UP1 = PH_OUT1 + 3, PH_DOWN1 = PH_OUT1 + 4, PH_COMB1 = PH_OUT1 + 5, N_PHASES = PH_OUT1 + 6;

__device__ __forceinline__ void moe_up(const Ctx& C, int layer) {
    const MoeTab T = moe_tables(C, layer);
    MoeOrder<2> S; S.T = T; S.A = (const char*)C.w<bf16>(WS_HS); S.B = (const char*)C.w<bf16>(WS_W13T); S.lda_bytes = DM * 2; S.b_expert_bytes = (size_t)512 * DM * 2; S.b_tile_bytes = 256 * DM * 2; S.G = C.G; S.c = C.vcu; S.nt = DM / 64;
    EpiSwiGLU E{C.w<bf16>(WS_HH)};
    pg8::gemm_phase<EpiSwiGLU, MoeOrder<2>, true>(C.lds, C.tid, DM, DM, S, E);
}
__device__ __forceinline__ void moe_down(const Ctx& C, int layer) {
    const MoeTab T = moe_tables(C, layer);
    MoeOrder<4> S; S.T = T; S.A = (const char*)C.w<bf16>(WS_HH); S.B = (const char*)C.w<bf16>(WS_W2T); S.lda_bytes = DEXP * 2; S.b_expert_bytes = (size_t)DM * DEXP * 2; S.b_tile_bytes = 256 * DEXP * 2; S.G = C.G; S.c = C.vcu; S.nt = DEXP / 64;
    pg8::EpiBf16 E{C.w<bf16>(WS_YS), DM, 0, nullptr, 0};
    pg8::gemm_phase<pg8::EpiBf16, MoeOrder<4>, true>(C.lds, C.tid, DEXP, DEXP, S, E);
}

__global__ void __launch_bounds__(512, 2) fwd_kernel(Args args) {
    extern __shared__ __attribute__((aligned(16))) unsigned char lds_raw[];
    Ctx C; C.a = &args; C.ws = args.ws; C.lds = (LAS unsigned char*)lds_raw; C.tid = threadIdx.x; C.lane = C.tid & 63; C.wave = __builtin_amdgcn_readfirstlane(C.tid >> 6);
    C.G = gridDim.x; { const int bx = blockIdx.x; C.vcu = (C.G % 8 == 0) ? (bx % 8) * (C.G / 8) + bx / 8 : bx; }
    volatile LAS unsigned* MISC = (volatile LAS unsigned*)(C.lds + MISC_OFF);
    if (C.tid < 64) MISC[C.tid] = 0u;
    __syncthreads();
    const int lo = args.ph_lo, hi = args.ph_hi;
    XcdBarrier bar; bar.bar = C.w<unsigned>(WS_CTL) + CW_BAR; bar.x = 0; bar.st = nullptr;
    if (hi - lo > 1) bar = xcd_barrier_post(C.w<unsigned>(WS_CTL) + CW_BAR, MISC + 8);
#ifndef PHSEL
#define PHSEL(k) true
#endif
#define IN(k) (PHSEL(k) && lo <= (k) && (k) < hi)
#define SEAM(k) do { if (IN(k) && IN((k) + 1)) xcd_barrier(bar); } while (0)
    float* xout = args.out;

    if (IN(PH_PRO)) { const Ctx P = fresh(C); p_prologue(P); } SEAM(PH_PRO);
    if (IN(PH_NORM0)) { const Ctx P = fresh(C); p_normmod(P, P.in(IN_X), 0, 0, NT, P.w<bf16>(WS_HM)); } SEAM(PH_NORM0);
    if (IN(PH_QKV)) { const Ctx P = fresh(C);
        { pg8::PlainOrder S{(const char*)P.w<bf16>(WS_HM), (const char*)P.w<bf16>(WS_WINT), DM, DM, NT / 256, 2048 / 256, P.G, P.vcu, DM / 64};
          pg8::EpiBf16 E{P.w<bf16>(WS_QK), 2048, 0, nullptr, 0};
          pg8::gemm_phase<pg8::EpiBf16, pg8::PlainOrder, true>(P.lds, P.tid, DM, DM, S, E); }
        { pg8::PlainOrder S{(const char*)(P.w<bf16>(WS_WINT) + (size_t)2048 * DM), (const char*)P.w<bf16>(WS_HM), DM, DM, 1024 / 256, NT / 256, P.G, P.vcu, DM / 64};
          pg8::EpiBf16 E{P.w<bf16>(WS_VT), NT, 0, nullptr, 0};
          pg8::gemm_phase<pg8::EpiBf16, pg8::PlainOrder, true>(P.lds, P.tid, DM, DM, S, E); }
    } SEAM(PH_QKV);
    if (IN(PH_ATTN)) { const Ctx P = fresh(C); p_attention(P); } SEAM(PH_ATTN);
    if (IN(PH_OUT0)) { const Ctx P = fresh(C);
        pg8::PlainOrder S{(const char*)P.w<bf16>(WS_O), (const char*)P.w<bf16>(WS_WOT), DM, DM, NT / 256, DM / 256, P.G, P.vcu, DM / 64};
        pg8::EpiResid E{P.in(IN_X), xout, P.mods(0, 2)};
        pg8::gemm_phase<pg8::EpiResid, pg8::PlainOrder, true>(P.lds, P.tid, DM, DM, S, E);
    } SEAM(PH_OUT0);
    if (IN(PH_ROUTE0)) { const Ctx P = fresh(C); p_route(P, 0); } SEAM(PH_ROUTE0);
    if (IN(PH_PERM0)) { const Ctx P = fresh(C); p_permute(P, 0); } SEAM(PH_PERM0);
    if (IN(PH_UP0)) { const Ctx P = fresh(C); moe_up(P, 0); } SEAM(PH_UP0);
    if (IN(PH_DOWN0)) { const Ctx P = fresh(C); moe_down(P, 0); } SEAM(PH_DOWN0);
    if (IN(PH_COMB0)) { const Ctx P = fresh(C); p_combine(P, 0); LAS float* scr = (LAS float*)(P.lds + P.wave * 16384); moe_weight_items(P, 1, scr); } SEAM(PH_COMB0);

    if (IN(PH_NORM1)) { const Ctx P = fresh(C); p_normmod(P, xout, 1, 0, RT, P.w<bf16>(WS_HMR)); } SEAM(PH_NORM1);
    for (int round = 0; round < NROUND; ++round) {
        const int pb = PH_RND + 6 * round;
        if (IN(pb + 0)) { const Ctx P = fresh(C);
            pg8::PlainOrder S{(const char*)P.w<bf16>(WS_HMR), (const char*)P.w<bf16>(WS_MLWINT), DM, DM, RT / 256, 4096 / 256, P.G, P.vcu, DM / 64};
            pg8::EpiBf16 E{P.w<bf16>(WS_XMH), ML_IN, ML_IN, P.w<bf16>(WS_Y) + (size_t)round * RT * ML_IN, ML_IN};
            pg8::gemm_phase<pg8::EpiBf16, pg8::PlainOrder, true>(P.lds, P.tid, DM, DM, S, E);
        } SEAM(pb + 0);
        if (IN(pb + 1)) { const Ctx P = fresh(C); p_conv(P, round); } SEAM(pb + 1);
        if (IN(pb + 2)) { const Ctx P = fresh(C); p_cumsum(P); } SEAM(pb + 2);
        if (IN(pb + 3)) { const Ctx P = fresh(C);
            DecayOrder S{(const char*)P.w<bf16>(WS_Q), (const char*)P.w<bf16>(WS_K), P.G, P.vcu};
            EpiDecay E{P.w<bf16>(WS_W), P.w<float>(WS_FG), P.w<float>(WS_DEN)};
            pg8::gemm_phase<EpiDecay, DecayOrder, true>(P.lds, P.tid, ML_IN, ML_IN, S, E);
        } SEAM(pb + 3);
        if (IN(pb + 4)) { const Ctx P = fresh(C);
            HOrder S{(const char*)P.w<bf16>(WS_W), (const char*)P.w<bf16>(WS_VTR), P.G, P.vcu};
            EpiH E{P.w<bf16>(WS_Q), P.w<bf16>(WS_K), P.w<float>(WS_DEN)};
            pg8::gemm_phase<EpiH, HOrder, true>(P.lds, P.tid, WLD, SEQ, S, E);
        } SEAM(pb + 4);
        if (IN(pb + 5)) { const Ctx P = fresh(C); p_ynorm(P, round); if (round + 1 < NROUND) p_normmod(P, xout, 1, (round + 1) * RT, (round + 2) * RT, P.w<bf16>(WS_HMR)); } SEAM(pb + 5);
    }
    if (IN(PH_OUT1)) { const Ctx P = fresh(C);
        pg8::PlainOrder S{(const char*)P.w<bf16>(WS_Y), (const char*)P.w<bf16>(WS_MLWOUTT), ML_IN, ML_IN, NT / 256, DM / 256, P.G, P.vcu, ML_IN / 64};
        pg8::EpiResid E{xout, xout, P.mods(1, 2)};
        pg8::gemm_phase<pg8::EpiResid, pg8::PlainOrder, true>(P.lds, P.tid, ML_IN, ML_IN, S, E);
    } SEAM(PH_OUT1);
    if (IN(PH_ROUTE1)) { const Ctx P = fresh(C); p_route(P, 1); } SEAM(PH_ROUTE1);
    if (IN(PH_PERM1)) { const Ctx P = fresh(C); p_permute(P, 1); } SEAM(PH_PERM1);
    if (IN(PH_UP1)) { const Ctx P = fresh(C); moe_up(P, 1); } SEAM(PH_UP1);
    if (IN(PH_DOWN1)) { const Ctx P = fresh(C); moe_down(P, 1); } SEAM(PH_DOWN1);
    if (IN(PH_COMB1)) { const Ctx P = fresh(C); p_combine(P, 1); }
#undef IN
#undef SEAM
}

extern "C" void kernel_launch(void* const* d_in, const int* in_sizes, int n_in, void* d_out, int out_size, void* d_ws, size_t ws_size, hipStream_t stream) {
    static int grid = 0;
    if (grid == 0) {
        if (n_in != 32 || in_sizes[0] != NT * DM || out_size != NT * DM || ws_size < WS_END) { fprintf(stderr, "kernel_launch: unexpected shapes (n_in %d, in0 %d, out %d, ws %zu)\n", n_in, n_in > 0 ? in_sizes[0] : -1, out_size, ws_size); grid = -1; return; }
        int dev = 0, cus = 0, per_cu = 0;
        if (hipGetDevice(&dev) != hipSuccess || hipDeviceGetAttribute(&cus, hipDeviceAttributeMultiprocessorCount, dev) != hipSuccess) { grid = -1; return; }
        if (hipFuncSetAttribute((const void*)fwd_kernel, hipFuncAttributeMaxDynamicSharedMemorySize, LDS_BYTES) != hipSuccess) { fprintf(stderr, "kernel_launch: hipFuncSetAttribute failed\n"); grid = -1; return; }
        if (hipOccupancyMaxActiveBlocksPerMultiprocessor(&per_cu, (const void*)fwd_kernel, 512, LDS_BYTES) != hipSuccess || per_cu < 1) fprintf(stderr, "kernel_launch: occupancy query reports %d\n", per_cu);
        (void)hipGetLastError();
        grid = cus;
    }
    if (grid < 0) return;
    (void)hipMemsetAsync((char*)d_ws + WS_CTL, 0, CTL_ZERO_BYTES, stream);
    Args a{};
    for (int i = 0; i < 32; ++i) a.in[i] = (const float*)d_in[i];
    a.out = (float*)d_out; a.ws = (unsigned char*)d_ws;
#if MK_ONE_LAUNCH
    a.ph_lo = 0; a.ph_hi = N_PHASES;
    hipLaunchKernelGGL(fwd_kernel, dim3(grid), dim3(512), LDS_BYTES, stream, a);
#else
    for (int p = 0; p < N_PHASES; ++p) { a.ph_lo = p; a.ph_hi = p + 1; hipLaunchKernelGGL(fwd_kernel, dim3(grid), dim3(512), LDS_BYTES, stream, a); }
#endif
}
```

```cpp
#include <hip/hip_runtime.h>
#include <cstdio>
#include <cstdint>

#ifndef MK_ONE_LAUNCH
#define MK_ONE_LAUNCH 1
#endif

#define GAS __attribute__((address_space(1)))
#define LAS __attribute__((address_space(3)))
typedef unsigned short bf16;
typedef short bf16x8 __attribute__((ext_vector_type(8)));
typedef float f32x4 __attribute__((ext_vector_type(4)));
typedef float f32x16 __attribute__((ext_vector_type(16)));
typedef float f32x2 __attribute__((ext_vector_type(2)));
typedef unsigned u32x4 __attribute__((ext_vector_type(4)));
typedef unsigned u32x2 __attribute__((ext_vector_type(2)));

constexpr int NB = 16, SEQ = 2048, DM = 1024, NT = NB * SEQ;
constexpr int DA_H = 8;
constexpr int ML_IN = 2048, ML_H = 4, ML_DH = 512;
constexpr int NEXP = 32, DEXP = 256;
constexpr float EPS = 1e-6f;
constexpr float LOG2E = 1.4426950408889634f;
constexpr int RB = 4;
constexpr int NROUND = NB / RB;
constexpr int RT = RB * SEQ;
constexpr int WLD = 2304;
constexpr int MAXSLOT = 2 * NT + NEXP * 256;

constexpr size_t MiB = 1u << 20;
constexpr size_t WS_CTL = 0, CTL_ZERO_BYTES = 1 * MiB;
constexpr size_t WS_MODS = 2 * MiB;
constexpr size_t WS_TAB2 = 3 * MiB;
constexpr size_t WS_SCAL = 3 * MiB + 128 * 1024;
constexpr size_t WS_GWT = 3 * MiB + 256 * 1024;
constexpr size_t WS_RE = 4 * MiB;
constexpr size_t WS_RW = 4 * MiB + 256 * 1024;
constexpr size_t WS_RP = 4 * MiB + 512 * 1024;
constexpr size_t WS_PRE = 5 * MiB;
constexpr size_t WS_FG = 5 * MiB + 512 * 1024;
constexpr size_t WS_DEN = 6 * MiB;
constexpr size_t WS_WINT = 8 * MiB;
constexpr size_t WS_WOT = 14 * MiB;
constexpr size_t WS_MLWINT = 16 * MiB;
constexpr size_t WS_MLWOUTT = 24 * MiB;
constexpr size_t WS_W13T = 28 * MiB;
constexpr size_t WS_W2T = 60 * MiB;
constexpr size_t WS_BIG = 76 * MiB;
constexpr size_t WS_HM = WS_BIG + 0 * MiB;
constexpr size_t WS_QK = WS_BIG + 64 * MiB;
constexpr size_t WS_VT = WS_BIG + 192 * MiB;
constexpr size_t WS_O = WS_BIG + 256 * MiB;
constexpr size_t WS_HF = WS_BIG + 0 * MiB;
constexpr size_t WS_HS = WS_BIG + 64 * MiB;
constexpr size_t WS_HH = WS_BIG + 208 * MiB;
constexpr size_t WS_YS = WS_BIG + 244 * MiB;
constexpr size_t WS_Y = WS_BIG + 0 * MiB;
constexpr size_t WS_W = WS_BIG + 128 * MiB;
constexpr size_t WS_HMR = WS_BIG + 128 * MiB;
constexpr size_t WS_XMH = WS_BIG + 272 * MiB;
constexpr size_t WS_XC = WS_BIG + 304 * MiB;
constexpr size_t WS_Q = WS_BIG + 336 * MiB;
constexpr size_t WS_K = WS_BIG + 368 * MiB;
constexpr size_t WS_VTR = WS_BIG + 400 * MiB;
constexpr size_t WS_END = WS_BIG + 432 * MiB;
static_assert(WS_END <= 512 * MiB, "ws map");
static_assert((size_t)MAXSLOT * 1024 * 2 <= 144 * MiB && (size_t)MAXSLOT * 256 * 2 <= 36 * MiB, "slot buffers");
constexpr int CW_CNT = 64;
constexpr int CW_BAR = 4096;

constexpr int RING_BYTES = 131072;
constexpr int MISC_OFF = RING_BYTES;
constexpr int LDS_BYTES = RING_BYTES + 16384;

__device__ __forceinline__ unsigned f2bf(float f) { unsigned u = __builtin_bit_cast(unsigned, f); return (u + 0x7fffu + ((u >> 16) & 1u)) >> 16; }
__device__ __forceinline__ unsigned pk2(float lo, float hi) { return f2bf(lo) | (f2bf(hi) << 16); }
__device__ __forceinline__ float bf2f(unsigned short b) { return __builtin_bit_cast(float, ((unsigned)b) << 16); }
__device__ __forceinline__ float bflo(unsigned w) { return __builtin_bit_cast(float, w << 16); }
__device__ __forceinline__ float bfhi(unsigned w) { return __builtin_bit_cast(float, w & 0xffff0000u); }
__device__ __forceinline__ float wave_sum(float v) {
#pragma unroll
    for (int o = 1; o < 64; o <<= 1) v += __shfl_xor(v, o);
    return v;
}
__device__ __forceinline__ float silu_f(float v) { return v / (1.0f + __expf(-v)); }
#define LDS_WAIT() asm volatile("s_waitcnt lgkmcnt(0)" ::: "memory")
#define VM_WAIT() asm volatile("s_waitcnt vmcnt(0)" ::: "memory")
__device__ __forceinline__ int opaque_v(int x) { asm volatile("" : "+v"(x)); return x; }
__device__ __forceinline__ int lane_id() { return (int)__builtin_amdgcn_mbcnt_hi(~0u, __builtin_amdgcn_mbcnt_lo(~0u, 0u)); }

namespace pg8 {
constexpr int BM = 256, BK = 64, HALF = 128, HTB = HALF * BK * 2, STAGE_BYTES = 8 * HTB;
static_assert(STAGE_BYTES == RING_BYTES, "stage region");
__host__ __device__ __forceinline__ int lds_byte(int r, int c) { const int st = (r >> 4) * 2 + (c >> 5), rr = r & 15, cc = c & 31, ob = rr * 64 + cc * 2; return st * 1024 + (ob ^ (((ob >> 9) & 1) << 5)); }
__host__ __device__ __forceinline__ void stage_rc(int b, int& R, int& C) { const int st = b / 1024, sb = b % 1024, swz = sb ^ (((sb >> 9) & 1) << 5); R = (st >> 1) * 16 + swz / 64; C = (st & 1) * 32 + (swz % 64) / 2; }
__host__ __device__ __forceinline__ int perm32(int rho) { const int n = rho >> 4, i = rho & 15; return 8 * (i >> 2) + 4 * n + (i & 3); }

struct Unit { const char* A; const char* B; int r0, c0, a0, a1, nt, flags; };

__device__ __forceinline__ unsigned cvt_pk_bf16(float lo, float hi) { unsigned r; asm volatile("v_cvt_pk_bf16_f32 %0, %1, %2" : "=v"(r) : "v"(lo), "v"(hi)); return r; }

template <class Epi, class Sched, bool ALIGN_EPI>
__device__ __forceinline__ void gemm_phase(LAS unsigned char* lds, const int tid, const int lda, const int ldb, const Sched& S, const Epi& E) {
    const int wid = __builtin_amdgcn_readfirstlane(tid >> 6), lane = tid & 63, wr = wid >> 2, wc = wid & 3, fr = lane & 15, fq = lane >> 4;
    unsigned voffA[2], voffB[2];
#pragma unroll
    for (int i = 0; i < 2; ++i) { int R, C; stage_rc(tid * 16 + i * 8192, R, C); const int Rb = Epi::PERM ? ((R & ~31) + perm32(R & 31)) : R;
        voffA[i] = (unsigned)(R * lda + C) * 2u; voffB[i] = (unsigned)(Rb * ldb + C) * 2u; }
    const size_t kstep = (size_t)(BK * 2);
    const size_t hstepA = (size_t)HALF * lda * 2, hstepB = (size_t)HALF * ldb * 2;
    const unsigned ldsw = (unsigned)wid * 1024u;
    const int aoff = lds_byte(wr * 64 + fr, fq * 8), boff = lds_byte(wc * 32 + fr, fq * 8);
#define PG8_SA(b, h) (((b) * 2 + (h)) * HTB)
#define PG8_SB(b, h) ((4 + (b) * 2 + (h)) * HTB)
#define PG8_STAGE(bufoff, gbase, voff) do { _Pragma("unroll") for (int _i = 0; _i < 2; ++_i) \
        __builtin_amdgcn_global_load_lds((const unsigned*)((const char*)(gbase) + (voff)[_i]), (LAS unsigned*)(lds + (bufoff) + ldsw + _i * 8192), 16, 0, 0); } while (0)
#define PG8_LDA(dst, b, h) do { _Pragma("unroll") for (int m = 0; m < 4; ++m) _Pragma("unroll") for (int k = 0; k < 2; ++k) dst[m][k] = *(const LAS bf16x8*)(lds + PG8_SA(b, h) + aoff + m * 2048 + k * 1024); } while (0)
#define PG8_LDB(dst, b, h) do { _Pragma("unroll") for (int n = 0; n < 2; ++n) _Pragma("unroll") for (int k = 0; k < 2; ++k) dst[n][k] = *(const LAS bf16x8*)(lds + PG8_SB(b, h) + boff + n * 2048 + k * 1024); } while (0)
#define PG8_MMA(ai, bj, At, Bt) do { __builtin_amdgcn_s_setprio(1); _Pragma("unroll") for (int m = 0; m < 4; ++m) _Pragma("unroll") for (int n = 0; n < 2; ++n) _Pragma("unroll") for (int k = 0; k < 2; ++k) \
        acc[ai][bj][m][n] = __builtin_amdgcn_mfma_f32_16x16x32_bf16(Bt[n][k], At[m][k], acc[ai][bj][m][n], 0, 0, 0); __builtin_amdgcn_s_setprio(0); } while (0)
#define PG8_WAIT_V(n) asm volatile("s_waitcnt vmcnt(" #n ")" ::: "memory")
#define PG8_WAIT_L(n) asm volatile("s_waitcnt lgkmcnt(" #n ")" ::: "memory")
#define PG8_BAR __builtin_amdgcn_s_barrier()
#define PG8_SCHED __builtin_amdgcn_sched_barrier(0)
    Unit cur, nxt; int ui = 0;
    if (!S.next(0, cur)) return;
    f32x4 acc[2][2][4][2];
#pragma unroll
    for (int a = 0; a < 2; ++a)
#pragma unroll
        for (int b = 0; b < 2; ++b)
#pragma unroll
            for (int m = 0; m < 4; ++m)
#pragma unroll
                for (int n = 0; n < 2; ++n) acc[a][b][m][n] = (f32x4){0.f, 0.f, 0.f, 0.f};
    bf16x8 At[4][2], B0[2][2], B1[2][2];
    const char* cA = cur.A; const char* cB = cur.B;
    {
        const char* b0 = cB + (size_t)S.kb(cur, 0) * kstep; const char* b1 = cB + (size_t)S.kb(cur, 1) * kstep;
        PG8_STAGE(PG8_SB(0, 0), b0, voffB); PG8_STAGE(PG8_SB(0, 1), b0 + hstepB, voffB); PG8_STAGE(PG8_SA(0, 0), cA, voffA); PG8_STAGE(PG8_SA(0, 1), cA + hstepA, voffA);
        if (wr == 1) PG8_BAR;
        PG8_WAIT_V(2); PG8_BAR;
        PG8_STAGE(PG8_SB(1, 0), b1, voffB); PG8_STAGE(PG8_SA(1, 0), cA + kstep, voffA); PG8_STAGE(PG8_SB(1, 1), b1 + hstepB, voffB);
        PG8_WAIT_V(6); PG8_BAR;
    }
    for (;;) {
        const bool has_next = S.next(ui + 1, nxt);
        const Unit& nu = has_next ? nxt : cur;
        const char* nA = nu.A; const char* nB = nu.B;
        const int nt = cur.nt;
        for (int t = 0; t < nt; t += 2) {
            const bool last = (t == nt - 2);
            const char* a1 = cA + (size_t)(t + 1) * kstep;
            const char* a2 = last ? nA : cA + (size_t)(t + 2) * kstep;
            const char* a3 = a2 + kstep;
            const char* b2 = last ? nB + (size_t)S.kb(nu, 0) * kstep : cB + (size_t)S.kb(cur, t + 2) * kstep;
            const char* b3 = last ? nB + (size_t)S.kb(nu, 1) * kstep : cB + (size_t)S.kb(cur, t + 3) * kstep;
            PG8_LDB(B0, 0, 0); PG8_LDB(B1, 0, 1); PG8_SCHED; PG8_LDA(At, 0, 0); PG8_STAGE(PG8_SA(1, 1), a1 + hstepA, voffA);
            PG8_WAIT_V(8); PG8_WAIT_L(0); PG8_BAR; PG8_MMA(0, 0, At, B0); PG8_MMA(0, 1, At, B1); PG8_BAR; PG8_SCHED;
            PG8_LDA(At, 0, 1); PG8_STAGE(PG8_SB(0, 0), b2, voffB); PG8_STAGE(PG8_SB(0, 1), b2 + hstepB, voffB); PG8_STAGE(PG8_SA(0, 0), a2, voffA);
            PG8_WAIT_V(8); PG8_WAIT_L(0); PG8_BAR; PG8_MMA(1, 0, At, B0); PG8_MMA(1, 1, At, B1); PG8_BAR; PG8_SCHED;
            PG8_LDB(B0, 1, 0); PG8_LDB(B1, 1, 1); PG8_SCHED; PG8_LDA(At, 1, 0); PG8_STAGE(PG8_SA(0, 1), a2 + hstepA, voffA);
            PG8_WAIT_V(8); PG8_WAIT_L(0); PG8_BAR; PG8_MMA(0, 0, At, B0); PG8_MMA(0, 1, At, B1); PG8_BAR; PG8_SCHED;
            PG8_LDA(At, 1, 1); PG8_STAGE(PG8_SB(1, 0), b3, voffB); PG8_STAGE(PG8_SB(1, 1), b3 + hstepB, voffB); PG8_STAGE(PG8_SA(1, 0), a3, voffA);
            PG8_WAIT_V(8); PG8_WAIT_L(0); PG8_BAR; PG8_MMA(1, 0, At, B0); PG8_MMA(1, 1, At, B1); PG8_BAR; PG8_SCHED;
        }
        if constexpr (ALIGN_EPI) { if (wr == 0) PG8_BAR; }
        E(acc, cur, wr, wc, fr, fq);
        if (!has_next) break;
#pragma unroll
        for (int a = 0; a < 2; ++a)
#pragma unroll
            for (int b = 0; b < 2; ++b)
#pragma unroll
                for (int m = 0; m < 4; ++m)
#pragma unroll
                    for (int n = 0; n < 2; ++n) acc[a][b][m][n] = (f32x4){0.f, 0.f, 0.f, 0.f};
        cur = nxt; cA = nA; cB = nB; ++ui;
        if constexpr (ALIGN_EPI) { if (wr == 1) PG8_BAR; }
    }
    PG8_WAIT_V(0);
    if constexpr (!ALIGN_EPI) { if (wr == 0) PG8_BAR; }
    PG8_BAR;
#undef PG8_SA
#undef PG8_SB
#undef PG8_STAGE
#undef PG8_LDA
#undef PG8_LDB
#undef PG8_MMA
#undef PG8_WAIT_V
#undef PG8_WAIT_L
#undef PG8_BAR
#undef PG8_SCHED
}

struct PlainOrder {
    const char* A; const char* B; int lda, ldb, nM, nN, G, c, nt;
    __device__ __forceinline__ bool next(int i, Unit& u) const {
        const int L = i * G + c; if (L >= nM * nN) return false;
        const int pm = L / nN, pn = L - pm * nN;
        u.A = A + (size_t)pm * 256 * lda * 2; u.B = B + (size_t)pn * 256 * ldb * 2; u.r0 = pm * 256; u.c0 = pn * 256; u.a0 = 0; u.a1 = 0; u.nt = nt; u.flags = 3; return true;
    }
    __device__ __forceinline__ int kb(const Unit&, int t) const { return t; }
};
struct EpiBf16 {
    static constexpr bool PERM = true;
    bf16* O; int ldc; int split_cols; bf16* O2; int ldc2;
    __device__ __forceinline__ void operator()(const f32x4 (&acc)[2][2][4][2], const Unit& u, int wr, int wc, int fr_, int fq_) const {
        (void)fr_; (void)fq_; const int ln_ = opaque_v(lane_id()); const int fr = ln_ & 15, fq = ln_ >> 4;
        bf16* base = O; int ld = ldc; int colt = u.c0;
        if (split_cols > 0 && colt >= split_cols) { base = O2; ld = ldc2; colt -= split_cols; }
        const int row0 = u.r0 + wr * 64 + fr, col0 = colt + wc * 32 + 8 * fq;
#pragma unroll
        for (int ai = 0; ai < 2; ++ai)
#pragma unroll
            for (int m = 0; m < 4; ++m) { bf16* rowp = base + (size_t)(row0 + ai * HALF + m * 16) * ld + col0;
#pragma unroll
                for (int bj = 0; bj < 2; ++bj) { const f32x4 v0 = acc[ai][bj][m][0], v1 = acc[ai][bj][m][1];
                    u32x4 w; w.x = cvt_pk_bf16(v0[0], v0[1]); w.y = cvt_pk_bf16(v0[2], v0[3]); w.z = cvt_pk_bf16(v1[0], v1[1]); w.w = cvt_pk_bf16(v1[2], v1[3]);
                    *(u32x4*)(rowp + bj * HALF) = w; } }
    }
};
struct EpiResid {
    static constexpr bool PERM = false;
    const float* xin; float* out; const float* gate;
    __device__ __forceinline__ void operator()(const f32x4 (&acc)[2][2][4][2], const Unit& u, int wr, int wc, int fr_, int fq_) const {
        (void)fr_; (void)fq_; const int ln_ = opaque_v(lane_id()); const int fr = ln_ & 15, fq = ln_ >> 4;
        const int row0 = u.r0 + wr * 64 + fr, col0 = u.c0 + wc * 32 + 4 * fq;
        const float* g = gate + (size_t)(u.r0 / SEQ) * 6144 + col0;
        f32x4 gv[2][2];
#pragma unroll
        for (int bj = 0; bj < 2; ++bj)
#pragma unroll
            for (int n = 0; n < 2; ++n) gv[bj][n] = *(const f32x4*)(g + bj * HALF + n * 16);
#pragma unroll
        for (int ai = 0; ai < 2; ++ai)
#pragma unroll
            for (int m = 0; m < 4; ++m) { const size_t off = (size_t)(row0 + ai * HALF + m * 16) * DM + col0;
#pragma unroll
                for (int bj = 0; bj < 2; ++bj)
#pragma unroll
                    for (int n = 0; n < 2; ++n) { const f32x4 xv = *(const f32x4*)(xin + off + bj * HALF + n * 16);
                        *(f32x4*)(out + off + bj * HALF + n * 16) = xv + gv[bj][n] * acc[ai][bj][m][n]; }
                if (m & 1) asm volatile("" ::: "memory"); }
    }
};
}

#define XB_TMO      128
#define XB_XCNT(j)  (256  + 64 * (j))
#define XB_XSUB(j)  (1280 + 64 * (j))
#define XB_XGEN(j)  (2304 + 64 * (j))
#define XB_TOP      3328
#define XB_TOPGEN   3392
#define XCD_BAR_WORDS 3456
#define XB_SPIN_CAP (1u << 18)
__device__ __forceinline__ unsigned xb_ld(unsigned* p)              { return __hip_atomic_load(p, __ATOMIC_RELAXED, __HIP_MEMORY_SCOPE_AGENT); }
__device__ __forceinline__ unsigned xb_add(unsigned* p, unsigned v) { return __hip_atomic_fetch_add(p, v, __ATOMIC_RELAXED, __HIP_MEMORY_SCOPE_AGENT); }
__device__ __forceinline__ unsigned xb_xcc_id() { return (unsigned)__builtin_amdgcn_s_getreg((3 << 11) | 20) & 0xFu; }
#define XB_SPIN(cond, bar) do { unsigned _sp = 0; while (cond) { __builtin_amdgcn_s_sleep(1); \
    if ((++_sp & 255u) == 0u) { if (xb_ld(&(bar)[XB_TMO])) break; if (_sp > XB_SPIN_CAP) { atomicAdd(&(bar)[XB_TMO], 1u); break; } } } } while (0)
struct XcdBarrier { unsigned* bar; unsigned x; volatile LAS unsigned* st; };
__device__ __forceinline__ XcdBarrier xcd_barrier_post(unsigned* bar, volatile LAS unsigned* st) {
    XcdBarrier b; b.bar = bar; b.x = xb_xcc_id(); b.st = st;
    if (threadIdx.x == 0) (void)xb_add(&bar[XB_XCNT(b.x)], 1u);
    return b;
}
__device__ __forceinline__ void xcd_barrier_complete(unsigned* bar, unsigned x, unsigned& nloc, unsigned& nx) {
    const unsigned G = gridDim.x * gridDim.y * gridDim.z;
    unsigned sum, cnt, mine, sp = 0u;
    for (;;) {
        sum = 0u; cnt = 0u; mine = 0u;
#pragma unroll
        for (unsigned j = 0; j < 16; ++j) { const unsigned c = xb_ld(&bar[XB_XCNT(j)]); sum += c; cnt += (c > 0u) ? 1u : 0u; mine = (j == x) ? c : mine; }
        if (sum == G) break;
        __builtin_amdgcn_s_sleep(1);
        if ((++sp & 255u) == 0u) { if (xb_ld(&bar[XB_TMO])) break; if (sp > XB_SPIN_CAP) { atomicAdd(&bar[XB_TMO], 1u); break; } }
    }
    nloc = mine > 0u ? mine : 1u; nx = cnt > 0u ? cnt : 1u;
}
__device__ __forceinline__ void xcd_barrier(const XcdBarrier& b) {
    asm volatile("s_waitcnt vmcnt(0)" ::: "memory");
    __syncthreads();
    if (threadIdx.x == 0) {
        unsigned* bar = b.bar;
        __builtin_amdgcn_s_waitcnt(0);
        unsigned nloc = b.st[0], nx = b.st[1];
        if (nloc == 0u) { xcd_barrier_complete(bar, b.x, nloc, nx); b.st[0] = nloc; b.st[1] = nx; }
        const unsigned old = xb_add(&bar[XB_XSUB(b.x)], 1u);
        const unsigned gen = old / nloc;
        if (old + 1u == (gen + 1u) * nloc) {
            __builtin_amdgcn_fence(__ATOMIC_RELEASE, "agent");
            asm volatile("s_waitcnt vmcnt(0)" ::: "memory");
            const unsigned og = xb_add(&bar[XB_TOP], 1u);
            const unsigned tg = og / nx;
            if (og + 1u == (tg + 1u) * nx) xb_add(&bar[XB_TOPGEN], 1u);
            else XB_SPIN(xb_ld(&bar[XB_TOPGEN]) == tg, bar);
            __builtin_amdgcn_fence(__ATOMIC_ACQUIRE, "agent");
            xb_add(&bar[XB_XGEN(b.x)], 1u);
            asm volatile("s_waitcnt vmcnt(0)" ::: "memory");
        } else {
            XB_SPIN(xb_ld(&bar[XB_XGEN(b.x)]) == gen, bar);
            __builtin_amdgcn_fence(__ATOMIC_ACQUIRE, "agent");
            asm volatile("s_waitcnt vmcnt(0)" ::: "memory");
        }
    }
    __syncthreads();
}

struct Args { const float* in[32]; float* out; unsigned char* ws; int ph_lo, ph_hi; };
enum { IN_X = 0, IN_C, IN_REL, IN_ADAW, IN_ADAB, IN_NMG, IN_NFG, IN_DAWIN, IN_DAWOUT, IN_QG, IN_KG, IN_LQ1, IN_LK1, IN_LQ2, IN_LK2, IN_SUBLN,
       IN_MLWIN, IN_CONVW, IN_CONVB, IN_WQ, IN_WK, IN_WV, IN_GATEW, IN_GATEB, IN_ONG, IN_SKIP, IN_MLWOUT, IN_WGRP, IN_WRT, IN_W1, IN_W3, IN_W2 };

struct Ctx {
    const Args* a; unsigned char* ws; LAS unsigned char* lds; int tid, lane, wave, G, vcu;
    __device__ __forceinline__ const float* in(int i) const { return a->in[i]; }
    template <class Tp> __device__ __forceinline__ Tp* w(size_t off) const { return (Tp*)(ws + off); }
    __device__ __forceinline__ const float* mods(int layer, int which) const { return (const float*)(ws + WS_MODS) + (size_t)layer * 16 * 6144 + which * 1024; }
};

__device__ __forceinline__ Ctx fresh(const Ctx& C) {
    Ctx P = C; int t = C.tid; asm volatile("" : "+v"(t)); P.tid = t; P.lane = t & 63; P.wave = __builtin_amdgcn_readfirstlane(t >> 6);
    unsigned char* w = C.ws; asm volatile("" : "+s"(w)); P.ws = w; int g = __builtin_amdgcn_readfirstlane(C.G), v = __builtin_amdgcn_readfirstlane(C.vcu); asm volatile("" : "+s"(g), "+s"(v)); P.G = g; P.vcu = v;
    return P;
}
__device__ __forceinline__ void transpose_item(const float* W, int K, int N, bf16* WT, int ldt, int dst_row0, LAS float* scr, int kb, int nb, int lane) {
    const int k0 = 64 * kb, n0 = 32 * nb;
#pragma unroll 8
    for (int i = 0; i < 32; ++i) { const int kk = 2 * i + (lane >> 5); scr[kk * 33 + (lane & 31)] = W[(size_t)(k0 + kk) * N + n0 + (lane & 31)]; }
    LDS_WAIT(); asm volatile("" ::: "memory");
    const int c = lane & 7;
#pragma unroll
    for (int j = 0; j < 4; ++j) { const int n = (lane >> 3) + 8 * j; const LAS float* s = scr + (8 * c) * 33 + n;
        u32x4 o; o.x = pk2(s[0 * 33], s[1 * 33]); o.y = pk2(s[2 * 33], s[3 * 33]); o.z = pk2(s[4 * 33], s[5 * 33]); o.w = pk2(s[6 * 33], s[7 * 33]);
        *(u32x4*)(WT + (size_t)(dst_row0 + n) * ldt + k0 + 8 * c) = o; }
    LDS_WAIT(); asm volatile("" ::: "memory");
}
__device__ __forceinline__ void moe_weight_items(const Ctx& C, int layer, LAS float* scr) {
    const int gw = C.vcu * 8 + C.wave, NGW = C.G * 8;
    const float* w1 = C.in(IN_W1) + (size_t)layer * NEXP * DM * DEXP; const float* w3 = C.in(IN_W3) + (size_t)layer * NEXP * DM * DEXP; const float* w2 = C.in(IN_W2) + (size_t)layer * NEXP * DEXP * DM;
    bf16* W13T = C.w<bf16>(WS_W13T); bf16* W2T = C.w<bf16>(WS_W2T);
    constexpr int I13 = 16 * 8, I2 = 4 * 32;
    for (int it = gw; it < NEXP * (2 * I13 + I2); it += NGW) {
        const int e = it / (2 * I13 + I2); int r = it - e * (2 * I13 + I2);
        if (r < 2 * I13) { const int which = r / I13; r -= which * I13; const int kb = r / 8, nb = r % 8; const int n0 = 32 * nb;
            const int dst = (n0 / 128) * 256 + which * 128 + (n0 % 128);
            transpose_item((which ? w3 : w1) + (size_t)e * DM * DEXP, DM, DEXP, W13T + (size_t)e * 512 * DM, DM, dst, scr, kb, nb, C.lane); }
        else { r -= 2 * I13; const int kb = r / 32, nb = r % 32;
            transpose_item(w2 + (size_t)e * DEXP * DM, DEXP, DM, W2T + (size_t)e * DM * DEXP, DEXP, 32 * nb, scr, kb, nb, C.lane); }
    }
}
__device__ __forceinline__ void plain_weight_items(const Ctx& C, const float* W, int K, int N, bf16* WT, LAS float* scr) {
    const int gw = C.vcu * 8 + C.wave, NGW = C.G * 8; const int nblk = N / 32;
    for (int it = gw; it < (K / 64) * nblk; it += NGW) { const int kb = it / nblk, nb = it % nblk; transpose_item(W, K, N, WT, K, 32 * nb, scr, kb, nb, C.lane); }
}
__device__ __forceinline__ int t5_bucket(int rel) {
    const int n = rel < 0 ? -rel : rel; int b;
    if (n < 8) b = n; else b = 8 + (n >= 12) + (n >= 16) + (n >= 23) + (n >= 32) + (n >= 46) + (n >= 64) + (n >= 91);
    return b + (rel > 0 ? 16 : 0);
}
__device__ __forceinline__ void p_prologue(const Ctx& C) {
    {
        LAS float* cact = (LAS float*)C.lds;
        LAS float* red = (LAS float*)(C.lds + 65536);
        const float* c = C.in(IN_C);
        for (int i = C.tid; i < 16 * 1024; i += 512) cact[i] = silu_f(c[i]);
        __syncthreads();
        for (int task = C.vcu; task < 192; task += C.G) {
            const int layer = task / 96, n0 = (task % 96) * 64, nl = C.tid & 63, kc = C.tid >> 6;
            const float* W = C.in(IN_ADAW) + (size_t)layer * DM * 6144 + n0 + nl;
            float acc[16];
#pragma unroll
            for (int b = 0; b < 16; ++b) acc[b] = 0.f;
            for (int k = kc * 128; k < kc * 128 + 128; ++k) { const float wv = W[(size_t)k * 6144];
#pragma unroll
                for (int b = 0; b < 16; ++b) acc[b] += cact[b * 1024 + k] * wv; }
#pragma unroll
            for (int b = 0; b < 16; ++b) red[(kc * 16 + b) * 64 + nl] = acc[b];
            __syncthreads();
            for (int o = C.tid; o < 16 * 64; o += 512) { const int b = o >> 6, n = o & 63; float s = 0.f;
#pragma unroll
                for (int q = 0; q < 8; ++q) s += red[(q * 16 + b) * 64 + n];
                C.w<float>(WS_MODS)[(size_t)layer * 16 * 6144 + (size_t)b * 6144 + n0 + n] = s + C.in(IN_ADAB)[layer * 6144 + n0 + n]; }
            __syncthreads();
        }
    }
    {
        const int gt = C.vcu * 512 + C.tid, NGT = C.G * 512;
        float mq = 0.f, mk = 0.f;
        for (int i = 0; i < 64; ++i) { mq = fmaxf(mq, fabsf(C.in(IN_QG)[i])); mk = fmaxf(mk, fabsf(C.in(IN_KG)[i])); }
        for (int i = gt; i < 8 * 4096; i += NGT) { const int h = i >> 12, idx = i & 4095; if (idx < 4095) {
            float mb = -1e30f; for (int b = 0; b < 32; ++b) mb = fmaxf(mb, C.in(IN_REL)[b * 8 + h]);
            const float cshift = 8.0f * mq * mk + mb;
            C.w<float>(WS_TAB2)[i] = (C.in(IN_REL)[t5_bucket(idx - 2047) * 8 + h] - cshift) * LOG2E; } else C.w<float>(WS_TAB2)[i] = 0.f; }
        if (gt == 0) { float s1 = 0.f, s2 = 0.f; for (int i = 0; i < 64; ++i) { s1 += C.in(IN_LQ1)[i] * C.in(IN_LK1)[i]; s2 += C.in(IN_LQ2)[i] * C.in(IN_LK2)[i]; }
            C.w<float>(WS_SCAL)[0] = __expf(s1) - __expf(s2) + 0.2f; }
        for (int i = gt; i < 16 * 6144; i += NGT) { const int n = i / 6144, k = i % 6144, d = n >> 3, g = n & 7, m = k / 2048, c = k % 2048;
            C.w<bf16>(WS_GWT)[i] = (bf16)f2bf(C.in(IN_GATEW)[(((size_t)d * 3 + m) * 2048 + c) * 8 + g]); }
    }
    LAS float* scr = (LAS float*)(C.lds + C.wave * 16384);
    plain_weight_items(C, C.in(IN_DAWIN), DM, 3 * DM, C.w<bf16>(WS_WINT), scr);
    plain_weight_items(C, C.in(IN_DAWOUT), DM, DM, C.w<bf16>(WS_WOT), scr);
    plain_weight_items(C, C.in(IN_MLWIN), DM, 2 * ML_IN, C.w<bf16>(WS_MLWINT), scr);
    plain_weight_items(C, C.in(IN_MLWOUT), ML_IN, DM, C.w<bf16>(WS_MLWOUTT), scr);
    moe_weight_items(C, 0, scr);
}

__device__ __forceinline__ void normmod_row(const float* xrow, const float* g, const float* sc, const float* sh, bf16* orow, int lane) {
    const f32x4* xr = (const f32x4*)xrow + lane; f32x4 v[4]; float s = 0.f;
#pragma unroll
    for (int j = 0; j < 4; ++j) { v[j] = xr[64 * j]; s += (v[j].x * v[j].x + v[j].y * v[j].y) + (v[j].z * v[j].z + v[j].w * v[j].w); }
    const float rstd = 1.0f / sqrtf(wave_sum(s) * (1.0f / DM) + EPS);
    u32x2* o8 = (u32x2*)orow + lane;
#pragma unroll
    for (int j = 0; j < 4; ++j) { const f32x4 gv = ((const f32x4*)g)[lane + 64 * j], scv = ((const f32x4*)sc)[lane + 64 * j], shv = ((const f32x4*)sh)[lane + 64 * j];
        const f32x4 y = (v[j] * rstd * gv) * (scv + 1.0f) + shv; u32x2 w; w.x = pk2(y.x, y.y); w.y = pk2(y.z, y.w); o8[64 * j] = w; }
}
__device__ __forceinline__ void p_normmod(const Ctx& C, const float* xsrc, int layer, int row_lo, int row_hi, bf16* dst) {
    const int gw = C.vcu * 8 + C.wave, NGW = C.G * 8;
    const float* g = C.in(IN_NMG) + layer * DM;
    for (int r = row_lo + gw; r < row_hi; r += NGW) { const int b = r / SEQ;
        normmod_row(xsrc + (size_t)r * DM, g, C.mods(layer, 1) + (size_t)b * 6144, C.mods(layer, 0) + (size_t)b * 6144, dst + (size_t)(r - row_lo) * DM, C.lane); }
}

constexpr int AT_KS = 144, AT_VS = 136;
constexpr int AT_K_OFF = 0, AT_K_BYTES = 2 * 64 * AT_KS;
constexpr int AT_V_OFF = AT_K_BYTES, AT_V_BYTES = 128 * AT_VS;
constexpr int AT_TAB_OFF = AT_V_OFF + AT_V_BYTES;
constexpr int AT_EX_OFF = 0, AT_EX_PITCH = 132;
static_assert(AT_TAB_OFF % 16 == 0 && AT_TAB_OFF + 16384 <= RING_BYTES && 4 * 32 * AT_EX_PITCH * 4 <= RING_BYTES, "attention LDS");
__device__ __forceinline__ void attn_unit(const Ctx& C, int b, int h, int qt) {
    LAS unsigned char* lds = C.lds;
    const int tid = C.tid, lane = C.lane, wid = C.wave, mp = wid >> 2, rb = wid & 3, r32 = lane & 31, hi = lane >> 5;
    const bf16* QK = C.w<bf16>(WS_QK); const bf16* VT = C.w<bf16>(WS_VT);
    const size_t tok0 = (size_t)b * SEQ; const int q0 = qt * 128;
    LAS float* tab = (LAS float*)(lds + AT_TAB_OFF);
    __syncthreads();
    { const float* t2 = C.w<float>(WS_TAB2) + h * 4096; for (int i = tid; i < 4096; i += 512) tab[i] = t2[i]; }
    bf16x8 qf[4];
    {
        const bf16* qrow = QK + (tok0 + q0 + rb * 32 + r32) * 2048 + h * 128 + mp * 64 + hi * 8;
        float qv[4][8]; float ss = 0.f;
#pragma unroll
        for (int ks = 0; ks < 4; ++ks) { const u32x4 w = *(const u32x4*)(qrow + ks * 16);
            qv[ks][0] = bflo(w.x); qv[ks][1] = bfhi(w.x); qv[ks][2] = bflo(w.y); qv[ks][3] = bfhi(w.y); qv[ks][4] = bflo(w.z); qv[ks][5] = bfhi(w.z); qv[ks][6] = bflo(w.w); qv[ks][7] = bfhi(w.w);
#pragma unroll
            for (int j = 0; j < 8; ++j) ss += qv[ks][j] * qv[ks][j]; }
        ss += __shfl_xor(ss, 32);
        const float rs = (1.0f / sqrtf(ss * (1.0f / 64.0f) + EPS)) * (0.125f * LOG2E);
        const float* qg = C.in(IN_QG);
#pragma unroll
        for (int ks = 0; ks < 4; ++ks) { u32x4 w; const float* gg = qg + ks * 16 + hi * 8;
            w.x = pk2(qv[ks][0] * rs * gg[0], qv[ks][1] * rs * gg[1]); w.y = pk2(qv[ks][2] * rs * gg[2], qv[ks][3] * rs * gg[3]);
            w.z = pk2(qv[ks][4] * rs * gg[4], qv[ks][5] * rs * gg[5]); w.w = pk2(qv[ks][6] * rs * gg[6], qv[ks][7] * rs * gg[7]);
            qf[ks] = __builtin_bit_cast(bf16x8, w); }
    }
    const int kkey = tid >> 4, kcc = tid & 15, vdv = tid >> 3, vkc = tid & 7;
    const bf16* ksrc = QK + (tok0 + kkey) * 2048 + 1024 + h * 128 + kcc * 8;
    const bf16* vsrc = VT + (size_t)(h * 128 + vdv) * NT + tok0 + vkc * 8;
    float kgain[8];
#pragma unroll
    for (int j = 0; j < 8; ++j) kgain[j] = C.in(IN_KG)[(kcc & 7) * 8 + j];
    u32x4 kst[2], vst[2];
#define AT_LOAD(t) do { const int k0_ = (t) * 64; kst[0] = *(const u32x4*)(ksrc + (size_t)k0_ * 2048); kst[1] = *(const u32x4*)(ksrc + (size_t)(k0_ + 32) * 2048); \
        vst[0] = *(const u32x4*)(vsrc + k0_); vst[1] = *(const u32x4*)(vsrc + (size_t)64 * NT + k0_); } while (0)
    AT_LOAD(0);
    f32x16 o[4];
#pragma unroll
    for (int i = 0; i < 4; ++i) o[i] = (f32x16){0.f, 0.f, 0.f, 0.f, 0.f, 0.f, 0.f, 0.f, 0.f, 0.f, 0.f, 0.f, 0.f, 0.f, 0.f, 0.f};
    float lsum = 0.f;
    const LAS unsigned char* kfp = lds + AT_K_OFF + (mp * 64 + r32) * AT_KS + hi * 16;
    const LAS unsigned char* vfp = lds + AT_V_OFF + r32 * AT_VS + hi * 8;
    for (int t = 0; t < 32; ++t) {
        __syncthreads();
#pragma unroll
        for (int i = 0; i < 2; ++i) { const u32x4 w = kst[i]; float v[8] = {bflo(w.x), bfhi(w.x), bflo(w.y), bfhi(w.y), bflo(w.z), bfhi(w.z), bflo(w.w), bfhi(w.w)};
            float ss = 0.f;
#pragma unroll
            for (int j = 0; j < 8; ++j) ss += v[j] * v[j];
            ss += __shfl_xor(ss, 1); ss += __shfl_xor(ss, 2); ss += __shfl_xor(ss, 4);
            const float rs = 1.0f / sqrtf(ss * (1.0f / 64.0f) + EPS);
            u32x4 ow; ow.x = pk2(v[0] * rs * kgain[0], v[1] * rs * kgain[1]); ow.y = pk2(v[2] * rs * kgain[2], v[3] * rs * kgain[3]);
            ow.z = pk2(v[4] * rs * kgain[4], v[5] * rs * kgain[5]); ow.w = pk2(v[6] * rs * kgain[6], v[7] * rs * kgain[7]);
            *(LAS u32x4*)(lds + AT_K_OFF + ((kcc >> 3) * 64 + kkey + 32 * i) * AT_KS + (kcc & 7) * 16) = ow;
            LAS u32x2* vd = (LAS u32x2*)(lds + AT_V_OFF + (vdv + 64 * i) * AT_VS + vkc * 16);
            vd[0] = (u32x2){vst[i].x, vst[i].y}; vd[1] = (u32x2){vst[i].z, vst[i].w}; }
        if (t + 1 < 32) AT_LOAD(t + 1);
        __syncthreads();
        const int k0 = t * 64;
        bf16x8 pf[4];
#pragma unroll
        for (int kb = 0; kb < 2; ++kb) {
            f32x16 s = (f32x16){0.f, 0.f, 0.f, 0.f, 0.f, 0.f, 0.f, 0.f, 0.f, 0.f, 0.f, 0.f, 0.f, 0.f, 0.f, 0.f};
#pragma unroll
            for (int ks = 0; ks < 4; ++ks) { const bf16x8 kf = *(const LAS bf16x8*)(kfp + kb * 32 * AT_KS + ks * 32); s = __builtin_amdgcn_mfma_f32_32x32x16_bf16(kf, qf[ks], s, 0, 0, 0); }
            const LAS float* tp = tab + (k0 + 32 * kb + 4 * hi - (q0 + 32 * rb + r32) + 2047);
            float p[16];
#pragma unroll
            for (int r = 0; r < 16; ++r) { p[r] = __builtin_amdgcn_exp2f(s[r] + tp[(r & 3) + 8 * (r >> 2)]); lsum += p[r]; }
#pragma unroll
            for (int sh = 0; sh < 2; ++sh) { u32x4 w; w.x = pk2(p[8 * sh + 0], p[8 * sh + 1]); w.y = pk2(p[8 * sh + 2], p[8 * sh + 3]); w.z = pk2(p[8 * sh + 4], p[8 * sh + 5]); w.w = pk2(p[8 * sh + 6], p[8 * sh + 7]);
                pf[2 * kb + sh] = __builtin_bit_cast(bf16x8, w); }
        }
#pragma unroll
        for (int dvb = 0; dvb < 4; ++dvb)
#pragma unroll
            for (int s4 = 0; s4 < 4; ++s4) { const u32x2 lo = *(const LAS u32x2*)(vfp + dvb * 32 * AT_VS + s4 * 32), hi2 = *(const LAS u32x2*)(vfp + dvb * 32 * AT_VS + s4 * 32 + 16);
                const u32x4 w = (u32x4){lo.x, lo.y, hi2.x, hi2.y};
                o[dvb] = __builtin_amdgcn_mfma_f32_32x32x16_bf16(__builtin_bit_cast(bf16x8, w), pf[s4], o[dvb], 0, 0, 0); }
    }
#undef AT_LOAD
    lsum += __shfl_xor(lsum, 32);
    const float lam = C.w<float>(WS_SCAL)[0];
    const float sc = (mp == 0 ? 1.0f : lam) / lsum;
    __syncthreads();
    LAS float* ex = (LAS float*)(lds + AT_EX_OFF) + (rb * 32 + r32) * AT_EX_PITCH;
    if (mp == 1) {
#pragma unroll
        for (int dvb = 0; dvb < 4; ++dvb)
#pragma unroll
            for (int g = 0; g < 4; ++g) *(LAS f32x4*)(ex + dvb * 32 + 8 * g + 4 * hi) = (f32x4){o[dvb][4 * g] * sc, o[dvb][4 * g + 1] * sc, o[dvb][4 * g + 2] * sc, o[dvb][4 * g + 3] * sc};
    }
    __syncthreads();
    if (mp == 0) {
        float ss = 0.f;
#pragma unroll
        for (int dvb = 0; dvb < 4; ++dvb)
#pragma unroll
            for (int g = 0; g < 4; ++g) { const f32x4 e = *(const LAS f32x4*)(ex + dvb * 32 + 8 * g + 4 * hi);
#pragma unroll
                for (int i = 0; i < 4; ++i) { const float v = o[dvb][4 * g + i] * sc - e[i]; o[dvb][4 * g + i] = v; ss += v * v; } }
        ss += __shfl_xor(ss, 32);
        const float rs = (1.0f / sqrtf(ss * (1.0f / 128.0f) + EPS)) * 0.8f;
        bf16* orow = C.w<bf16>(WS_O) + (tok0 + q0 + rb * 32 + r32) * DM + h * 128;
        const float* sg = C.in(IN_SUBLN);
#pragma unroll
        for (int dvb = 0; dvb < 4; ++dvb)
#pragma unroll
            for (int g = 0; g < 4; ++g) { const int dv = dvb * 32 + 8 * g + 4 * hi; const f32x4 gv = *(const f32x4*)(sg + dv);
                u32x2 w; w.x = pk2(o[dvb][4 * g] * rs * gv.x, o[dvb][4 * g + 1] * rs * gv.y); w.y = pk2(o[dvb][4 * g + 2] * rs * gv.z, o[dvb][4 * g + 3] * rs * gv.w);
                *(u32x2*)(orow + dv) = w; }
    }
}
__device__ __forceinline__ void p_attention(const Ctx& C) {
    for (int u = C.vcu; u < NB * DA_H * 16; u += C.G) { const int qt = u & 15, bh = u >> 4; attn_unit(C, bh >> 3, bh & 7, qt); }
    __syncthreads();
}

__device__ __forceinline__ void p_route(const Ctx& C, int layer) {
    const float* x = C.a->out; const int lane = C.lane, tok = lane & 15, kq = lane >> 4;
    const float* g = C.in(IN_NFG) + layer * DM;
    const float* wr_ = C.in(IN_WRT) + (size_t)layer * DM * 32; const float* wg_ = C.in(IN_WGRP) + (size_t)layer * DM * 4;
    unsigned* cnt = C.w<unsigned>(WS_CTL) + CW_CNT + layer * 64;
    LAS float* lg = (LAS float*)(C.lds) + C.wave * (16 * 48);
    bf16* HF = C.w<bf16>(WS_HF);
    for (int wt = C.vcu * 8 + C.wave; wt < NT / 16; wt += C.G * 8) {
        const int t0 = wt * 16, b = t0 / SEQ;
        const float* xrow = x + (size_t)(t0 + tok) * DM + 4 * kq;
        float ss = 0.f;
        for (int kk = 0; kk < 64; ++kk) { const f32x4 v = *(const f32x4*)(xrow + 16 * kk); ss += (v.x * v.x + v.y * v.y) + (v.z * v.z + v.w * v.w); }
        ss += __shfl_xor(ss, 16); ss += __shfl_xor(ss, 32);
        const float rstd = 1.0f / sqrtf(ss * (1.0f / DM) + EPS);
        const float* sc = C.mods(layer, 4) + (size_t)b * 6144 + 4 * kq; const float* sh = C.mods(layer, 3) + (size_t)b * 6144 + 4 * kq;
        f32x4 a0 = (f32x4){0.f, 0.f, 0.f, 0.f}, a1 = a0, a2 = a0;
        bf16* hrow = HF + (size_t)(t0 + tok) * DM + 4 * kq;
        for (int kk = 0; kk < 64; ++kk) {
            const f32x4 v = *(const f32x4*)(xrow + 16 * kk), gv = *(const f32x4*)(g + 16 * kk + 4 * kq), scv = *(const f32x4*)(sc + 16 * kk), shv = *(const f32x4*)(sh + 16 * kk);
            const f32x4 hf = (v * rstd * gv) * (scv + 1.0f) + shv;
            u32x2 w; w.x = pk2(hf.x, hf.y); w.y = pk2(hf.z, hf.w); *(u32x2*)(hrow + 16 * kk) = w;
#pragma unroll
            for (int i = 0; i < 4; ++i) { const int k = 16 * kk + 4 * kq + i;
                const float b0 = wr_[k * 32 + tok], b1 = wr_[k * 32 + 16 + tok], b2 = tok < 4 ? wg_[k * 4 + tok] : 0.f;
                a0 = __builtin_amdgcn_mfma_f32_16x16x4f32(hf[i], b0, a0, 0, 0, 0); a1 = __builtin_amdgcn_mfma_f32_16x16x4f32(hf[i], b1, a1, 0, 0, 0); a2 = __builtin_amdgcn_mfma_f32_16x16x4f32(hf[i], b2, a2, 0, 0, 0); }
        }
#pragma unroll
        for (int r = 0; r < 4; ++r) { lg[(4 * kq + r) * 48 + tok] = a0[r]; lg[(4 * kq + r) * 48 + 16 + tok] = a1[r]; lg[(4 * kq + r) * 48 + 32 + tok] = a2[r]; }
        LDS_WAIT(); asm volatile("" ::: "memory");
        if (lane < 16) {
            const LAS float* L = lg + lane * 48;
            int gs = 0; float gm = L[32];
#pragma unroll
            for (int j = 1; j < 4; ++j) { const float v = L[32 + j]; if (v > gm) { gm = v; gs = j; } }
            float gsum = 0.f;
#pragma unroll
            for (int j = 0; j < 4; ++j) gsum += __expf(L[32 + j] - gm);
            const float pg = 1.0f / gsum;
            int ia = 0; float la = L[gs * 8];
#pragma unroll
            for (int j = 1; j < 8; ++j) { const float v = L[gs * 8 + j]; if (v > la) { la = v; ia = j; } }
            int ib = -1; float lb = -3.0e38f;
#pragma unroll
            for (int j = 0; j < 8; ++j) { const float v = L[gs * 8 + j]; if (j != ia && v > lb) { lb = v; ib = j; } }
            const float wa = pg / (1.0f + __expf(lb - la)), wb = pg - wa;
            const int ea = gs * 8 + ia, eb = gs * 8 + ib, t = t0 + lane;
            const unsigned pa = atomicAdd(cnt + ea, 1u), pb = atomicAdd(cnt + eb, 1u);
            C.w<int>(WS_RE)[2 * t] = ea; C.w<int>(WS_RE)[2 * t + 1] = eb; C.w<float>(WS_RW)[2 * t] = wa; C.w<float>(WS_RW)[2 * t + 1] = wb;
            C.w<int>(WS_RP)[2 * t] = (int)pa; C.w<int>(WS_RP)[2 * t + 1] = (int)pb;
        }
        LDS_WAIT(); asm volatile("" ::: "memory");
    }
}
struct MoeTab { LAS int* off; LAS int* tile_e; LAS int* ntile; };
__device__ __forceinline__ MoeTab moe_tables(const Ctx& C, int layer) {
    MoeTab T; T.off = (LAS int*)(C.lds + MISC_OFF + 256); T.tile_e = T.off + 64; T.ntile = T.off + 48;
    __syncthreads();
    if (C.tid == 0) { const unsigned* cnt = C.w<unsigned>(WS_CTL) + CW_CNT + layer * 64; int o = 0, nt = 0;
        for (int e = 0; e < NEXP; ++e) { const int c = (int)__hip_atomic_load(cnt + e, __ATOMIC_RELAXED, __HIP_MEMORY_SCOPE_AGENT); T.off[e] = o; const int tiles = (c + 255) >> 8; for (int j = 0; j < tiles; ++j) T.tile_e[nt + j] = e; nt += tiles; o += tiles * 256; }
        T.off[32] = o; T.ntile[0] = nt; }
    __syncthreads();
    return T;
}
__device__ __forceinline__ void p_permute(const Ctx& C, int layer) {
    const MoeTab T = moe_tables(C, layer);
    const bf16* HF = C.w<bf16>(WS_HF); bf16* HS = C.w<bf16>(WS_HS);
    int* RP = C.w<int>(WS_RP); const int* RE = C.w<int>(WS_RE);
    for (int p = C.vcu * 8 + C.wave; p < 2 * NT; p += C.G * 8) {
        const int e = RE[p], pos = RP[p], slot = T.off[e] + pos, t = p >> 1;
        const u32x4* s = (const u32x4*)(HF + (size_t)t * DM) + C.lane; u32x4* d = (u32x4*)(HS + (size_t)slot * DM) + C.lane;
        const u32x4 v0 = s[0], v1 = s[64]; d[0] = v0; d[64] = v1;
        asm volatile("" ::: "memory");
        if (C.lane == 0) RP[p] = slot;
    }
}
template <int NPN> struct MoeOrder {
    MoeTab T; const char* A; const char* B; int lda_bytes; size_t b_expert_bytes; int b_tile_bytes; int G, c, nt;
    __device__ __forceinline__ bool next(int i, pg8::Unit& u) const {
        const int L = i * G + c; const int rt = L / NPN, pn = L - rt * NPN; if (rt >= T.ntile[0]) return false;
        const int e = T.tile_e[rt];
        u.A = A + (size_t)rt * 256 * lda_bytes; u.B = B + (size_t)e * b_expert_bytes + (size_t)pn * b_tile_bytes; u.r0 = rt * 256; u.c0 = pn * 256; u.a0 = e; u.a1 = pn; u.nt = nt; u.flags = 3; return true;
    }
    __device__ __forceinline__ int kb(const pg8::Unit&, int t) const { return t; }
};
struct EpiSwiGLU {
    static constexpr bool PERM = true;
    bf16* H;
    __device__ __forceinline__ void operator()(const f32x4 (&acc)[2][2][4][2], const pg8::Unit& u, int wr, int wc, int fr_, int fq_) const {
        (void)fr_; (void)fq_; const int ln_ = opaque_v(lane_id()); const int fr = ln_ & 15, fq = ln_ >> 4;
        const int row0 = u.r0 + wr * 64 + fr, col0 = u.a1 * 128 + wc * 32 + 8 * fq;
#pragma unroll
        for (int ai = 0; ai < 2; ++ai)
#pragma unroll
            for (int m = 0; m < 4; ++m) { float r[8];
#pragma unroll
                for (int n = 0; n < 2; ++n)
#pragma unroll
                    for (int i = 0; i < 4; ++i) { const float a = acc[ai][0][m][n][i], b = acc[ai][1][m][n][i]; r[4 * n + i] = silu_f(a) * b; }
                u32x4 w; w.x = pk2(r[0], r[1]); w.y = pk2(r[2], r[3]); w.z = pk2(r[4], r[5]); w.w = pk2(r[6], r[7]);
                *(u32x4*)(H + (size_t)(row0 + ai * 128 + m * 16) * DEXP + col0) = w; }
    }
};
__device__ __forceinline__ void p_combine(const Ctx& C, int layer) {
    float* x = C.a->out; const bf16* YS = C.w<bf16>(WS_YS); const int* RP = C.w<int>(WS_RP); const float* RW = C.w<float>(WS_RW);
    for (int t = C.vcu * 8 + C.wave; t < NT; t += C.G * 8) {
        const int s0 = RP[2 * t], s1 = RP[2 * t + 1]; const float w0 = RW[2 * t], w1 = RW[2 * t + 1];
        const float* g2 = C.mods(layer, 5) + (size_t)(t / SEQ) * 6144;
        const u32x4* y0 = (const u32x4*)(YS + (size_t)s0 * DM) + C.lane; const u32x4* y1 = (const u32x4*)(YS + (size_t)s1 * DM) + C.lane;
        float* xr = x + (size_t)t * DM + 8 * C.lane;
#pragma unroll
        for (int j = 0; j < 2; ++j) { const u32x4 a = y0[64 * j], b = y1[64 * j]; const f32x4 ga = *(const f32x4*)(g2 + 512 * j + 8 * C.lane), gb = *(const f32x4*)(g2 + 512 * j + 8 * C.lane + 4);
            f32x4 xa = *(f32x4*)(xr + 512 * j), xb = *(f32x4*)(xr + 512 * j + 4);
            xa.x += ga.x * (w0 * bflo(a.x) + w1 * bflo(b.x)); xa.y += ga.y * (w0 * bfhi(a.x) + w1 * bfhi(b.x)); xa.z += ga.z * (w0 * bflo(a.y) + w1 * bflo(b.y)); xa.w += ga.w * (w0 * bfhi(a.y) + w1 * bfhi(b.y));
            xb.x += gb.x * (w0 * bflo(a.z) + w1 * bflo(b.z)); xb.y += gb.y * (w0 * bfhi(a.z) + w1 * bfhi(b.z)); xb.z += gb.z * (w0 * bflo(a.w) + w1 * bflo(b.w)); xb.w += gb.w * (w0 * bfhi(a.w) + w1 * bfhi(b.w));
            *(f32x4*)(xr + 512 * j) = xa; *(f32x4*)(xr + 512 * j + 4) = xb; }
    }
}

constexpr int CV_XM = 0;
constexpr int CV_QKV = 18432;
constexpr int CV_QKV_P = 1552;
constexpr int CV_VT = CV_QKV + 32 * CV_QKV_P;
constexpr int CV_RED = CV_VT + 256 * 80;
static_assert(CV_RED + 16384 <= RING_BYTES && CV_VT % 16 == 0 && CV_RED % 16 == 0, "conv LDS");
__device__ __forceinline__ void conv_unit(const Ctx& C, int round, int bl, int ti) {
    LAS unsigned char* lds = C.lds; const int tid = C.tid, lane = C.lane, wid = C.wave;
    const int s0 = ti * 32; const size_t rrow0 = (size_t)bl * SEQ;
    const bf16* XM = C.w<bf16>(WS_XMH); bf16* XC = C.w<bf16>(WS_XC); bf16* Q = C.w<bf16>(WS_Q); bf16* K = C.w<bf16>(WS_K); bf16* VTR = C.w<bf16>(WS_VTR);
    const bf16* GWT = C.w<bf16>(WS_GWT);
    f32x4 gacc[2]; gacc[0] = (f32x4){0.f, 0.f, 0.f, 0.f}; gacc[1] = gacc[0];
    const int nblk = tid & 63, tg = tid >> 6;
    for (int ch = 0; ch < 8; ++ch) {
        const int c0 = ch * 256;
        __syncthreads();
        for (int i = tid; i < 36 * 32; i += 512) { const int r = i >> 5, cc = i & 31, s = s0 - 2 + r; u32x4 v = (u32x4){0u, 0u, 0u, 0u};
            if (s >= 0 && s < SEQ) v = *(const u32x4*)(XM + (rrow0 + s) * ML_IN + c0 + cc * 8);
            *(LAS u32x4*)(lds + CV_XM + r * 512 + cc * 16) = v; }
        __syncthreads();
        {
            const int c = c0 + 4 * nblk;
            float cw[5][4], cb[4], wq[4][4], wk[4][4], wv[4][4];
            const float* convw = C.in(IN_CONVW); const float* convb = C.in(IN_CONVB);
#pragma unroll
            for (int j = 0; j < 5; ++j) { const f32x4 v = *(const f32x4*)(convw + j * ML_IN + c); cw[j][0] = v.x; cw[j][1] = v.y; cw[j][2] = v.z; cw[j][3] = v.w; }
            { const f32x4 v = *(const f32x4*)(convb + c); cb[0] = v.x; cb[1] = v.y; cb[2] = v.z; cb[3] = v.w; }
            const int nb = c >> 2;
#pragma unroll
            for (int i = 0; i < 4; ++i) { const f32x4 a = *(const f32x4*)(C.in(IN_WQ) + nb * 16 + i * 4), b = *(const f32x4*)(C.in(IN_WK) + nb * 16 + i * 4), d = *(const f32x4*)(C.in(IN_WV) + nb * 16 + i * 4);
                wq[i][0] = a.x; wq[i][1] = a.y; wq[i][2] = a.z; wq[i][3] = a.w; wk[i][0] = b.x; wk[i][1] = b.y; wk[i][2] = b.z; wk[i][3] = b.w; wv[i][0] = d.x; wv[i][1] = d.y; wv[i][2] = d.z; wv[i][3] = d.w; }
            float xw[8][4];
#pragma unroll
            for (int r = 0; r < 8; ++r) { const u32x2 v = *(const LAS u32x2*)(lds + CV_XM + (4 * tg + r) * 512 + nblk * 8); xw[r][0] = bflo(v.x); xw[r][1] = bfhi(v.x); xw[r][2] = bflo(v.y); xw[r][3] = bfhi(v.y); }
#pragma unroll
            for (int tt = 0; tt < 4; ++tt) {
                const int tl = 4 * tg + tt;
                float xc[4], qv[4], kv[4], vv[4];
#pragma unroll
                for (int i = 0; i < 4; ++i) { float a = cb[i];
#pragma unroll
                    for (int j = 0; j < 5; ++j) a += cw[j][i] * xw[tt + j][i];
                    xc[i] = silu_f(a); }
#pragma unroll
                for (int o = 0; o < 4; ++o) { float a = 0.f, b = 0.f, d = 0.f;
#pragma unroll
                    for (int i = 0; i < 4; ++i) { a += xc[i] * wq[i][o]; b += xc[i] * wk[i][o]; d += xw[tt + 2][i] * wv[i][o]; }
                    qv[o] = a; kv[o] = b; vv[o] = d; }
                const size_t grow = (rrow0 + s0 + tl) * ML_IN + c;
                const u32x2 xcw = (u32x2){pk2(xc[0], xc[1]), pk2(xc[2], xc[3])}, qw = (u32x2){pk2(qv[0], qv[1]), pk2(qv[2], qv[3])}, kw = (u32x2){pk2(kv[0], kv[1]), pk2(kv[2], kv[3])}, vw = (u32x2){pk2(vv[0], vv[1]), pk2(vv[2], vv[3])};
                *(u32x2*)(XC + grow) = xcw; *(u32x2*)(Q + grow) = qw; *(u32x2*)(K + grow) = kw;
                LAS unsigned char* qrow = lds + CV_QKV + tl * CV_QKV_P + nblk * 8;
                *(LAS u32x2*)(qrow) = qw; *(LAS u32x2*)(qrow + 512) = kw; *(LAS u32x2*)(qrow + 1024) = vw;
                LAS unsigned short* vt = (LAS unsigned short*)(lds + CV_VT) + (4 * nblk) * 40 + tl;
                vt[0] = (unsigned short)(vw.x & 0xffffu); vt[40] = (unsigned short)(vw.x >> 16); vt[80] = (unsigned short)(vw.y & 0xffffu); vt[120] = (unsigned short)(vw.y >> 16);
            }
        }
        __syncthreads();
        for (int i = tid; i < 256 * 4; i += 512) { const int cr = i >> 2, cc = i & 3; const int cg = c0 + cr, head = cg >> 9, dv = cg & 511;
            const LAS u32x2* s = (const LAS u32x2*)(lds + CV_VT + cr * 80 + cc * 16); const u32x2 a = s[0], b2 = s[1];
            *(u32x4*)(VTR + ((size_t)(bl * 4 + head) * 512 + dv) * SEQ + s0 + cc * 8) = (u32x4){a.x, a.y, b2.x, b2.y}; }
#pragma unroll
        for (int ks = 0; ks < 3; ++ks) { const int kk = 96 * wid + 32 * ks + 8 * (lane >> 4);
            const int m = kk >> 8, cl = kk & 255;
            const bf16x8 bfr = *(const bf16x8*)(GWT + (size_t)(lane & 15) * 6144 + m * 2048 + c0 + cl);
#pragma unroll
            for (int tgp = 0; tgp < 2; ++tgp) { const bf16x8 afr = *(const LAS bf16x8*)(lds + CV_QKV + (16 * tgp + (lane & 15)) * CV_QKV_P + kk * 2);
                gacc[tgp] = __builtin_amdgcn_mfma_f32_16x16x32_bf16(afr, bfr, gacc[tgp], 0, 0, 0); } }
    }
    __syncthreads();
    LAS float* red = (LAS float*)(lds + CV_RED);
#pragma unroll
    for (int tgp = 0; tgp < 2; ++tgp)
#pragma unroll
        for (int r = 0; r < 4; ++r) red[(wid * 32 + 16 * tgp + 4 * (lane >> 4) + r) * 16 + (lane & 15)] = gacc[tgp][r];
    __syncthreads();
    { const int tkn = tid >> 4, n = tid & 15; float s = C.in(IN_GATEB)[n];
#pragma unroll
        for (int w = 0; w < 8; ++w) s += red[(w * 32 + tkn) * 16 + n];
        C.w<float>(WS_PRE)[(rrow0 + s0 + tkn) * 16 + n] = s; }
    (void)round;
}
__device__ __forceinline__ void p_conv(const Ctx& C, int round) {
    for (int u = C.vcu; u < RB * 64; u += C.G) conv_unit(C, round, u >> 6, u & 63);
    __syncthreads();
}
__device__ __forceinline__ void p_cumsum(const Ctx& C) {
    float* FG = C.w<float>(WS_FG); const float* PRE = C.w<float>(WS_PRE); float* DEN = C.w<float>(WS_DEN);
    for (int i = C.vcu * 512 + C.tid; i < 2 * 16 * 2048; i += C.G * 512) DEN[i] = 0.f;
    const int gw = C.vcu * 8 + C.wave;
    if (gw < 32) {
        const int dir = gw & 1, bh = gw >> 1, bl = bh >> 2, hd = bh & 3, lane = C.lane;
        const float* p = PRE + (size_t)bl * SEQ * 16 + dir * 8;
        float lf[32], ii[32]; float tot = 0.f;
#pragma unroll
        for (int j = 0; j < 32; ++j) { const int s = lane * 32 + j; const float f = p[(size_t)s * 16 + 4 + hd]; ii[j] = p[(size_t)s * 16 + hd];
            lf[j] = fminf(f, 0.f) - log1pf(__expf(-fabsf(f))); tot += lf[j]; }
        float inc = tot;
#pragma unroll
        for (int o = 1; o < 64; o <<= 1) { const float v = __shfl_up(inc, o); if (lane >= o) inc += v; }
        const float all = __shfl(inc, 63);
        float* F = FG + (size_t)(dir * 2) * 16 * 2048 + (size_t)bh * 2048; float* Gp = F + 16 * 2048;
        if (dir == 0) { float run = inc - tot;
#pragma unroll
            for (int j = 0; j < 32; ++j) { run += lf[j]; const int s = lane * 32 + j; F[s] = run * LOG2E; Gp[s] = (ii[j] - run) * LOG2E - 4.5f; } }
        else { float run = all - (inc - tot);
#pragma unroll
            for (int j = 0; j < 32; ++j) { const int s = lane * 32 + j; F[s] = run * LOG2E; Gp[s] = (ii[j] - run) * LOG2E - 4.5f; run -= lf[j]; } }
    }
}
struct DecayOrder {
    const char* Qb; const char* Kb; int G, c;
    __device__ __forceinline__ bool next(int ii, pg8::Unit& u) const {
        const int L = ii * G + c; if (L >= 16 * 64) return false;
        const int bh = L >> 6, i = (L >> 3) & 7, j = L & 7, bl = bh >> 2, hd = bh & 3;
        u.A = Qb + ((size_t)(bl * SEQ + 256 * i) * ML_IN + hd * 512) * 2; u.B = Kb + ((size_t)(bl * SEQ + 256 * j) * ML_IN + hd * 512) * 2; u.r0 = 256 * i; u.c0 = 256 * j; u.a0 = bh; u.a1 = (i << 4) | j; u.nt = ML_DH / 64; u.flags = 3; return true;
    }
    __device__ __forceinline__ int kb(const pg8::Unit&, int t) const { return t; }
};
struct EpiDecay {
    static constexpr bool PERM = true;
    bf16* W; const float* FG; float* DEN;
    __device__ __forceinline__ void pass(const f32x4 (&acc)[2][2][4][2], const pg8::Unit& u, int wr, int wc, int fr, int fq, int dir, int dmin, int dmax, int cblk) const {
        const int bh = u.a0; const float* F = FG + (size_t)(dir * 2) * 16 * 2048 + (size_t)bh * 2048; const float* Gp = F + 16 * 2048;
        const int rl0 = opaque_v(wr * 64 + fr), cl0 = opaque_v(wc * 32 + 8 * fq);
        f32x4 gv[2][2];
#pragma unroll
        for (int bj = 0; bj < 2; ++bj)
#pragma unroll
            for (int n = 0; n < 2; ++n) gv[bj][n] = *(const f32x4*)(Gp + u.c0 + cl0 + bj * 128 + 4 * n);
        bf16* wbase = W + ((size_t)bh * SEQ + u.r0) * WLD + cblk * 256 + cl0;
        float* den = DEN + (size_t)dir * 16 * 2048 + (size_t)bh * 2048 + u.r0;
        const float* Fr = F + u.r0;
#pragma unroll
        for (int ai = 0; ai < 2; ++ai)
#pragma unroll
            for (int m = 0; m < 4; ++m) { const int rl = rl0 + ai * 128 + m * 16; const float fv = Fr[rl]; float rs = 0.f;
#pragma unroll
                for (int bj = 0; bj < 2; ++bj) { float r[8];
#pragma unroll
                    for (int n = 0; n < 2; ++n)
#pragma unroll
                        for (int i = 0; i < 4; ++i) { const int d = cl0 + bj * 128 + 4 * n + i - rl; float wv = acc[ai][bj][m][n][i] * __builtin_amdgcn_exp2f(fv + gv[bj][n][i]);
                            wv = (d >= dmin && d <= dmax) ? wv : 0.f; r[4 * n + i] = wv; rs += wv; }
                    u32x4 w; w.x = pk2(r[0], r[1]); w.y = pk2(r[2], r[3]); w.z = pk2(r[4], r[5]); w.w = pk2(r[6], r[7]);
                    *(u32x4*)(wbase + (size_t)rl * WLD + bj * 128) = w; }
                rs += __shfl_xor(rs, 16); rs += __shfl_xor(rs, 32);
                if (fq == 0) atomicAdd(den + rl, rs); }
    }
    __device__ __forceinline__ void operator()(const f32x4 (&acc)[2][2][4][2], const pg8::Unit& u, int wr, int wc, int fr_, int fq_) const {
        (void)fr_; (void)fq_; const int ln_ = opaque_v(lane_id()); const int fr = ln_ & 15, fq = ln_ >> 4;
        const int i = u.a1 >> 4, j = u.a1 & 15;
        const int npass = (i == j) ? 2 : 1;
        for (int p = 0; p < npass; ++p) {
            int dir, dmin, dmax, cblk;
            if (j < i) { dir = 0; dmin = -100000; dmax = 100000; cblk = j; }
            else if (j > i) { dir = 1; dmin = -100000; dmax = 100000; cblk = j + 1; }
            else if (p == 0) { dir = 0; dmin = -100000; dmax = 0; cblk = i; }
            else { dir = 1; dmin = 0; dmax = 100000; cblk = i + 1; }
            pass(acc, u, wr, wc, fr, fq, dir, dmin, dmax, cblk);
        }
    }
};
struct HOrder {
    const char* Wb; const char* Vb; int G, c;
    __device__ __forceinline__ bool next(int ii, pg8::Unit& u) const {
        const int L = (ii >> 1) * G + c, part = ii & 1; if (L >= 16 * 16) return false;
        const int bh = L >> 4, i = (L >> 1) & 7, jn = L & 1;
        const int kt0 = part ? 4 * (i + 1) : 0;
        u.A = Wb + (((size_t)bh * SEQ + 256 * i) * WLD + (size_t)kt0 * 64) * 2;
        u.B = Vb + (((size_t)bh * 512 + 256 * jn) * SEQ + (size_t)(part ? 4 * i : 0) * 64) * 2;
        u.r0 = 256 * i; u.c0 = 256 * jn; u.a0 = bh; u.a1 = part; u.nt = part ? 36 - 4 * (i + 1) : 4 * (i + 1); u.flags = 3; return true;
    }
    __device__ __forceinline__ int kb(const pg8::Unit&, int t) const { return t; }
};
struct EpiH {
    static constexpr bool PERM = true;
    bf16* HF; bf16* HB; const float* DEN;
    __device__ __forceinline__ void operator()(const f32x4 (&acc)[2][2][4][2], const pg8::Unit& u, int wr, int wc, int fr_, int fq_) const {
        (void)fr_; (void)fq_; const int ln_ = opaque_v(lane_id()); const int fr = ln_ & 15, fq = ln_ >> 4;
        const int bh = u.a0, bl = bh >> 2, hd = bh & 3, part = u.a1; const float* dn = DEN + (size_t)part * 16 * 2048 + (size_t)bh * 2048 + u.r0;
        const int rl0 = wr * 64 + fr, col0 = hd * 512 + u.c0 + wc * 32 + 8 * fq;
        bf16* Hh = part ? HB : HF;
#pragma unroll
        for (int ai = 0; ai < 2; ++ai)
#pragma unroll
            for (int m = 0; m < 4; ++m) { const int rl = rl0 + ai * 128 + m * 16; const float rv = 1.0f / fmaxf(fabsf(dn[rl]), 1.0f);
                bf16* rowp = Hh + ((size_t)bl * SEQ + u.r0 + rl) * ML_IN + col0;
#pragma unroll
                for (int bj = 0; bj < 2; ++bj) { const f32x4 v0 = acc[ai][bj][m][0] * rv, v1 = acc[ai][bj][m][1] * rv;
                    u32x4 w; w.x = pk2(v0[0], v0[1]); w.y = pk2(v0[2], v0[3]); w.z = pk2(v1[0], v1[1]); w.w = pk2(v1[2], v1[3]);
                    *(u32x4*)(rowp + bj * 128) = w; } }
    }
};
__device__ __forceinline__ void p_ynorm(const Ctx& C, int round) {
    const bf16* HF = C.w<bf16>(WS_Q); const bf16* HB = C.w<bf16>(WS_K); const bf16* XC = C.w<bf16>(WS_XC); bf16* Y = C.w<bf16>(WS_Y) + (size_t)round * RT * ML_IN;
    const float* og = C.in(IN_ONG); const float* skip = C.in(IN_SKIP);
    for (int r = C.vcu * 8 + C.wave; r < RT; r += C.G * 8) {
        const size_t off = (size_t)r * ML_IN + 8 * C.lane;
#pragma unroll
        for (int hd = 0; hd < 4; ++hd) {
            const u32x4 hw = *(const u32x4*)(HF + off + hd * 512), hw2 = *(const u32x4*)(HB + off + hd * 512), xw = *(const u32x4*)(XC + off + hd * 512), zw = *(const u32x4*)(Y + off + hd * 512);
            float hv[8] = {bflo(hw.x) + bflo(hw2.x), bfhi(hw.x) + bfhi(hw2.x), bflo(hw.y) + bflo(hw2.y), bfhi(hw.y) + bfhi(hw2.y), bflo(hw.z) + bflo(hw2.z), bfhi(hw.z) + bfhi(hw2.z), bflo(hw.w) + bflo(hw2.w), bfhi(hw.w) + bfhi(hw2.w)};
            const float xv[8] = {bflo(xw.x), bfhi(xw.x), bflo(xw.y), bfhi(xw.y), bflo(xw.z), bfhi(xw.z), bflo(xw.w), bfhi(xw.w)};
            const float zv[8] = {bflo(zw.x), bfhi(zw.x), bflo(zw.y), bfhi(zw.y), bflo(zw.z), bfhi(zw.z), bflo(zw.w), bfhi(zw.w)};
            float ss = 0.f;
#pragma unroll
            for (int j = 0; j < 8; ++j) ss += hv[j] * hv[j];
            const float rs = 1.0f / sqrtf(wave_sum(ss) * (1.0f / 512.0f) + EPS);
            const float* gg = og + hd * 512 + 8 * C.lane; const float* sk = skip + hd * 512 + 8 * C.lane; float yv[8];
#pragma unroll
            for (int j = 0; j < 8; ++j) yv[j] = (hv[j] * rs * gg[j] + sk[j] * xv[j]) * silu_f(zv[j]);
            u32x4 w; w.x = pk2(yv[0], yv[1]); w.y = pk2(yv[2], yv[3]); w.z = pk2(yv[4], yv[5]); w.w = pk2(yv[6], yv[7]);
            *(u32x4*)(Y + off + hd * 512) = w;
        }
    }
}

constexpr int PH_PRO = 0, PH_NORM0 = 1, PH_QKV = 2, PH_ATTN = 3, PH_OUT0 = 4, PH_ROUTE0 = 5, PH_PERM0 = 6, PH_UP0 = 7, PH_DOWN0 = 8, PH_COMB0 = 9,
              PH_NORM1 = 10, PH_RND = 11  , PH_OUT1 = PH_RND + 6 * NROUND, PH_ROUTE1 = PH_OUT1 + 1, PH_PERM1 = PH_OUT1 + 2,
              PH_UP1 = PH_OUT1 + 3, PH_DOWN1 = PH_OUT1 + 4, PH_COMB1 = PH_OUT1 + 5, N_PHASES = PH_OUT1 + 6;

__device__ __forceinline__ void moe_up(const Ctx& C, int layer) {
    const MoeTab T = moe_tables(C, layer);
    MoeOrder<2> S; S.T = T; S.A = (const char*)C.w<bf16>(WS_HS); S.B = (const char*)C.w<bf16>(WS_W13T); S.lda_bytes = DM * 2; S.b_expert_bytes = (size_t)512 * DM * 2; S.b_tile_bytes = 256 * DM * 2; S.G = C.G; S.c = C.vcu; S.nt = DM / 64;
    EpiSwiGLU E{C.w<bf16>(WS_HH)};
    pg8::gemm_phase<EpiSwiGLU, MoeOrder<2>, true>(C.lds, C.tid, DM, DM, S, E);
}
__device__ __forceinline__ void moe_down(const Ctx& C, int layer) {
    const MoeTab T = moe_tables(C, layer);
    MoeOrder<4> S; S.T = T; S.A = (const char*)C.w<bf16>(WS_HH); S.B = (const char*)C.w<bf16>(WS_W2T); S.lda_bytes = DEXP * 2; S.b_expert_bytes = (size_t)DM * DEXP * 2; S.b_tile_bytes = 256 * DEXP * 2; S.G = C.G; S.c = C.vcu; S.nt = DEXP / 64;
    pg8::EpiBf16 E{C.w<bf16>(WS_YS), DM, 0, nullptr, 0};
    pg8::gemm_phase<pg8::EpiBf16, MoeOrder<4>, true>(C.lds, C.tid, DEXP, DEXP, S, E);
}

__global__ void __launch_bounds__(512, 2) fwd_kernel(Args args) {
    extern __shared__ __attribute__((aligned(16))) unsigned char lds_raw[];
    Ctx C; C.a = &args; C.ws = args.ws; C.lds = (LAS unsigned char*)lds_raw; C.tid = threadIdx.x; C.lane = C.tid & 63; C.wave = __builtin_amdgcn_readfirstlane(C.tid >> 6);
    C.G = gridDim.x; { const int bx = blockIdx.x; C.vcu = (C.G % 8 == 0) ? (bx % 8) * (C.G / 8) + bx / 8 : bx; }
    volatile LAS unsigned* MISC = (volatile LAS unsigned*)(C.lds + MISC_OFF);
    if (C.tid < 64) MISC[C.tid] = 0u;
    __syncthreads();
    const int lo = args.ph_lo, hi = args.ph_hi;
    XcdBarrier bar; bar.bar = C.w<unsigned>(WS_CTL) + CW_BAR; bar.x = 0; bar.st = nullptr;
    if (hi - lo > 1) bar = xcd_barrier_post(C.w<unsigned>(WS_CTL) + CW_BAR, MISC + 8);
#ifndef PHSEL
#define PHSEL(k) true
#endif
#define IN(k) (PHSEL(k) && lo <= (k) && (k) < hi)
#define SEAM(k) do { if (IN(k) && IN((k) + 1)) xcd_barrier(bar); } while (0)
    float* xout = args.out;

    if (IN(PH_PRO)) { const Ctx P = fresh(C); p_prologue(P); } SEAM(PH_PRO);
    if (IN(PH_NORM0)) { const Ctx P = fresh(C); p_normmod(P, P.in(IN_X), 0, 0, NT, P.w<bf16>(WS_HM)); } SEAM(PH_NORM0);
    if (IN(PH_QKV)) { const Ctx P = fresh(C);
        { pg8::PlainOrder S{(const char*)P.w<bf16>(WS_HM), (const char*)P.w<bf16>(WS_WINT), DM, DM, NT / 256, 2048 / 256, P.G, P.vcu, DM / 64};
          pg8::EpiBf16 E{P.w<bf16>(WS_QK), 2048, 0, nullptr, 0};
          pg8::gemm_phase<pg8::EpiBf16, pg8::PlainOrder, true>(P.lds, P.tid, DM, DM, S, E); }
        { pg8::PlainOrder S{(const char*)(P.w<bf16>(WS_WINT) + (size_t)2048 * DM), (const char*)P.w<bf16>(WS_HM), DM, DM, 1024 / 256, NT / 256, P.G, P.vcu, DM / 64};
          pg8::EpiBf16 E{P.w<bf16>(WS_VT), NT, 0, nullptr, 0};
          pg8::gemm_phase<pg8::EpiBf16, pg8::PlainOrder, true>(P.lds, P.tid, DM, DM, S, E); }
    } SEAM(PH_QKV);
    if (IN(PH_ATTN)) { const Ctx P = fresh(C); p_attention(P); } SEAM(PH_ATTN);
    if (IN(PH_OUT0)) { const Ctx P = fresh(C);
        pg8::PlainOrder S{(const char*)P.w<bf16>(WS_O), (const char*)P.w<bf16>(WS_WOT), DM, DM, NT / 256, DM / 256, P.G, P.vcu, DM / 64};
        pg8::EpiResid E{P.in(IN_X), xout, P.mods(0, 2)};
        pg8::gemm_phase<pg8::EpiResid, pg8::PlainOrder, true>(P.lds, P.tid, DM, DM, S, E);
    } SEAM(PH_OUT0);
    if (IN(PH_ROUTE0)) { const Ctx P = fresh(C); p_route(P, 0); } SEAM(PH_ROUTE0);
    if (IN(PH_PERM0)) { const Ctx P = fresh(C); p_permute(P, 0); } SEAM(PH_PERM0);
    if (IN(PH_UP0)) { const Ctx P = fresh(C); moe_up(P, 0); } SEAM(PH_UP0);
    if (IN(PH_DOWN0)) { const Ctx P = fresh(C); moe_down(P, 0); } SEAM(PH_DOWN0);
    if (IN(PH_COMB0)) { const Ctx P = fresh(C); p_combine(P, 0); LAS float* scr = (LAS float*)(P.lds + P.wave * 16384); moe_weight_items(P, 1, scr); } SEAM(PH_COMB0);

    if (IN(PH_NORM1)) { const Ctx P = fresh(C); p_normmod(P, xout, 1, 0, RT, P.w<bf16>(WS_HMR)); } SEAM(PH_NORM1);
    for (int round = 0; round < NROUND; ++round) {
        const int pb = PH_RND + 6 * round;
        if (IN(pb + 0)) { const Ctx P = fresh(C);
            pg8::PlainOrder S{(const char*)P.w<bf16>(WS_HMR), (const char*)P.w<bf16>(WS_MLWINT), DM, DM, RT / 256, 4096 / 256, P.G, P.vcu, DM / 64};
            pg8::EpiBf16 E{P.w<bf16>(WS_XMH), ML_IN, ML_IN, P.w<bf16>(WS_Y) + (size_t)round * RT * ML_IN, ML_IN};
            pg8::gemm_phase<pg8::EpiBf16, pg8::PlainOrder, true>(P.lds, P.tid, DM, DM, S, E);
        } SEAM(pb + 0);
        if (IN(pb + 1)) { const Ctx P = fresh(C); p_conv(P, round); } SEAM(pb + 1);
        if (IN(pb + 2)) { const Ctx P = fresh(C); p_cumsum(P); } SEAM(pb + 2);
        if (IN(pb + 3)) { const Ctx P = fresh(C);
            DecayOrder S{(const char*)P.w<bf16>(WS_Q), (const char*)P.w<bf16>(WS_K), P.G, P.vcu};
            EpiDecay E{P.w<bf16>(WS_W), P.w<float>(WS_FG), P.w<float>(WS_DEN)};
            pg8::gemm_phase<EpiDecay, DecayOrder, true>(P.lds, P.tid, ML_IN, ML_IN, S, E);
        } SEAM(pb + 3);
        if (IN(pb + 4)) { const Ctx P = fresh(C);
            HOrder S{(const char*)P.w<bf16>(WS_W), (const char*)P.w<bf16>(WS_VTR), P.G, P.vcu};
            EpiH E{P.w<bf16>(WS_Q), P.w<bf16>(WS_K), P.w<float>(WS_DEN)};
            pg8::gemm_phase<EpiH, HOrder, true>(P.lds, P.tid, WLD, SEQ, S, E);
        } SEAM(pb + 4);
        if (IN(pb + 5)) { const Ctx P = fresh(C); p_ynorm(P, round); if (round + 1 < NROUND) p_normmod(P, xout, 1, (round + 1) * RT, (round + 2) * RT, P.w<bf16>(WS_HMR)); } SEAM(pb + 5);
    }
    if (IN(PH_OUT1)) { const Ctx P = fresh(C);
        pg8::PlainOrder S{(const char*)P.w<bf16>(WS_Y), (const char*)P.w<bf16>(WS_MLWOUTT), ML_IN, ML_IN, NT / 256, DM / 256, P.G, P.vcu, ML_IN / 64};
        pg8::EpiResid E{xout, xout, P.mods(1, 2)};
        pg8::gemm_phase<pg8::EpiResid, pg8::PlainOrder, true>(P.lds, P.tid, ML_IN, ML_IN, S, E);
    } SEAM(PH_OUT1);
    if (IN(PH_ROUTE1)) { const Ctx P = fresh(C); p_route(P, 1); } SEAM(PH_ROUTE1);
    if (IN(PH_PERM1)) { const Ctx P = fresh(C); p_permute(P, 1); } SEAM(PH_PERM1);
    if (IN(PH_UP1)) { const Ctx P = fresh(C); moe_up(P, 1); } SEAM(PH_UP1);
    if (IN(PH_DOWN1)) { const Ctx P = fresh(C); moe_down(P, 1); } SEAM(PH_DOWN1);
    if (IN(PH_COMB1)) { const Ctx P = fresh(C); p_combine(P, 1); }
#undef IN
#undef SEAM
}

extern "C" void kernel_launch(void* const* d_in, const int* in_sizes, int n_in, void* d_out, int out_size, void* d_ws, size_t ws_size, hipStream_t stream) {
    static int grid = 0;
    if (grid == 0) {
        if (n_in != 32 || in_sizes[0] != NT * DM || out_size != NT * DM || ws_size < WS_END) { fprintf(stderr, "kernel_launch: unexpected shapes (n_in %d, in0 %d, out %d, ws %zu)\n", n_in, n_in > 0 ? in_sizes[0] : -1, out_size, ws_size); grid = -1; return; }
        int dev = 0, cus = 0, per_cu = 0;
        if (hipGetDevice(&dev) != hipSuccess || hipDeviceGetAttribute(&cus, hipDeviceAttributeMultiprocessorCount, dev) != hipSuccess) { grid = -1; return; }
        if (hipFuncSetAttribute((const void*)fwd_kernel, hipFuncAttributeMaxDynamicSharedMemorySize, LDS_BYTES) != hipSuccess) { fprintf(stderr, "kernel_launch: hipFuncSetAttribute failed\n"); grid = -1; return; }
        if (hipOccupancyMaxActiveBlocksPerMultiprocessor(&per_cu, (const void*)fwd_kernel, 512, LDS_BYTES) != hipSuccess || per_cu < 1) fprintf(stderr, "kernel_launch: occupancy query reports %d\n", per_cu);
        (void)hipGetLastError();
        grid = cus;
    }
    if (grid < 0) return;
    (void)hipMemsetAsync((char*)d_ws + WS_CTL, 0, CTL_ZERO_BYTES, stream);
    Args a{};
    for (int i = 0; i < 32; ++i) a.in[i] = (const float*)d_in[i];
    a.out = (float*)d_out; a.ws = (unsigned char*)d_ws;
#if MK_ONE_LAUNCH
    a.ph_lo = 0; a.ph_hi = N_PHASES;
    hipLaunchKernelGGL(fwd_kernel, dim3(grid), dim3(512), LDS_BYTES, stream, a);
#else
    for (int p = 0; p < N_PHASES; ++p) { a.ph_lo = p; a.ph_hi = p + 1; hipLaunchKernelGGL(fwd_kernel, dim3(grid), dim3(512), LDS_BYTES, stream, a); }
#endif
}
```

```cpp
#include <hip/hip_runtime.h>
#include <cstdio>
#include <cstdint>

#ifndef MK_ONE_LAUNCH
#define MK_ONE_LAUNCH 1
#endif

#define GAS __attribute__((address_space(1)))
#define LAS __attribute__((address_space(3)))
typedef unsigned short bf16;
typedef short bf16x8 __attribute__((ext_vector_type(8)));
typedef float f32x4 __attribute__((ext_vector_type(4)));
typedef float f32x16 __attribute__((ext_vector_type(16)));
typedef float f32x2 __attribute__((ext_vector_type(2)));
typedef unsigned u32x4 __attribute__((ext_vector_type(4)));
typedef unsigned u32x2 __attribute__((ext_vector_type(2)));

constexpr int NB = 16, SEQ = 2048, DM = 1024, NT = NB * SEQ;
constexpr int DA_H = 8;
constexpr int ML_IN = 2048, ML_H = 4, ML_DH = 512;
constexpr int NEXP = 32, DEXP = 256;
constexpr float EPS = 1e-6f;
constexpr float LOG2E = 1.4426950408889634f;
constexpr int RB = 4;
constexpr int NROUND = NB / RB;
constexpr int RT = RB * SEQ;
constexpr int WLD = 2304;
constexpr int MAXSLOT = 2 * NT + NEXP * 256;

constexpr size_t MiB = 1u << 20;
constexpr size_t WS_CTL = 0, CTL_ZERO_BYTES = 1 * MiB;
constexpr size_t WS_MODS = 2 * MiB;
constexpr size_t WS_TAB2 = 3 * MiB;
constexpr size_t WS_SCAL = 3 * MiB + 128 * 1024;
constexpr size_t WS_GWT = 3 * MiB + 256 * 1024;
constexpr size_t WS_RE = 4 * MiB;
constexpr size_t WS_RW = 4 * MiB + 256 * 1024;
constexpr size_t WS_RP = 4 * MiB + 512 * 1024;
constexpr size_t WS_RS = 4 * MiB + 768 * 1024;
constexpr size_t WS_PRE = 5 * MiB;
constexpr size_t WS_FG = 5 * MiB + 512 * 1024;
constexpr size_t WS_DEN = 6 * MiB;
constexpr size_t WS_WINT = 8 * MiB;
constexpr size_t WS_WOT = 14 * MiB;
constexpr size_t WS_MLWINT = 16 * MiB;
constexpr size_t WS_MLWOUTT = 24 * MiB;
constexpr size_t WS_W13T = 28 * MiB;
constexpr size_t WS_W2T = 60 * MiB;
constexpr size_t WS_BIG = 76 * MiB;
constexpr size_t WS_HM = WS_BIG + 0 * MiB;
constexpr size_t WS_QK = WS_BIG + 64 * MiB;
constexpr size_t WS_VT = WS_BIG + 192 * MiB;
constexpr size_t WS_O = WS_BIG + 256 * MiB;
constexpr size_t WS_HF = WS_BIG + 0 * MiB;
constexpr size_t WS_HS = WS_BIG + 64 * MiB;
constexpr size_t WS_HH = WS_BIG + 208 * MiB;
constexpr size_t WS_YS = WS_BIG + 244 * MiB;
constexpr size_t WS_Y = WS_BIG + 0 * MiB;
constexpr size_t WS_W = WS_BIG + 128 * MiB;
constexpr size_t WS_HMR = WS_BIG + 128 * MiB;
constexpr size_t WS_XMH = WS_BIG + 272 * MiB;
constexpr size_t WS_XC = WS_BIG + 304 * MiB;
constexpr size_t WS_Q = WS_BIG + 336 * MiB;
constexpr size_t WS_K = WS_BIG + 368 * MiB;
constexpr size_t WS_VTR = WS_BIG + 400 * MiB;
constexpr size_t WS_END = WS_BIG + 432 * MiB;
static_assert(WS_END <= 512 * MiB, "ws map");
static_assert((size_t)MAXSLOT * 1024 * 2 <= 144 * MiB && (size_t)MAXSLOT * 256 * 2 <= 36 * MiB, "slot buffers");
constexpr int CW_CNT = 64;
constexpr int CW_BAR = 4096;

constexpr int RING_BYTES = 131072;
constexpr int MISC_OFF = RING_BYTES;
constexpr int LDS_BYTES = RING_BYTES + 16384;

__device__ __forceinline__ unsigned f2bf(float f) { unsigned u = __builtin_bit_cast(unsigned, f); return (u + 0x7fffu + ((u >> 16) & 1u)) >> 16; }
__device__ __forceinline__ unsigned pk2(float lo, float hi) { unsigned r; asm("v_cvt_pk_bf16_f32 %0, %1, %2" : "=v"(r) : "v"(lo), "v"(hi)); return r; }
__device__ __forceinline__ float bf2f(unsigned short b) { return __builtin_bit_cast(float, ((unsigned)b) << 16); }
__device__ __forceinline__ float bflo(unsigned w) { return __builtin_bit_cast(float, w << 16); }
__device__ __forceinline__ float bfhi(unsigned w) { return __builtin_bit_cast(float, w & 0xffff0000u); }
__device__ __forceinline__ float wave_sum(float v) {
#pragma unroll
    for (int o = 1; o < 64; o <<= 1) v += __shfl_xor(v, o);
    return v;
}
__device__ __forceinline__ float silu_f(float v) { return v / (1.0f + __expf(-v)); }
#define LDS_WAIT() asm volatile("s_waitcnt lgkmcnt(0)" ::: "memory")
#define VM_WAIT() asm volatile("s_waitcnt vmcnt(0)" ::: "memory")
__device__ __forceinline__ int opaque_v(int x) { asm volatile("" : "+v"(x)); return x; }
__device__ __forceinline__ int lane_id() { return (int)__builtin_amdgcn_mbcnt_hi(~0u, __builtin_amdgcn_mbcnt_lo(~0u, 0u)); }

namespace pg8 {
constexpr int BM = 256, BK = 64, HALF = 128, HTB = HALF * BK * 2, STAGE_BYTES = 8 * HTB;
static_assert(STAGE_BYTES == RING_BYTES, "stage region");
__host__ __device__ __forceinline__ int lds_byte(int r, int c) { const int st = (r >> 4) * 2 + (c >> 5), rr = r & 15, cc = c & 31, ob = rr * 64 + cc * 2; return st * 1024 + (ob ^ (((ob >> 9) & 1) << 5)); }
__host__ __device__ __forceinline__ void stage_rc(int b, int& R, int& C) { const int st = b / 1024, sb = b % 1024, swz = sb ^ (((sb >> 9) & 1) << 5); R = (st >> 1) * 16 + swz / 64; C = (st & 1) * 32 + (swz % 64) / 2; }
__host__ __device__ __forceinline__ int perm32(int rho) { const int n = rho >> 4, i = rho & 15; return 8 * (i >> 2) + 4 * n + (i & 3); }

struct Unit { const char* A; const char* B; int r0, c0, a0, a1, nt, flags; };

__device__ __forceinline__ unsigned cvt_pk_bf16(float lo, float hi) { unsigned r; asm volatile("v_cvt_pk_bf16_f32 %0, %1, %2" : "=v"(r) : "v"(lo), "v"(hi)); return r; }

template <class Epi, class Sched, bool ALIGN_EPI>
__device__ __forceinline__ void gemm_phase(LAS unsigned char* lds, const int tid, const int lda, const int ldb, const Sched& S, const Epi& E) {
    const int wid = __builtin_amdgcn_readfirstlane(tid >> 6), lane = tid & 63, wr = wid >> 2, wc = wid & 3, fr = lane & 15, fq = lane >> 4;
    unsigned voffA[2], voffB[2];
#pragma unroll
    for (int i = 0; i < 2; ++i) { int R, C; stage_rc(tid * 16 + i * 8192, R, C); const int Rb = Epi::PERM ? ((R & ~31) + perm32(R & 31)) : R;
        voffA[i] = (unsigned)(R * lda + C) * 2u; voffB[i] = (unsigned)(Rb * ldb + C) * 2u; }
    const size_t kstep = (size_t)(BK * 2);
    const size_t hstepA = (size_t)HALF * lda * 2, hstepB = (size_t)HALF * ldb * 2;
    const unsigned ldsw = (unsigned)wid * 1024u;
    const int aoff = lds_byte(wr * 64 + fr, fq * 8), boff = lds_byte(wc * 32 + fr, fq * 8);
#define PG8_SA(b, h) (((b) * 2 + (h)) * HTB)
#define PG8_SB(b, h) ((4 + (b) * 2 + (h)) * HTB)
#define PG8_STAGE(bufoff, gbase, voff) do { _Pragma("unroll") for (int _i = 0; _i < 2; ++_i) \
        __builtin_amdgcn_global_load_lds((const unsigned*)((const char*)(gbase) + (voff)[_i]), (LAS unsigned*)(lds + (bufoff) + ldsw + _i * 8192), 16, 0, 0); } while (0)
#define PG8_LDA(dst, b, h) do { _Pragma("unroll") for (int m = 0; m < 4; ++m) _Pragma("unroll") for (int k = 0; k < 2; ++k) dst[m][k] = *(const LAS bf16x8*)(lds + PG8_SA(b, h) + aoff + m * 2048 + k * 1024); } while (0)
#define PG8_LDB(dst, b, h) do { _Pragma("unroll") for (int n = 0; n < 2; ++n) _Pragma("unroll") for (int k = 0; k < 2; ++k) dst[n][k] = *(const LAS bf16x8*)(lds + PG8_SB(b, h) + boff + n * 2048 + k * 1024); } while (0)
#define PG8_MMA(ai, bj, At, Bt) do { __builtin_amdgcn_s_setprio(1); _Pragma("unroll") for (int m = 0; m < 4; ++m) _Pragma("unroll") for (int n = 0; n < 2; ++n) _Pragma("unroll") for (int k = 0; k < 2; ++k) \
        acc[ai][bj][m][n] = __builtin_amdgcn_mfma_f32_16x16x32_bf16(Bt[n][k], At[m][k], acc[ai][bj][m][n], 0, 0, 0); __builtin_amdgcn_s_setprio(0); } while (0)
#define PG8_WAIT_V(n) asm volatile("s_waitcnt vmcnt(" #n ")" ::: "memory")
#define PG8_WAIT_L(n) asm volatile("s_waitcnt lgkmcnt(" #n ")" ::: "memory")
#define PG8_BAR __builtin_amdgcn_s_barrier()
#define PG8_SCHED __builtin_amdgcn_sched_barrier(0)
    Unit cur, nxt; int ui = 0;
    if (!S.next(0, cur)) return;
    f32x4 acc[2][2][4][2];
#pragma unroll
    for (int a = 0; a < 2; ++a)
#pragma unroll
        for (int b = 0; b < 2; ++b)
#pragma unroll
            for (int m = 0; m < 4; ++m)
#pragma unroll
                for (int n = 0; n < 2; ++n) acc[a][b][m][n] = (f32x4){0.f, 0.f, 0.f, 0.f};
    bf16x8 At[4][2], B0[2][2], B1[2][2];
    const char* cA = cur.A; const char* cB = cur.B;
    {
        const char* b0 = cB + (size_t)S.kb(cur, 0) * kstep; const char* b1 = cB + (size_t)S.kb(cur, 1) * kstep;
        PG8_STAGE(PG8_SB(0, 0), b0, voffB); PG8_STAGE(PG8_SB(0, 1), b0 + hstepB, voffB); PG8_STAGE(PG8_SA(0, 0), cA, voffA); PG8_STAGE(PG8_SA(0, 1), cA + hstepA, voffA);
        if (wr == 1) PG8_BAR;
        PG8_WAIT_V(2); PG8_BAR;
        PG8_STAGE(PG8_SB(1, 0), b1, voffB); PG8_STAGE(PG8_SA(1, 0), cA + kstep, voffA); PG8_STAGE(PG8_SB(1, 1), b1 + hstepB, voffB);
        PG8_WAIT_V(6); PG8_BAR;
    }
    for (;;) {
        const bool has_next = S.next(ui + 1, nxt);
        const Unit& nu = has_next ? nxt : cur;
        const char* nA = nu.A; const char* nB = nu.B;
        const int nt = cur.nt;
        for (int t = 0; t < nt; t += 2) {
            const bool last = (t == nt - 2);
            const char* a1 = cA + (size_t)(t + 1) * kstep;
            const char* a2 = last ? nA : cA + (size_t)(t + 2) * kstep;
            const char* a3 = a2 + kstep;
            const char* b2 = last ? nB + (size_t)S.kb(nu, 0) * kstep : cB + (size_t)S.kb(cur, t + 2) * kstep;
            const char* b3 = last ? nB + (size_t)S.kb(nu, 1) * kstep : cB + (size_t)S.kb(cur, t + 3) * kstep;
            PG8_LDB(B0, 0, 0); PG8_LDB(B1, 0, 1); PG8_SCHED; PG8_LDA(At, 0, 0); PG8_STAGE(PG8_SA(1, 1), a1 + hstepA, voffA);
            PG8_WAIT_V(8); PG8_WAIT_L(0); PG8_BAR; PG8_MMA(0, 0, At, B0); PG8_MMA(0, 1, At, B1); PG8_BAR; PG8_SCHED;
            PG8_LDA(At, 0, 1); PG8_STAGE(PG8_SB(0, 0), b2, voffB); PG8_STAGE(PG8_SB(0, 1), b2 + hstepB, voffB); PG8_STAGE(PG8_SA(0, 0), a2, voffA);
            PG8_WAIT_V(8); PG8_WAIT_L(0); PG8_BAR; PG8_MMA(1, 0, At, B0); PG8_MMA(1, 1, At, B1); PG8_BAR; PG8_SCHED;
            PG8_LDB(B0, 1, 0); PG8_LDB(B1, 1, 1); PG8_SCHED; PG8_LDA(At, 1, 0); PG8_STAGE(PG8_SA(0, 1), a2 + hstepA, voffA);
            PG8_WAIT_V(8); PG8_WAIT_L(0); PG8_BAR; PG8_MMA(0, 0, At, B0); PG8_MMA(0, 1, At, B1); PG8_BAR; PG8_SCHED;
            PG8_LDA(At, 1, 1); PG8_STAGE(PG8_SB(1, 0), b3, voffB); PG8_STAGE(PG8_SB(1, 1), b3 + hstepB, voffB); PG8_STAGE(PG8_SA(1, 0), a3, voffA);
            PG8_WAIT_V(8); PG8_WAIT_L(0); PG8_BAR; PG8_MMA(1, 0, At, B0); PG8_MMA(1, 1, At, B1); PG8_BAR; PG8_SCHED;
        }
        if constexpr (ALIGN_EPI) { if (wr == 0) PG8_BAR; }
        E(acc, cur, wr, wc, fr, fq);
        if (!has_next) break;
#pragma unroll
        for (int a = 0; a < 2; ++a)
#pragma unroll
            for (int b = 0; b < 2; ++b)
#pragma unroll
                for (int m = 0; m < 4; ++m)
#pragma unroll
                    for (int n = 0; n < 2; ++n) acc[a][b][m][n] = (f32x4){0.f, 0.f, 0.f, 0.f};
        cur = nxt; cA = nA; cB = nB; ++ui;
        if constexpr (ALIGN_EPI) { if (wr == 1) PG8_BAR; }
    }
    PG8_WAIT_V(0);
    if constexpr (!ALIGN_EPI) { if (wr == 0) PG8_BAR; }
    PG8_BAR;
#undef PG8_SA
#undef PG8_SB
#undef PG8_STAGE
#undef PG8_LDA
#undef PG8_LDB
#undef PG8_MMA
#undef PG8_WAIT_V
#undef PG8_WAIT_L
#undef PG8_BAR
#undef PG8_SCHED
}

struct PlainOrder {
    const char* A; const char* B; int lda, ldb, nM, nN, G, c, nt;
    __device__ __forceinline__ bool next(int i, Unit& u) const {
        const int L = i * G + c; if (L >= nM * nN) return false;
        const int pm = L / nN, pn = L - pm * nN;
        u.A = A + (size_t)pm * 256 * lda * 2; u.B = B + (size_t)pn * 256 * ldb * 2; u.r0 = pm * 256; u.c0 = pn * 256; u.a0 = 0; u.a1 = 0; u.nt = nt; u.flags = 3; return true;
    }
    __device__ __forceinline__ int kb(const Unit&, int t) const { return t; }
};
struct EpiBf16 {
    static constexpr bool PERM = true;
    bf16* O; int ldc; int split_cols; bf16* O2; int ldc2;
    __device__ __forceinline__ void operator()(const f32x4 (&acc)[2][2][4][2], const Unit& u, int wr, int wc, int fr_, int fq_) const {
        (void)fr_; (void)fq_; const int ln_ = opaque_v(lane_id()); const int fr = ln_ & 15, fq = ln_ >> 4;
        bf16* base = O; int ld = ldc; int colt = u.c0;
        if (split_cols > 0 && colt >= split_cols) { base = O2; ld = ldc2; colt -= split_cols; }
        const int row0 = u.r0 + wr * 64 + fr, col0 = colt + wc * 32 + 8 * fq;
#pragma unroll
        for (int ai = 0; ai < 2; ++ai)
#pragma unroll
            for (int m = 0; m < 4; ++m) { bf16* rowp = base + (size_t)(row0 + ai * HALF + m * 16) * ld + col0;
#pragma unroll
                for (int bj = 0; bj < 2; ++bj) { const f32x4 v0 = acc[ai][bj][m][0], v1 = acc[ai][bj][m][1];
                    u32x4 w; w.x = cvt_pk_bf16(v0[0], v0[1]); w.y = cvt_pk_bf16(v0[2], v0[3]); w.z = cvt_pk_bf16(v1[0], v1[1]); w.w = cvt_pk_bf16(v1[2], v1[3]);
                    *(u32x4*)(rowp + bj * HALF) = w; } }
    }
};
struct EpiResid {
    static constexpr bool PERM = false;
    const float* xin; float* out; const float* gate;
    __device__ __forceinline__ void operator()(const f32x4 (&acc)[2][2][4][2], const Unit& u, int wr, int wc, int fr_, int fq_) const {
        (void)fr_; (void)fq_; const int ln_ = opaque_v(lane_id()); const int fr = ln_ & 15, fq = ln_ >> 4;
        const int row0 = u.r0 + wr * 64 + fr, col0 = u.c0 + wc * 32 + 4 * fq;
        const float* g = gate + (size_t)(u.r0 / SEQ) * 6144 + col0;
        f32x4 gv[2][2];
#pragma unroll
        for (int bj = 0; bj < 2; ++bj)
#pragma unroll
            for (int n = 0; n < 2; ++n) gv[bj][n] = *(const f32x4*)(g + bj * HALF + n * 16);
#pragma unroll
        for (int ai = 0; ai < 2; ++ai)
#pragma unroll
            for (int m = 0; m < 4; ++m) { const size_t off = (size_t)(row0 + ai * HALF + m * 16) * DM + col0;
#pragma unroll
                for (int bj = 0; bj < 2; ++bj)
#pragma unroll
                    for (int n = 0; n < 2; ++n) { const f32x4 xv = *(const f32x4*)(xin + off + bj * HALF + n * 16);
                        *(f32x4*)(out + off + bj * HALF + n * 16) = xv + gv[bj][n] * acc[ai][bj][m][n]; }
                if (m & 1) asm volatile("" ::: "memory"); }
    }
};
}

#define XB_TMO      128
#define XB_XCNT(j)  (256  + 64 * (j))
#define XB_XSUB(j)  (1280 + 64 * (j))
#define XB_XGEN(j)  (2304 + 64 * (j))
#define XB_TOP      3328
#define XB_TOPGEN   3392
#define XCD_BAR_WORDS 3456
#define XB_SPIN_CAP (1u << 18)
__device__ __forceinline__ unsigned xb_ld(unsigned* p)              { return __hip_atomic_load(p, __ATOMIC_RELAXED, __HIP_MEMORY_SCOPE_AGENT); }
__device__ __forceinline__ unsigned xb_add(unsigned* p, unsigned v) { return __hip_atomic_fetch_add(p, v, __ATOMIC_RELAXED, __HIP_MEMORY_SCOPE_AGENT); }
__device__ __forceinline__ unsigned xb_xcc_id() { return (unsigned)__builtin_amdgcn_s_getreg((3 << 11) | 20) & 0xFu; }
#define XB_SPIN(cond, bar) do { unsigned _sp = 0; while (cond) { __builtin_amdgcn_s_sleep(1); \
    if ((++_sp & 255u) == 0u) { if (xb_ld(&(bar)[XB_TMO])) break; if (_sp > XB_SPIN_CAP) { atomicAdd(&(bar)[XB_TMO], 1u); break; } } } } while (0)
struct XcdBarrier { unsigned* bar; unsigned x; volatile LAS unsigned* st; };
__device__ __forceinline__ XcdBarrier xcd_barrier_post(unsigned* bar, volatile LAS unsigned* st) {
    XcdBarrier b; b.bar = bar; b.x = xb_xcc_id(); b.st = st;
    if (threadIdx.x == 0) (void)xb_add(&bar[XB_XCNT(b.x)], 1u);
    return b;
}
__device__ __forceinline__ void xcd_barrier_complete(unsigned* bar, unsigned x, unsigned& nloc, unsigned& nx) {
    const unsigned G = gridDim.x * gridDim.y * gridDim.z;
    unsigned sum, cnt, mine, sp = 0u;
    for (;;) {
        sum = 0u; cnt = 0u; mine = 0u;
#pragma unroll
        for (unsigned j = 0; j < 16; ++j) { const unsigned c = xb_ld(&bar[XB_XCNT(j)]); sum += c; cnt += (c > 0u) ? 1u : 0u; mine = (j == x) ? c : mine; }
        if (sum == G) break;
        __builtin_amdgcn_s_sleep(1);
        if ((++sp & 255u) == 0u) { if (xb_ld(&bar[XB_TMO])) break; if (sp > XB_SPIN_CAP) { atomicAdd(&bar[XB_TMO], 1u); break; } }
    }
    nloc = mine > 0u ? mine : 1u; nx = cnt > 0u ? cnt : 1u;
}
__device__ __forceinline__ void xcd_barrier(const XcdBarrier& b) {
    asm volatile("s_waitcnt vmcnt(0)" ::: "memory");
    __syncthreads();
    if (threadIdx.x == 0) {
        unsigned* bar = b.bar;
        __builtin_amdgcn_s_waitcnt(0);
        unsigned nloc = b.st[0], nx = b.st[1];
        if (nloc == 0u) { xcd_barrier_complete(bar, b.x, nloc, nx); b.st[0] = nloc; b.st[1] = nx; }
        const unsigned old = xb_add(&bar[XB_XSUB(b.x)], 1u);
        const unsigned gen = old / nloc;
        if (old + 1u == (gen + 1u) * nloc) {
            __builtin_amdgcn_fence(__ATOMIC_RELEASE, "agent");
            asm volatile("s_waitcnt vmcnt(0)" ::: "memory");
            const unsigned og = xb_add(&bar[XB_TOP], 1u);
            const unsigned tg = og / nx;
            if (og + 1u == (tg + 1u) * nx) xb_add(&bar[XB_TOPGEN], 1u);
            else XB_SPIN(xb_ld(&bar[XB_TOPGEN]) == tg, bar);
            __builtin_amdgcn_fence(__ATOMIC_ACQUIRE, "agent");
            xb_add(&bar[XB_XGEN(b.x)], 1u);
            asm volatile("s_waitcnt vmcnt(0)" ::: "memory");
        } else {
            XB_SPIN(xb_ld(&bar[XB_XGEN(b.x)]) == gen, bar);
            __builtin_amdgcn_fence(__ATOMIC_ACQUIRE, "agent");
            asm volatile("s_waitcnt vmcnt(0)" ::: "memory");
        }
    }
    __syncthreads();
}

struct Args { const float* in[32]; float* out; unsigned char* ws; int ph_lo, ph_hi; };
enum { IN_X = 0, IN_C, IN_REL, IN_ADAW, IN_ADAB, IN_NMG, IN_NFG, IN_DAWIN, IN_DAWOUT, IN_QG, IN_KG, IN_LQ1, IN_LK1, IN_LQ2, IN_LK2, IN_SUBLN,
       IN_MLWIN, IN_CONVW, IN_CONVB, IN_WQ, IN_WK, IN_WV, IN_GATEW, IN_GATEB, IN_ONG, IN_SKIP, IN_MLWOUT, IN_WGRP, IN_WRT, IN_W1, IN_W3, IN_W2 };

struct Ctx {
    const Args* a; unsigned char* ws; LAS unsigned char* lds; int tid, lane, wave, G, vcu;
    __device__ __forceinline__ const float* in(int i) const { return a->in[i]; }
    template <class Tp> __device__ __forceinline__ Tp* w(size_t off) const { return (Tp*)(ws + off); }
    __device__ __forceinline__ const float* mods(int layer, int which) const { return (const float*)(ws + WS_MODS) + (size_t)layer * 16 * 6144 + which * 1024; }
};

__device__ __forceinline__ Ctx fresh(const Ctx& C) {
    Ctx P = C; int t = C.tid; asm volatile("" : "+v"(t)); P.tid = t; P.lane = t & 63; P.wave = __builtin_amdgcn_readfirstlane(t >> 6);
    unsigned char* w = C.ws; asm volatile("" : "+s"(w)); P.ws = w; int g = __builtin_amdgcn_readfirstlane(C.G), v = __builtin_amdgcn_readfirstlane(C.vcu); asm volatile("" : "+s"(g), "+s"(v)); P.G = g; P.vcu = v;
    return P;
}
__device__ __forceinline__ void transpose_item(const float* W, int K, int N, bf16* WT, int ldt, int dst_row0, LAS float* scr, int kb, int nb, int lane) {
    const int k0 = 64 * kb, n0 = 32 * nb;
#pragma unroll 8
    for (int i = 0; i < 32; ++i) { const int kk = 2 * i + (lane >> 5); scr[kk * 33 + (lane & 31)] = W[(size_t)(k0 + kk) * N + n0 + (lane & 31)]; }
    LDS_WAIT(); asm volatile("" ::: "memory");
    const int c = lane & 7;
#pragma unroll
    for (int j = 0; j < 4; ++j) { const int n = (lane >> 3) + 8 * j; const LAS float* s = scr + (8 * c) * 33 + n;
        u32x4 o; o.x = pk2(s[0 * 33], s[1 * 33]); o.y = pk2(s[2 * 33], s[3 * 33]); o.z = pk2(s[4 * 33], s[5 * 33]); o.w = pk2(s[6 * 33], s[7 * 33]);
        *(u32x4*)(WT + (size_t)(dst_row0 + n) * ldt + k0 + 8 * c) = o; }
    LDS_WAIT(); asm volatile("" ::: "memory");
}
__device__ __forceinline__ void moe_weight_items(const Ctx& C, int layer, LAS float* scr) {
    const int gw = C.vcu * 8 + C.wave, NGW = C.G * 8;
    const float* w1 = C.in(IN_W1) + (size_t)layer * NEXP * DM * DEXP; const float* w3 = C.in(IN_W3) + (size_t)layer * NEXP * DM * DEXP; const float* w2 = C.in(IN_W2) + (size_t)layer * NEXP * DEXP * DM;
    bf16* W13T = C.w<bf16>(WS_W13T); bf16* W2T = C.w<bf16>(WS_W2T);
    constexpr int I13 = 16 * 8, I2 = 4 * 32;
    for (int it = gw; it < NEXP * (2 * I13 + I2); it += NGW) {
        const int e = it / (2 * I13 + I2); int r = it - e * (2 * I13 + I2);
        if (r < 2 * I13) { const int which = r / I13; r -= which * I13; const int kb = r / 8, nb = r % 8; const int n0 = 32 * nb;
            const int dst = (n0 / 128) * 256 + which * 128 + (n0 % 128);
            transpose_item((which ? w3 : w1) + (size_t)e * DM * DEXP, DM, DEXP, W13T + (size_t)e * 512 * DM, DM, dst, scr, kb, nb, C.lane); }
        else { r -= 2 * I13; const int kb = r / 32, nb = r % 32;
            transpose_item(w2 + (size_t)e * DEXP * DM, DEXP, DM, W2T + (size_t)e * DM * DEXP, DEXP, 32 * nb, scr, kb, nb, C.lane); }
    }
}
__device__ __forceinline__ void plain_weight_items(const Ctx& C, const float* W, int K, int N, bf16* WT, LAS float* scr) {
    const int gw = C.vcu * 8 + C.wave, NGW = C.G * 8; const int nblk = N / 32;
    for (int it = gw; it < (K / 64) * nblk; it += NGW) { const int kb = it / nblk, nb = it % nblk; transpose_item(W, K, N, WT, K, 32 * nb, scr, kb, nb, C.lane); }
}
__device__ __forceinline__ int t5_bucket(int rel) {
    const int n = rel < 0 ? -rel : rel; int b;
    if (n < 8) b = n; else b = 8 + (n >= 12) + (n >= 16) + (n >= 23) + (n >= 32) + (n >= 46) + (n >= 64) + (n >= 91);
    return b + (rel > 0 ? 16 : 0);
}
__device__ __forceinline__ void p_prologue(const Ctx& C) {
    __syncthreads();
    {
        LAS float* cact = (LAS float*)C.lds;
        LAS float* red = (LAS float*)(C.lds + 65536);
        const float* c = C.in(IN_C);
        for (int i = C.tid; i < 16 * 1024; i += 512) cact[i] = silu_f(c[i]);
        __syncthreads();
        for (int task = C.vcu; task < 192; task += C.G) {
            const int layer = task / 96, n0 = (task % 96) * 64, nl = C.tid & 63, kc = C.tid >> 6;
            const float* W = C.in(IN_ADAW) + (size_t)layer * DM * 6144 + n0 + nl;
            float acc[16];
#pragma unroll
            for (int b = 0; b < 16; ++b) acc[b] = 0.f;
            for (int k = kc * 128; k < kc * 128 + 128; ++k) { const float wv = W[(size_t)k * 6144];
#pragma unroll
                for (int b = 0; b < 16; ++b) acc[b] += cact[b * 1024 + k] * wv; }
#pragma unroll
            for (int b = 0; b < 16; ++b) red[(kc * 16 + b) * 64 + nl] = acc[b];
            __syncthreads();
            for (int o = C.tid; o < 16 * 64; o += 512) { const int b = o >> 6, n = o & 63; float s = 0.f;
#pragma unroll
                for (int q = 0; q < 8; ++q) s += red[(q * 16 + b) * 64 + n];
                C.w<float>(WS_MODS)[(size_t)layer * 16 * 6144 + (size_t)b * 6144 + n0 + n] = s + C.in(IN_ADAB)[layer * 6144 + n0 + n]; }
            __syncthreads();
        }
    }
    {
        const int gt = C.vcu * 512 + C.tid, NGT = C.G * 512;
        float mq = 0.f, mk = 0.f;
        for (int i = 0; i < 64; ++i) { mq = fmaxf(mq, fabsf(C.in(IN_QG)[i])); mk = fmaxf(mk, fabsf(C.in(IN_KG)[i])); }
        for (int i = gt; i < 8 * 4096; i += NGT) { const int h = i >> 12, idx = i & 4095; if (idx < 4095) {
            float mb = -1e30f; for (int b = 0; b < 32; ++b) mb = fmaxf(mb, C.in(IN_REL)[b * 8 + h]);
            const float cshift = 8.0f * mq * mk + mb;
            C.w<float>(WS_TAB2)[i] = (C.in(IN_REL)[t5_bucket(idx - 2047) * 8 + h] - cshift) * LOG2E; } else C.w<float>(WS_TAB2)[i] = 0.f; }
        if (gt == 0) { float s1 = 0.f, s2 = 0.f; for (int i = 0; i < 64; ++i) { s1 += C.in(IN_LQ1)[i] * C.in(IN_LK1)[i]; s2 += C.in(IN_LQ2)[i] * C.in(IN_LK2)[i]; }
            C.w<float>(WS_SCAL)[0] = __expf(s1) - __expf(s2) + 0.2f; }
        for (int i = gt; i < 16 * 6144; i += NGT) { const int n = i / 6144, k = i % 6144, d = n >> 3, g = n & 7, m = k / 2048, c = k % 2048;
            C.w<bf16>(WS_GWT)[i] = (bf16)f2bf(C.in(IN_GATEW)[(((size_t)d * 3 + m) * 2048 + c) * 8 + g]); }
    }
    LAS float* scr = (LAS float*)(C.lds + C.wave * 16384);
    plain_weight_items(C, C.in(IN_DAWIN), DM, 3 * DM, C.w<bf16>(WS_WINT), scr);
    plain_weight_items(C, C.in(IN_DAWOUT), DM, DM, C.w<bf16>(WS_WOT), scr);
    plain_weight_items(C, C.in(IN_MLWIN), DM, 2 * ML_IN, C.w<bf16>(WS_MLWINT), scr);
    plain_weight_items(C, C.in(IN_MLWOUT), ML_IN, DM, C.w<bf16>(WS_MLWOUTT), scr);
    moe_weight_items(C, 0, scr);
}

__device__ __forceinline__ void normmod_row(const float* xrow, const float* g, const float* sc, const float* sh, bf16* orow, int lane) {
    const f32x4* xr = (const f32x4*)xrow + lane; f32x4 v[4]; float s = 0.f;
#pragma unroll
    for (int j = 0; j < 4; ++j) { v[j] = xr[64 * j]; s += (v[j].x * v[j].x + v[j].y * v[j].y) + (v[j].z * v[j].z + v[j].w * v[j].w); }
    const float rstd = 1.0f / sqrtf(wave_sum(s) * (1.0f / DM) + EPS);
    u32x2* o8 = (u32x2*)orow + lane;
#pragma unroll
    for (int j = 0; j < 4; ++j) { const f32x4 gv = ((const f32x4*)g)[lane + 64 * j], scv = ((const f32x4*)sc)[lane + 64 * j], shv = ((const f32x4*)sh)[lane + 64 * j];
        const f32x4 y = (v[j] * rstd * gv) * (scv + 1.0f) + shv; u32x2 w; w.x = pk2(y.x, y.y); w.y = pk2(y.z, y.w); o8[64 * j] = w; }
}
__device__ __forceinline__ void p_normmod(const Ctx& C, const float* xsrc, int layer, int row_lo, int row_hi, bf16* dst) {
    const int gw = C.vcu * 8 + C.wave, NGW = C.G * 8;
    const float* g = C.in(IN_NMG) + layer * DM;
    for (int r = row_lo + gw; r < row_hi; r += NGW) { const int b = r / SEQ;
        normmod_row(xsrc + (size_t)r * DM, g, C.mods(layer, 1) + (size_t)b * 6144, C.mods(layer, 0) + (size_t)b * 6144, dst + (size_t)(r - row_lo) * DM, C.lane); }
}

constexpr int AT_KS = 144, AT_VS = 136;
constexpr int AT_K_OFF = 0, AT_K_BYTES = 2 * 64 * AT_KS;
constexpr int AT_V_OFF = AT_K_BYTES, AT_V_BYTES = 128 * AT_VS;
constexpr int AT_TAB_OFF = AT_V_OFF + AT_V_BYTES;
constexpr int AT_EX_OFF = 0, AT_EX_PITCH = 132;
static_assert(AT_TAB_OFF % 16 == 0 && AT_TAB_OFF + 16384 <= RING_BYTES && 4 * 32 * AT_EX_PITCH * 4 <= RING_BYTES, "attention LDS");
__device__ __forceinline__ void attn_unit(const Ctx& C, int b, int h, int qt) {
    LAS unsigned char* lds = C.lds;
    const int tid = C.tid, lane = C.lane, wid = C.wave, mp = wid >> 2, rb = wid & 3, r32 = lane & 31, hi = lane >> 5;
    const bf16* QK = C.w<bf16>(WS_QK); const bf16* VT = C.w<bf16>(WS_VT);
    const size_t tok0 = (size_t)b * SEQ; const int q0 = qt * 128;
    LAS float* tab = (LAS float*)(lds + AT_TAB_OFF);
    __syncthreads();
    { const float* t2 = C.w<float>(WS_TAB2) + h * 4096; for (int i = tid; i < 4096; i += 512) tab[i] = t2[i]; }
    bf16x8 qf[4];
    {
        const bf16* qrow = QK + (tok0 + q0 + rb * 32 + r32) * 2048 + h * 128 + mp * 64 + hi * 8;
        float qv[4][8]; float ss = 0.f;
#pragma unroll
        for (int ks = 0; ks < 4; ++ks) { const u32x4 w = *(const u32x4*)(qrow + ks * 16);
            qv[ks][0] = bflo(w.x); qv[ks][1] = bfhi(w.x); qv[ks][2] = bflo(w.y); qv[ks][3] = bfhi(w.y); qv[ks][4] = bflo(w.z); qv[ks][5] = bfhi(w.z); qv[ks][6] = bflo(w.w); qv[ks][7] = bfhi(w.w);
#pragma unroll
            for (int j = 0; j < 8; ++j) ss += qv[ks][j] * qv[ks][j]; }
        ss += __shfl_xor(ss, 32);
        const float rs = (1.0f / sqrtf(ss * (1.0f / 64.0f) + EPS)) * (0.125f * LOG2E);
        const float* qg = C.in(IN_QG);
#pragma unroll
        for (int ks = 0; ks < 4; ++ks) { u32x4 w; const float* gg = qg + ks * 16 + hi * 8;
            w.x = pk2(qv[ks][0] * rs * gg[0], qv[ks][1] * rs * gg[1]); w.y = pk2(qv[ks][2] * rs * gg[2], qv[ks][3] * rs * gg[3]);
            w.z = pk2(qv[ks][4] * rs * gg[4], qv[ks][5] * rs * gg[5]); w.w = pk2(qv[ks][6] * rs * gg[6], qv[ks][7] * rs * gg[7]);
            qf[ks] = __builtin_bit_cast(bf16x8, w); }
    }
    const int kkey = tid >> 4, kcc = tid & 15, vdv = tid >> 3, vkc = tid & 7;
    const bf16* ksrc = QK + (tok0 + kkey) * 2048 + 1024 + h * 128 + kcc * 8;
    const bf16* vsrc = VT + (size_t)(h * 128 + vdv) * NT + tok0 + vkc * 8;
    float kgain[8];
#pragma unroll
    for (int j = 0; j < 8; ++j) kgain[j] = C.in(IN_KG)[(kcc & 7) * 8 + j];
    u32x4 kst[2], vst[2];
#define AT_LOAD(t) do { const int k0_ = (t) * 64; kst[0] = *(const u32x4*)(ksrc + (size_t)k0_ * 2048); kst[1] = *(const u32x4*)(ksrc + (size_t)(k0_ + 32) * 2048); \
        vst[0] = *(const u32x4*)(vsrc + k0_); vst[1] = *(const u32x4*)(vsrc + (size_t)64 * NT + k0_); } while (0)
    AT_LOAD(0);
    f32x16 o[4];
#pragma unroll
    for (int i = 0; i < 4; ++i) o[i] = (f32x16){0.f, 0.f, 0.f, 0.f, 0.f, 0.f, 0.f, 0.f, 0.f, 0.f, 0.f, 0.f, 0.f, 0.f, 0.f, 0.f};
    float lsum = 0.f;
    const LAS unsigned char* kfp = lds + AT_K_OFF + (mp * 64 + r32) * AT_KS + hi * 16;
    const LAS unsigned char* vfp = lds + AT_V_OFF + r32 * AT_VS + hi * 8;
    for (int t = 0; t < 32; ++t) {
        __syncthreads();
#pragma unroll
        for (int i = 0; i < 2; ++i) { const u32x4 w = kst[i]; float v[8] = {bflo(w.x), bfhi(w.x), bflo(w.y), bfhi(w.y), bflo(w.z), bfhi(w.z), bflo(w.w), bfhi(w.w)};
            float ss = 0.f;
#pragma unroll
            for (int j = 0; j < 8; ++j) ss += v[j] * v[j];
            ss += __shfl_xor(ss, 1); ss += __shfl_xor(ss, 2); ss += __shfl_xor(ss, 4);
            const float rs = 1.0f / sqrtf(ss * (1.0f / 64.0f) + EPS);
            u32x4 ow; ow.x = pk2(v[0] * rs * kgain[0], v[1] * rs * kgain[1]); ow.y = pk2(v[2] * rs * kgain[2], v[3] * rs * kgain[3]);
            ow.z = pk2(v[4] * rs * kgain[4], v[5] * rs * kgain[5]); ow.w = pk2(v[6] * rs * kgain[6], v[7] * rs * kgain[7]);
            *(LAS u32x4*)(lds + AT_K_OFF + ((kcc >> 3) * 64 + kkey + 32 * i) * AT_KS + (kcc & 7) * 16) = ow;
            LAS u32x2* vd = (LAS u32x2*)(lds + AT_V_OFF + (vdv + 64 * i) * AT_VS + vkc * 16);
            vd[0] = (u32x2){vst[i].x, vst[i].y}; vd[1] = (u32x2){vst[i].z, vst[i].w}; }
        if (t + 1 < 32) AT_LOAD(t + 1);
        __syncthreads();
        const int k0 = t * 64;
        bf16x8 pf[4];
#pragma unroll
        for (int kb = 0; kb < 2; ++kb) {
            f32x16 s = (f32x16){0.f, 0.f, 0.f, 0.f, 0.f, 0.f, 0.f, 0.f, 0.f, 0.f, 0.f, 0.f, 0.f, 0.f, 0.f, 0.f};
#pragma unroll
            for (int ks = 0; ks < 4; ++ks) { const bf16x8 kf = *(const LAS bf16x8*)(kfp + kb * 32 * AT_KS + ks * 32); s = __builtin_amdgcn_mfma_f32_32x32x16_bf16(kf, qf[ks], s, 0, 0, 0); }
            const LAS float* tp = tab + (k0 + 32 * kb + 4 * hi - (q0 + 32 * rb + r32) + 2047);
            float p[16];
#pragma unroll
            for (int r = 0; r < 16; ++r) { p[r] = __builtin_amdgcn_exp2f(s[r] + tp[(r & 3) + 8 * (r >> 2)]); lsum += p[r]; }
#pragma unroll
            for (int sh = 0; sh < 2; ++sh) { u32x4 w; w.x = pk2(p[8 * sh + 0], p[8 * sh + 1]); w.y = pk2(p[8 * sh + 2], p[8 * sh + 3]); w.z = pk2(p[8 * sh + 4], p[8 * sh + 5]); w.w = pk2(p[8 * sh + 6], p[8 * sh + 7]);
                pf[2 * kb + sh] = __builtin_bit_cast(bf16x8, w); }
        }
#pragma unroll
        for (int dvb = 0; dvb < 4; ++dvb)
#pragma unroll
            for (int s4 = 0; s4 < 4; ++s4) { const u32x2 lo = *(const LAS u32x2*)(vfp + dvb * 32 * AT_VS + s4 * 32), hi2 = *(const LAS u32x2*)(vfp + dvb * 32 * AT_VS + s4 * 32 + 16);
                const u32x4 w = (u32x4){lo.x, lo.y, hi2.x, hi2.y};
                o[dvb] = __builtin_amdgcn_mfma_f32_32x32x16_bf16(__builtin_bit_cast(bf16x8, w), pf[s4], o[dvb], 0, 0, 0); }
    }
#undef AT_LOAD
    lsum += __shfl_xor(lsum, 32);
    const float lam = C.w<float>(WS_SCAL)[0];
    const float sc = (mp == 0 ? 1.0f : lam) / lsum;
    __syncthreads();
    LAS float* ex = (LAS float*)(lds + AT_EX_OFF) + (rb * 32 + r32) * AT_EX_PITCH;
    if (mp == 1) {
#pragma unroll
        for (int dvb = 0; dvb < 4; ++dvb)
#pragma unroll
            for (int g = 0; g < 4; ++g) *(LAS f32x4*)(ex + dvb * 32 + 8 * g + 4 * hi) = (f32x4){o[dvb][4 * g] * sc, o[dvb][4 * g + 1] * sc, o[dvb][4 * g + 2] * sc, o[dvb][4 * g + 3] * sc};
    }
    __syncthreads();
    if (mp == 0) {
        float ss = 0.f;
#pragma unroll
        for (int dvb = 0; dvb < 4; ++dvb)
#pragma unroll
            for (int g = 0; g < 4; ++g) { const f32x4 e = *(const LAS f32x4*)(ex + dvb * 32 + 8 * g + 4 * hi);
#pragma unroll
                for (int i = 0; i < 4; ++i) { const float v = o[dvb][4 * g + i] * sc - e[i]; o[dvb][4 * g + i] = v; ss += v * v; } }
        ss += __shfl_xor(ss, 32);
        const float rs = (1.0f / sqrtf(ss * (1.0f / 128.0f) + EPS)) * 0.8f;
        bf16* orow = C.w<bf16>(WS_O) + (tok0 + q0 + rb * 32 + r32) * DM + h * 128;
        const float* sg = C.in(IN_SUBLN);
#pragma unroll
        for (int dvb = 0; dvb < 4; ++dvb)
#pragma unroll
            for (int g = 0; g < 4; ++g) { const int dv = dvb * 32 + 8 * g + 4 * hi; const f32x4 gv = *(const f32x4*)(sg + dv);
                u32x2 w; w.x = pk2(o[dvb][4 * g] * rs * gv.x, o[dvb][4 * g + 1] * rs * gv.y); w.y = pk2(o[dvb][4 * g + 2] * rs * gv.z, o[dvb][4 * g + 3] * rs * gv.w);
                *(u32x2*)(orow + dv) = w; }
    }
}
__device__ __forceinline__ void p_attention(const Ctx& C) {
    for (int u = C.vcu; u < NB * DA_H * 16; u += C.G) { const int qt = u & 15, bh = u >> 4; attn_unit(C, bh >> 3, bh & 7, qt); }
    __syncthreads();
}

__device__ __forceinline__ void p_route(const Ctx& C, int layer, bool commit = true) {
    const float* x = C.a->out; const int lane = C.lane, tok = lane & 15, kq = lane >> 4;
    const float* g = C.in(IN_NFG) + layer * DM;
    const float* wr_ = C.in(IN_WRT) + (size_t)layer * DM * 32; const float* wg_ = C.in(IN_WGRP) + (size_t)layer * DM * 4;
    unsigned* cnt = C.w<unsigned>(WS_CTL) + CW_CNT + layer * 64;
    LAS float* lg = (LAS float*)(C.lds) + C.wave * (16 * 48);
    bf16* HF = C.w<bf16>(WS_HF);
    for (int wt = C.vcu * 8 + C.wave; wt < NT / 16; wt += C.G * 8) {
        const int t0 = wt * 16, b = t0 / SEQ;
        const float* xrow = x + (size_t)(t0 + tok) * DM + 4 * kq;
        float ss = 0.f;
        for (int kk = 0; kk < 64; ++kk) { const f32x4 v = *(const f32x4*)(xrow + 16 * kk); ss += (v.x * v.x + v.y * v.y) + (v.z * v.z + v.w * v.w); }
        ss += __shfl_xor(ss, 16); ss += __shfl_xor(ss, 32);
        const float rstd = 1.0f / sqrtf(ss * (1.0f / DM) + EPS);
        const float* sc = C.mods(layer, 4) + (size_t)b * 6144 + 4 * kq; const float* sh = C.mods(layer, 3) + (size_t)b * 6144 + 4 * kq;
        f32x4 a0 = (f32x4){0.f, 0.f, 0.f, 0.f}, a1 = a0, a2 = a0;
        bf16* hrow = HF + (size_t)(t0 + tok) * DM + 4 * kq;
        for (int kk = 0; kk < 64; ++kk) {
            const f32x4 v = *(const f32x4*)(xrow + 16 * kk), gv = *(const f32x4*)(g + 16 * kk + 4 * kq), scv = *(const f32x4*)(sc + 16 * kk), shv = *(const f32x4*)(sh + 16 * kk);
            const f32x4 hf = (v * rstd * gv) * (scv + 1.0f) + shv;
            u32x2 w; w.x = pk2(hf.x, hf.y); w.y = pk2(hf.z, hf.w); *(u32x2*)(hrow + 16 * kk) = w;
#pragma unroll
            for (int i = 0; i < 4; ++i) { const int k = 16 * kk + 4 * kq + i;
                const float b0 = wr_[k * 32 + tok], b1 = wr_[k * 32 + 16 + tok], b2 = tok < 4 ? wg_[k * 4 + tok] : 0.f;
                a0 = __builtin_amdgcn_mfma_f32_16x16x4f32(hf[i], b0, a0, 0, 0, 0); a1 = __builtin_amdgcn_mfma_f32_16x16x4f32(hf[i], b1, a1, 0, 0, 0); a2 = __builtin_amdgcn_mfma_f32_16x16x4f32(hf[i], b2, a2, 0, 0, 0); }
        }
#pragma unroll
        for (int r = 0; r < 4; ++r) { lg[(4 * kq + r) * 48 + tok] = a0[r]; lg[(4 * kq + r) * 48 + 16 + tok] = a1[r]; lg[(4 * kq + r) * 48 + 32 + tok] = a2[r]; }
        LDS_WAIT(); asm volatile("" ::: "memory");
        if (lane < 16 && commit) {
            const LAS float* L = lg + lane * 48;
            int gs = 0; float gm = L[32];
#pragma unroll
            for (int j = 1; j < 4; ++j) { const float v = L[32 + j]; if (v > gm) { gm = v; gs = j; } }
            float gsum = 0.f;
#pragma unroll
            for (int j = 0; j < 4; ++j) gsum += __expf(L[32 + j] - gm);
            const float pg = 1.0f / gsum;
            int ia = 0; float la = L[gs * 8];
#pragma unroll
            for (int j = 1; j < 8; ++j) { const float v = L[gs * 8 + j]; if (v > la) { la = v; ia = j; } }
            int ib = -1; float lb = -3.0e38f;
#pragma unroll
            for (int j = 0; j < 8; ++j) { const float v = L[gs * 8 + j]; if (j != ia && v > lb) { lb = v; ib = j; } }
            const float wa = pg / (1.0f + __expf(lb - la)), wb = pg - wa;
            const int ea = gs * 8 + ia, eb = gs * 8 + ib, t = t0 + lane;
            const unsigned pa = atomicAdd(cnt + ea, 1u), pb = atomicAdd(cnt + eb, 1u);
            C.w<int>(WS_RE)[2 * t] = ea; C.w<int>(WS_RE)[2 * t + 1] = eb; C.w<float>(WS_RW)[2 * t] = wa; C.w<float>(WS_RW)[2 * t + 1] = wb;
            C.w<int>(WS_RP)[2 * t] = (int)pa; C.w<int>(WS_RP)[2 * t + 1] = (int)pb;
        }
        LDS_WAIT(); asm volatile("" ::: "memory");
    }
}
struct MoeTab { LAS int* off; LAS int* tile_e; LAS int* ntile; };
__device__ __forceinline__ MoeTab moe_tables(const Ctx& C, int layer) {
    MoeTab T; T.off = (LAS int*)(C.lds + MISC_OFF + 256); T.tile_e = T.off + 64; T.ntile = T.off + 48;
    __syncthreads();
    if (C.tid == 0) { const unsigned* cnt = C.w<unsigned>(WS_CTL) + CW_CNT + layer * 64; int o = 0, nt = 0;
        for (int e = 0; e < NEXP; ++e) { const int c = (int)__hip_atomic_load(cnt + e, __ATOMIC_RELAXED, __HIP_MEMORY_SCOPE_AGENT); T.off[e] = o; const int tiles = (c + 255) >> 8; for (int j = 0; j < tiles; ++j) T.tile_e[nt + j] = e; nt += tiles; o += tiles * 256; }
        T.off[32] = o; T.ntile[0] = nt; }
    __syncthreads();
    return T;
}
__device__ __forceinline__ void p_permute(const Ctx& C, int layer) {
    const MoeTab T = moe_tables(C, layer);
    const bf16* HF = C.w<bf16>(WS_HF); bf16* HS = C.w<bf16>(WS_HS);
    const int* RP = C.w<int>(WS_RP); const int* RE = C.w<int>(WS_RE);
    for (int p = C.vcu * 8 + C.wave; p < 2 * NT; p += C.G * 8) {
        const int e = RE[p], pos = RP[p], slot = T.off[e] + pos, t = p >> 1;
        const u32x4* s = (const u32x4*)(HF + (size_t)t * DM) + C.lane; u32x4* d = (u32x4*)(HS + (size_t)slot * DM) + C.lane;
        const u32x4 v0 = s[0], v1 = s[64]; d[0] = v0; d[64] = v1;
        asm volatile("" ::: "memory");
        if (C.lane == 0) C.w<int>(WS_RS)[p] = slot;
    }
}
template <int NPN> struct MoeOrder {
    MoeTab T; const char* A; const char* B; int lda_bytes; size_t b_expert_bytes; int b_tile_bytes; int G, c, nt;
    __device__ __forceinline__ bool next(int i, pg8::Unit& u) const {
        const int L = i * G + c; const int rt = L / NPN, pn = L - rt * NPN; if (rt >= T.ntile[0]) return false;
        const int e = T.tile_e[rt];
        u.A = A + (size_t)rt * 256 * lda_bytes; u.B = B + (size_t)e * b_expert_bytes + (size_t)pn * b_tile_bytes; u.r0 = rt * 256; u.c0 = pn * 256; u.a0 = e; u.a1 = pn; u.nt = nt; u.flags = 3; return true;
    }
    __device__ __forceinline__ int kb(const pg8::Unit&, int t) const { return t; }
};
struct EpiSwiGLU {
    static constexpr bool PERM = true;
    bf16* H;
    __device__ __forceinline__ void operator()(const f32x4 (&acc)[2][2][4][2], const pg8::Unit& u, int wr, int wc, int fr_, int fq_) const {
        (void)fr_; (void)fq_; const int ln_ = opaque_v(lane_id()); const int fr = ln_ & 15, fq = ln_ >> 4;
        const int row0 = u.r0 + wr * 64 + fr, col0 = u.a1 * 128 + wc * 32 + 8 * fq;
#pragma unroll
        for (int ai = 0; ai < 2; ++ai)
#pragma unroll
            for (int m = 0; m < 4; ++m) { float r[8];
#pragma unroll
                for (int n = 0; n < 2; ++n)
#pragma unroll
                    for (int i = 0; i < 4; ++i) { const float a = acc[ai][0][m][n][i], b = acc[ai][1][m][n][i]; r[4 * n + i] = silu_f(a) * b; }
                u32x4 w; w.x = pk2(r[0], r[1]); w.y = pk2(r[2], r[3]); w.z = pk2(r[4], r[5]); w.w = pk2(r[6], r[7]);
                *(u32x4*)(H + (size_t)(row0 + ai * 128 + m * 16) * DEXP + col0) = w; }
    }
};
__device__ __forceinline__ void p_combine(const Ctx& C, int layer, float* xdst) {
    const float* x = C.a->out; const bf16* YS = C.w<bf16>(WS_YS); const int* RP = C.w<int>(WS_RS); const float* RW = C.w<float>(WS_RW);
    for (int t = C.vcu * 8 + C.wave; t < NT; t += C.G * 8) {
        const int s0 = RP[2 * t], s1 = RP[2 * t + 1]; const float w0 = RW[2 * t], w1 = RW[2 * t + 1];
        const float* g2 = C.mods(layer, 5) + (size_t)(t / SEQ) * 6144;
        const u32x4* y0 = (const u32x4*)(YS + (size_t)s0 * DM) + C.lane; const u32x4* y1 = (const u32x4*)(YS + (size_t)s1 * DM) + C.lane;
        const float* xr = x + (size_t)t * DM + 8 * C.lane; float* xw_ = xdst + (size_t)t * DM + 8 * C.lane;
#pragma unroll
        for (int j = 0; j < 2; ++j) { const u32x4 a = y0[64 * j], b = y1[64 * j]; const f32x4 ga = *(const f32x4*)(g2 + 512 * j + 8 * C.lane), gb = *(const f32x4*)(g2 + 512 * j + 8 * C.lane + 4);
            f32x4 xa = *(const f32x4*)(xr + 512 * j), xb = *(const f32x4*)(xr + 512 * j + 4);
            xa.x += ga.x * (w0 * bflo(a.x) + w1 * bflo(b.x)); xa.y += ga.y * (w0 * bfhi(a.x) + w1 * bfhi(b.x)); xa.z += ga.z * (w0 * bflo(a.y) + w1 * bflo(b.y)); xa.w += ga.w * (w0 * bfhi(a.y) + w1 * bfhi(b.y));
            xb.x += gb.x * (w0 * bflo(a.z) + w1 * bflo(b.z)); xb.y += gb.y * (w0 * bfhi(a.z) + w1 * bfhi(b.z)); xb.z += gb.z * (w0 * bflo(a.w) + w1 * bflo(b.w)); xb.w += gb.w * (w0 * bfhi(a.w) + w1 * bfhi(b.w));
            *(f32x4*)(xw_ + 512 * j) = xa; *(f32x4*)(xw_ + 512 * j + 4) = xb; }
    }
}

constexpr int CV_XM = 0;
constexpr int CV_QKV = 18432;
constexpr int CV_QKV_P = 1552;
constexpr int CV_VT = CV_QKV + 32 * CV_QKV_P;
constexpr int CV_RED = CV_VT + 256 * 80;
static_assert(CV_RED + 16384 <= RING_BYTES && CV_VT % 16 == 0 && CV_RED % 16 == 0, "conv LDS");
__device__ __forceinline__ void conv_unit(const Ctx& C, int round, int bl, int ti) {
    LAS unsigned char* lds = C.lds; const int tid = C.tid, lane = C.lane, wid = C.wave;
    const int s0 = ti * 32; const size_t rrow0 = (size_t)bl * SEQ;
    const bf16* XM = C.w<bf16>(WS_XMH); bf16* XC = C.w<bf16>(WS_XC); bf16* Q = C.w<bf16>(WS_Q); bf16* K = C.w<bf16>(WS_K); bf16* VTR = C.w<bf16>(WS_VTR);
    const bf16* GWT = C.w<bf16>(WS_GWT);
    f32x4 gacc[2]; gacc[0] = (f32x4){0.f, 0.f, 0.f, 0.f}; gacc[1] = gacc[0];
    const int nblk = tid & 63, tg = tid >> 6;
    for (int ch = 0; ch < 8; ++ch) {
        const int c0 = ch * 256;
        __syncthreads();
        for (int i = tid; i < 36 * 32; i += 512) { const int r = i >> 5, cc = i & 31, s = s0 - 2 + r; u32x4 v = (u32x4){0u, 0u, 0u, 0u};
            if (s >= 0 && s < SEQ) v = *(const u32x4*)(XM + (rrow0 + s) * ML_IN + c0 + cc * 8);
            *(LAS u32x4*)(lds + CV_XM + r * 512 + cc * 16) = v; }
        __syncthreads();
        {
            const int c = c0 + 4 * nblk;
            float cw[5][4], cb[4], wq[4][4], wk[4][4], wv[4][4];
            const float* convw = C.in(IN_CONVW); const float* convb = C.in(IN_CONVB);
#pragma unroll
            for (int j = 0; j < 5; ++j) { const f32x4 v = *(const f32x4*)(convw + j * ML_IN + c); cw[j][0] = v.x; cw[j][1] = v.y; cw[j][2] = v.z; cw[j][3] = v.w; }
            { const f32x4 v = *(const f32x4*)(convb + c); cb[0] = v.x; cb[1] = v.y; cb[2] = v.z; cb[3] = v.w; }
            const int nb = c >> 2;
#pragma unroll
            for (int i = 0; i < 4; ++i) { const f32x4 a = *(const f32x4*)(C.in(IN_WQ) + nb * 16 + i * 4), b = *(const f32x4*)(C.in(IN_WK) + nb * 16 + i * 4), d = *(const f32x4*)(C.in(IN_WV) + nb * 16 + i * 4);
                wq[i][0] = a.x; wq[i][1] = a.y; wq[i][2] = a.z; wq[i][3] = a.w; wk[i][0] = b.x; wk[i][1] = b.y; wk[i][2] = b.z; wk[i][3] = b.w; wv[i][0] = d.x; wv[i][1] = d.y; wv[i][2] = d.z; wv[i][3] = d.w; }
            float xw[8][4];
#pragma unroll
            for (int r = 0; r < 8; ++r) { const u32x2 v = *(const LAS u32x2*)(lds + CV_XM + (4 * tg + r) * 512 + nblk * 8); xw[r][0] = bflo(v.x); xw[r][1] = bfhi(v.x); xw[r][2] = bflo(v.y); xw[r][3] = bfhi(v.y); }
#pragma unroll
            for (int tt = 0; tt < 4; ++tt) {
                const int tl = 4 * tg + tt;
                float xc[4], qv[4], kv[4], vv[4];
#pragma unroll
                for (int i = 0; i < 4; ++i) { float a = cb[i];
#pragma unroll
                    for (int j = 0; j < 5; ++j) a += cw[j][i] * xw[tt + j][i];
                    xc[i] = silu_f(a); }
#pragma unroll
                for (int o = 0; o < 4; ++o) { float a = 0.f, b = 0.f, d = 0.f;
#pragma unroll
                    for (int i = 0; i < 4; ++i) { a += xc[i] * wq[i][o]; b += xc[i] * wk[i][o]; d += xw[tt + 2][i] * wv[i][o]; }
                    qv[o] = a; kv[o] = b; vv[o] = d; }
                const size_t grow = (rrow0 + s0 + tl) * ML_IN + c;
                const u32x2 xcw = (u32x2){pk2(xc[0], xc[1]), pk2(xc[2], xc[3])}, qw = (u32x2){pk2(qv[0], qv[1]), pk2(qv[2], qv[3])}, kw = (u32x2){pk2(kv[0], kv[1]), pk2(kv[2], kv[3])}, vw = (u32x2){pk2(vv[0], vv[1]), pk2(vv[2], vv[3])};
                *(u32x2*)(XC + grow) = xcw; *(u32x2*)(Q + grow) = qw; *(u32x2*)(K + grow) = kw;
                LAS unsigned char* qrow = lds + CV_QKV + tl * CV_QKV_P + nblk * 8;
                *(LAS u32x2*)(qrow) = qw; *(LAS u32x2*)(qrow + 512) = kw; *(LAS u32x2*)(qrow + 1024) = vw;
            }
        }
        __syncthreads();
        for (int i = tid; i < 256 * 4; i += 512) { const int cr = i >> 2, cc = i & 3; const int cg = c0 + cr, head = cg >> 9, dv = cg & 511;
            const LAS unsigned short* s = (const LAS unsigned short*)(lds + CV_QKV + (8 * cc) * CV_QKV_P + 1024) + cr; unsigned short v[8];
#pragma unroll
            for (int j = 0; j < 8; ++j) v[j] = s[j * (CV_QKV_P / 2)];
            *(u32x4*)(VTR + ((size_t)(bl * 4 + head) * 512 + dv) * SEQ + s0 + cc * 8) = (u32x4){(unsigned)v[0] | ((unsigned)v[1] << 16), (unsigned)v[2] | ((unsigned)v[3] << 16), (unsigned)v[4] | ((unsigned)v[5] << 16), (unsigned)v[6] | ((unsigned)v[7] << 16)}; }
#pragma unroll
        for (int ks = 0; ks < 3; ++ks) { const int kk = 96 * wid + 32 * ks + 8 * (lane >> 4);
            const int m = kk >> 8, cl = kk & 255;
            const bf16x8 bfr = *(const bf16x8*)(GWT + (size_t)(lane & 15) * 6144 + m * 2048 + c0 + cl);
#pragma unroll
            for (int tgp = 0; tgp < 2; ++tgp) { const bf16x8 afr = *(const LAS bf16x8*)(lds + CV_QKV + (16 * tgp + (lane & 15)) * CV_QKV_P + kk * 2);
                gacc[tgp] = __builtin_amdgcn_mfma_f32_16x16x32_bf16(afr, bfr, gacc[tgp], 0, 0, 0); } }
    }
    __syncthreads();
    LAS float* red = (LAS float*)(lds + CV_RED);
#pragma unroll
    for (int tgp = 0; tgp < 2; ++tgp)
#pragma unroll
        for (int r = 0; r < 4; ++r) red[(wid * 32 + 16 * tgp + 4 * (lane >> 4) + r) * 16 + (lane & 15)] = gacc[tgp][r];
    __syncthreads();
    { const int tkn = tid >> 4, n = tid & 15; float s = C.in(IN_GATEB)[n];
#pragma unroll
        for (int w = 0; w < 8; ++w) s += red[(w * 32 + tkn) * 16 + n];
        C.w<float>(WS_PRE)[(rrow0 + s0 + tkn) * 16 + n] = s; }
    (void)round;
}
__device__ __forceinline__ void p_conv(const Ctx& C, int round) {
    for (int u = C.vcu; u < RB * 64; u += C.G) conv_unit(C, round, u >> 6, u & 63);
    __syncthreads();
}
__device__ __forceinline__ void p_cumsum(const Ctx& C) {
    float* FG = C.w<float>(WS_FG); const float* PRE = C.w<float>(WS_PRE); float* DEN = C.w<float>(WS_DEN);
    for (int i = C.vcu * 512 + C.tid; i < 2 * 16 * 2048; i += C.G * 512) DEN[i] = 0.f;
    LAS float* wtot = (LAS float*)(C.lds);
    for (int sq = C.vcu; sq < 32; sq += C.G) {
        const int dir = sq & 1, bh = sq >> 1, bl = bh >> 2, hd = bh & 3, lane = C.lane, tid = C.tid;
        const float* p = PRE + (size_t)bl * SEQ * 16 + dir * 8;
        float lf[4], ii[4]; float tot = 0.f;
#pragma unroll
        for (int j = 0; j < 4; ++j) { const int s = tid * 4 + j; const float f = p[(size_t)s * 16 + 4 + hd]; ii[j] = p[(size_t)s * 16 + hd];
            lf[j] = fminf(f, 0.f) - log1pf(__expf(-fabsf(f))); tot += lf[j]; }
        float inc = tot;
#pragma unroll
        for (int o = 1; o < 64; o <<= 1) { const float v = __shfl_up(inc, o); if (lane >= o) inc += v; }
        __syncthreads();
        if (lane == 63) wtot[C.wave] = inc;
        __syncthreads();
        float before = 0.f, all = 0.f;
#pragma unroll
        for (int w = 0; w < 8; ++w) { const float v = wtot[w]; all += v; if (w < C.wave) before += v; }
        const float excl = before + inc - tot;
        float* F = FG + (size_t)(dir * 2) * 16 * 2048 + (size_t)bh * 2048; float* Gp = F + 16 * 2048;
        f32x4 fo, go;
        if (dir == 0) { float run = excl;
#pragma unroll
            for (int j = 0; j < 4; ++j) { run += lf[j]; fo[j] = run * LOG2E; go[j] = (ii[j] - run) * LOG2E - 4.5f; } }
        else { float run = all - excl;
#pragma unroll
            for (int j = 0; j < 4; ++j) { fo[j] = run * LOG2E; go[j] = (ii[j] - run) * LOG2E - 4.5f; run -= lf[j]; } }
        *(f32x4*)(F + tid * 4) = fo; *(f32x4*)(Gp + tid * 4) = go;
    }
}
struct DecayOrder {
    const char* Qb; const char* Kb; int G, c;
    __device__ __forceinline__ bool next(int ii, pg8::Unit& u) const {
        const int L = ii * G + c; if (L >= 16 * 64) return false;
        const int bh = L >> 6, i = (L >> 3) & 7, j = L & 7, bl = bh >> 2, hd = bh & 3;
        u.A = Qb + ((size_t)(bl * SEQ + 256 * i) * ML_IN + hd * 512) * 2; u.B = Kb + ((size_t)(bl * SEQ + 256 * j) * ML_IN + hd * 512) * 2; u.r0 = 256 * i; u.c0 = 256 * j; u.a0 = bh; u.a1 = (i << 4) | j; u.nt = ML_DH / 64; u.flags = 3; return true;
    }
    __device__ __forceinline__ int kb(const pg8::Unit&, int t) const { return t; }
};
struct EpiDecay {
    static constexpr bool PERM = true;
    bf16* W; const float* FG; float* DEN; int den_on;
    __device__ __forceinline__ void pass(const f32x4 (&acc)[2][2][4][2], const pg8::Unit& u, int wr, int wc, int fr, int fq, int dir, int dmin, int dmax, int cblk) const {
        const int bh = u.a0; const float* F = FG + (size_t)(dir * 2) * 16 * 2048 + (size_t)bh * 2048; const float* Gp = F + 16 * 2048;
        const int rl0 = opaque_v(wr * 64 + fr), cl0 = opaque_v(wc * 32 + 8 * fq);
        f32x4 gv[2][2];
#pragma unroll
        for (int bj = 0; bj < 2; ++bj)
#pragma unroll
            for (int n = 0; n < 2; ++n) gv[bj][n] = *(const f32x4*)(Gp + u.c0 + cl0 + bj * 128 + 4 * n);
        bf16* wbase = W + ((size_t)bh * SEQ + u.r0) * WLD + cblk * 256 + cl0;
        float* den = DEN + (size_t)dir * 16 * 2048 + (size_t)bh * 2048 + u.r0;
        const float* Fr = F + u.r0;
#pragma unroll
        for (int ai = 0; ai < 2; ++ai)
#pragma unroll
            for (int m = 0; m < 4; ++m) { const int rl = rl0 + ai * 128 + m * 16; const float fv = Fr[rl]; float rs = 0.f;
#pragma unroll
                for (int bj = 0; bj < 2; ++bj) { float r[8];
#pragma unroll
                    for (int n = 0; n < 2; ++n)
#pragma unroll
                        for (int i = 0; i < 4; ++i) { const int d = cl0 + bj * 128 + 4 * n + i - rl; float wv = acc[ai][bj][m][n][i] * __builtin_amdgcn_exp2f(fv + gv[bj][n][i]);
                            wv = (d >= dmin && d <= dmax) ? wv : 0.f; r[4 * n + i] = wv; rs += wv; }
                    u32x4 w; w.x = pk2(r[0], r[1]); w.y = pk2(r[2], r[3]); w.z = pk2(r[4], r[5]); w.w = pk2(r[6], r[7]);
                    *(u32x4*)(wbase + (size_t)rl * WLD + bj * 128) = w; }
                rs += __shfl_xor(rs, 16); rs += __shfl_xor(rs, 32);
                if (fq == 0 && den_on) atomicAdd(den + rl, rs); }
    }
    __device__ __forceinline__ void operator()(const f32x4 (&acc)[2][2][4][2], const pg8::Unit& u, int wr, int wc, int fr_, int fq_) const {
        (void)fr_; (void)fq_; const int ln_ = opaque_v(lane_id()); const int fr = ln_ & 15, fq = ln_ >> 4;
        const int i = u.a1 >> 4, j = u.a1 & 15;
        const int npass = (i == j) ? 2 : 1;
        for (int p = 0; p < npass; ++p) {
            int dir, dmin, dmax, cblk;
            if (j < i) { dir = 0; dmin = -100000; dmax = 100000; cblk = j; }
            else if (j > i) { dir = 1; dmin = -100000; dmax = 100000; cblk = j + 1; }
            else if (p == 0) { dir = 0; dmin = -100000; dmax = 0; cblk = i; }
            else { dir = 1; dmin = 0; dmax = 100000; cblk = i + 1; }
            pass(acc, u, wr, wc, fr, fq, dir, dmin, dmax, cblk);
        }
    }
};
struct HOrder {
    const char* Wb; const char* Vb; int G, c;
    __device__ __forceinline__ bool next(int ii, pg8::Unit& u) const {
        const int L = (ii >> 1) * G + c, part = ii & 1; if (L >= 16 * 16) return false;
        const int bh = L >> 4, i = (L >> 1) & 7, jn = L & 1;
        const int kt0 = part ? 4 * (i + 1) : 0;
        u.A = Wb + (((size_t)bh * SEQ + 256 * i) * WLD + (size_t)kt0 * 64) * 2;
        u.B = Vb + (((size_t)bh * 512 + 256 * jn) * SEQ + (size_t)(part ? 4 * i : 0) * 64) * 2;
        u.r0 = 256 * i; u.c0 = 256 * jn; u.a0 = bh; u.a1 = part; u.nt = part ? 36 - 4 * (i + 1) : 4 * (i + 1); u.flags = 3; return true;
    }
    __device__ __forceinline__ int kb(const pg8::Unit&, int t) const { return t; }
};
struct EpiH {
    static constexpr bool PERM = true;
    bf16* HF; bf16* HB; const float* DEN;
    __device__ __forceinline__ void operator()(const f32x4 (&acc)[2][2][4][2], const pg8::Unit& u, int wr, int wc, int fr_, int fq_) const {
        (void)fr_; (void)fq_; const int ln_ = opaque_v(lane_id()); const int fr = ln_ & 15, fq = ln_ >> 4;
        const int bh = u.a0, bl = bh >> 2, hd = bh & 3, part = u.a1; const float* dn = DEN + (size_t)part * 16 * 2048 + (size_t)bh * 2048 + u.r0;
        const int rl0 = wr * 64 + fr, col0 = hd * 512 + u.c0 + wc * 32 + 8 * fq;
        bf16* Hh = part ? HB : HF;
#pragma unroll
        for (int ai = 0; ai < 2; ++ai)
#pragma unroll
            for (int m = 0; m < 4; ++m) { const int rl = rl0 + ai * 128 + m * 16; const float rv = 1.0f / fmaxf(fabsf(dn[rl]), 1.0f);
                bf16* rowp = Hh + ((size_t)bl * SEQ + u.r0 + rl) * ML_IN + col0;
#pragma unroll
                for (int bj = 0; bj < 2; ++bj) { const f32x4 v0 = acc[ai][bj][m][0] * rv, v1 = acc[ai][bj][m][1] * rv;
                    u32x4 w; w.x = pk2(v0[0], v0[1]); w.y = pk2(v0[2], v0[3]); w.z = pk2(v1[0], v1[1]); w.w = pk2(v1[2], v1[3]);
                    *(u32x4*)(rowp + bj * 128) = w; } }
    }
};
__device__ __forceinline__ void p_ynorm(const Ctx& C, int round, bool dummy = false) {
    const bf16* HF = C.w<bf16>(WS_Q); const bf16* HB = C.w<bf16>(WS_K); const bf16* XC = C.w<bf16>(WS_XC); bf16* Y = C.w<bf16>(WS_Y) + (size_t)round * RT * ML_IN;
    const float* og = C.in(IN_ONG); const float* skip = C.in(IN_SKIP);
    bf16* Yd = dummy ? C.w<bf16>(WS_XMH) : Y;
    for (int r = C.vcu * 8 + C.wave; r < RT; r += C.G * 8) {
        const size_t off = (size_t)r * ML_IN + 8 * C.lane;
#pragma unroll
        for (int hd = 0; hd < 4; ++hd) {
            const u32x4 hw = *(const u32x4*)(HF + off + hd * 512), hw2 = *(const u32x4*)(HB + off + hd * 512), xw = *(const u32x4*)(XC + off + hd * 512), zw = *(const u32x4*)(Y + off + hd * 512);
            float hv[8] = {bflo(hw.x) + bflo(hw2.x), bfhi(hw.x) + bfhi(hw2.x), bflo(hw.y) + bflo(hw2.y), bfhi(hw.y) + bfhi(hw2.y), bflo(hw.z) + bflo(hw2.z), bfhi(hw.z) + bfhi(hw2.z), bflo(hw.w) + bflo(hw2.w), bfhi(hw.w) + bfhi(hw2.w)};
            const float xv[8] = {bflo(xw.x), bfhi(xw.x), bflo(xw.y), bfhi(xw.y), bflo(xw.z), bfhi(xw.z), bflo(xw.w), bfhi(xw.w)};
            const float zv[8] = {bflo(zw.x), bfhi(zw.x), bflo(zw.y), bfhi(zw.y), bflo(zw.z), bfhi(zw.z), bflo(zw.w), bfhi(zw.w)};
            float ss = 0.f;
#pragma unroll
            for (int j = 0; j < 8; ++j) ss += hv[j] * hv[j];
            const float rs = 1.0f / sqrtf(wave_sum(ss) * (1.0f / 512.0f) + EPS);
            const float* gg = og + hd * 512 + 8 * C.lane; const float* sk = skip + hd * 512 + 8 * C.lane; float yv[8];
#pragma unroll
            for (int j = 0; j < 8; ++j) yv[j] = (hv[j] * rs * gg[j] + sk[j] * xv[j]) * silu_f(zv[j]);
            u32x4 w; w.x = pk2(yv[0], yv[1]); w.y = pk2(yv[2], yv[3]); w.z = pk2(yv[4], yv[5]); w.w = pk2(yv[6], yv[7]);
            *(u32x4*)(Yd + off + hd * 512) = w;
        }
    }
}

constexpr int PH_PRO = 0, PH_NORM0 = 1, PH_QKV = 2, PH_ATTN = 3, PH_OUT0 = 4, PH_ROUTE0 = 5, PH_PERM0 = 6, PH_UP0 = 7, PH_DOWN0 = 8, PH_COMB0 = 9,
              PH_NORM1 = 10, PH_RND = 11  , PH_OUT1 = PH_RND + 6 * NROUND, PH_ROUTE1 = PH_OUT1 + 1, PH_PERM1 = PH_OUT1 + 2,
              PH_UP1 = PH_OUT1 + 3, PH_DOWN1 = PH_OUT1 + 4, PH_COMB1 = PH_OUT1 + 5, N_PHASES = PH_OUT1 + 6;

__device__ __forceinline__ void moe_up(const Ctx& C, int layer) {
    const MoeTab T = moe_tables(C, layer);
    MoeOrder<2> S; S.T = T; S.A = (const char*)C.w<bf16>(WS_HS); S.B = (const char*)C.w<bf16>(WS_W13T); S.lda_bytes = DM * 2; S.b_expert_bytes = (size_t)512 * DM * 2; S.b_tile_bytes = 256 * DM * 2; S.G = C.G; S.c = C.vcu; S.nt = DM / 64;
    EpiSwiGLU E{C.w<bf16>(WS_HH)};
    pg8::gemm_phase<EpiSwiGLU, MoeOrder<2>, true>(C.lds, C.tid, DM, DM, S, E);
}
__device__ __forceinline__ void moe_down(const Ctx& C, int layer) {
    const MoeTab T = moe_tables(C, layer);
    MoeOrder<4> S; S.T = T; S.A = (const char*)C.w<bf16>(WS_HH); S.B = (const char*)C.w<bf16>(WS_W2T); S.lda_bytes = DEXP * 2; S.b_expert_bytes = (size_t)DM * DEXP * 2; S.b_tile_bytes = 256 * DEXP * 2; S.G = C.G; S.c = C.vcu; S.nt = DEXP / 64;
    pg8::EpiBf16 E{C.w<bf16>(WS_YS), DM, 0, nullptr, 0};
    pg8::gemm_phase<pg8::EpiBf16, MoeOrder<4>, true>(C.lds, C.tid, DEXP, DEXP, S, E);
}

__global__ void __launch_bounds__(512, 2) fwd_kernel(Args args) {
    extern __shared__ __attribute__((aligned(16))) unsigned char lds_raw[];
    Ctx C; C.a = &args; C.ws = args.ws; C.lds = (LAS unsigned char*)lds_raw; C.tid = threadIdx.x; C.lane = C.tid & 63; C.wave = __builtin_amdgcn_readfirstlane(C.tid >> 6);
    C.G = gridDim.x; { const int bx = blockIdx.x; C.vcu = (C.G % 8 == 0) ? (bx % 8) * (C.G / 8) + bx / 8 : bx; }
    volatile LAS unsigned* MISC = (volatile LAS unsigned*)(C.lds + MISC_OFF);
    if (C.tid < 64) MISC[C.tid] = 0u;
    __syncthreads();
    const int lo = args.ph_lo, hi = args.ph_hi;
    XcdBarrier bar; bar.bar = C.w<unsigned>(WS_CTL) + CW_BAR; bar.x = 0; bar.st = nullptr;
    if (hi - lo > 1) bar = xcd_barrier_post(C.w<unsigned>(WS_CTL) + CW_BAR, MISC + 8);
#ifndef PHSEL
#define PHSEL(k) true
#endif
#define IN(k) (PHSEL(k) && lo <= (k) && (k) < hi)
#ifndef REP_PH
#define REP_PH (-1)
#endif
#ifndef REP_J
#define REP_J (-1)
#endif
#ifndef REP_N
#define REP_N 0
#endif
#define NREP(k) (1 + (((k) == REP_PH) ? REP_N : 0))
#define NREPJ(j) (1 + (((j) == REP_J) ? REP_N : 0))
#define SEAM(k) do { if (IN(k) && IN((k) + 1)) xcd_barrier(bar); } while (0)
    float* xout = args.out;

    if (IN(PH_PRO)) for (int rep_ = 0; rep_ < NREP(PH_PRO); ++rep_) { const Ctx P = fresh(C); p_prologue(P); } SEAM(PH_PRO);
    if (IN(PH_NORM0)) for (int rep_ = 0; rep_ < NREP(PH_NORM0); ++rep_) { const Ctx P = fresh(C); p_normmod(P, P.in(IN_X), 0, 0, NT, P.w<bf16>(WS_HM)); } SEAM(PH_NORM0);
    if (IN(PH_QKV)) for (int rep_ = 0; rep_ < NREP(PH_QKV); ++rep_) { const Ctx P = fresh(C);
        { pg8::PlainOrder S{(const char*)P.w<bf16>(WS_HM), (const char*)P.w<bf16>(WS_WINT), DM, DM, NT / 256, 2048 / 256, P.G, P.vcu, DM / 64};
          pg8::EpiBf16 E{P.w<bf16>(WS_QK), 2048, 0, nullptr, 0};
          pg8::gemm_phase<pg8::EpiBf16, pg8::PlainOrder, true>(P.lds, P.tid, DM, DM, S, E); }
        { pg8::PlainOrder S{(const char*)(P.w<bf16>(WS_WINT) + (size_t)2048 * DM), (const char*)P.w<bf16>(WS_HM), DM, DM, 1024 / 256, NT / 256, P.G, P.vcu, DM / 64};
          pg8::EpiBf16 E{P.w<bf16>(WS_VT), NT, 0, nullptr, 0};
          pg8::gemm_phase<pg8::EpiBf16, pg8::PlainOrder, true>(P.lds, P.tid, DM, DM, S, E); }
    } SEAM(PH_QKV);
    if (IN(PH_ATTN)) for (int rep_ = 0; rep_ < NREP(PH_ATTN); ++rep_) { const Ctx P = fresh(C); p_attention(P); } SEAM(PH_ATTN);
    if (IN(PH_OUT0)) for (int rep_ = 0; rep_ < NREP(PH_OUT0); ++rep_) { const Ctx P = fresh(C);
        pg8::PlainOrder S{(const char*)P.w<bf16>(WS_O), (const char*)P.w<bf16>(WS_WOT), DM, DM, NT / 256, DM / 256, P.G, P.vcu, DM / 64};
        pg8::EpiResid E{P.in(IN_X), xout, P.mods(0, 2)};
        pg8::gemm_phase<pg8::EpiResid, pg8::PlainOrder, true>(P.lds, P.tid, DM, DM, S, E);
    } SEAM(PH_OUT0);
    if (IN(PH_ROUTE0)) for (int rep_ = 0; rep_ < NREP(PH_ROUTE0); ++rep_) { const Ctx P = fresh(C); p_route(P, 0, rep_ == 0); } SEAM(PH_ROUTE0);
    if (IN(PH_PERM0)) for (int rep_ = 0; rep_ < NREP(PH_PERM0); ++rep_) { const Ctx P = fresh(C); p_permute(P, 0); } SEAM(PH_PERM0);
    if (IN(PH_UP0)) for (int rep_ = 0; rep_ < NREP(PH_UP0); ++rep_) { const Ctx P = fresh(C); moe_up(P, 0); } SEAM(PH_UP0);
    if (IN(PH_DOWN0)) for (int rep_ = 0; rep_ < NREP(PH_DOWN0); ++rep_) { const Ctx P = fresh(C); moe_down(P, 0); } SEAM(PH_DOWN0);
    if (IN(PH_COMB0)) for (int rep_ = 0; rep_ < NREP(PH_COMB0); ++rep_) { const Ctx P = fresh(C); p_combine(P, 0, rep_ == 0 ? xout : P.w<float>(WS_HS)); LAS float* scr = (LAS float*)(P.lds + P.wave * 16384); moe_weight_items(P, 1, scr); } SEAM(PH_COMB0);

    if (IN(PH_NORM1)) for (int rep_ = 0; rep_ < NREP(PH_NORM1); ++rep_) { const Ctx P = fresh(C); p_normmod(P, xout, 1, 0, RT, P.w<bf16>(WS_HMR)); } SEAM(PH_NORM1);
    for (int round = 0; round < NROUND; ++round) {
        const int pb = PH_RND + 6 * round;
        if (IN(pb + 0)) for (int rep_ = 0; rep_ < NREPJ(0); ++rep_) { const Ctx P = fresh(C);
            pg8::PlainOrder S{(const char*)P.w<bf16>(WS_HMR), (const char*)P.w<bf16>(WS_MLWINT), DM, DM, RT / 256, 4096 / 256, P.G, P.vcu, DM / 64};
            pg8::EpiBf16 E{P.w<bf16>(WS_XMH), ML_IN, ML_IN, P.w<bf16>(WS_Y) + (size_t)round * RT * ML_IN, ML_IN};
            pg8::gemm_phase<pg8::EpiBf16, pg8::PlainOrder, true>(P.lds, P.tid, DM, DM, S, E);
        } SEAM(pb + 0);
        if (IN(pb + 1)) for (int rep_ = 0; rep_ < NREPJ(1); ++rep_) { const Ctx P = fresh(C); p_conv(P, round); } SEAM(pb + 1);
        if (IN(pb + 2)) for (int rep_ = 0; rep_ < NREPJ(2); ++rep_) { const Ctx P = fresh(C); p_cumsum(P); } SEAM(pb + 2);
        if (IN(pb + 3)) for (int rep_ = 0; rep_ < NREPJ(3); ++rep_) { const Ctx P = fresh(C);
            DecayOrder S{(const char*)P.w<bf16>(WS_Q), (const char*)P.w<bf16>(WS_K), P.G, P.vcu};
            EpiDecay E{P.w<bf16>(WS_W), P.w<float>(WS_FG), P.w<float>(WS_DEN), rep_ == 0 ? 1 : 0};
            pg8::gemm_phase<EpiDecay, DecayOrder, true>(P.lds, P.tid, ML_IN, ML_IN, S, E);
        } SEAM(pb + 3);
        if (IN(pb + 4)) for (int rep_ = 0; rep_ < NREPJ(4); ++rep_) { const Ctx P = fresh(C);
            HOrder S{(const char*)P.w<bf16>(WS_W), (const char*)P.w<bf16>(WS_VTR), P.G, P.vcu};
            EpiH E{P.w<bf16>(WS_Q), P.w<bf16>(WS_K), P.w<float>(WS_DEN)};
            pg8::gemm_phase<EpiH, HOrder, true>(P.lds, P.tid, WLD, SEQ, S, E);
        } SEAM(pb + 4);
        if (IN(pb + 5)) for (int rep_ = 0; rep_ < NREPJ(5); ++rep_) { const Ctx P = fresh(C); p_ynorm(P, round, rep_ != 0); if (round + 1 < NROUND) p_normmod(P, xout, 1, (round + 1) * RT, (round + 2) * RT, P.w<bf16>(WS_HMR)); } SEAM(pb + 5);
    }
    if (IN(PH_OUT1)) for (int rep_ = 0; rep_ < NREP(PH_OUT1); ++rep_) { const Ctx P = fresh(C);
        pg8::PlainOrder S{(const char*)P.w<bf16>(WS_Y), (const char*)P.w<bf16>(WS_MLWOUTT), ML_IN, ML_IN, NT / 256, DM / 256, P.G, P.vcu, ML_IN / 64};
        pg8::EpiResid E{xout, xout, P.mods(1, 2)};
        pg8::gemm_phase<pg8::EpiResid, pg8::PlainOrder, true>(P.lds, P.tid, ML_IN, ML_IN, S, E);
    } SEAM(PH_OUT1);
    if (IN(PH_ROUTE1)) for (int rep_ = 0; rep_ < NREP(PH_ROUTE1); ++rep_) { const Ctx P = fresh(C); p_route(P, 1, rep_ == 0); } SEAM(PH_ROUTE1);
    if (IN(PH_PERM1)) for (int rep_ = 0; rep_ < NREP(PH_PERM1); ++rep_) { const Ctx P = fresh(C); p_permute(P, 1); } SEAM(PH_PERM1);
    if (IN(PH_UP1)) for (int rep_ = 0; rep_ < NREP(PH_UP1); ++rep_) { const Ctx P = fresh(C); moe_up(P, 1); } SEAM(PH_UP1);
    if (IN(PH_DOWN1)) for (int rep_ = 0; rep_ < NREP(PH_DOWN1); ++rep_) { const Ctx P = fresh(C); moe_down(P, 1); } SEAM(PH_DOWN1);
    if (IN(PH_COMB1)) for (int rep_ = 0; rep_ < NREP(PH_COMB1); ++rep_) { const Ctx P = fresh(C); p_combine(P, 1, rep_ == 0 ? xout : P.w<float>(WS_HS)); }
#undef IN
#undef SEAM
}

extern "C" void kernel_launch(void* const* d_in, const int* in_sizes, int n_in, void* d_out, int out_size, void* d_ws, size_t ws_size, hipStream_t stream) {
    static int grid = 0;
    if (grid == 0) {
        if (n_in != 32 || in_sizes[0] != NT * DM || out_size != NT * DM || ws_size < WS_END) { fprintf(stderr, "kernel_launch: unexpected shapes (n_in %d, in0 %d, out %d, ws %zu)\n", n_in, n_in > 0 ? in_sizes[0] : -1, out_size, ws_size); grid = -1; return; }
        int dev = 0, cus = 0, per_cu = 0;
        if (hipGetDevice(&dev) != hipSuccess || hipDeviceGetAttribute(&cus, hipDeviceAttributeMultiprocessorCount, dev) != hipSuccess) { grid = -1; return; }
        if (hipFuncSetAttribute((const void*)fwd_kernel, hipFuncAttributeMaxDynamicSharedMemorySize, LDS_BYTES) != hipSuccess) { fprintf(stderr, "kernel_launch: hipFuncSetAttribute failed\n"); grid = -1; return; }
        if (hipOccupancyMaxActiveBlocksPerMultiprocessor(&per_cu, (const void*)fwd_kernel, 512, LDS_BYTES) != hipSuccess || per_cu < 1) fprintf(stderr, "kernel_launch: occupancy query reports %d\n", per_cu);
        (void)hipGetLastError();
        grid = cus;
    }
    if (grid < 0) return;
    (void)hipMemsetAsync((char*)d_ws + WS_CTL, 0, CTL_ZERO_BYTES, stream);
    Args a{};
    for (int i = 0; i < 32; ++i) a.in[i] = (const float*)d_in[i];
    a.out = (float*)d_out; a.ws = (unsigned char*)d_ws;
#if MK_ONE_LAUNCH
    a.ph_lo = 0; a.ph_hi = N_PHASES;
    hipLaunchKernelGGL(fwd_kernel, dim3(grid), dim3(512), LDS_BYTES, stream, a);
#else
    for (int p = 0; p < N_PHASES; ++p) { a.ph_lo = p; a.ph_hi = p + 1; hipLaunchKernelGGL(fwd_kernel, dim3(grid), dim3(512), LDS_BYTES, stream, a); }
#endif
}
```

```cpp
#include <hip/hip_runtime.h>
#include <cstdio>
#include <cstdint>

#ifndef REP_ABL
#define REP_ABL 0
#endif
#ifndef GEMM1_STAGGER
#define GEMM1_STAGGER 0ull
#endif
#ifndef GEMM1_ALIGN
#define GEMM1_ALIGN true
#endif
#ifndef MK_ONE_LAUNCH
#define MK_ONE_LAUNCH 1
#endif

#define GAS __attribute__((address_space(1)))
#define LAS __attribute__((address_space(3)))
typedef unsigned short bf16;
typedef short bf16x8 __attribute__((ext_vector_type(8)));
typedef float f32x4 __attribute__((ext_vector_type(4)));
typedef float f32x16 __attribute__((ext_vector_type(16)));
typedef float f32x2 __attribute__((ext_vector_type(2)));
typedef unsigned u32x4 __attribute__((ext_vector_type(4)));
typedef unsigned u32x2 __attribute__((ext_vector_type(2)));

constexpr int NB = 16, SEQ = 2048, DM = 1024, NT = NB * SEQ;
constexpr int DA_H = 8;
constexpr int ML_IN = 2048, ML_H = 4, ML_DH = 512;
constexpr int NEXP = 32, DEXP = 256;
constexpr float EPS = 1e-6f;
constexpr float LOG2E = 1.4426950408889634f;
constexpr int RB = 4;
constexpr int NROUND = NB / RB;
constexpr int RT = RB * SEQ;
constexpr int WLD = 2304;
constexpr int MAXSLOT = 2 * NT + NEXP * 256;

constexpr size_t MiB = 1u << 20;
constexpr size_t WS_CTL = 0, CTL_ZERO_BYTES = 1 * MiB;
constexpr size_t WS_MODS = 2 * MiB;
constexpr size_t WS_TAB2 = 3 * MiB;
constexpr size_t WS_SCAL = 3 * MiB + 128 * 1024;
constexpr size_t WS_GWT = 3 * MiB + 256 * 1024;
constexpr size_t WS_RE = 4 * MiB;
constexpr size_t WS_RW = 4 * MiB + 256 * 1024;
constexpr size_t WS_RP = 4 * MiB + 512 * 1024;
constexpr size_t WS_RS = 4 * MiB + 768 * 1024;
constexpr size_t WS_PRE = 5 * MiB;
constexpr size_t WS_FG = 5 * MiB + 512 * 1024;
constexpr size_t WS_DEN = 6 * MiB;
constexpr size_t WS_WINT = 8 * MiB;
constexpr size_t WS_WOT = 14 * MiB;
constexpr size_t WS_MLWINT = 16 * MiB;
constexpr size_t WS_MLWOUTT = 24 * MiB;
constexpr size_t WS_W13T = 28 * MiB;
constexpr size_t WS_W2T = 60 * MiB;
constexpr size_t WS_BIG = 76 * MiB;
constexpr size_t WS_HM = WS_BIG + 0 * MiB;
constexpr size_t WS_QK = WS_BIG + 64 * MiB;
constexpr size_t WS_VT = WS_BIG + 192 * MiB;
constexpr size_t WS_O = WS_BIG + 256 * MiB;
constexpr size_t WS_HF = WS_BIG + 0 * MiB;
constexpr size_t WS_HS = WS_BIG + 64 * MiB;
constexpr size_t WS_TL = WS_BIG + 64 * MiB;
constexpr size_t WS_HH = WS_BIG + 208 * MiB;
constexpr size_t WS_YS = WS_BIG + 244 * MiB;
constexpr size_t WS_Y = WS_BIG + 0 * MiB;
constexpr size_t WS_W = WS_BIG + 128 * MiB;
constexpr size_t WS_HMR = WS_BIG + 128 * MiB;
constexpr size_t WS_XMH = WS_BIG + 272 * MiB;
constexpr size_t WS_XC = WS_BIG + 304 * MiB;
constexpr size_t WS_Q = WS_BIG + 336 * MiB;
constexpr size_t WS_K = WS_BIG + 368 * MiB;
constexpr size_t WS_VTR = WS_BIG + 400 * MiB;
constexpr size_t WS_XB3 = WS_BIG + 128 * MiB;
constexpr size_t WS_END = WS_BIG + 432 * MiB;
static_assert(WS_END <= 512 * MiB, "ws map");
static_assert((size_t)MAXSLOT * 1024 * 2 <= 144 * MiB && (size_t)MAXSLOT * 256 * 2 <= 36 * MiB, "slot buffers");
constexpr int CW_CNT = 64;
constexpr int CW_BAR = 4096;

constexpr int RING_BYTES = 131072;
constexpr int MISC_OFF = RING_BYTES;
constexpr int LDS_BYTES = RING_BYTES + 16384;

__device__ __forceinline__ unsigned f2bf(float f) { unsigned u = __builtin_bit_cast(unsigned, f); return (u + 0x7fffu + ((u >> 16) & 1u)) >> 16; }
__device__ __forceinline__ unsigned pk2(float lo, float hi) { unsigned r; asm("v_cvt_pk_bf16_f32 %0, %1, %2" : "=v"(r) : "v"(lo), "v"(hi)); return r; }
__device__ __forceinline__ float bf2f(unsigned short b) { return __builtin_bit_cast(float, ((unsigned)b) << 16); }
__device__ __forceinline__ float bflo(unsigned w) { return __builtin_bit_cast(float, w << 16); }
__device__ __forceinline__ float bfhi(unsigned w) { return __builtin_bit_cast(float, w & 0xffff0000u); }
__device__ __forceinline__ float wave_sum(float v) {
#pragma unroll
    for (int o = 1; o < 64; o <<= 1) v += __shfl_xor(v, o);
    return v;
}
__device__ __forceinline__ float silu_f(float v) { return v / (1.0f + __expf(-v)); }
#define LDS_WAIT() asm volatile("s_waitcnt lgkmcnt(0)" ::: "memory")
#define VM_WAIT() asm volatile("s_waitcnt vmcnt(0)" ::: "memory")
#define LDS_BARRIER() do { asm volatile("s_waitcnt lgkmcnt(0)" ::: "memory"); __builtin_amdgcn_s_barrier(); asm volatile("" ::: "memory"); } while (0)
__device__ __forceinline__ int opaque_v(int x) { asm volatile("" : "+v"(x)); return x; }
__device__ __forceinline__ int lane_id() { return (int)__builtin_amdgcn_mbcnt_hi(~0u, __builtin_amdgcn_mbcnt_lo(~0u, 0u)); }

namespace pg8 {
constexpr int BM = 256, BK = 64, HALF = 128, HTB = HALF * BK * 2, STAGE_BYTES = 8 * HTB;
static_assert(STAGE_BYTES == RING_BYTES, "stage region");
__host__ __device__ __forceinline__ int lds_byte(int r, int c) { const int st = (r >> 4) * 2 + (c >> 5), rr = r & 15, cc = c & 31, ob = rr * 64 + cc * 2; return st * 1024 + (ob ^ (((ob >> 9) & 1) << 5)); }
__host__ __device__ __forceinline__ void stage_rc(int b, int& R, int& C) { const int st = b / 1024, sb = b % 1024, swz = sb ^ (((sb >> 9) & 1) << 5); R = (st >> 1) * 16 + swz / 64; C = (st & 1) * 32 + (swz % 64) / 2; }
__host__ __device__ __forceinline__ int perm32(int rho) { const int n = rho >> 4, i = rho & 15; return 8 * (i >> 2) + 4 * n + (i & 3); }

struct Unit { const char* A; const char* B; int r0, c0, a0, a1, nt, flags; };

__device__ __forceinline__ unsigned cvt_pk_bf16(float lo, float hi) { unsigned r; asm volatile("v_cvt_pk_bf16_f32 %0, %1, %2" : "=v"(r) : "v"(lo), "v"(hi)); return r; }

template <class Epi, class Sched, bool ALIGN_EPI, bool GATHER = false, bool PAIR = false>
__device__ __forceinline__ void gemm_phase(LAS unsigned char* lds, const int tid, const int lda, const int ldb, const Sched& S, const Epi& E) {
    const int wid = __builtin_amdgcn_readfirstlane(tid >> 6), lane = tid & 63, wr = wid >> 2, wc = wid & 3, fr = lane & 15, fq = lane >> 4;
    unsigned voffA[2], voffB[2]; int gR[2], gC[2];
#pragma unroll
    for (int i = 0; i < 2; ++i) { int R, C; stage_rc(tid * 16 + i * 8192, R, C); const int Rb = Epi::PERM ? ((R & ~31) + perm32(R & 31)) : R; gR[i] = R; gC[i] = C;
        voffA[i] = (unsigned)(R * lda + C) * 2u; voffB[i] = (unsigned)(Rb * ldb + C) * 2u; }
    unsigned cv[2][2], nv[2][2];
    const size_t kstep = (size_t)(BK * 2);
    const size_t hstepA = GATHER ? 0 : (size_t)HALF * lda * 2, hstepB = (size_t)HALF * ldb * 2;
    const unsigned ldsw = (unsigned)wid * 1024u;
    const int aoff = lds_byte(wr * 64 + fr, fq * 8), boff = lds_byte(wc * 32 + fr, fq * 8);
#define PG8_SA(b, h) (((b) * 2 + (h)) * HTB)
#define PG8_SB(b, h) ((4 + (b) * 2 + (h)) * HTB)
#define PG8_STAGE(bufoff, gbase, voff) do { _Pragma("unroll") for (int _i = 0; _i < 2; ++_i) \
        __builtin_amdgcn_global_load_lds((const unsigned*)((const char*)(gbase) + (voff)[_i]), (LAS unsigned*)(lds + (bufoff) + ldsw + _i * 8192), 16, 0, 0); } while (0)
#define PG8_STAGE_A(bufoff, gbase, h, nx) do { if constexpr (GATHER) { if (nx) PG8_STAGE(bufoff, gbase, nv[h]); else PG8_STAGE(bufoff, gbase, cv[h]); } else PG8_STAGE(bufoff, (gbase) + (h) * hstepA, voffA); } while (0)
#define PG8_LDA(dst, b, h) do { _Pragma("unroll") for (int m = 0; m < 4; ++m) _Pragma("unroll") for (int k = 0; k < 2; ++k) dst[m][k] = *(const LAS bf16x8*)(lds + PG8_SA(b, h) + aoff + m * 2048 + k * 1024); } while (0)
#define PG8_LDB(dst, b, h) do { _Pragma("unroll") for (int n = 0; n < 2; ++n) _Pragma("unroll") for (int k = 0; k < 2; ++k) dst[n][k] = *(const LAS bf16x8*)(lds + PG8_SB(b, h) + boff + n * 2048 + k * 1024); } while (0)
#define PG8_MMA(ai, bj, At, Bt) do { __builtin_amdgcn_s_setprio(1); _Pragma("unroll") for (int m = 0; m < 4; ++m) _Pragma("unroll") for (int n = 0; n < 2; ++n) _Pragma("unroll") for (int k = 0; k < 2; ++k) \
        acc[ai][bj][m][n] = __builtin_amdgcn_mfma_f32_16x16x32_bf16(Bt[n][k], At[m][k], acc[ai][bj][m][n], 0, 0, 0); __builtin_amdgcn_s_setprio(0); } while (0)
#define PG8_WAIT_V(n) asm volatile("s_waitcnt vmcnt(" #n ")" ::: "memory")
#define PG8_WAIT_L(n) asm volatile("s_waitcnt lgkmcnt(" #n ")" ::: "memory")
#define PG8_BAR __builtin_amdgcn_s_barrier()
#define PG8_SCHED __builtin_amdgcn_sched_barrier(0)
    Unit cur, nxt; int ui = 0;
    if (!S.next(0, cur)) return;
    f32x4 acc[2][2][4][2];
#pragma unroll
    for (int a = 0; a < 2; ++a)
#pragma unroll
        for (int b = 0; b < 2; ++b)
#pragma unroll
            for (int m = 0; m < 4; ++m)
#pragma unroll
                for (int n = 0; n < 2; ++n) acc[a][b][m][n] = (f32x4){0.f, 0.f, 0.f, 0.f};
    bf16x8 At[4][2], B0[2][2], B1[2][2];
    const char* cA = cur.A; const char* cB = cur.B;
    if constexpr (GATHER) {
#pragma unroll
        for (int h = 0; h < 2; ++h)
#pragma unroll
            for (int i = 0; i < 2; ++i) cv[h][i] = S.arow(cur, h * HALF + gR[i]) + (unsigned)gC[i] * 2u; }
    {
        const char* b0 = cB + (size_t)S.kb(cur, 0) * kstep; const char* b1 = cB + (size_t)S.kb(cur, 1) * kstep;
        PG8_STAGE(PG8_SB(0, 0), b0, voffB); PG8_STAGE(PG8_SB(0, 1), b0 + hstepB, voffB); PG8_STAGE_A(PG8_SA(0, 0), cA, 0, false); PG8_STAGE_A(PG8_SA(0, 1), cA, 1, false);
        if (wr == 1) PG8_BAR;
        PG8_WAIT_V(2); PG8_BAR;
        PG8_STAGE(PG8_SB(1, 0), b1, voffB); PG8_STAGE_A(PG8_SA(1, 0), cA + kstep, 0, false); PG8_STAGE(PG8_SB(1, 1), b1 + hstepB, voffB);
        PG8_WAIT_V(6); PG8_BAR;
    }
    bool has_next; const char* nA; const char* nB;
#define PG8_UNIT_KLOOP() do { \
        has_next = S.next(ui + 1, nxt); \
        const Unit& nu = has_next ? nxt : cur; \
        if constexpr (GATHER) { \
            _Pragma("unroll") for (int h = 0; h < 2; ++h) _Pragma("unroll") for (int i = 0; i < 2; ++i) nv[h][i] = S.arow(nu, h * HALF + gR[i]) + (unsigned)gC[i] * 2u; } \
        nA = nu.A; nB = nu.B; \
        const int nt = cur.nt; \
        for (int t = 0; t < nt; t += 2) { \
            const bool last = (t == nt - 2); \
            const char* a1 = cA + (size_t)(t + 1) * kstep; \
            const char* a2 = last ? nA : cA + (size_t)(t + 2) * kstep; \
            const char* a3 = a2 + kstep; \
            const char* b2 = last ? nB + (size_t)S.kb(nu, 0) * kstep : cB + (size_t)S.kb(cur, t + 2) * kstep; \
            const char* b3 = last ? nB + (size_t)S.kb(nu, 1) * kstep : cB + (size_t)S.kb(cur, t + 3) * kstep; \
            PG8_LDB(B0, 0, 0); PG8_LDB(B1, 0, 1); PG8_SCHED; PG8_LDA(At, 0, 0); PG8_STAGE_A(PG8_SA(1, 1), a1, 1, false); \
            PG8_WAIT_V(8); PG8_WAIT_L(0); PG8_BAR; PG8_MMA(0, 0, At, B0); PG8_MMA(0, 1, At, B1); PG8_BAR; PG8_SCHED; \
            PG8_LDA(At, 0, 1); PG8_STAGE(PG8_SB(0, 0), b2, voffB); PG8_STAGE(PG8_SB(0, 1), b2 + hstepB, voffB); PG8_STAGE_A(PG8_SA(0, 0), a2, 0, last); \
            PG8_WAIT_V(8); PG8_WAIT_L(0); PG8_BAR; PG8_MMA(1, 0, At, B0); PG8_MMA(1, 1, At, B1); PG8_BAR; PG8_SCHED; \
            PG8_LDB(B0, 1, 0); PG8_LDB(B1, 1, 1); PG8_SCHED; PG8_LDA(At, 1, 0); PG8_STAGE_A(PG8_SA(0, 1), a2, 1, last); \
            PG8_WAIT_V(8); PG8_WAIT_L(0); PG8_BAR; PG8_MMA(0, 0, At, B0); PG8_MMA(0, 1, At, B1); PG8_BAR; PG8_SCHED; \
            PG8_LDA(At, 1, 1); PG8_STAGE(PG8_SB(1, 0), b3, voffB); PG8_STAGE(PG8_SB(1, 1), b3 + hstepB, voffB); PG8_STAGE_A(PG8_SA(1, 0), a3, 0, last); \
            PG8_WAIT_V(8); PG8_WAIT_L(0); PG8_BAR; PG8_MMA(1, 0, At, B0); PG8_MMA(1, 1, At, B1); PG8_BAR; PG8_SCHED; \
        } } while (0)
#define PG8_ADVANCE() do { cur = nxt; cA = nA; cB = nB; ++ui; \
        if constexpr (GATHER) { _Pragma("unroll") for (int h = 0; h < 2; ++h) _Pragma("unroll") for (int i = 0; i < 2; ++i) cv[h][i] = nv[h][i]; } } while (0)
    for (;;) {
        PG8_UNIT_KLOOP();
        if constexpr (PAIR) {
            S.between(cur, acc, wr);
            PG8_ADVANCE();
            PG8_UNIT_KLOOP();
        }
        if constexpr (ALIGN_EPI) { if (wr == 0) PG8_BAR; }
        E(acc, cur, wr, wc, fr, fq);
        if (!has_next) break;
#pragma unroll
        for (int a = 0; a < 2; ++a)
#pragma unroll
            for (int b = 0; b < 2; ++b)
#pragma unroll
                for (int m = 0; m < 4; ++m)
#pragma unroll
                    for (int n = 0; n < 2; ++n) acc[a][b][m][n] = (f32x4){0.f, 0.f, 0.f, 0.f};
        PG8_ADVANCE();
        if constexpr (ALIGN_EPI) { if (wr == 1) PG8_BAR; }
    }
#undef PG8_UNIT_KLOOP
#undef PG8_ADVANCE
    PG8_WAIT_V(0);
    if constexpr (!ALIGN_EPI) { if (wr == 0) PG8_BAR; }
    PG8_BAR;
#undef PG8_SA
#undef PG8_SB
#undef PG8_STAGE
#undef PG8_STAGE_A
#undef PG8_LDA
#undef PG8_LDB
#undef PG8_MMA
#undef PG8_WAIT_V
#undef PG8_WAIT_L
#undef PG8_BAR
#undef PG8_SCHED
}

struct PlainOrder {
    const char* A; const char* B; int lda, ldb, nM, nN, G, c, nt;
    __device__ __forceinline__ bool next(int i, Unit& u) const {
        const int L = i * G + c; if (L >= nM * nN) return false;
        const int pm = L / nN, pn = L - pm * nN;
        u.A = A + (size_t)pm * 256 * lda * 2; u.B = B + (size_t)pn * 256 * ldb * 2; u.r0 = pm * 256; u.c0 = pn * 256; u.a0 = 0; u.a1 = 0; u.nt = nt; u.flags = 3; return true;
    }
    __device__ __forceinline__ int kb(const Unit&, int t) const { return t; }
};
struct EpiBf16 {
    static constexpr bool PERM = true;
    bf16* O; int ldc; int split_cols; bf16* O2; int ldc2; int skip = 0;
    __device__ __forceinline__ void operator()(const f32x4 (&acc)[2][2][4][2], const Unit& u, int wr, int wc, int fr_, int fq_) const {
        (void)fr_; (void)fq_; const int ln_ = opaque_v(lane_id()); const int fr = ln_ & 15, fq = ln_ >> 4;
        bf16* base = O; int ld = ldc; int colt = u.c0;
        if (split_cols > 0 && colt >= split_cols) { base = O2; ld = ldc2; colt -= split_cols; }
        const int row0 = u.r0 + wr * 64 + fr, col0 = colt + wc * 32 + 8 * fq;
#pragma unroll
        for (int ai = 0; ai < 2; ++ai)
#pragma unroll
            for (int m = 0; m < 4; ++m) { bf16* rowp = base + (size_t)(row0 + ai * HALF + m * 16) * ld + col0;
#pragma unroll
                for (int bj = 0; bj < 2; ++bj) { const f32x4 v0 = acc[ai][bj][m][0], v1 = acc[ai][bj][m][1];
                    u32x4 w; w.x = cvt_pk_bf16(v0[0], v0[1]); w.y = cvt_pk_bf16(v0[2], v0[3]); w.z = cvt_pk_bf16(v1[0], v1[1]); w.w = cvt_pk_bf16(v1[2], v1[3]);
                    if (!((REP_ABL & 128) && skip)) *(u32x4*)(rowp + bj * HALF) = w; else if (w.x == 0x12345678u) *(u32x4*)(rowp) = w; } }
    }
};
template <bool XF32> struct EpiResid {
    static constexpr bool PERM = true;
    const void* xin; bf16* out; const float* gate;
    __device__ __forceinline__ void operator()(const f32x4 (&acc)[2][2][4][2], const Unit& u, int wr, int wc, int fr_, int fq_) const {
        (void)fr_; (void)fq_; const int ln_ = opaque_v(lane_id()); const int fr = ln_ & 15, fq = ln_ >> 4;
        const int row0 = u.r0 + wr * 64 + fr, col0 = u.c0 + wc * 32 + 8 * fq;
        const float* g = gate + (size_t)(u.r0 / SEQ) * 6144 + col0;
        f32x4 gv[2][2];
#pragma unroll
        for (int bj = 0; bj < 2; ++bj)
#pragma unroll
            for (int n = 0; n < 2; ++n) gv[bj][n] = *(const f32x4*)(g + bj * HALF + 4 * n);
#pragma unroll
        for (int ai = 0; ai < 2; ++ai)
#pragma unroll
            for (int m = 0; m < 4; ++m) { const size_t off = (size_t)(row0 + ai * HALF + m * 16) * DM + col0;
#pragma unroll
                for (int bj = 0; bj < 2; ++bj) { f32x4 x0, x1;
                    if (XF32) { x0 = *(const f32x4*)((const float*)xin + off + bj * HALF); x1 = *(const f32x4*)((const float*)xin + off + bj * HALF + 4); }
                    else { const u32x4 w = *(const u32x4*)((const bf16*)xin + off + bj * HALF); x0 = (f32x4){bflo(w.x), bfhi(w.x), bflo(w.y), bfhi(w.y)}; x1 = (f32x4){bflo(w.z), bfhi(w.z), bflo(w.w), bfhi(w.w)}; }
                    const f32x4 y0 = x0 + gv[bj][0] * acc[ai][bj][m][0], y1 = x1 + gv[bj][1] * acc[ai][bj][m][1];
                    u32x4 o; o.x = cvt_pk_bf16(y0[0], y0[1]); o.y = cvt_pk_bf16(y0[2], y0[3]); o.z = cvt_pk_bf16(y1[0], y1[1]); o.w = cvt_pk_bf16(y1[2], y1[3]);
                    *(u32x4*)(out + off + bj * HALF) = o; }
                if (m & 1) asm volatile("" ::: "memory"); }
    }
};
struct EpiQKNorm {
    static constexpr bool PERM = true;
    bf16* O; const float* qg; const float* kg; LAS float* xch;
    __device__ __forceinline__ void operator()(const f32x4 (&acc)[2][2][4][2], const Unit& u, int wr, int wc, int fr_, int fq_) const {
        (void)fr_; (void)fq_; const int ln_ = opaque_v(lane_id()); const int fr = ln_ & 15, fq = ln_ >> 4;
        const int wv = wr * 4 + wc;
        float ss[2][4][2];
#pragma unroll
        for (int ai = 0; ai < 2; ++ai)
#pragma unroll
            for (int m = 0; m < 4; ++m)
#pragma unroll
                for (int bj = 0; bj < 2; ++bj) { const f32x4 a = acc[ai][bj][m][0], b = acc[ai][bj][m][1];
                    float s = (a[0] * a[0] + a[1] * a[1]) + (a[2] * a[2] + a[3] * a[3]) + (b[0] * b[0] + b[1] * b[1]) + (b[2] * b[2] + b[3] * b[3]);
                    s += __shfl_xor(s, 16); s += __shfl_xor(s, 32); ss[ai][m][bj] = s;
                    if (fq == 0) xch[((wv * 2 + ai) * 4 + m) * 32 + fr * 2 + bj] = s; }
        asm volatile("s_waitcnt lgkmcnt(0)" ::: "memory"); __builtin_amdgcn_s_barrier(); asm volatile("" ::: "memory");
        const bool isq = u.c0 < 1024; const float* gain = (isq ? qg : kg) + (wc & 1) * 32 + 8 * fq; const float osc = isq ? 0.125f * LOG2E : 1.0f;
        f32x4 g0 = *(const f32x4*)gain, g1 = *(const f32x4*)(gain + 4); g0 = g0 * osc; g1 = g1 * osc;
        const int row0 = u.r0 + wr * 64 + fr, col0 = u.c0 + wc * 32 + 8 * fq; const int pw = wr * 4 + (wc ^ 1);
#pragma unroll
        for (int ai = 0; ai < 2; ++ai)
#pragma unroll
            for (int m = 0; m < 4; ++m) { bf16* rowp = O + (size_t)(row0 + ai * HALF + m * 16) * 2048 + col0;
#pragma unroll
                for (int bj = 0; bj < 2; ++bj) { const float tot = ss[ai][m][bj] + xch[((pw * 2 + ai) * 4 + m) * 32 + fr * 2 + bj];
                    const float rs = 1.0f / sqrtf(tot * (1.0f / 64.0f) + EPS);
                    const f32x4 v0 = acc[ai][bj][m][0] * rs * g0, v1 = acc[ai][bj][m][1] * rs * g1;
                    u32x4 w; w.x = cvt_pk_bf16(v0[0], v0[1]); w.y = cvt_pk_bf16(v0[2], v0[3]); w.z = cvt_pk_bf16(v1[0], v1[1]); w.w = cvt_pk_bf16(v1[2], v1[3]);
                    *(u32x4*)(rowp + bj * HALF) = w; } }
    }
};
}

#define XB_TMO      128
#define XB_XCNT(j)  (256  + 64 * (j))
#define XB_XSUB(j)  (1280 + 64 * (j))
#define XB_XGEN(j)  (2304 + 64 * (j))
#define XB_TOP      3328
#define XB_TOPGEN   3392
#define XCD_BAR_WORDS 3456
#define XB_SPIN_CAP (1u << 18)
__device__ __forceinline__ unsigned xb_ld(unsigned* p)              { return __hip_atomic_load(p, __ATOMIC_RELAXED, __HIP_MEMORY_SCOPE_AGENT); }
__device__ __forceinline__ unsigned xb_add(unsigned* p, unsigned v) { return __hip_atomic_fetch_add(p, v, __ATOMIC_RELAXED, __HIP_MEMORY_SCOPE_AGENT); }
__device__ __forceinline__ unsigned xb_xcc_id() { return (unsigned)__builtin_amdgcn_s_getreg((3 << 11) | 20) & 0xFu; }
#define XB_SPIN(cond, bar) do { unsigned _sp = 0; while (cond) { __builtin_amdgcn_s_sleep(1); \
    if ((++_sp & 255u) == 0u) { if (xb_ld(&(bar)[XB_TMO])) break; if (_sp > XB_SPIN_CAP) { atomicAdd(&(bar)[XB_TMO], 1u); break; } } } } while (0)
struct XcdBarrier { unsigned* bar; unsigned x; volatile LAS unsigned* st; };
__device__ __forceinline__ XcdBarrier xcd_barrier_post(unsigned* bar, volatile LAS unsigned* st) {
    XcdBarrier b; b.bar = bar; b.x = xb_xcc_id(); b.st = st;
    if (threadIdx.x == 0) (void)xb_add(&bar[XB_XCNT(b.x)], 1u);
    return b;
}
__device__ __forceinline__ void xcd_barrier_complete(unsigned* bar, unsigned x, unsigned& nloc, unsigned& nx) {
    const unsigned G = gridDim.x * gridDim.y * gridDim.z;
    unsigned sum, cnt, mine, sp = 0u;
    for (;;) {
        sum = 0u; cnt = 0u; mine = 0u;
#pragma unroll
        for (unsigned j = 0; j < 16; ++j) { const unsigned c = xb_ld(&bar[XB_XCNT(j)]); sum += c; cnt += (c > 0u) ? 1u : 0u; mine = (j == x) ? c : mine; }
        if (sum == G) break;
        __builtin_amdgcn_s_sleep(1);
        if ((++sp & 255u) == 0u) { if (xb_ld(&bar[XB_TMO])) break; if (sp > XB_SPIN_CAP) { atomicAdd(&bar[XB_TMO], 1u); break; } }
    }
    nloc = mine > 0u ? mine : 1u; nx = cnt > 0u ? cnt : 1u;
}
__device__ __forceinline__ void xcd_barrier(const XcdBarrier& b) {
    asm volatile("s_waitcnt vmcnt(0)" ::: "memory");
    __syncthreads();
    if (threadIdx.x == 0) {
        unsigned* bar = b.bar;
        __builtin_amdgcn_s_waitcnt(0);
        unsigned nloc = b.st[0], nx = b.st[1];
        if (nloc == 0u) { xcd_barrier_complete(bar, b.x, nloc, nx); b.st[0] = nloc; b.st[1] = nx; }
        const unsigned old = xb_add(&bar[XB_XSUB(b.x)], 1u);
        const unsigned gen = old / nloc;
        if (old + 1u == (gen + 1u) * nloc) {
            __builtin_amdgcn_fence(__ATOMIC_RELEASE, "agent");
            asm volatile("s_waitcnt vmcnt(0)" ::: "memory");
            const unsigned og = xb_add(&bar[XB_TOP], 1u);
            const unsigned tg = og / nx;
            if (og + 1u == (tg + 1u) * nx) xb_add(&bar[XB_TOPGEN], 1u);
            else XB_SPIN(xb_ld(&bar[XB_TOPGEN]) == tg, bar);
            __builtin_amdgcn_fence(__ATOMIC_ACQUIRE, "agent");
            xb_add(&bar[XB_XGEN(b.x)], 1u);
            asm volatile("s_waitcnt vmcnt(0)" ::: "memory");
        } else {
            XB_SPIN(xb_ld(&bar[XB_XGEN(b.x)]) == gen, bar);
            __builtin_amdgcn_fence(__ATOMIC_ACQUIRE, "agent");
            asm volatile("s_waitcnt vmcnt(0)" ::: "memory");
        }
    }
    __syncthreads();
}

struct Args { const float* in[32]; float* out; unsigned char* ws; int ph_lo, ph_hi; };
enum { IN_X = 0, IN_C, IN_REL, IN_ADAW, IN_ADAB, IN_NMG, IN_NFG, IN_DAWIN, IN_DAWOUT, IN_QG, IN_KG, IN_LQ1, IN_LK1, IN_LQ2, IN_LK2, IN_SUBLN,
       IN_MLWIN, IN_CONVW, IN_CONVB, IN_WQ, IN_WK, IN_WV, IN_GATEW, IN_GATEB, IN_ONG, IN_SKIP, IN_MLWOUT, IN_WGRP, IN_WRT, IN_W1, IN_W3, IN_W2 };

struct Ctx {
    const Args* a; GAS unsigned char* ws; LAS unsigned char* lds; int tid, lane, wave, G, vcu;
    __device__ __forceinline__ const float* in(int i) const { return (const float*)(const GAS float*)a->in[i]; }
    template <class Tp> __device__ __forceinline__ Tp* w(size_t off) const { return (Tp*)(GAS Tp*)(ws + off); }
    __device__ __forceinline__ float* xout() const { return (float*)(GAS float*)a->out; }
    __device__ __forceinline__ const float* mods(int layer, int which) const { return (const float*)(ws + WS_MODS) + (size_t)layer * 16 * 6144 + which * 1024; }
};

__device__ __forceinline__ Ctx fresh(const Ctx& C) {
    Ctx P = C; int t = C.tid; asm volatile("" : "+v"(t)); P.tid = t; P.lane = t & 63; P.wave = __builtin_amdgcn_readfirstlane(t >> 6);
    GAS unsigned char* w = C.ws; asm volatile("" : "+s"(w)); P.ws = w; int g = __builtin_amdgcn_readfirstlane(C.G), v = __builtin_amdgcn_readfirstlane(C.vcu); asm volatile("" : "+s"(g), "+s"(v)); P.G = g; P.vcu = v;
    return P;
}
__device__ __forceinline__ void transpose_item(const float* W, int K, int N, bf16* WT, int ldt, int dst_row0, LAS float* scr, int kb, int nb, int lane) {
    const int k0 = 64 * kb, n0 = 32 * nb;
#pragma unroll 8
    for (int i = 0; i < 32; ++i) { const int kk = 2 * i + (lane >> 5); scr[kk * 33 + (lane & 31)] = W[(size_t)(k0 + kk) * N + n0 + (lane & 31)]; }
    LDS_WAIT(); asm volatile("" ::: "memory");
    const int c = lane & 7;
#pragma unroll
    for (int j = 0; j < 4; ++j) { const int n = (lane >> 3) + 8 * j; const LAS float* s = scr + (8 * c) * 33 + n;
        u32x4 o; o.x = pk2(s[0 * 33], s[1 * 33]); o.y = pk2(s[2 * 33], s[3 * 33]); o.z = pk2(s[4 * 33], s[5 * 33]); o.w = pk2(s[6 * 33], s[7 * 33]);
        *(u32x4*)(WT + (size_t)(dst_row0 + n) * ldt + k0 + 8 * c) = o; }
    LDS_WAIT(); asm volatile("" ::: "memory");
}
__device__ __forceinline__ void moe_weight_items(const Ctx& C, int layer, LAS float* scr) {
    const int gw = C.vcu * 8 + C.wave, NGW = C.G * 8;
    const float* w1 = C.in(IN_W1) + (size_t)layer * NEXP * DM * DEXP; const float* w3 = C.in(IN_W3) + (size_t)layer * NEXP * DM * DEXP; const float* w2 = C.in(IN_W2) + (size_t)layer * NEXP * DEXP * DM;
    bf16* W13T = C.w<bf16>(WS_W13T); bf16* W2T = C.w<bf16>(WS_W2T);
    constexpr int I13 = 16 * 8, I2 = 4 * 32;
    for (int it = gw; it < NEXP * (2 * I13 + I2); it += NGW) {
        const int e = it / (2 * I13 + I2); int r = it - e * (2 * I13 + I2);
        if (r < 2 * I13) { const int which = r / I13; r -= which * I13; const int kb = r / 8, nb = r % 8; const int n0 = 32 * nb;
            const int dst = (n0 / 128) * 256 + which * 128 + (n0 % 128);
            transpose_item((which ? w3 : w1) + (size_t)e * DM * DEXP, DM, DEXP, W13T + (size_t)e * 512 * DM, DM, dst, scr, kb, nb, C.lane); }
        else { r -= 2 * I13; const int kb = r / 32, nb = r % 32;
            transpose_item(w2 + (size_t)e * DEXP * DM, DEXP, DM, W2T + (size_t)e * DM * DEXP, DEXP, 32 * nb, scr, kb, nb, C.lane); }
    }
}
__device__ __forceinline__ void plain_weight_items(const Ctx& C, const float* W, int K, int N, bf16* WT, LAS float* scr) {
    const int gw = C.vcu * 8 + C.wave, NGW = C.G * 8; const int nblk = N / 32;
    for (int it = gw; it < (K / 64) * nblk; it += NGW) { const int kb = it / nblk, nb = it % nblk; transpose_item(W, K, N, WT, K, 32 * nb, scr, kb, nb, C.lane); }
}
__device__ __forceinline__ int t5_bucket(int rel) {
    const int n = rel < 0 ? -rel : rel; int b;
    if (n < 8) b = n; else b = 8 + (n >= 12) + (n >= 16) + (n >= 23) + (n >= 32) + (n >= 46) + (n >= 64) + (n >= 91);
    return b + (rel > 0 ? 16 : 0);
}
__device__ __forceinline__ void p_prologue(const Ctx& C) {
    __syncthreads();
    {
        LAS float* cact = (LAS float*)C.lds;
        LAS float* red = (LAS float*)(C.lds + 65536);
        const float* c = C.in(IN_C);
        for (int i = C.tid; i < 16 * 1024; i += 512) cact[i] = silu_f(c[i]);
        __syncthreads();
        for (int task = C.vcu; task < 192; task += C.G) {
            const int layer = task / 96, n0 = (task % 96) * 64, nl = C.tid & 63, kc = C.tid >> 6;
            const float* W = C.in(IN_ADAW) + (size_t)layer * DM * 6144 + n0 + nl;
            float acc[16];
#pragma unroll
            for (int b = 0; b < 16; ++b) acc[b] = 0.f;
            for (int k = kc * 128; k < kc * 128 + 128; ++k) { const float wv = W[(size_t)k * 6144];
#pragma unroll
                for (int b = 0; b < 16; ++b) acc[b] += cact[b * 1024 + k] * wv; }
#pragma unroll
            for (int b = 0; b < 16; ++b) red[(kc * 16 + b) * 64 + nl] = acc[b];
            __syncthreads();
            for (int o = C.tid; o < 16 * 64; o += 512) { const int b = o >> 6, n = o & 63; float s = 0.f;
#pragma unroll
                for (int q = 0; q < 8; ++q) s += red[(q * 16 + b) * 64 + n];
                C.w<float>(WS_MODS)[(size_t)layer * 16 * 6144 + (size_t)b * 6144 + n0 + n] = s + C.in(IN_ADAB)[layer * 6144 + n0 + n]; }
            __syncthreads();
        }
    }
    {
        const int gt = C.vcu * 512 + C.tid, NGT = C.G * 512;
        float mq = 0.f, mk = 0.f;
        for (int i = 0; i < 64; ++i) { mq = fmaxf(mq, fabsf(C.in(IN_QG)[i])); mk = fmaxf(mk, fabsf(C.in(IN_KG)[i])); }
        for (int i = gt; i < 8 * 4096; i += NGT) { const int h = i >> 12, idx = i & 4095; if (idx < 4095) {
            float mb = -1e30f; for (int b = 0; b < 32; ++b) mb = fmaxf(mb, C.in(IN_REL)[b * 8 + h]);
            const float cshift = 8.0f * mq * mk + mb;
            C.w<float>(WS_TAB2)[i] = (C.in(IN_REL)[t5_bucket(idx - 2047) * 8 + h] - cshift) * LOG2E; } else C.w<float>(WS_TAB2)[i] = 0.f; }
        if (gt == 0) { float s1 = 0.f, s2 = 0.f; for (int i = 0; i < 64; ++i) { s1 += C.in(IN_LQ1)[i] * C.in(IN_LK1)[i]; s2 += C.in(IN_LQ2)[i] * C.in(IN_LK2)[i]; }
            C.w<float>(WS_SCAL)[0] = __expf(s1) - __expf(s2) + 0.2f; }
        for (int i = gt; i < 16 * 6144; i += NGT) { const int n = i / 6144, k = i % 6144, d = n >> 3, g = n & 7, m = k / 2048, c = k % 2048;
            C.w<bf16>(WS_GWT)[i] = (bf16)f2bf(C.in(IN_GATEW)[(((size_t)d * 3 + m) * 2048 + c) * 8 + g]); }
    }
    LAS float* scr = (LAS float*)(C.lds + C.wave * 16384);
    plain_weight_items(C, C.in(IN_DAWIN), DM, 3 * DM, C.w<bf16>(WS_WINT), scr);
    plain_weight_items(C, C.in(IN_DAWOUT), DM, DM, C.w<bf16>(WS_WOT), scr);
    plain_weight_items(C, C.in(IN_MLWIN), DM, 2 * ML_IN, C.w<bf16>(WS_MLWINT), scr);
    plain_weight_items(C, C.in(IN_MLWOUT), ML_IN, DM, C.w<bf16>(WS_MLWOUTT), scr);
    moe_weight_items(C, 0, scr);
}

__device__ __forceinline__ void normmod_row(const float* xrow, const float* g, const float* sc, const float* sh, bf16* orow, int lane) {
    const f32x4* xr = (const f32x4*)xrow + lane; f32x4 v[4]; float s = 0.f;
#pragma unroll
    for (int j = 0; j < 4; ++j) { v[j] = xr[64 * j]; s += (v[j].x * v[j].x + v[j].y * v[j].y) + (v[j].z * v[j].z + v[j].w * v[j].w); }
    const float rstd = 1.0f / sqrtf(wave_sum(s) * (1.0f / DM) + EPS);
    u32x2* o8 = (u32x2*)orow + lane;
#pragma unroll
    for (int j = 0; j < 4; ++j) { const f32x4 gv = ((const f32x4*)g)[lane + 64 * j], scv = ((const f32x4*)sc)[lane + 64 * j], shv = ((const f32x4*)sh)[lane + 64 * j];
        const f32x4 y = (v[j] * rstd * gv) * (scv + 1.0f) + shv; u32x2 w; w.x = pk2(y.x, y.y); w.y = pk2(y.z, y.w); o8[64 * j] = w; }
}
__device__ __forceinline__ void normmod_row_bf(const bf16* xrow, const float* g, const float* sc, const float* sh, bf16* orow, int lane) {
    float v[2][8]; float s = 0.f;
#pragma unroll
    for (int j = 0; j < 2; ++j) { const u32x4 w = *((const u32x4*)(xrow + 512 * j) + lane);
        v[j][0] = bflo(w.x); v[j][1] = bfhi(w.x); v[j][2] = bflo(w.y); v[j][3] = bfhi(w.y); v[j][4] = bflo(w.z); v[j][5] = bfhi(w.z); v[j][6] = bflo(w.w); v[j][7] = bfhi(w.w);
#pragma unroll
        for (int i = 0; i < 8; ++i) s += v[j][i] * v[j][i]; }
    const float rstd = 1.0f / sqrtf(wave_sum(s) * (1.0f / DM) + EPS);
#pragma unroll
    for (int j = 0; j < 2; ++j) { const int c = 512 * j + 8 * lane; float y[8];
#pragma unroll
        for (int i = 0; i < 8; ++i) y[i] = (v[j][i] * rstd * g[c + i]) * (sc[c + i] + 1.0f) + sh[c + i];
        u32x4 w; w.x = pk2(y[0], y[1]); w.y = pk2(y[2], y[3]); w.z = pk2(y[4], y[5]); w.w = pk2(y[6], y[7]);
        *((u32x4*)(orow + 512 * j) + lane) = w; }
}
__device__ __forceinline__ void p_normmod_bf(const Ctx& C, const bf16* xsrc, int layer, int row_lo, int row_hi, bf16* dst) {
    const int gw = C.vcu * 8 + C.wave, NGW = C.G * 8;
    const float* g = C.in(IN_NMG) + layer * DM;
    for (int r = row_lo + gw; r < row_hi; r += NGW) { const int b = r / SEQ;
        normmod_row_bf(xsrc + (size_t)r * DM, g, C.mods(layer, 1) + (size_t)b * 6144, C.mods(layer, 0) + (size_t)b * 6144, dst + (size_t)(r - row_lo) * DM, C.lane); }
}
__device__ __forceinline__ void p_normmod(const Ctx& C, const float* xsrc, int layer, int row_lo, int row_hi, bf16* dst) {
    const int gw = C.vcu * 8 + C.wave, NGW = C.G * 8;
    const float* g = C.in(IN_NMG) + layer * DM;
    for (int r = row_lo + gw; r < row_hi; r += NGW) { const int b = r / SEQ;
        normmod_row(xsrc + (size_t)r * DM, g, C.mods(layer, 1) + (size_t)b * 6144, C.mods(layer, 0) + (size_t)b * 6144, dst + (size_t)(r - row_lo) * DM, C.lane); }
}

constexpr int AT_KS = 144, AT_VS = 144;
constexpr int AT_K_BYTES = 2 * 64 * AT_KS, AT_V_BYTES = 128 * AT_VS, AT_BUF = AT_K_BYTES + AT_V_BYTES;
constexpr int AT_TAB_OFF = 3 * AT_BUF;
constexpr int AT_EX_OFF = 0, AT_EX_PITCH = 132;
static_assert(AT_BUF % 16 == 0 && AT_TAB_OFF + 16384 <= RING_BYTES && 4 * 32 * AT_EX_PITCH * 4 <= AT_TAB_OFF, "attention LDS");
template <int ABL> __device__ __forceinline__ void attn_unit(const Ctx& C, int b, int h, int qt, bool load_tab) {
    LAS unsigned char* lds = C.lds;
    const int tid = C.tid, lane = C.lane, wid = C.wave, mp = wid >> 2, rb = wid & 3, r32 = lane & 31, hi = lane >> 5;
    const bf16* QK = C.w<bf16>(WS_QK); const bf16* VT = C.w<bf16>(WS_VT);
    const size_t tok0 = (size_t)b * SEQ; const int q0 = qt * 128, qa = q0 + 32 * rb;
    LAS float* tab = (LAS float*)(lds + AT_TAB_OFF);
    __syncthreads();
    if (load_tab) { const float* t2 = C.w<float>(WS_TAB2) + h * 4096; for (int i = tid; i < 4096; i += 512) tab[i] = t2[i]; }
    const float c_neg = C.w<float>(WS_TAB2)[h * 4096 + 1000], c_pos = C.w<float>(WS_TAB2)[h * 4096 + 3000];
    bf16x8 qf[4];
    { const bf16* qrow = QK + (tok0 + qa + r32) * 2048 + h * 128 + mp * 64 + hi * 8;
#pragma unroll
      for (int ks = 0; ks < 4; ++ks) qf[ks] = *(const bf16x8*)(qrow + ks * 16);
      asm volatile("" : "+v"(qf[0]), "+v"(qf[1]), "+v"(qf[2]), "+v"(qf[3])); }
    const int kkey = tid >> 4, kcc = tid & 15, vdv = tid >> 3, vkc = tid & 7;
    const bf16* ksrc = QK + (tok0 + kkey) * 2048 + 1024 + h * 128 + kcc * 8;
    const bf16* vsrc = VT + (size_t)(h * 128 + vdv) * NT + tok0 + vkc * 8;
    const int kdst = ((kcc >> 3) * 64 + kkey) * AT_KS + (kcc & 7) * 16;
    const int vdst = AT_K_BYTES + vdv * AT_VS + (vkc >> 1) * 32 + (vkc & 1) * 8;
    u32x4 kst[2], vst[2];
#define AT_LOAD(t) do { const int k0_ = (t) * 64; kst[0] = *(const u32x4*)(ksrc + (size_t)k0_ * 2048); kst[1] = *(const u32x4*)(ksrc + (size_t)(k0_ + 32) * 2048); \
        vst[0] = *(const u32x4*)(vsrc + k0_); vst[1] = *(const u32x4*)(vsrc + (size_t)64 * NT + k0_); } while (0)
#define AT_WRITE(bufo) do { _Pragma("unroll") for (int i_ = 0; i_ < 2; ++i_) { *(LAS u32x4*)(lds + (bufo) + kdst + 32 * i_ * AT_KS) = kst[i_]; \
        LAS u32x2* vd_ = (LAS u32x2*)(lds + (bufo) + vdst + 64 * i_ * AT_VS); vd_[0] = (u32x2){vst[i_].x, vst[i_].y}; vd_[2] = (u32x2){vst[i_].z, vst[i_].w}; } } while (0)
    const int kfo = (mp * 64 + r32) * AT_KS + hi * 16;
    const int vfo = AT_K_BYTES + r32 * AT_VS + hi * 16;
    f32x16 o[4];
#pragma unroll
    for (int i = 0; i < 4; ++i) o[i] = (f32x16){0.f, 0.f, 0.f, 0.f, 0.f, 0.f, 0.f, 0.f, 0.f, 0.f, 0.f, 0.f, 0.f, 0.f, 0.f, 0.f};
    f32x2 lacc = (f32x2){0.f, 0.f};
    bf16x8 pf[4];

#define AT_SOFT(t, bo) do { const int k0_ = (t) * 64; const int dlo_ = k0_ - qa - 31, dhi_ = k0_ + 63 - qa; \
        const bool cst_ = (dhi_ <= -91) || (dlo_ >= 91); const float ini_ = (dhi_ <= -91) ? c_neg : ((dlo_ >= 91) ? c_pos : 0.f); \
        bf16x8 kf_[2][4]; \
        _Pragma("unroll") for (int kb_ = 0; kb_ < 2; ++kb_) _Pragma("unroll") for (int ks_ = 0; ks_ < 4; ++ks_) kf_[kb_][ks_] = *(const LAS bf16x8*)(lds + (bo) + kfo + kb_ * 32 * AT_KS + ks_ * 32); \
        f32x16 s0_, s1_; \
        _Pragma("unroll") for (int r_ = 0; r_ < 16; ++r_) { s0_[r_] = ini_; s1_[r_] = ini_; } \
        if (!(ABL & 16)) { _Pragma("unroll") for (int ks_ = 0; ks_ < 4; ++ks_) { s0_ = __builtin_amdgcn_mfma_f32_32x32x16_bf16(kf_[0][ks_], qf[ks_], s0_, 0, 0, 0); s1_ = __builtin_amdgcn_mfma_f32_32x32x16_bf16(kf_[1][ks_], qf[ks_], s1_, 0, 0, 0); } } \
        else { _Pragma("unroll") for (int ks_ = 0; ks_ < 4; ++ks_) { s0_[ks_] += __builtin_bit_cast(float, kf_[0][ks_][0] + kf_[0][ks_][1]); s1_[ks_] += __builtin_bit_cast(float, kf_[1][ks_][0] + kf_[1][ks_][1]); } } \
        _Pragma("unroll") for (int kb_ = 0; kb_ < 2; ++kb_) { f32x16 s_ = kb_ ? s1_ : s0_; \
            if (!cst_) { const LAS float* tp_ = tab + (k0_ + 32 * kb_ + 4 * hi - (qa + r32) + 2047); _Pragma("unroll") for (int r_ = 0; r_ < 16; ++r_) s_[r_] += tp_[(r_ & 3) + 8 * (r_ >> 2)]; } \
            float p_[16]; \
            _Pragma("unroll") for (int r_ = 0; r_ < 16; ++r_) p_[r_] = (ABL & 1) ? s_[r_] : __builtin_amdgcn_exp2f(s_[r_]); \
            _Pragma("unroll") for (int r_ = 0; r_ < 16; r_ += 2) lacc += (f32x2){p_[r_], p_[r_ + 1]}; \
            _Pragma("unroll") for (int sh_ = 0; sh_ < 2; ++sh_) { u32x4 w_; w_.x = pk2(p_[8 * sh_ + 0], p_[8 * sh_ + 1]); w_.y = pk2(p_[8 * sh_ + 2], p_[8 * sh_ + 3]); w_.z = pk2(p_[8 * sh_ + 4], p_[8 * sh_ + 5]); w_.w = pk2(p_[8 * sh_ + 6], p_[8 * sh_ + 7]); \
                pf[2 * kb_ + sh_] = __builtin_bit_cast(bf16x8, w_); } } } while (0)
#define AT_PV(bo) do { _Pragma("unroll") for (int hb_ = 0; hb_ < 2; ++hb_) { u32x4 vf_[8]; \
        _Pragma("unroll") for (int i_ = 0; i_ < 8; ++i_) { const int dvb_ = 2 * hb_ + (i_ >> 2), s4_ = i_ & 3; vf_[i_] = *(const LAS u32x4*)(lds + (bo) + vfo + dvb_ * 32 * AT_VS + s4_ * 32); } \
        if (!(ABL & 2)) { _Pragma("unroll") for (int i_ = 0; i_ < 8; ++i_) o[2 * hb_ + (i_ >> 2)] = __builtin_amdgcn_mfma_f32_32x32x16_bf16(__builtin_bit_cast(bf16x8, vf_[i_]), pf[i_ & 3], o[2 * hb_ + (i_ >> 2)], 0, 0, 0); } \
        else { _Pragma("unroll") for (int i_ = 0; i_ < 8; ++i_) o[2 * hb_ + (i_ >> 2)][i_] += __builtin_bit_cast(float, vf_[i_].x ^ vf_[i_].y ^ vf_[i_].z ^ vf_[i_].w) + __builtin_bit_cast(float, __builtin_bit_cast(u32x4, pf[i_ & 3]).x); } } } while (0)
    AT_LOAD(0); AT_WRITE(0); AT_LOAD(1);
    __syncthreads();
    int b_prv = 2 * AT_BUF, b_cur = 0, b_nxt = AT_BUF;
#pragma nounroll
    for (int t = 0; t <= 32; ++t) {
        if (t + 1 < 32 && (!(ABL & 4) || t < 2)) AT_WRITE(b_nxt);
        if (t + 2 < 32 && (!(ABL & 4) || t < 2)) AT_LOAD(t + 2);
        if (mp == 0) { if (t < 32) AT_SOFT(t, b_cur); }
        else { if (t >= 1) AT_PV(b_prv); }
        if (!(ABL & 8)) __syncthreads();
        if (mp == 0) { if (t < 32) AT_PV(b_cur); }
        else { if (t < 32) AT_SOFT(t, b_cur); }
        { const int tmp = b_prv; b_prv = b_cur; b_cur = b_nxt; b_nxt = tmp; }
        if (!(ABL & 8)) __syncthreads();
    }
#undef AT_LOAD
#undef AT_WRITE
#undef AT_SOFT
#undef AT_PV
    float lsum = lacc.x + lacc.y;
    lsum += __shfl_xor(lsum, 32);
    const float lam = C.w<float>(WS_SCAL)[0];
    const float sc = (mp == 0 ? 1.0f : lam) / lsum;
    LAS float* ex = (LAS float*)(lds + AT_EX_OFF) + (rb * 32 + r32) * AT_EX_PITCH;
    if (mp == 1) {
#pragma unroll
        for (int dvb = 0; dvb < 4; ++dvb)
#pragma unroll
            for (int g = 0; g < 4; ++g) *(LAS f32x4*)(ex + dvb * 32 + 8 * g + 4 * hi) = (f32x4){o[dvb][4 * g] * sc, o[dvb][4 * g + 1] * sc, o[dvb][4 * g + 2] * sc, o[dvb][4 * g + 3] * sc};
    }
    __syncthreads();
    if (mp == 0) {
        float ss = 0.f;
#pragma unroll
        for (int dvb = 0; dvb < 4; ++dvb)
#pragma unroll
            for (int g = 0; g < 4; ++g) { const f32x4 e = *(const LAS f32x4*)(ex + dvb * 32 + 8 * g + 4 * hi);
#pragma unroll
                for (int i = 0; i < 4; ++i) { const float v = o[dvb][4 * g + i] * sc - e[i]; o[dvb][4 * g + i] = v; ss += v * v; } }
        ss += __shfl_xor(ss, 32);
        const float rs = (1.0f / sqrtf(ss * (1.0f / 128.0f) + EPS)) * 0.8f;
        bf16* orow = C.w<bf16>(ABL ? WS_HM : WS_O) + (tok0 + qa + r32) * DM + h * 128;
        const float* sg = C.in(IN_SUBLN);
#pragma unroll
        for (int dvb = 0; dvb < 4; ++dvb)
#pragma unroll
            for (int g = 0; g < 4; ++g) { const int dv = dvb * 32 + 8 * g + 4 * hi; const f32x4 gv = *(const f32x4*)(sg + dv);
                u32x2 w; w.x = pk2(o[dvb][4 * g] * rs * gv.x, o[dvb][4 * g + 1] * rs * gv.y); w.y = pk2(o[dvb][4 * g + 2] * rs * gv.z, o[dvb][4 * g + 3] * rs * gv.w);
                *(u32x2*)(orow + dv) = w; }
    }
}
template <int ABL> __device__ __forceinline__ void p_attention(const Ctx& C) {
    int last_h = -1;
    for (int w = C.vcu; w < NB * DA_H * 2; w += C.G) { const int bh = w >> 1, half = w & 1, h = bh & 7;
        for (int i = 0; i < 8; ++i) { attn_unit<ABL>(C, bh >> 3, h, half * 8 + i, h != last_h); last_h = h; } }
    __syncthreads();
}

constexpr int RT_CH = 128, RT_IMG = RT_CH * 16 * 16;
__device__ __forceinline__ void p_route(const Ctx& C, int layer, const bf16* x, bool commit = true) {
    const int lane = C.lane, tid = C.tid, tok = lane & 15, kq = lane >> 4;
    const float* g = C.in(IN_NFG) + layer * DM;
    const float* wr_ = C.in(IN_WRT) + (size_t)layer * DM * 32; const float* wg_ = C.in(IN_WGRP) + (size_t)layer * DM * 4;
    unsigned* cnt = C.w<unsigned>(WS_CTL) + CW_CNT + layer * 64;
    LAS float* lg = (LAS float*)(C.lds + 2 * RT_IMG) + C.wave * (16 * 48);
    bf16* HF = C.w<bf16>(WS_HF);
    const int sk = tid >> 2, sn = (tid & 3) * 4;
    f32x4 st0, st1, st2;
#define RT_LOAD(c) do { const int k_ = (c) * RT_CH + sk; st0 = *(const f32x4*)(wr_ + k_ * 32 + sn); st1 = *(const f32x4*)(wr_ + k_ * 32 + 16 + sn); st2 = (sn == 0) ? *(const f32x4*)(wg_ + k_ * 4) : (f32x4){0.f, 0.f, 0.f, 0.f}; } while (0)
#define RT_WRITE(bo) do { LAS f32x4* d_ = (LAS f32x4*)(C.lds + (bo)) + sk * 16 + sn; d_[0] = (f32x4){st0[0], st1[0], st2[0], 0.f}; d_[1] = (f32x4){st0[1], st1[1], st2[1], 0.f}; d_[2] = (f32x4){st0[2], st1[2], st2[2], 0.f}; d_[3] = (f32x4){st0[3], st1[3], st2[3], 0.f}; } while (0)
    for (int ts = C.vcu; ts < NT / 128; ts += C.G) {
        const int t0 = ts * 128 + C.wave * 16, b = t0 / SEQ;
        const bf16* xrow = x + (size_t)(t0 + tok) * DM + 4 * kq;
        __syncthreads();
        RT_LOAD(0);
        float ss = 0.f;
#pragma unroll 8
        for (int kk = 0; kk < 64; ++kk) { const u32x2 w = *(const u32x2*)(xrow + 16 * kk); const f32x4 v = (f32x4){bflo(w.x), bfhi(w.x), bflo(w.y), bfhi(w.y)}; ss += (v.x * v.x + v.y * v.y) + (v.z * v.z + v.w * v.w); }
        ss += __shfl_xor(ss, 16); ss += __shfl_xor(ss, 32);
        const float rstd = 1.0f / sqrtf(ss * (1.0f / DM) + EPS);
        const float* sc = C.mods(layer, 4) + (size_t)b * 6144 + 4 * kq; const float* sh = C.mods(layer, 3) + (size_t)b * 6144 + 4 * kq;
        f32x4 a0 = (f32x4){0.f, 0.f, 0.f, 0.f}, a1 = a0, a2 = a0;
        bf16* hrow = HF + (size_t)(t0 + tok) * DM + 4 * kq;
        RT_WRITE(0);
        for (int c = 0; c < DM / RT_CH; ++c) {
            const int bo = (c & 1) * RT_IMG;
            __syncthreads();
            if (c + 1 < DM / RT_CH) RT_LOAD(c + 1);
            const LAS f32x4* bimg = (const LAS f32x4*)(C.lds + bo) + (4 * kq) * 16 + tok;
#pragma unroll
            for (int half = 0; half < 2; ++half) {
                f32x4 hfv[4];
#pragma unroll
                for (int q = 0; q < 4; ++q) { const int kk = c * 8 + half * 4 + q;
                    const u32x2 xw2 = *(const u32x2*)(xrow + 16 * kk); const f32x4 v = (f32x4){bflo(xw2.x), bfhi(xw2.x), bflo(xw2.y), bfhi(xw2.y)};
                    const f32x4 gv = *(const f32x4*)(g + 16 * kk + 4 * kq), scv = *(const f32x4*)(sc + 16 * kk), shv = *(const f32x4*)(sh + 16 * kk);
                    hfv[q] = (v * rstd * gv) * (scv + 1.0f) + shv;
                    u32x2 w; w.x = pk2(hfv[q].x, hfv[q].y); w.y = pk2(hfv[q].z, hfv[q].w); *(u32x2*)(hrow + 16 * kk) = w; }
#pragma unroll
                for (int q = 0; q < 4; ++q)
#pragma unroll
                    for (int i = 0; i < 4; ++i) { const f32x4 bv = bimg[((half * 4 + q) * 16 + i) * 16];
                        a0 = __builtin_amdgcn_mfma_f32_16x16x4f32(hfv[q][i], bv[0], a0, 0, 0, 0); a1 = __builtin_amdgcn_mfma_f32_16x16x4f32(hfv[q][i], bv[1], a1, 0, 0, 0); a2 = __builtin_amdgcn_mfma_f32_16x16x4f32(hfv[q][i], bv[2], a2, 0, 0, 0); }
            }
            if (c + 1 < DM / RT_CH) RT_WRITE(RT_IMG - bo);
        }
#pragma unroll
        for (int r = 0; r < 4; ++r) { lg[(4 * kq + r) * 48 + tok] = a0[r]; lg[(4 * kq + r) * 48 + 16 + tok] = a1[r]; lg[(4 * kq + r) * 48 + 32 + tok] = a2[r]; }
        LDS_WAIT(); asm volatile("" ::: "memory");
        if (lane < 16 && commit) {
            const LAS float* L = lg + lane * 48;
            int gs = 0; float gm = L[32];
#pragma unroll
            for (int j = 1; j < 4; ++j) { const float v = L[32 + j]; if (v > gm) { gm = v; gs = j; } }
            float gsum = 0.f;
#pragma unroll
            for (int j = 0; j < 4; ++j) gsum += __expf(L[32 + j] - gm);
            const float pg = 1.0f / gsum;
            int ia = 0; float la = L[gs * 8];
#pragma unroll
            for (int j = 1; j < 8; ++j) { const float v = L[gs * 8 + j]; if (v > la) { la = v; ia = j; } }
            int ib = -1; float lb = -3.0e38f;
#pragma unroll
            for (int j = 0; j < 8; ++j) { const float v = L[gs * 8 + j]; if (j != ia && v > lb) { lb = v; ib = j; } }
            const float wa = pg / (1.0f + __expf(lb - la)), wb = pg - wa;
            const int ea = gs * 8 + ia, eb = gs * 8 + ib, t = t0 + lane;
            const unsigned pa = atomicAdd(cnt + ea, 1u), pb = atomicAdd(cnt + eb, 1u);
            C.w<int>(WS_RE)[2 * t] = ea; C.w<int>(WS_RE)[2 * t + 1] = eb; C.w<float>(WS_RW)[2 * t] = wa; C.w<float>(WS_RW)[2 * t + 1] = wb;
            C.w<int>(WS_RP)[2 * t] = (int)pa; C.w<int>(WS_RP)[2 * t + 1] = (int)pb;
            C.w<int>(WS_TL)[(size_t)ea * NT + pa] = t; C.w<int>(WS_TL)[(size_t)eb * NT + pb] = t;
        }
        LDS_WAIT(); asm volatile("" ::: "memory");
    }
#undef RT_LOAD
#undef RT_WRITE
}
struct MoeTab { LAS int* off; LAS int* tile_e; LAS int* ntile; LAS int* cnt; LAS int* tile_p0; };
__device__ __forceinline__ MoeTab moe_tables(const Ctx& C, int layer) {
    MoeTab T; T.off = (LAS int*)(C.lds + MISC_OFF + 256); T.tile_e = T.off + 128; T.ntile = T.off + 48; T.cnt = T.off + 64; T.tile_p0 = T.off + 128 + 320;
    __syncthreads();
    if (C.tid == 0) { const unsigned* cnt = C.w<unsigned>(WS_CTL) + CW_CNT + layer * 64; int o = 0, nt = 0;
        for (int e = 0; e < NEXP; ++e) { const int c = (int)__hip_atomic_load(cnt + e, __ATOMIC_RELAXED, __HIP_MEMORY_SCOPE_AGENT); T.off[e] = o; T.cnt[e] = c; const int tiles = (c + 255) >> 8; for (int j = 0; j < tiles; ++j) { T.tile_e[nt + j] = e; T.tile_p0[nt + j] = j * 256; } nt += tiles; o += tiles * 256; }
        T.off[32] = o; T.ntile[0] = nt; }
    __syncthreads();
    return T;
}
__device__ __forceinline__ void p_permute(const Ctx& C, int layer) {
    const MoeTab T = moe_tables(C, layer);
    const bf16* HF = C.w<bf16>(WS_HF); bf16* HS = C.w<bf16>(WS_HS);
    const int* RP = C.w<int>(WS_RP); const int* RE = C.w<int>(WS_RE);
    for (int p = C.vcu * 8 + C.wave; p < 2 * NT; p += C.G * 8) {
        const int e = RE[p], pos = RP[p], slot = T.off[e] + pos, t = p >> 1;
        const u32x4* s = (const u32x4*)(HF + (size_t)t * DM) + C.lane; u32x4* d = (u32x4*)(HS + (size_t)slot * DM) + C.lane;
        const u32x4 v0 = s[0], v1 = s[64]; d[0] = v0; d[64] = v1;
        asm volatile("" ::: "memory");
        if (C.lane == 0) C.w<int>(WS_RS)[p] = slot;
    }
}
template <int NPN, bool GATH> struct MoeOrder {
    const int* tl; MoeTab T; const char* A; const char* B; int lda_bytes; size_t b_expert_bytes; int b_tile_bytes; int G, c, nt;
    __device__ __forceinline__ bool next(int i, pg8::Unit& u) const {
        const int L = i * G + c; const int rt = L / NPN, pn = L - rt * NPN; if (rt >= T.ntile[0]) return false;
        const int e = T.tile_e[rt];
        u.A = GATH ? A : A + (size_t)rt * 256 * lda_bytes; u.B = B + (size_t)e * b_expert_bytes + (size_t)pn * b_tile_bytes; u.r0 = rt * 256; u.c0 = GATH ? T.tile_p0[rt] : pn * 256; u.a0 = e; u.a1 = pn; u.nt = nt; u.flags = GATH ? T.cnt[e] : 3; return true;
    }
    __device__ __forceinline__ int kb(const pg8::Unit&, int t) const { return t; }
    __device__ __forceinline__ unsigned arow(const pg8::Unit& u, int r) const { const int pos = u.c0 + r; const int tok = pos < u.flags ? tl[(size_t)u.a0 * NT + pos] : 0; return (unsigned)tok * (unsigned)(DM * 2); }
};
struct EpiSwiGLU {
    static constexpr bool PERM = true;
    bf16* H;
    __device__ __forceinline__ void operator()(const f32x4 (&acc)[2][2][4][2], const pg8::Unit& u, int wr, int wc, int fr_, int fq_) const {
        (void)fr_; (void)fq_; const int ln_ = opaque_v(lane_id()); const int fr = ln_ & 15, fq = ln_ >> 4;
        const int row0 = u.r0 + wr * 64 + fr, col0 = u.a1 * 128 + wc * 32 + 8 * fq;
#pragma unroll
        for (int ai = 0; ai < 2; ++ai)
#pragma unroll
            for (int m = 0; m < 4; ++m) { float r[8];
#pragma unroll
                for (int n = 0; n < 2; ++n)
#pragma unroll
                    for (int i = 0; i < 4; ++i) { const float a = acc[ai][0][m][n][i], b = acc[ai][1][m][n][i]; r[4 * n + i] = silu_f(a) * b; }
                u32x4 w; w.x = pk2(r[0], r[1]); w.y = pk2(r[2], r[3]); w.z = pk2(r[4], r[5]); w.w = pk2(r[6], r[7]);
                *(u32x4*)(H + (size_t)(row0 + ai * 128 + m * 16) * DEXP + col0) = w; }
    }
};
template <bool OUT_F32> __device__ __forceinline__ void p_combine(const Ctx& C, int layer, const bf16* xsrc, void* xdst, int norm_rows = 0, bf16* hm = nullptr) {
    const MoeTab T = moe_tables(C, layer);
    const bf16* YS = C.w<bf16>(WS_YS); const int* RP = C.w<int>(WS_RP); const int* RE = C.w<int>(WS_RE); const float* RW = C.w<float>(WS_RW);
    const float* ng = C.in(IN_NMG) + (layer + 1 < 2 ? layer + 1 : 1) * DM;
    for (int t = C.vcu * 8 + C.wave; t < NT; t += C.G * 8) {
        const int s0 = T.off[RE[2 * t]] + RP[2 * t], s1 = T.off[RE[2 * t + 1]] + RP[2 * t + 1]; const float w0 = RW[2 * t], w1 = RW[2 * t + 1];
        const int b = t / SEQ;
        const float* g2 = C.mods(layer, 5) + (size_t)b * 6144;
        const u32x4* y0 = (const u32x4*)(YS + (size_t)s0 * DM) + C.lane; const u32x4* y1 = (const u32x4*)(YS + (size_t)s1 * DM) + C.lane;
        const u32x4* xr = (const u32x4*)(xsrc + (size_t)t * DM) + C.lane;
        f32x4 xa[2], xb[2]; float ss = 0.f;
#pragma unroll
        for (int j = 0; j < 2; ++j) { const u32x4 a = y0[64 * j], bq = y1[64 * j], xw = xr[64 * j]; const f32x4 ga = *(const f32x4*)(g2 + 512 * j + 8 * C.lane), gb = *(const f32x4*)(g2 + 512 * j + 8 * C.lane + 4);
            xa[j] = (f32x4){bflo(xw.x), bfhi(xw.x), bflo(xw.y), bfhi(xw.y)}; xb[j] = (f32x4){bflo(xw.z), bfhi(xw.z), bflo(xw.w), bfhi(xw.w)};
            xa[j].x += ga.x * (w0 * bflo(a.x) + w1 * bflo(bq.x)); xa[j].y += ga.y * (w0 * bfhi(a.x) + w1 * bfhi(bq.x)); xa[j].z += ga.z * (w0 * bflo(a.y) + w1 * bflo(bq.y)); xa[j].w += ga.w * (w0 * bfhi(a.y) + w1 * bfhi(bq.y));
            xb[j].x += gb.x * (w0 * bflo(a.z) + w1 * bflo(bq.z)); xb[j].y += gb.y * (w0 * bfhi(a.z) + w1 * bfhi(bq.z)); xb[j].z += gb.z * (w0 * bflo(a.w) + w1 * bflo(bq.w)); xb[j].w += gb.w * (w0 * bfhi(a.w) + w1 * bfhi(bq.w));
            if (OUT_F32) { float* o = (float*)xdst + (size_t)t * DM + 512 * j + 8 * C.lane; *(f32x4*)o = xa[j]; *(f32x4*)(o + 4) = xb[j]; }
            else { u32x4 w; w.x = pk2(xa[j].x, xa[j].y); w.y = pk2(xa[j].z, xa[j].w); w.z = pk2(xb[j].x, xb[j].y); w.w = pk2(xb[j].z, xb[j].w); *((u32x4*)((bf16*)xdst + (size_t)t * DM + 512 * j) + C.lane) = w; }
            ss += (xa[j].x * xa[j].x + xa[j].y * xa[j].y) + (xa[j].z * xa[j].z + xa[j].w * xa[j].w) + (xb[j].x * xb[j].x + xb[j].y * xb[j].y) + (xb[j].z * xb[j].z + xb[j].w * xb[j].w); }
        if (t < norm_rows) {
            const float rstd = 1.0f / sqrtf(wave_sum(ss) * (1.0f / DM) + EPS);
            const float* sc = C.mods(layer + 1, 1) + (size_t)b * 6144; const float* sh = C.mods(layer + 1, 0) + (size_t)b * 6144;
#pragma unroll
            for (int j = 0; j < 2; ++j) { const int c = 512 * j + 8 * C.lane;
                const f32x4 g0 = *(const f32x4*)(ng + c), g1 = *(const f32x4*)(ng + c + 4), c0 = *(const f32x4*)(sc + c), c1 = *(const f32x4*)(sc + c + 4), h0 = *(const f32x4*)(sh + c), h1 = *(const f32x4*)(sh + c + 4);
                const f32x4 ya = (xa[j] * rstd * g0) * (c0 + 1.0f) + h0, yb = (xb[j] * rstd * g1) * (c1 + 1.0f) + h1;
                u32x4 w; w.x = pk2(ya.x, ya.y); w.y = pk2(ya.z, ya.w); w.z = pk2(yb.x, yb.y); w.w = pk2(yb.z, yb.w);
                *(u32x4*)(hm + (size_t)t * DM + c) = w; }
        }
    }
}

constexpr int CV_XM = 0;
constexpr int CV_QKV = 18432;
constexpr int CV_QKV_P = 1552;
constexpr int CV_VT = CV_QKV + 32 * CV_QKV_P;
constexpr int CV_RED = CV_VT + 256 * 80;
static_assert(CV_RED + 16384 <= RING_BYTES && CV_VT % 16 == 0 && CV_RED % 16 == 0, "conv LDS");
__device__ __forceinline__ void conv_unit(const Ctx& C, int round, int bl, int ti) {
    LAS unsigned char* lds = C.lds; const int tid = C.tid, lane = C.lane, wid = C.wave;
    const int s0 = ti * 32; const size_t rrow0 = (size_t)bl * SEQ;
    const bf16* XM = C.w<bf16>(WS_XMH); bf16* XC = C.w<bf16>(WS_XC); bf16* K = C.w<bf16>(WS_K); bf16* VTR = C.w<bf16>(WS_VTR);
    const bf16* GWT = C.w<bf16>(WS_GWT);
    f32x4 gacc[2]; gacc[0] = (f32x4){0.f, 0.f, 0.f, 0.f}; gacc[1] = gacc[0];
    const int nblk = tid & 63, tg = tid >> 6;
    u32x4 xs[3];
#define CV_LOAD(chn) do { _Pragma("unroll") for (int q_ = 0; q_ < 3; ++q_) { const int i_ = tid + 512 * q_; const int r_ = i_ >> 5, cc_ = i_ & 31, s_ = s0 - 2 + r_; xs[q_] = (u32x4){0u, 0u, 0u, 0u}; \
        if (i_ < 36 * 32 && s_ >= 0 && s_ < SEQ) xs[q_] = *(const u32x4*)(XM + (rrow0 + s_) * ML_IN + (chn) * 256 + cc_ * 8); } } while (0)
    CV_LOAD(0);
    for (int ch = 0; ch < 8; ++ch) {
        const int c0 = ch * 256;
        LDS_BARRIER();
#pragma unroll
        for (int q = 0; q < 3; ++q) { const int i = tid + 512 * q; if (i < 36 * 32) *(LAS u32x4*)(lds + CV_XM + (i >> 5) * 512 + (i & 31) * 16) = xs[q]; }
        if (ch + 1 < 8) CV_LOAD(ch + 1);
        LDS_BARRIER();
        {
            const int c = c0 + 4 * nblk;
            float cw[5][4], cb[4], wq[4][4], wk[4][4], wv[4][4];
            const float* convw = C.in(IN_CONVW); const float* convb = C.in(IN_CONVB);
#pragma unroll
            for (int j = 0; j < 5; ++j) { const f32x4 v = *(const f32x4*)(convw + j * ML_IN + c); cw[j][0] = v.x; cw[j][1] = v.y; cw[j][2] = v.z; cw[j][3] = v.w; }
            { const f32x4 v = *(const f32x4*)(convb + c); cb[0] = v.x; cb[1] = v.y; cb[2] = v.z; cb[3] = v.w; }
            const int nb = c >> 2;
#pragma unroll
            for (int i = 0; i < 4; ++i) { const f32x4 a = *(const f32x4*)(C.in(IN_WQ) + nb * 16 + i * 4), b = *(const f32x4*)(C.in(IN_WK) + nb * 16 + i * 4), d = *(const f32x4*)(C.in(IN_WV) + nb * 16 + i * 4);
                wq[i][0] = a.x; wq[i][1] = a.y; wq[i][2] = a.z; wq[i][3] = a.w; wk[i][0] = b.x; wk[i][1] = b.y; wk[i][2] = b.z; wk[i][3] = b.w; wv[i][0] = d.x; wv[i][1] = d.y; wv[i][2] = d.z; wv[i][3] = d.w; }
            float xw[8][4];
#pragma unroll
            for (int r = 0; r < 8; ++r) { const u32x2 v = *(const LAS u32x2*)(lds + CV_XM + (4 * tg + r) * 512 + nblk * 8); xw[r][0] = bflo(v.x); xw[r][1] = bfhi(v.x); xw[r][2] = bflo(v.y); xw[r][3] = bfhi(v.y); }
#pragma unroll
            for (int tt = 0; tt < 4; ++tt) {
                const int tl = 4 * tg + tt;
                float xc[4], qv[4], kv[4], vv[4];
#pragma unroll
                for (int i = 0; i < 4; ++i) { float a = cb[i];
#pragma unroll
                    for (int j = 0; j < 5; ++j) a += cw[j][i] * xw[tt + j][i];
                    xc[i] = silu_f(a); }
#pragma unroll
                for (int o = 0; o < 4; ++o) { float a = 0.f, b = 0.f, d = 0.f;
#pragma unroll
                    for (int i = 0; i < 4; ++i) { a += xc[i] * wq[i][o]; b += xc[i] * wk[i][o]; d += xw[tt + 2][i] * wv[i][o]; }
                    qv[o] = a; kv[o] = b; vv[o] = d; }
                const size_t grow = (rrow0 + s0 + tl) * ML_IN + c;
                float k2[4];
#pragma unroll
                for (int i = 0; i < 4; ++i) { float a = 0.f;
#pragma unroll
                    for (int o = 0; o < 4; ++o) a += kv[o] * wq[i][o];
                    k2[i] = a; }
                const u32x2 xcw = (u32x2){pk2(xc[0], xc[1]), pk2(xc[2], xc[3])}, qw = (u32x2){pk2(qv[0], qv[1]), pk2(qv[2], qv[3])}, kw = (u32x2){pk2(kv[0], kv[1]), pk2(kv[2], kv[3])}, vw = (u32x2){pk2(vv[0], vv[1]), pk2(vv[2], vv[3])};
                *(u32x2*)(XC + grow) = xcw; *(u32x2*)(K + grow) = (u32x2){pk2(k2[0], k2[1]), pk2(k2[2], k2[3])};
                LAS unsigned char* qrow = lds + CV_QKV + tl * CV_QKV_P + nblk * 8;
                *(LAS u32x2*)(qrow) = qw; *(LAS u32x2*)(qrow + 512) = kw; *(LAS u32x2*)(qrow + 1024) = vw;
            }
        }
        LDS_BARRIER();
        for (int i = tid; i < 256 * 4; i += 512) { const int cr = i >> 2, cc = i & 3; const int cg = c0 + cr, head = cg >> 9, dv = cg & 511;
            const LAS unsigned short* s = (const LAS unsigned short*)(lds + CV_QKV + (8 * cc) * CV_QKV_P + 1024) + cr; unsigned short v[8];
#pragma unroll
            for (int j = 0; j < 8; ++j) v[j] = s[j * (CV_QKV_P / 2)];
            *(u32x4*)(VTR + ((size_t)(bl * 4 + head) * 512 + dv) * SEQ + s0 + cc * 8) = (u32x4){(unsigned)v[0] | ((unsigned)v[1] << 16), (unsigned)v[2] | ((unsigned)v[3] << 16), (unsigned)v[4] | ((unsigned)v[5] << 16), (unsigned)v[6] | ((unsigned)v[7] << 16)}; }
#pragma unroll
        for (int ks = 0; ks < 3; ++ks) { const int kk = 96 * wid + 32 * ks + 8 * (lane >> 4);
            const int m = kk >> 8, cl = kk & 255;
            const bf16x8 bfr = *(const bf16x8*)(GWT + (size_t)(lane & 15) * 6144 + m * 2048 + c0 + cl);
#pragma unroll
            for (int tgp = 0; tgp < 2; ++tgp) { const bf16x8 afr = *(const LAS bf16x8*)(lds + CV_QKV + (16 * tgp + (lane & 15)) * CV_QKV_P + kk * 2);
                gacc[tgp] = __builtin_amdgcn_mfma_f32_16x16x32_bf16(afr, bfr, gacc[tgp], 0, 0, 0); } }
    }
    LDS_BARRIER();
    LAS float* red = (LAS float*)(lds + CV_RED);
#pragma unroll
    for (int tgp = 0; tgp < 2; ++tgp)
#pragma unroll
        for (int r = 0; r < 4; ++r) red[(wid * 32 + 16 * tgp + 4 * (lane >> 4) + r) * 16 + (lane & 15)] = gacc[tgp][r];
    LDS_BARRIER();
    { const int tkn = tid >> 4, n = tid & 15; float s = C.in(IN_GATEB)[n];
#pragma unroll
        for (int w = 0; w < 8; ++w) s += red[(w * 32 + tkn) * 16 + n];
        C.w<float>(WS_PRE)[(rrow0 + s0 + tkn) * 16 + n] = s; }
    (void)round;
#undef CV_LOAD
}
__device__ __forceinline__ void p_conv(const Ctx& C, int round) {
    { float* DEN = C.w<float>(WS_DEN); for (int i = C.vcu * 512 + C.tid; i < 2 * 16 * 2048; i += C.G * 512) DEN[i] = 0.f; }
    for (int u = C.vcu; u < RB * 64; u += C.G) conv_unit(C, round, u >> 6, u & 63);
    __syncthreads();
}
__device__ __forceinline__ void cumsum_seq(const Ctx& C, int sq) {
    float* FG = C.w<float>(WS_FG); const float* PRE = C.w<float>(WS_PRE);
    LAS float* wtot = (LAS float*)(C.lds);
    const int dir = sq & 1, bh = sq >> 1, bl = bh >> 2, hd = bh & 3, lane = C.lane, tid = C.tid;
    const float* p = PRE + (size_t)bl * SEQ * 16 + dir * 8;
    float lf[4], ii[4]; float tot = 0.f;
#pragma unroll
    for (int j = 0; j < 4; ++j) { const int s = tid * 4 + j; const float f = p[(size_t)s * 16 + 4 + hd]; ii[j] = p[(size_t)s * 16 + hd];
        lf[j] = fminf(f, 0.f) - log1pf(__expf(-fabsf(f))); tot += lf[j]; }
    float inc = tot;
#pragma unroll
    for (int o = 1; o < 64; o <<= 1) { const float v = __shfl_up(inc, o); if (lane >= o) inc += v; }
    __syncthreads();
    if (lane == 63) wtot[C.wave] = inc;
    __syncthreads();
    float before = 0.f, all = 0.f;
#pragma unroll
    for (int w = 0; w < 8; ++w) { const float v = wtot[w]; all += v; if (w < C.wave) before += v; }
    const float excl = before + inc - tot;
    float* F = FG + (size_t)(dir * 2) * 16 * 2048 + (size_t)bh * 2048; float* Gp = F + 16 * 2048;
    f32x4 fo, go;
    if (dir == 0) { float run = excl;
#pragma unroll
        for (int j = 0; j < 4; ++j) { run += lf[j]; fo[j] = run * LOG2E; go[j] = (ii[j] - run) * LOG2E - 4.5f; } }
    else { float run = all - excl;
#pragma unroll
        for (int j = 0; j < 4; ++j) { fo[j] = run * LOG2E; go[j] = (ii[j] - run) * LOG2E - 4.5f; run -= lf[j]; } }
    *(f32x4*)(F + tid * 4) = fo; *(f32x4*)(Gp + tid * 4) = go;
}
struct DecayOrder {
    const char* Qb; const char* Kb; int G, c;
    __device__ __forceinline__ bool next(int ii, pg8::Unit& u) const {
        const int grp = (ii >> 2) * G + c; if (grp >= 256) return false;
        const int bh = grp >> 4, i = (grp >> 1) & 7, j = 4 * (grp & 1) + (ii & 3), bl = bh >> 2, hd = bh & 3;
        u.A = Qb + ((size_t)(bl * SEQ + 256 * i) * ML_IN + hd * 512) * 2; u.B = Kb + ((size_t)(bl * SEQ + 256 * j) * ML_IN + hd * 512) * 2; u.r0 = 256 * i; u.c0 = 256 * j; u.a0 = bh; u.a1 = (i << 4) | j; u.nt = ML_DH / 64; u.flags = 3; return true;
    }
    __device__ __forceinline__ int kb(const pg8::Unit&, int t) const { return t; }
};
struct EpiDecay {
    static constexpr bool PERM = true;
    bf16* W; const float* FG; float* DEN; int den_on; bf16* DUMMY;
    template <bool MASK>
    __device__ __forceinline__ void pass(const f32x4 (&acc)[2][2][4][2], const pg8::Unit& u, int wr, int wc, int fr, int fq, int dir, int dmin, int dmax, int cblk) const {
        const int bh = u.a0; const float* F = FG + (size_t)(dir * 2) * 16 * 2048 + (size_t)bh * 2048; const float* Gp = F + 16 * 2048;
        const int rl0 = opaque_v(wr * 64 + fr), cl0 = opaque_v(wc * 32 + 8 * fq);
        const float* Fr = F + u.r0;
        const bool fake_ = (REP_ABL & 256) && !den_on;
        const float ref = fake_ ? 0.5f : (dir ? Fr[255] : Fr[0]);
        f32x4 gv[2][2];
#pragma unroll
        for (int bj = 0; bj < 2; ++bj)
#pragma unroll
            for (int n = 0; n < 2; ++n) { const f32x4 g = fake_ ? (f32x4){0.1f * fq, 0.2f, 0.3f * fr, 0.4f} : *(const f32x4*)(Gp + u.c0 + cl0 + bj * 128 + 4 * n);
#pragma unroll
                for (int i = 0; i < 4; ++i) gv[bj][n][i] = __builtin_amdgcn_exp2f(fminf(g[i] + ref, 120.0f)); }
        float fa[2][4];
#pragma unroll
        for (int ai = 0; ai < 2; ++ai)
#pragma unroll
            for (int m = 0; m < 4; ++m) fa[ai][m] = __builtin_amdgcn_exp2f(fmaxf((fake_ ? 0.01f * (fr + m) : Fr[rl0 + ai * 128 + m * 16]) - ref, -126.0f));
        bf16* wbase = W + ((size_t)bh * SEQ + u.r0) * WLD + cblk * 256 + cl0;
        float* den = DEN + (size_t)dir * 16 * 2048 + (size_t)bh * 2048 + u.r0;
#pragma unroll
        for (int ai = 0; ai < 2; ++ai)
#pragma unroll
            for (int m = 0; m < 4; ++m) { const int rl = rl0 + ai * 128 + m * 16; const float fv = fa[ai][m]; f32x4 rsv = (f32x4){0.f, 0.f, 0.f, 0.f};
#pragma unroll
                for (int bj = 0; bj < 2; ++bj) { f32x4 t0 = acc[ai][bj][m][0] * gv[bj][0], t1 = acc[ai][bj][m][1] * gv[bj][1];
                    if (MASK) {
#pragma unroll
                        for (int i = 0; i < 4; ++i) { const int d0 = cl0 + bj * 128 + i - rl, d1 = d0 + 4; t0[i] = (d0 >= dmin && d0 <= dmax) ? t0[i] : 0.f; t1[i] = (d1 >= dmin && d1 <= dmax) ? t1[i] : 0.f; } }
                    rsv += t0; rsv += t1; t0 = t0 * fv; t1 = t1 * fv;
                    u32x4 w; w.x = pk2(t0[0], t0[1]); w.y = pk2(t0[2], t0[3]); w.z = pk2(t1[0], t1[1]); w.w = pk2(t1[2], t1[3]);
                    if (!((REP_ABL & 64) && !den_on)) *(u32x4*)(wbase + (size_t)rl * WLD + bj * 128) = w; else rsv[0] += __builtin_bit_cast(float, w.x ^ w.y ^ w.z ^ w.w); }
                float rs = ((rsv[0] + rsv[1]) + (rsv[2] + rsv[3])) * fv;
                rs += __shfl_xor(rs, 16); rs += __shfl_xor(rs, 32);
                if (fq == 0 && den_on) atomicAdd(den + rl, rs); else if ((REP_ABL & 64) && rs == 12345.678f) den[rl] = rs; }
    }
    __device__ __forceinline__ void operator()(const f32x4 (&acc)[2][2][4][2], const pg8::Unit& u, int wr, int wc, int fr_, int fq_) const {
        (void)fr_; (void)fq_; const int ln_ = opaque_v(lane_id()); const int fr = ln_ & 15, fq = ln_ >> 4;
        if ((REP_ABL & 32) && !den_on) { if (acc[0][0][0][0][0] == 12345.678f) W[0] = 1; return; }
        if ((REP_ABL & 512) && !den_on) {
            bf16* wb = DUMMY + ((size_t)(u.a0 & 1) * SEQ + u.r0) * 2048 + (u.a1 & 7) * 256 + wc * 32 + 8 * fq;
#pragma unroll
            for (int ai = 0; ai < 2; ++ai)
#pragma unroll
                for (int m = 0; m < 4; ++m) { const int rl = wr * 64 + fr + ai * 128 + m * 16;
#pragma unroll
                    for (int bj = 0; bj < 2; ++bj) { const f32x4 v0 = acc[ai][bj][m][0], v1 = acc[ai][bj][m][1];
                        u32x4 w; w.x = pk2(v0[0], v0[1]); w.y = pk2(v0[2], v0[3]); w.z = pk2(v1[0], v1[1]); w.w = pk2(v1[2], v1[3]);
                        *(u32x4*)(wb + (size_t)rl * 2048 + bj * 128) = w; } }
            return; }
        const int i = u.a1 >> 4, j = u.a1 & 15;
        if (j != i) pass<false>(acc, u, wr, wc, fr, fq, j > i ? 1 : 0, 0, 0, j > i ? j + 1 : j);
        else { for (int p = 0; p < 2; ++p) pass<true>(acc, u, wr, wc, fr, fq, p, p ? 0 : -100000, p ? 100000 : 0, i + p); }
    }
};
struct HOrder {
    const char* Wb; const char* Vb; const float* DEN; int G, c;
    __device__ __forceinline__ bool next(int ii, pg8::Unit& u) const {
        const int L = (ii >> 1) * G + c, part = ii & 1; if (L >= 16 * 16) return false;
        const int bh = L >> 4, i = (L >> 1) & 7, jn = L & 1;
        const int kt0 = part ? 4 * (i + 1) : 0;
        u.A = Wb + (((size_t)bh * SEQ + 256 * i) * WLD + (size_t)kt0 * 64) * 2;
        u.B = Vb + (((size_t)bh * 512 + 256 * jn) * SEQ + (size_t)(part ? 4 * i : 0) * 64) * 2;
        u.r0 = 256 * i; u.c0 = 256 * jn; u.a0 = bh; u.a1 = part; u.nt = part ? 36 - 4 * (i + 1) : 4 * (i + 1); u.flags = 3; return true;
    }
    __device__ __forceinline__ int kb(const pg8::Unit&, int t) const { return t; }
    __device__ __forceinline__ void between(const pg8::Unit& u, f32x4 (&acc)[2][2][4][2], int wr) const {
        const int fr = opaque_v(lane_id()) & 15;
        const float* df = DEN + (size_t)u.a0 * 2048 + u.r0; const float* db = df + 16 * 2048;
#pragma unroll
        for (int ai = 0; ai < 2; ++ai)
#pragma unroll
            for (int m = 0; m < 4; ++m) { const int rl = ai * 128 + wr * 64 + m * 16 + fr; const float f = fmaxf(fabsf(db[rl]), 1.0f) / fmaxf(fabsf(df[rl]), 1.0f);
#pragma unroll
                for (int bj = 0; bj < 2; ++bj)
#pragma unroll
                    for (int n = 0; n < 2; ++n) acc[ai][bj][m][n] *= f; }
    }
};
struct EpiH {
    static constexpr bool PERM = true;
    bf16* HF; bf16* HB; const float* DEN;
    __device__ __forceinline__ void operator()(const f32x4 (&acc)[2][2][4][2], const pg8::Unit& u, int wr, int wc, int fr_, int fq_) const {
        (void)fr_; (void)fq_; const int ln_ = opaque_v(lane_id()); const int fr = ln_ & 15, fq = ln_ >> 4;
        const int bh = u.a0, bl = bh >> 2, hd = bh & 3, part = u.a1; const float* dn = DEN + (size_t)part * 16 * 2048 + (size_t)bh * 2048 + u.r0;
        const int rl0 = wr * 64 + fr, col0 = hd * 512 + u.c0 + wc * 32 + 8 * fq;
        bf16* Hh = HF; (void)HB;
#pragma unroll
        for (int ai = 0; ai < 2; ++ai)
#pragma unroll
            for (int m = 0; m < 4; ++m) { const int rl = rl0 + ai * 128 + m * 16; const float rv = 1.0f / fmaxf(fabsf(dn[rl]), 1.0f);
                bf16* rowp = Hh + ((size_t)bl * SEQ + u.r0 + rl) * ML_IN + col0;
#pragma unroll
                for (int bj = 0; bj < 2; ++bj) { f32x4 v0 = acc[ai][bj][m][0] * rv, v1 = acc[ai][bj][m][1] * rv;
                    u32x4 w; w.x = pk2(v0[0], v0[1]); w.y = pk2(v0[2], v0[3]); w.z = pk2(v1[0], v1[1]); w.w = pk2(v1[2], v1[3]);
                    *(u32x4*)(rowp + bj * 128) = w; } }
    }
};
__device__ __forceinline__ void p_ynorm(const Ctx& C, int round, bool dummy = false) {
    const bf16* HF = C.w<bf16>(WS_Q); const bf16* XC = C.w<bf16>(WS_XC); bf16* Y = C.w<bf16>(WS_Y) + (size_t)round * RT * ML_IN;
    const float* og = C.in(IN_ONG); const float* skip = C.in(IN_SKIP);
    bf16* Yd = dummy ? C.w<bf16>(WS_XMH) : Y;
    for (int r = C.vcu * 8 + C.wave; r < RT; r += C.G * 8) {
        const size_t off = (size_t)r * ML_IN + 8 * C.lane;
#pragma unroll
        for (int hd = 0; hd < 4; ++hd) {
            const u32x4 hw = *(const u32x4*)(HF + off + hd * 512), xw = *(const u32x4*)(XC + off + hd * 512), zw = *(const u32x4*)(Y + off + hd * 512);
            float hv[8] = {bflo(hw.x), bfhi(hw.x), bflo(hw.y), bfhi(hw.y), bflo(hw.z), bfhi(hw.z), bflo(hw.w), bfhi(hw.w)};
            const float xv[8] = {bflo(xw.x), bfhi(xw.x), bflo(xw.y), bfhi(xw.y), bflo(xw.z), bfhi(xw.z), bflo(xw.w), bfhi(xw.w)};
            const float zv[8] = {bflo(zw.x), bfhi(zw.x), bflo(zw.y), bfhi(zw.y), bflo(zw.z), bfhi(zw.z), bflo(zw.w), bfhi(zw.w)};
            float ss = 0.f;
#pragma unroll
            for (int j = 0; j < 8; ++j) ss += hv[j] * hv[j];
            const float rs = 1.0f / sqrtf(wave_sum(ss) * (1.0f / 512.0f) + EPS);
            const float* gg = og + hd * 512 + 8 * C.lane; const float* sk = skip + hd * 512 + 8 * C.lane; float yv[8];
#pragma unroll
            for (int j = 0; j < 8; ++j) yv[j] = (hv[j] * rs * gg[j] + sk[j] * xv[j]) * silu_f(zv[j]);
            u32x4 w; w.x = pk2(yv[0], yv[1]); w.y = pk2(yv[2], yv[3]); w.z = pk2(yv[4], yv[5]); w.w = pk2(yv[6], yv[7]);
            *(u32x4*)(Yd + off + hd * 512) = w;
        }
    }
}

constexpr int PH_PRO = 0, PH_NORM0 = 1, PH_QKV = 2, PH_ATTN = 3, PH_OUT0 = 4, PH_ROUTE0 = 5, PH_UP0 = 6, PH_DOWN0 = 7, PH_COMB0 = 8,
              PH_INPROJ0 = 9, PH_RND = 10  , PH_OUT1 = PH_RND + 4 * NROUND, PH_ROUTE1 = PH_OUT1 + 1,
              PH_UP1 = PH_OUT1 + 2, PH_DOWN1 = PH_OUT1 + 3, PH_COMB1 = PH_OUT1 + 4, N_PHASES = PH_OUT1 + 5;

__device__ __forceinline__ void moe_up(const Ctx& C, int layer) {
    const MoeTab T = moe_tables(C, layer);
    MoeOrder<2, true> S; S.tl = C.w<int>(WS_TL); S.T = T; S.A = (const char*)C.w<bf16>(WS_HF); S.B = (const char*)C.w<bf16>(WS_W13T); S.lda_bytes = DM * 2; S.b_expert_bytes = (size_t)512 * DM * 2; S.b_tile_bytes = 256 * DM * 2; S.G = C.G; S.c = C.vcu; S.nt = DM / 64;
    EpiSwiGLU E{C.w<bf16>(WS_HH)};
    pg8::gemm_phase<EpiSwiGLU, MoeOrder<2, true>, true, true>(C.lds, C.tid, DM, DM, S, E);
}
__device__ __forceinline__ void moe_down(const Ctx& C, int layer) {
    const MoeTab T = moe_tables(C, layer);
    MoeOrder<4, false> S; S.tl = nullptr; S.T = T; S.A = (const char*)C.w<bf16>(WS_HH); S.B = (const char*)C.w<bf16>(WS_W2T); S.lda_bytes = DEXP * 2; S.b_expert_bytes = (size_t)DM * DEXP * 2; S.b_tile_bytes = 256 * DEXP * 2; S.G = C.G; S.c = C.vcu; S.nt = DEXP / 64;
    pg8::EpiBf16 E{C.w<bf16>(WS_YS), DM, 0, nullptr, 0};
    pg8::gemm_phase<pg8::EpiBf16, MoeOrder<4, false>, true>(C.lds, C.tid, DEXP, DEXP, S, E);
}

__global__ void __launch_bounds__(512, 2) fwd_kernel(Args args) {
    extern __shared__ __attribute__((aligned(16))) unsigned char lds_raw[];
    Ctx C; C.a = &args; C.ws = (GAS unsigned char*)args.ws; C.lds = (LAS unsigned char*)lds_raw; C.tid = threadIdx.x; C.lane = C.tid & 63; C.wave = __builtin_amdgcn_readfirstlane(C.tid >> 6);
    C.G = gridDim.x; { const int bx = blockIdx.x; C.vcu = (C.G % 8 == 0) ? (bx % 8) * (C.G / 8) + bx / 8 : bx; }
    volatile LAS unsigned* MISC = (volatile LAS unsigned*)(C.lds + MISC_OFF);
    if (C.tid < 64) MISC[C.tid] = 0u;
    __syncthreads();
    const int lo = args.ph_lo, hi = args.ph_hi;
    XcdBarrier bar; bar.bar = C.w<unsigned>(WS_CTL) + CW_BAR; bar.x = 0; bar.st = nullptr;
    if (hi - lo > 1) bar = xcd_barrier_post(C.w<unsigned>(WS_CTL) + CW_BAR, MISC + 8);
#ifndef PHSEL
#define PHSEL(k) true
#endif
#define IN(k) (PHSEL(k) && lo <= (k) && (k) < hi)
#ifndef REP_PH
#define REP_PH (-1)
#endif
#ifndef REP_J
#define REP_J (-1)
#endif
#ifndef REP_N
#define REP_N 0
#endif
#define NREP(k) (1 + (((k) == REP_PH) ? REP_N : 0))
#define NREPJ(j) (1 + (((j) == REP_J) ? REP_N : 0))
#define SEAM(k) do { if (IN(k) && IN((k) + 1)) xcd_barrier(bar); } while (0)
    float* xout = (float*)(GAS float*)args.out;
    bf16* hmall = (bf16*)xout + (size_t)NT * DM;
    bf16* xb = (bf16*)xout;

    if (IN(PH_PRO)) for (int rep_ = 0; rep_ < NREP(PH_PRO); ++rep_) { const Ctx P = fresh(C); p_prologue(P); } SEAM(PH_PRO);
#ifdef XTRA_BARRIERS
    for (int xb_ = 0; xb_ < XTRA_BARRIERS; ++xb_) xcd_barrier(bar);
#endif
    if (IN(PH_NORM0)) for (int rep_ = 0; rep_ < NREP(PH_NORM0); ++rep_) { const Ctx P = fresh(C); p_normmod(P, P.in(IN_X), 0, 0, NT, P.w<bf16>(WS_HM)); } SEAM(PH_NORM0);
    if (IN(PH_QKV)) for (int rep_ = 0; rep_ < NREP(PH_QKV); ++rep_) { const Ctx P = fresh(C);
        { pg8::PlainOrder S{(const char*)P.w<bf16>(WS_HM), (const char*)P.w<bf16>(WS_WINT), DM, DM, NT / 256, 2048 / 256, P.G, P.vcu, DM / 64};
          pg8::EpiQKNorm E{P.w<bf16>(WS_QK), P.in(IN_QG), P.in(IN_KG), (LAS float*)(P.lds + MISC_OFF + 4096)};
          pg8::gemm_phase<pg8::EpiQKNorm, pg8::PlainOrder, true>(P.lds, P.tid, DM, DM, S, E); }
        { pg8::PlainOrder S{(const char*)(P.w<bf16>(WS_WINT) + (size_t)2048 * DM), (const char*)P.w<bf16>(WS_HM), DM, DM, 1024 / 256, NT / 256, P.G, P.vcu, DM / 64};
          pg8::EpiBf16 E{P.w<bf16>(WS_VT), NT, 0, nullptr, 0};
          pg8::gemm_phase<pg8::EpiBf16, pg8::PlainOrder, true>(P.lds, P.tid, DM, DM, S, E); }
    } SEAM(PH_QKV);
    if (IN(PH_ATTN)) for (int rep_ = 0; rep_ < NREP(PH_ATTN); ++rep_) { const Ctx P = fresh(C); if (rep_ == 0) p_attention<0>(P); else p_attention<REP_ABL>(P); } SEAM(PH_ATTN);
    if (IN(PH_OUT0)) for (int rep_ = 0; rep_ < NREP(PH_OUT0); ++rep_) { const Ctx P = fresh(C);
        pg8::PlainOrder S{(const char*)P.w<bf16>(WS_O), (const char*)P.w<bf16>(WS_WOT), DM, DM, NT / 256, DM / 256, P.G, P.vcu, DM / 64};
        pg8::EpiResid<true> E{P.in(IN_X), xb, P.mods(0, 2)};
        pg8::gemm_phase<pg8::EpiResid<true>, pg8::PlainOrder, true>(P.lds, P.tid, DM, DM, S, E);
    } SEAM(PH_OUT0);
    if (IN(PH_ROUTE0)) for (int rep_ = 0; rep_ < NREP(PH_ROUTE0); ++rep_) { const Ctx P = fresh(C); p_route(P, 0, xb, rep_ == 0); } SEAM(PH_ROUTE0);
    if (IN(PH_UP0)) for (int rep_ = 0; rep_ < NREP(PH_UP0); ++rep_) { const Ctx P = fresh(C); moe_up(P, 0); } SEAM(PH_UP0);
    if (IN(PH_DOWN0)) for (int rep_ = 0; rep_ < NREP(PH_DOWN0); ++rep_) { const Ctx P = fresh(C); moe_down(P, 0); } SEAM(PH_DOWN0);
    if (IN(PH_COMB0)) for (int rep_ = 0; rep_ < NREP(PH_COMB0); ++rep_) { const Ctx P = fresh(C); p_combine<false>(P, 0, xb, rep_ == 0 ? (void*)xb : (void*)P.w<bf16>(WS_HS + 8 * MiB), rep_ == 0 ? NT : 0, hmall); LAS float* scr = (LAS float*)(P.lds + P.wave * 16384); moe_weight_items(P, 1, scr); } SEAM(PH_COMB0);

#define INPROJ(P_, rnd_, skip_) do { \
        pg8::PlainOrder S_{(const char*)(hmall + (size_t)(rnd_) * RT * DM), (const char*)(P_).w<bf16>(WS_MLWINT), DM, DM, RT / 256, 4096 / 256, (P_).G, (P_).vcu, DM / 64}; \
        pg8::EpiBf16 E_{(P_).w<bf16>(WS_XMH), ML_IN, ML_IN, (P_).w<bf16>(WS_Y) + (size_t)(rnd_) * RT * ML_IN, ML_IN, skip_}; \
        pg8::gemm_phase<pg8::EpiBf16, pg8::PlainOrder, true>((P_).lds, (P_).tid, DM, DM, S_, E_); } while (0)
    if (IN(PH_INPROJ0)) for (int rep_ = 0; rep_ < NREP(PH_INPROJ0); ++rep_) { const Ctx P = fresh(C); INPROJ(P, 0, rep_); } SEAM(PH_INPROJ0);
    for (int round = 0; round < NROUND; ++round) {
        const int pb = PH_RND + 4 * round;
        if (IN(pb + 0)) for (int rep_ = 0; rep_ < NREPJ(0); ++rep_) { const Ctx P = fresh(C); p_conv(P, round); } SEAM(pb + 0);
        if (IN(pb + 1)) for (int rep_ = 0; rep_ < NREPJ(1); ++rep_) { const Ctx P = fresh(C);
            { int last_bh = -1; for (int grp = P.vcu; grp < 256; grp += P.G) { const int bh = grp >> 4; if (bh != last_bh) { cumsum_seq(P, 2 * bh); cumsum_seq(P, 2 * bh + 1); last_bh = bh; } }
              asm volatile("s_waitcnt vmcnt(0)" ::: "memory"); __syncthreads(); }
            DecayOrder S{(const char*)P.w<bf16>(WS_XC), (const char*)P.w<bf16>(WS_K), P.G, P.vcu};
            EpiDecay E{P.w<bf16>(WS_W), P.w<float>(WS_FG), P.w<float>(WS_DEN), rep_ == 0 ? 1 : 0, P.w<bf16>(WS_XMH)};
            pg8::gemm_phase<EpiDecay, DecayOrder, GEMM1_ALIGN>(P.lds, P.tid, ML_IN, ML_IN, S, E);
        } SEAM(pb + 1);
        if (IN(pb + 2)) for (int rep_ = 0; rep_ < NREPJ(2); ++rep_) { const Ctx P = fresh(C);
            { HOrder S{(const char*)P.w<bf16>(WS_W), (const char*)P.w<bf16>(WS_VTR), P.w<float>(WS_DEN), P.G, P.vcu};
              EpiH E{P.w<bf16>(WS_Q), P.w<bf16>(WS_K), P.w<float>(WS_DEN)};
              pg8::gemm_phase<EpiH, HOrder, true, false, true>(P.lds, P.tid, WLD, SEQ, S, E); }
            if (round + 1 < NROUND) { const Ctx P2 = fresh(C); INPROJ(P2, round + 1, rep_); }
        } SEAM(pb + 2);
        if (IN(pb + 3)) for (int rep_ = 0; rep_ < NREPJ(3); ++rep_) { const Ctx P = fresh(C); p_ynorm(P, round, rep_ != 0); } SEAM(pb + 3);
    }
#undef INPROJ
    if (IN(PH_OUT1)) for (int rep_ = 0; rep_ < NREP(PH_OUT1); ++rep_) { const Ctx P = fresh(C);
        pg8::PlainOrder S{(const char*)P.w<bf16>(WS_Y), (const char*)P.w<bf16>(WS_MLWOUTT), ML_IN, ML_IN, NT / 256, DM / 256, P.G, P.vcu, ML_IN / 64};
        pg8::EpiResid<false> E{xb, P.w<bf16>(WS_XB3), P.mods(1, 2)};
        pg8::gemm_phase<pg8::EpiResid<false>, pg8::PlainOrder, true>(P.lds, P.tid, ML_IN, ML_IN, S, E);
    } SEAM(PH_OUT1);
    if (IN(PH_ROUTE1)) for (int rep_ = 0; rep_ < NREP(PH_ROUTE1); ++rep_) { const Ctx P = fresh(C); p_route(P, 1, P.w<bf16>(WS_XB3), rep_ == 0); } SEAM(PH_ROUTE1);
    if (IN(PH_UP1)) for (int rep_ = 0; rep_ < NREP(PH_UP1); ++rep_) { const Ctx P = fresh(C); moe_up(P, 1); } SEAM(PH_UP1);
    if (IN(PH_DOWN1)) for (int rep_ = 0; rep_ < NREP(PH_DOWN1); ++rep_) { const Ctx P = fresh(C); moe_down(P, 1); } SEAM(PH_DOWN1);
    if (IN(PH_COMB1)) for (int rep_ = 0; rep_ < NREP(PH_COMB1); ++rep_) { const Ctx P = fresh(C); p_combine<true>(P, 1, P.w<bf16>(WS_XB3), rep_ == 0 ? (void*)xout : (void*)P.w<float>(WS_HS + 8 * MiB)); }
#undef IN
#undef SEAM
}

extern "C" void kernel_launch(void* const* d_in, const int* in_sizes, int n_in, void* d_out, int out_size, void* d_ws, size_t ws_size, hipStream_t stream) {
    static int grid = 0;
    if (grid == 0) {
        if (n_in != 32 || in_sizes[0] != NT * DM || out_size != NT * DM || ws_size < WS_END) { fprintf(stderr, "kernel_launch: unexpected shapes (n_in %d, in0 %d, out %d, ws %zu)\n", n_in, n_in > 0 ? in_sizes[0] : -1, out_size, ws_size); grid = -1; return; }
        int dev = 0, cus = 0, per_cu = 0;
        if (hipGetDevice(&dev) != hipSuccess || hipDeviceGetAttribute(&cus, hipDeviceAttributeMultiprocessorCount, dev) != hipSuccess) { grid = -1; return; }
        if (hipFuncSetAttribute((const void*)fwd_kernel, hipFuncAttributeMaxDynamicSharedMemorySize, LDS_BYTES) != hipSuccess) { fprintf(stderr, "kernel_launch: hipFuncSetAttribute failed\n"); grid = -1; return; }
        if (hipOccupancyMaxActiveBlocksPerMultiprocessor(&per_cu, (const void*)fwd_kernel, 512, LDS_BYTES) != hipSuccess || per_cu < 1) fprintf(stderr, "kernel_launch: occupancy query reports %d\n", per_cu);
        (void)hipGetLastError();
        grid = cus;
    }
    if (grid < 0) return;
    (void)hipMemsetAsync((char*)d_ws + WS_CTL, 0, CTL_ZERO_BYTES, stream);
    Args a{};
    for (int i = 0; i < 32; ++i) a.in[i] = (const float*)d_in[i];
    a.out = (float*)d_out; a.ws = (unsigned char*)d_ws;
#if MK_ONE_LAUNCH
    a.ph_lo = 0; a.ph_hi = N_PHASES;
    hipLaunchKernelGGL(fwd_kernel, dim3(grid), dim3(512), LDS_BYTES, stream, a);
#else
    for (int p = 0; p < N_PHASES; ++p) { a.ph_lo = p; a.ph_hi = p + 1; hipLaunchKernelGGL(fwd_kernel, dim3(grid), dim3(512), LDS_BYTES, stream, a); }
#endif
}
```

```cpp
#include <hip/hip_runtime.h>
#include <cstdio>
#include <cstdint>

#ifndef REP_ABL
#define REP_ABL 0
#endif
#ifndef GEMM1_STAGGER
#define GEMM1_STAGGER 0ull
#endif
#ifndef GEMM1_ALIGN
#define GEMM1_ALIGN true
#endif
#ifndef MK_ONE_LAUNCH
#define MK_ONE_LAUNCH 1
#endif

#define GAS __attribute__((address_space(1)))
#define LAS __attribute__((address_space(3)))
typedef unsigned short bf16;
typedef short bf16x8 __attribute__((ext_vector_type(8)));
typedef float f32x4 __attribute__((ext_vector_type(4)));
typedef float f32x16 __attribute__((ext_vector_type(16)));
typedef float f32x2 __attribute__((ext_vector_type(2)));
typedef unsigned u32x4 __attribute__((ext_vector_type(4)));
typedef unsigned u32x2 __attribute__((ext_vector_type(2)));

constexpr int NB = 16, SEQ = 2048, DM = 1024, NT = NB * SEQ;
constexpr int DA_H = 8;
constexpr int ML_IN = 2048, ML_H = 4, ML_DH = 512;
constexpr int NEXP = 32, DEXP = 256;
constexpr float EPS = 1e-6f;
constexpr float LOG2E = 1.4426950408889634f;
constexpr int RB = 4;
constexpr int NROUND = NB / RB;
constexpr int RT = RB * SEQ;
constexpr int WLD = 2304;
constexpr int MAXSLOT = 2 * NT + NEXP * 256;

constexpr size_t MiB = 1u << 20;
constexpr size_t WS_CTL = 0, CTL_ZERO_BYTES = 1 * MiB;
constexpr size_t WS_MODS = 2 * MiB;
constexpr size_t WS_TAB2 = 3 * MiB;
constexpr size_t WS_SCAL = 3 * MiB + 128 * 1024;
constexpr size_t WS_GWT = 3 * MiB + 256 * 1024;
constexpr size_t WS_RE = 4 * MiB;
constexpr size_t WS_RW = 4 * MiB + 256 * 1024;
constexpr size_t WS_RP = 4 * MiB + 512 * 1024;
constexpr size_t WS_RS = 4 * MiB + 768 * 1024;
constexpr size_t WS_PRE = 5 * MiB;
constexpr size_t WS_FG = 5 * MiB + 512 * 1024;
constexpr size_t WS_DEN = 6 * MiB;
constexpr size_t WS_WINT = 8 * MiB;
constexpr size_t WS_WOT = 14 * MiB;
constexpr size_t WS_MLWINT = 16 * MiB;
constexpr size_t WS_MLWOUTT = 24 * MiB;
constexpr size_t WS_W13T = 28 * MiB;
constexpr size_t WS_W2T = 60 * MiB;
constexpr size_t WS_BIG = 76 * MiB;
constexpr size_t WS_HM = WS_BIG + 0 * MiB;
constexpr size_t WS_QK = WS_BIG + 64 * MiB;
constexpr size_t WS_VT = WS_BIG + 192 * MiB;
constexpr size_t WS_O = WS_BIG + 256 * MiB;
constexpr size_t WS_HF = WS_BIG + 0 * MiB;
constexpr size_t WS_HS = WS_BIG + 64 * MiB;
constexpr size_t WS_TL = WS_BIG + 64 * MiB;
constexpr size_t WS_HH = WS_BIG + 208 * MiB;
constexpr size_t WS_YS = WS_BIG + 244 * MiB;
constexpr size_t WS_Y = WS_BIG + 0 * MiB;
constexpr size_t WS_W = WS_BIG + 128 * MiB;
constexpr size_t WS_HMR = WS_BIG + 128 * MiB;
constexpr size_t WS_XMH = WS_BIG + 272 * MiB;
constexpr size_t WS_XC = WS_BIG + 304 * MiB;
constexpr size_t WS_Q = WS_BIG + 336 * MiB;
constexpr size_t WS_K = WS_BIG + 368 * MiB;
constexpr size_t WS_VTR = WS_BIG + 400 * MiB;
constexpr size_t WS_XB3 = WS_BIG + 128 * MiB;
constexpr size_t WS_END = WS_BIG + 432 * MiB;
static_assert(WS_END <= 512 * MiB, "ws map");
static_assert((size_t)MAXSLOT * 1024 * 2 <= 144 * MiB && (size_t)MAXSLOT * 256 * 2 <= 36 * MiB, "slot buffers");
constexpr int CW_CNT = 64;
constexpr int CW_BAR = 4096;

constexpr int RING_BYTES = 131072;
constexpr int MISC_OFF = RING_BYTES;
constexpr int LDS_BYTES = RING_BYTES + 16384;

__device__ __forceinline__ unsigned f2bf(float f) { unsigned u = __builtin_bit_cast(unsigned, f); return (u + 0x7fffu + ((u >> 16) & 1u)) >> 16; }
__device__ __forceinline__ unsigned pk2(float lo, float hi) { unsigned r; asm("v_cvt_pk_bf16_f32 %0, %1, %2" : "=v"(r) : "v"(lo), "v"(hi)); return r; }
__device__ __forceinline__ float bf2f(unsigned short b) { return __builtin_bit_cast(float, ((unsigned)b) << 16); }
__device__ __forceinline__ float bflo(unsigned w) { return __builtin_bit_cast(float, w << 16); }
__device__ __forceinline__ float bfhi(unsigned w) { return __builtin_bit_cast(float, w & 0xffff0000u); }
__device__ __forceinline__ float wave_sum(float v) {
#pragma unroll
    for (int o = 1; o < 64; o <<= 1) v += __shfl_xor(v, o);
    return v;
}
__device__ __forceinline__ float silu_f(float v) { return v / (1.0f + __expf(-v)); }
#define LDS_WAIT() asm volatile("s_waitcnt lgkmcnt(0)" ::: "memory")
#define VM_WAIT() asm volatile("s_waitcnt vmcnt(0)" ::: "memory")
#define LDS_BARRIER() do { asm volatile("s_waitcnt lgkmcnt(0)" ::: "memory"); __builtin_amdgcn_s_barrier(); asm volatile("" ::: "memory"); } while (0)
__device__ __forceinline__ int opaque_v(int x) { asm volatile("" : "+v"(x)); return x; }
__device__ __forceinline__ int lane_id() { return (int)__builtin_amdgcn_mbcnt_hi(~0u, __builtin_amdgcn_mbcnt_lo(~0u, 0u)); }

namespace pg8 {
constexpr int BM = 256, BK = 64, HALF = 128, HTB = HALF * BK * 2, STAGE_BYTES = 8 * HTB;
static_assert(STAGE_BYTES == RING_BYTES, "stage region");
__host__ __device__ __forceinline__ int lds_byte(int r, int c) { const int st = (r >> 4) * 2 + (c >> 5), rr = r & 15, cc = c & 31, ob = rr * 64 + cc * 2; return st * 1024 + (ob ^ (((ob >> 9) & 1) << 5)); }
__host__ __device__ __forceinline__ void stage_rc(int b, int& R, int& C) { const int st = b / 1024, sb = b % 1024, swz = sb ^ (((sb >> 9) & 1) << 5); R = (st >> 1) * 16 + swz / 64; C = (st & 1) * 32 + (swz % 64) / 2; }
__host__ __device__ __forceinline__ int perm32(int rho) { const int n = rho >> 4, i = rho & 15; return 8 * (i >> 2) + 4 * n + (i & 3); }

struct Unit { const char* A; const char* B; int r0, c0, a0, a1, nt, flags; };

__device__ __forceinline__ unsigned cvt_pk_bf16(float lo, float hi) { unsigned r; asm volatile("v_cvt_pk_bf16_f32 %0, %1, %2" : "=v"(r) : "v"(lo), "v"(hi)); return r; }

template <class Epi, class Sched, bool ALIGN_EPI, bool GATHER = false, bool PAIR = false, bool BMAP = false>
__device__ __forceinline__ void gemm_phase(LAS unsigned char* lds, const int tid, const int lda, const int ldb, const Sched& S, const Epi& E) {
    const int wid = __builtin_amdgcn_readfirstlane(tid >> 6), lane = tid & 63, wr = wid >> 2, wc = wid & 3, fr = lane & 15, fq = lane >> 4;
    unsigned voffA[2], voffB[2]; int gR[2], gC[2];
#pragma unroll
    for (int i = 0; i < 2; ++i) { int R, C; stage_rc(tid * 16 + i * 8192, R, C); const int Rb = Epi::PERM ? ((R & ~31) + perm32(R & 31)) : R; gR[i] = R; gC[i] = C;
        voffA[i] = (unsigned)(R * lda + C) * 2u; voffB[i] = (unsigned)(Rb * ldb + C) * 2u; }
    unsigned vb[2][2];
    if constexpr (BMAP) {
#pragma unroll
        for (int h = 0; h < 2; ++h)
#pragma unroll
            for (int i = 0; i < 2; ++i) vb[h][i] = (unsigned)(S.brow(h, gR[i]) * ldb + gC[i]) * 2u; }
    unsigned cv[2][2], nv[2][2];
    const size_t kstep = (size_t)(BK * 2);
    const size_t hstepA = GATHER ? 0 : (size_t)HALF * lda * 2, hstepB = (size_t)HALF * ldb * 2;
    const unsigned ldsw = (unsigned)wid * 1024u;
    const int aoff = lds_byte(wr * 64 + fr, fq * 8), boff = lds_byte(wc * 32 + fr, fq * 8);
#define PG8_SA(b, h) (((b) * 2 + (h)) * HTB)
#define PG8_SB(b, h) ((4 + (b) * 2 + (h)) * HTB)
#define PG8_STAGE(bufoff, gbase, voff) do { _Pragma("unroll") for (int _i = 0; _i < 2; ++_i) \
        __builtin_amdgcn_global_load_lds((const unsigned*)((const char*)(gbase) + (voff)[_i]), (LAS unsigned*)(lds + (bufoff) + ldsw + _i * 8192), 16, 0, 0); } while (0)
#define PG8_STAGE_A(bufoff, gbase, h, nx) do { if constexpr (GATHER) { if (nx) PG8_STAGE(bufoff, gbase, nv[h]); else PG8_STAGE(bufoff, gbase, cv[h]); } else PG8_STAGE(bufoff, (gbase) + (h) * hstepA, voffA); } while (0)
#define PG8_STAGE_B(bufoff, gbase, h) do { if constexpr (BMAP) PG8_STAGE(bufoff, gbase, vb[h]); else PG8_STAGE(bufoff, (gbase) + (h) * hstepB, voffB); } while (0)
#define PG8_LDA(dst, b, h) do { _Pragma("unroll") for (int m = 0; m < 4; ++m) _Pragma("unroll") for (int k = 0; k < 2; ++k) dst[m][k] = *(const LAS bf16x8*)(lds + PG8_SA(b, h) + aoff + m * 2048 + k * 1024); } while (0)
#define PG8_LDB(dst, b, h) do { _Pragma("unroll") for (int n = 0; n < 2; ++n) _Pragma("unroll") for (int k = 0; k < 2; ++k) dst[n][k] = *(const LAS bf16x8*)(lds + PG8_SB(b, h) + boff + n * 2048 + k * 1024); } while (0)
#define PG8_MMA(ai, bj, At, Bt) do { __builtin_amdgcn_s_setprio(1); _Pragma("unroll") for (int m = 0; m < 4; ++m) _Pragma("unroll") for (int n = 0; n < 2; ++n) _Pragma("unroll") for (int k = 0; k < 2; ++k) \
        acc[ai][bj][m][n] = __builtin_amdgcn_mfma_f32_16x16x32_bf16(Bt[n][k], At[m][k], acc[ai][bj][m][n], 0, 0, 0); __builtin_amdgcn_s_setprio(0); } while (0)
#define PG8_WAIT_V(n) asm volatile("s_waitcnt vmcnt(" #n ")" ::: "memory")
#define PG8_WAIT_L(n) asm volatile("s_waitcnt lgkmcnt(" #n ")" ::: "memory")
#define PG8_BAR __builtin_amdgcn_s_barrier()
#define PG8_SCHED __builtin_amdgcn_sched_barrier(0)
    Unit cur, nxt; int ui = 0;
    if (!S.next(0, cur)) return;
    f32x4 acc[2][2][4][2];
#pragma unroll
    for (int a = 0; a < 2; ++a)
#pragma unroll
        for (int b = 0; b < 2; ++b)
#pragma unroll
            for (int m = 0; m < 4; ++m)
#pragma unroll
                for (int n = 0; n < 2; ++n) acc[a][b][m][n] = (f32x4){0.f, 0.f, 0.f, 0.f};
    bf16x8 At[4][2], B0[2][2], B1[2][2];
    const char* cA = cur.A; const char* cB = cur.B;
    if constexpr (GATHER) {
#pragma unroll
        for (int h = 0; h < 2; ++h)
#pragma unroll
            for (int i = 0; i < 2; ++i) cv[h][i] = S.arow(cur, h * HALF + gR[i]) + (unsigned)gC[i] * 2u; }
    {
        const char* b0 = cB + (size_t)S.kb(cur, 0) * kstep; const char* b1 = cB + (size_t)S.kb(cur, 1) * kstep;
        PG8_STAGE_B(PG8_SB(0, 0), b0, 0); PG8_STAGE_B(PG8_SB(0, 1), b0, 1); PG8_STAGE_A(PG8_SA(0, 0), cA, 0, false); PG8_STAGE_A(PG8_SA(0, 1), cA, 1, false);
        if (wr == 1) PG8_BAR;
        PG8_WAIT_V(2); PG8_BAR;
        PG8_STAGE_B(PG8_SB(1, 0), b1, 0); PG8_STAGE_A(PG8_SA(1, 0), cA + kstep, 0, false); PG8_STAGE_B(PG8_SB(1, 1), b1, 1);
        PG8_WAIT_V(6); PG8_BAR;
    }
    bool has_next; const char* nA; const char* nB;
#define PG8_UNIT_KLOOP() do { \
        has_next = S.next(ui + 1, nxt); \
        const Unit& nu = has_next ? nxt : cur; \
        if constexpr (GATHER) { \
            _Pragma("unroll") for (int h = 0; h < 2; ++h) _Pragma("unroll") for (int i = 0; i < 2; ++i) nv[h][i] = S.arow(nu, h * HALF + gR[i]) + (unsigned)gC[i] * 2u; } \
        nA = nu.A; nB = nu.B; \
        const int nt = cur.nt; \
        for (int t = 0; t < nt; t += 2) { \
            const bool last = (t == nt - 2); \
            const char* a1 = cA + (size_t)(t + 1) * kstep; \
            const char* a2 = last ? nA : cA + (size_t)(t + 2) * kstep; \
            const char* a3 = a2 + kstep; \
            const char* b2 = last ? nB + (size_t)S.kb(nu, 0) * kstep : cB + (size_t)S.kb(cur, t + 2) * kstep; \
            const char* b3 = last ? nB + (size_t)S.kb(nu, 1) * kstep : cB + (size_t)S.kb(cur, t + 3) * kstep; \
            PG8_LDB(B0, 0, 0); PG8_LDB(B1, 0, 1); PG8_SCHED; PG8_LDA(At, 0, 0); PG8_STAGE_A(PG8_SA(1, 1), a1, 1, false); \
            PG8_WAIT_V(8); PG8_WAIT_L(0); PG8_BAR; PG8_MMA(0, 0, At, B0); PG8_MMA(0, 1, At, B1); PG8_BAR; PG8_SCHED; \
            PG8_LDA(At, 0, 1); PG8_STAGE_B(PG8_SB(0, 0), b2, 0); PG8_STAGE_B(PG8_SB(0, 1), b2, 1); PG8_STAGE_A(PG8_SA(0, 0), a2, 0, last); \
            PG8_WAIT_V(8); PG8_WAIT_L(0); PG8_BAR; PG8_MMA(1, 0, At, B0); PG8_MMA(1, 1, At, B1); PG8_BAR; PG8_SCHED; \
            PG8_LDB(B0, 1, 0); PG8_LDB(B1, 1, 1); PG8_SCHED; PG8_LDA(At, 1, 0); PG8_STAGE_A(PG8_SA(0, 1), a2, 1, last); \
            PG8_WAIT_V(8); PG8_WAIT_L(0); PG8_BAR; PG8_MMA(0, 0, At, B0); PG8_MMA(0, 1, At, B1); PG8_BAR; PG8_SCHED; \
            PG8_LDA(At, 1, 1); PG8_STAGE_B(PG8_SB(1, 0), b3, 0); PG8_STAGE_B(PG8_SB(1, 1), b3, 1); PG8_STAGE_A(PG8_SA(1, 0), a3, 0, last); \
            PG8_WAIT_V(8); PG8_WAIT_L(0); PG8_BAR; PG8_MMA(1, 0, At, B0); PG8_MMA(1, 1, At, B1); PG8_BAR; PG8_SCHED; \
        } } while (0)
#define PG8_ADVANCE() do { cur = nxt; cA = nA; cB = nB; ++ui; \
        if constexpr (GATHER) { _Pragma("unroll") for (int h = 0; h < 2; ++h) _Pragma("unroll") for (int i = 0; i < 2; ++i) cv[h][i] = nv[h][i]; } } while (0)
    for (;;) {
        PG8_UNIT_KLOOP();
        if constexpr (PAIR) {
            S.between(cur, acc, wr);
            PG8_ADVANCE();
            PG8_UNIT_KLOOP();
        }
        if constexpr (ALIGN_EPI) { if (wr == 0) PG8_BAR; }
        E(acc, cur, wr, wc, fr, fq);
        if (!has_next) break;
#pragma unroll
        for (int a = 0; a < 2; ++a)
#pragma unroll
            for (int b = 0; b < 2; ++b)
#pragma unroll
                for (int m = 0; m < 4; ++m)
#pragma unroll
                    for (int n = 0; n < 2; ++n) acc[a][b][m][n] = (f32x4){0.f, 0.f, 0.f, 0.f};
        PG8_ADVANCE();
        if constexpr (ALIGN_EPI) { if (wr == 1) PG8_BAR; }
    }
#undef PG8_UNIT_KLOOP
#undef PG8_ADVANCE
    PG8_WAIT_V(0);
    if constexpr (!ALIGN_EPI) { if (wr == 0) PG8_BAR; }
    PG8_BAR;
#undef PG8_SA
#undef PG8_SB
#undef PG8_STAGE
#undef PG8_STAGE_A
#undef PG8_STAGE_B
#undef PG8_LDA
#undef PG8_LDB
#undef PG8_MMA
#undef PG8_WAIT_V
#undef PG8_WAIT_L
#undef PG8_BAR
#undef PG8_SCHED
}

struct PlainOrder {
    const char* A; const char* B; int lda, ldb, nM, nN, G, c, nt;
    __device__ __forceinline__ bool next(int i, Unit& u) const {
        const int L = i * G + c; if (L >= nM * nN) return false;
        const int pm = L / nN, pn = L - pm * nN;
        u.A = A + (size_t)pm * 256 * lda * 2; u.B = B + (size_t)pn * 256 * ldb * 2; u.r0 = pm * 256; u.c0 = pn * 256; u.a0 = 0; u.a1 = 0; u.nt = nt; u.flags = 3; return true;
    }
    __device__ __forceinline__ int kb(const Unit&, int t) const { return t; }
    __device__ __forceinline__ int brow(int h, int R) const { return 64 * (R >> 5) + 32 * h + perm32(R & 31); }
};
struct EpiBf16 {
    static constexpr bool PERM = true;
    bf16* O; int ldc; int split_cols; bf16* O2; int ldc2; int skip = 0;
    __device__ __forceinline__ void operator()(const f32x4 (&acc)[2][2][4][2], const Unit& u, int wr, int wc, int fr_, int fq_) const {
        (void)fr_; (void)fq_; const int ln_ = opaque_v(lane_id()); const int fr = ln_ & 15, fq = ln_ >> 4;
        bf16* base = O; int ld = ldc; int colt = u.c0;
        if (split_cols > 0 && colt >= split_cols) { base = O2; ld = ldc2; colt -= split_cols; }
        const int row0 = u.r0 + wr * 64 + fr, col0 = colt + wc * 32 + 8 * fq;
#pragma unroll
        for (int ai = 0; ai < 2; ++ai)
#pragma unroll
            for (int m = 0; m < 4; ++m) { bf16* rowp = base + (size_t)(row0 + ai * HALF + m * 16) * ld + col0;
#pragma unroll
                for (int bj = 0; bj < 2; ++bj) { const f32x4 v0 = acc[ai][bj][m][0], v1 = acc[ai][bj][m][1];
                    u32x4 w; w.x = cvt_pk_bf16(v0[0], v0[1]); w.y = cvt_pk_bf16(v0[2], v0[3]); w.z = cvt_pk_bf16(v1[0], v1[1]); w.w = cvt_pk_bf16(v1[2], v1[3]);
                    if (!((REP_ABL & 128) && skip)) *(u32x4*)(rowp + bj * HALF) = w; else if (w.x == 0x12345678u) *(u32x4*)(rowp) = w; } }
    }
};
template <bool XF32> struct EpiResid {
    static constexpr bool PERM = true;
    const void* xin; bf16* out; const float* gate;
    __device__ __forceinline__ void operator()(const f32x4 (&acc)[2][2][4][2], const Unit& u, int wr, int wc, int fr_, int fq_) const {
        (void)fr_; (void)fq_; const int ln_ = opaque_v(lane_id()); const int fr = ln_ & 15, fq = ln_ >> 4;
        const int row0 = u.r0 + wr * 64 + fr, col0 = u.c0 + wc * 32 + 8 * fq;
        const float* g = gate + (size_t)(u.r0 / SEQ) * 6144 + col0;
        f32x4 gv[2][2];
#pragma unroll
        for (int bj = 0; bj < 2; ++bj)
#pragma unroll
            for (int n = 0; n < 2; ++n) gv[bj][n] = *(const f32x4*)(g + bj * HALF + 4 * n);
#pragma unroll
        for (int ai = 0; ai < 2; ++ai)
#pragma unroll
            for (int m = 0; m < 4; ++m) { const size_t off = (size_t)(row0 + ai * HALF + m * 16) * DM + col0;
#pragma unroll
                for (int bj = 0; bj < 2; ++bj) { f32x4 x0, x1;
                    if (XF32) { x0 = *(const f32x4*)((const float*)xin + off + bj * HALF); x1 = *(const f32x4*)((const float*)xin + off + bj * HALF + 4); }
                    else { const u32x4 w = *(const u32x4*)((const bf16*)xin + off + bj * HALF); x0 = (f32x4){bflo(w.x), bfhi(w.x), bflo(w.y), bfhi(w.y)}; x1 = (f32x4){bflo(w.z), bfhi(w.z), bflo(w.w), bfhi(w.w)}; }
                    const f32x4 y0 = x0 + gv[bj][0] * acc[ai][bj][m][0], y1 = x1 + gv[bj][1] * acc[ai][bj][m][1];
                    u32x4 o; o.x = cvt_pk_bf16(y0[0], y0[1]); o.y = cvt_pk_bf16(y0[2], y0[3]); o.z = cvt_pk_bf16(y1[0], y1[1]); o.w = cvt_pk_bf16(y1[2], y1[3]);
                    *(u32x4*)(out + off + bj * HALF) = o; }
                if (m & 1) asm volatile("" ::: "memory"); }
    }
};
struct EpiQKNorm {
    static constexpr bool PERM = true;
    bf16* O; const float* qg; const float* kg;
    __device__ __forceinline__ void operator()(const f32x4 (&acc)[2][2][4][2], const Unit& u, int wr, int wc, int fr_, int fq_) const {
        (void)fr_; (void)fq_; const int ln_ = opaque_v(lane_id()); const int fr = ln_ & 15, fq = ln_ >> 4;
        const bool isq = u.c0 < 1024; const float* gain = (isq ? qg : kg) + 8 * fq; const float osc = isq ? 0.125f * LOG2E : 1.0f;
        f32x4 g[2][2];
#pragma unroll
        for (int bj = 0; bj < 2; ++bj)
#pragma unroll
            for (int n = 0; n < 2; ++n) g[bj][n] = *(const f32x4*)(gain + 32 * bj + 4 * n) * osc;
        const int row0 = u.r0 + wr * 64 + fr, col0 = u.c0 + wc * 64 + 8 * fq;
#pragma unroll
        for (int ai = 0; ai < 2; ++ai)
#pragma unroll
            for (int m = 0; m < 4; ++m) { f32x4 sv = (f32x4){0.f, 0.f, 0.f, 0.f};
#pragma unroll
                for (int bj = 0; bj < 2; ++bj) { sv += acc[ai][bj][m][0] * acc[ai][bj][m][0]; sv += acc[ai][bj][m][1] * acc[ai][bj][m][1]; }
                float s = (sv[0] + sv[1]) + (sv[2] + sv[3]);
                s += __shfl_xor(s, 16); s += __shfl_xor(s, 32);
                const float rs = 1.0f / sqrtf(s * (1.0f / 64.0f) + EPS);
                bf16* rowp = O + (size_t)(row0 + ai * HALF + m * 16) * 2048 + col0;
#pragma unroll
                for (int bj = 0; bj < 2; ++bj) { const f32x4 v0 = acc[ai][bj][m][0] * rs * g[bj][0], v1 = acc[ai][bj][m][1] * rs * g[bj][1];
                    u32x4 w; w.x = cvt_pk_bf16(v0[0], v0[1]); w.y = cvt_pk_bf16(v0[2], v0[3]); w.z = cvt_pk_bf16(v1[0], v1[1]); w.w = cvt_pk_bf16(v1[2], v1[3]);
                    *(u32x4*)(rowp + 32 * bj) = w; } }
    }
};
}

#define XB_TMO      128
#define XB_XCNT(j)  (256  + 64 * (j))
#define XB_XSUB(j)  (1280 + 64 * (j))
#define XB_XGEN(j)  (2304 + 64 * (j))
#define XB_TOP      3328
#define XB_TOPGEN   3392
#define XCD_BAR_WORDS 3456
#define XB_SPIN_CAP (1u << 18)
__device__ __forceinline__ unsigned xb_ld(unsigned* p)              { return __hip_atomic_load(p, __ATOMIC_RELAXED, __HIP_MEMORY_SCOPE_AGENT); }
__device__ __forceinline__ unsigned xb_add(unsigned* p, unsigned v) { return __hip_atomic_fetch_add(p, v, __ATOMIC_RELAXED, __HIP_MEMORY_SCOPE_AGENT); }
__device__ __forceinline__ unsigned xb_xcc_id() { return (unsigned)__builtin_amdgcn_s_getreg((3 << 11) | 20) & 0xFu; }
#define XB_SPIN(cond, bar) do { unsigned _sp = 0; while (cond) { __builtin_amdgcn_s_sleep(1); \
    if ((++_sp & 255u) == 0u) { if (xb_ld(&(bar)[XB_TMO])) break; if (_sp > XB_SPIN_CAP) { atomicAdd(&(bar)[XB_TMO], 1u); break; } } } } while (0)
struct XcdBarrier { unsigned* bar; unsigned x; volatile LAS unsigned* st; };
__device__ __forceinline__ XcdBarrier xcd_barrier_post(unsigned* bar, volatile LAS unsigned* st) {
    XcdBarrier b; b.bar = bar; b.x = xb_xcc_id(); b.st = st;
    if (threadIdx.x == 0) (void)xb_add(&bar[XB_XCNT(b.x)], 1u);
    return b;
}
__device__ __forceinline__ void xcd_barrier_complete(unsigned* bar, unsigned x, unsigned& nloc, unsigned& nx) {
    const unsigned G = gridDim.x * gridDim.y * gridDim.z;
    unsigned sum, cnt, mine, sp = 0u;
    for (;;) {
        sum = 0u; cnt = 0u; mine = 0u;
#pragma unroll
        for (unsigned j = 0; j < 16; ++j) { const unsigned c = xb_ld(&bar[XB_XCNT(j)]); sum += c; cnt += (c > 0u) ? 1u : 0u; mine = (j == x) ? c : mine; }
        if (sum == G) break;
        __builtin_amdgcn_s_sleep(1);
        if ((++sp & 255u) == 0u) { if (xb_ld(&bar[XB_TMO])) break; if (sp > XB_SPIN_CAP) { atomicAdd(&bar[XB_TMO], 1u); break; } }
    }
    nloc = mine > 0u ? mine : 1u; nx = cnt > 0u ? cnt : 1u;
}
__device__ __forceinline__ void xcd_barrier(const XcdBarrier& b) {
    asm volatile("s_waitcnt vmcnt(0)" ::: "memory");
    __syncthreads();
    if (threadIdx.x == 0) {
        unsigned* bar = b.bar;
        __builtin_amdgcn_s_waitcnt(0);
        unsigned nloc = b.st[0], nx = b.st[1];
        if (nloc == 0u) { xcd_barrier_complete(bar, b.x, nloc, nx); b.st[0] = nloc; b.st[1] = nx; }
        const unsigned old = xb_add(&bar[XB_XSUB(b.x)], 1u);
        const unsigned gen = old / nloc;
        if (old + 1u == (gen + 1u) * nloc) {
            __builtin_amdgcn_fence(__ATOMIC_RELEASE, "agent");
            asm volatile("s_waitcnt vmcnt(0)" ::: "memory");
            const unsigned og = xb_add(&bar[XB_TOP], 1u);
            const unsigned tg = og / nx;
            if (og + 1u == (tg + 1u) * nx) xb_add(&bar[XB_TOPGEN], 1u);
            else XB_SPIN(xb_ld(&bar[XB_TOPGEN]) == tg, bar);
            __builtin_amdgcn_fence(__ATOMIC_ACQUIRE, "agent");
            xb_add(&bar[XB_XGEN(b.x)], 1u);
            asm volatile("s_waitcnt vmcnt(0)" ::: "memory");
        } else {
            XB_SPIN(xb_ld(&bar[XB_XGEN(b.x)]) == gen, bar);
            __builtin_amdgcn_fence(__ATOMIC_ACQUIRE, "agent");
            asm volatile("s_waitcnt vmcnt(0)" ::: "memory");
        }
    }
    __syncthreads();
}

struct Args { const float* in[32]; float* out; unsigned char* ws; int ph_lo, ph_hi; };
enum { IN_X = 0, IN_C, IN_REL, IN_ADAW, IN_ADAB, IN_NMG, IN_NFG, IN_DAWIN, IN_DAWOUT, IN_QG, IN_KG, IN_LQ1, IN_LK1, IN_LQ2, IN_LK2, IN_SUBLN,
       IN_MLWIN, IN_CONVW, IN_CONVB, IN_WQ, IN_WK, IN_WV, IN_GATEW, IN_GATEB, IN_ONG, IN_SKIP, IN_MLWOUT, IN_WGRP, IN_WRT, IN_W1, IN_W3, IN_W2 };

struct Ctx {
    const Args* a; GAS unsigned char* ws; LAS unsigned char* lds; int tid, lane, wave, G, vcu;
    __device__ __forceinline__ const float* in(int i) const { return (const float*)(const GAS float*)a->in[i]; }
    template <class Tp> __device__ __forceinline__ Tp* w(size_t off) const { return (Tp*)(GAS Tp*)(ws + off); }
    __device__ __forceinline__ float* xout() const { return (float*)(GAS float*)a->out; }
    __device__ __forceinline__ const float* mods(int layer, int which) const { return (const float*)(ws + WS_MODS) + (size_t)layer * 16 * 6144 + which * 1024; }
};

__device__ __forceinline__ Ctx fresh(const Ctx& C) {
    Ctx P = C; int t = C.tid; asm volatile("" : "+v"(t)); P.tid = t; P.lane = t & 63; P.wave = __builtin_amdgcn_readfirstlane(t >> 6);
    GAS unsigned char* w = C.ws; asm volatile("" : "+s"(w)); P.ws = w; int g = __builtin_amdgcn_readfirstlane(C.G), v = __builtin_amdgcn_readfirstlane(C.vcu); asm volatile("" : "+s"(g), "+s"(v)); P.G = g; P.vcu = v;
    return P;
}
__device__ __forceinline__ void transpose_item(const float* W, int K, int N, bf16* WT, int ldt, int dst_row0, LAS float* scr, int kb, int nb, int lane) {
    const int k0 = 64 * kb, n0 = 32 * nb;
#pragma unroll 8
    for (int i = 0; i < 32; ++i) { const int kk = 2 * i + (lane >> 5); scr[kk * 33 + (lane & 31)] = W[(size_t)(k0 + kk) * N + n0 + (lane & 31)]; }
    LDS_WAIT(); asm volatile("" ::: "memory");
    const int c = lane & 7;
#pragma unroll
    for (int j = 0; j < 4; ++j) { const int n = (lane >> 3) + 8 * j; const LAS float* s = scr + (8 * c) * 33 + n;
        u32x4 o; o.x = pk2(s[0 * 33], s[1 * 33]); o.y = pk2(s[2 * 33], s[3 * 33]); o.z = pk2(s[4 * 33], s[5 * 33]); o.w = pk2(s[6 * 33], s[7 * 33]);
        *(u32x4*)(WT + (size_t)(dst_row0 + n) * ldt + k0 + 8 * c) = o; }
    LDS_WAIT(); asm volatile("" ::: "memory");
}
__device__ __forceinline__ void moe_weight_items(const Ctx& C, int layer, LAS float* scr) {
    const int gw = C.vcu * 8 + C.wave, NGW = C.G * 8;
    const float* w1 = C.in(IN_W1) + (size_t)layer * NEXP * DM * DEXP; const float* w3 = C.in(IN_W3) + (size_t)layer * NEXP * DM * DEXP; const float* w2 = C.in(IN_W2) + (size_t)layer * NEXP * DEXP * DM;
    bf16* W13T = C.w<bf16>(WS_W13T); bf16* W2T = C.w<bf16>(WS_W2T);
    constexpr int I13 = 16 * 8, I2 = 4 * 32;
    for (int it = gw; it < NEXP * (2 * I13 + I2); it += NGW) {
        const int e = it / (2 * I13 + I2); int r = it - e * (2 * I13 + I2);
        if (r < 2 * I13) { const int which = r / I13; r -= which * I13; const int kb = r / 8, nb = r % 8; const int n0 = 32 * nb;
            const int dst = (n0 / 128) * 256 + which * 128 + (n0 % 128);
            transpose_item((which ? w3 : w1) + (size_t)e * DM * DEXP, DM, DEXP, W13T + (size_t)e * 512 * DM, DM, dst, scr, kb, nb, C.lane); }
        else { r -= 2 * I13; const int kb = r / 32, nb = r % 32;
            transpose_item(w2 + (size_t)e * DEXP * DM, DEXP, DM, W2T + (size_t)e * DM * DEXP, DEXP, 32 * nb, scr, kb, nb, C.lane); }
    }
}
__device__ __forceinline__ void plain_weight_items(const Ctx& C, const float* W, int K, int N, bf16* WT, LAS float* scr) {
    const int gw = C.vcu * 8 + C.wave, NGW = C.G * 8; const int nblk = N / 32;
    for (int it = gw; it < (K / 64) * nblk; it += NGW) { const int kb = it / nblk, nb = it % nblk; transpose_item(W, K, N, WT, K, 32 * nb, scr, kb, nb, C.lane); }
}
__device__ __forceinline__ int t5_bucket(int rel) {
    const int n = rel < 0 ? -rel : rel; int b;
    if (n < 8) b = n; else b = 8 + (n >= 12) + (n >= 16) + (n >= 23) + (n >= 32) + (n >= 46) + (n >= 64) + (n >= 91);
    return b + (rel > 0 ? 16 : 0);
}
__device__ __forceinline__ void p_prologue(const Ctx& C) {
    __syncthreads();
    {
        LAS float* cact = (LAS float*)C.lds;
        LAS float* red = (LAS float*)(C.lds + 65536);
        const float* c = C.in(IN_C);
        for (int i = C.tid; i < 16 * 1024; i += 512) cact[i] = silu_f(c[i]);
        __syncthreads();
        for (int task = C.vcu; task < 192; task += C.G) {
            const int layer = task / 96, n0 = (task % 96) * 64, nl = C.tid & 63, kc = C.tid >> 6;
            const float* W = C.in(IN_ADAW) + (size_t)layer * DM * 6144 + n0 + nl;
            float acc[16];
#pragma unroll
            for (int b = 0; b < 16; ++b) acc[b] = 0.f;
            for (int k = kc * 128; k < kc * 128 + 128; ++k) { const float wv = W[(size_t)k * 6144];
#pragma unroll
                for (int b = 0; b < 16; ++b) acc[b] += cact[b * 1024 + k] * wv; }
#pragma unroll
            for (int b = 0; b < 16; ++b) red[(kc * 16 + b) * 64 + nl] = acc[b];
            __syncthreads();
            for (int o = C.tid; o < 16 * 64; o += 512) { const int b = o >> 6, n = o & 63; float s = 0.f;
#pragma unroll
                for (int q = 0; q < 8; ++q) s += red[(q * 16 + b) * 64 + n];
                C.w<float>(WS_MODS)[(size_t)layer * 16 * 6144 + (size_t)b * 6144 + n0 + n] = s + C.in(IN_ADAB)[layer * 6144 + n0 + n]; }
            __syncthreads();
        }
    }
    {
        const int gt = C.vcu * 512 + C.tid, NGT = C.G * 512;
        float mq = 0.f, mk = 0.f;
        for (int i = 0; i < 64; ++i) { mq = fmaxf(mq, fabsf(C.in(IN_QG)[i])); mk = fmaxf(mk, fabsf(C.in(IN_KG)[i])); }
        for (int i = gt; i < 8 * 4096; i += NGT) { const int h = i >> 12, idx = i & 4095; if (idx < 4095) {
            float mb = -1e30f; for (int b = 0; b < 32; ++b) mb = fmaxf(mb, C.in(IN_REL)[b * 8 + h]);
            const float cshift = 8.0f * mq * mk + mb;
            C.w<float>(WS_TAB2)[i] = (C.in(IN_REL)[t5_bucket(idx - 2047) * 8 + h] - cshift) * LOG2E; } else C.w<float>(WS_TAB2)[i] = 0.f; }
        if (gt == 0) { float s1 = 0.f, s2 = 0.f; for (int i = 0; i < 64; ++i) { s1 += C.in(IN_LQ1)[i] * C.in(IN_LK1)[i]; s2 += C.in(IN_LQ2)[i] * C.in(IN_LK2)[i]; }
            C.w<float>(WS_SCAL)[0] = __expf(s1) - __expf(s2) + 0.2f; }
        for (int i = gt; i < 16 * 6144; i += NGT) { const int n = i / 6144, k = i % 6144, d = n >> 3, g = n & 7, m = k / 2048, c = k % 2048;
            C.w<bf16>(WS_GWT)[i] = (bf16)f2bf(C.in(IN_GATEW)[(((size_t)d * 3 + m) * 2048 + c) * 8 + g]); }
    }
    LAS float* scr = (LAS float*)(C.lds + C.wave * 16384);
    plain_weight_items(C, C.in(IN_DAWIN), DM, 3 * DM, C.w<bf16>(WS_WINT), scr);
    plain_weight_items(C, C.in(IN_DAWOUT), DM, DM, C.w<bf16>(WS_WOT), scr);
    plain_weight_items(C, C.in(IN_MLWIN), DM, 2 * ML_IN, C.w<bf16>(WS_MLWINT), scr);
    plain_weight_items(C, C.in(IN_MLWOUT), ML_IN, DM, C.w<bf16>(WS_MLWOUTT), scr);
    moe_weight_items(C, 0, scr);
}

__device__ __forceinline__ void normmod_row(const float* xrow, const float* g, const float* sc, const float* sh, bf16* orow, int lane) {
    const f32x4* xr = (const f32x4*)xrow + lane; f32x4 v[4]; float s = 0.f;
#pragma unroll
    for (int j = 0; j < 4; ++j) { v[j] = xr[64 * j]; s += (v[j].x * v[j].x + v[j].y * v[j].y) + (v[j].z * v[j].z + v[j].w * v[j].w); }
    const float rstd = 1.0f / sqrtf(wave_sum(s) * (1.0f / DM) + EPS);
    u32x2* o8 = (u32x2*)orow + lane;
#pragma unroll
    for (int j = 0; j < 4; ++j) { const f32x4 gv = ((const f32x4*)g)[lane + 64 * j], scv = ((const f32x4*)sc)[lane + 64 * j], shv = ((const f32x4*)sh)[lane + 64 * j];
        const f32x4 y = (v[j] * rstd * gv) * (scv + 1.0f) + shv; u32x2 w; w.x = pk2(y.x, y.y); w.y = pk2(y.z, y.w); o8[64 * j] = w; }
}
__device__ __forceinline__ void normmod_row_bf(const bf16* xrow, const float* g, const float* sc, const float* sh, bf16* orow, int lane) {
    float v[2][8]; float s = 0.f;
#pragma unroll
    for (int j = 0; j < 2; ++j) { const u32x4 w = *((const u32x4*)(xrow + 512 * j) + lane);
        v[j][0] = bflo(w.x); v[j][1] = bfhi(w.x); v[j][2] = bflo(w.y); v[j][3] = bfhi(w.y); v[j][4] = bflo(w.z); v[j][5] = bfhi(w.z); v[j][6] = bflo(w.w); v[j][7] = bfhi(w.w);
#pragma unroll
        for (int i = 0; i < 8; ++i) s += v[j][i] * v[j][i]; }
    const float rstd = 1.0f / sqrtf(wave_sum(s) * (1.0f / DM) + EPS);
#pragma unroll
    for (int j = 0; j < 2; ++j) { const int c = 512 * j + 8 * lane; float y[8];
#pragma unroll
        for (int i = 0; i < 8; ++i) y[i] = (v[j][i] * rstd * g[c + i]) * (sc[c + i] + 1.0f) + sh[c + i];
        u32x4 w; w.x = pk2(y[0], y[1]); w.y = pk2(y[2], y[3]); w.z = pk2(y[4], y[5]); w.w = pk2(y[6], y[7]);
        *((u32x4*)(orow + 512 * j) + lane) = w; }
}
__device__ __forceinline__ void p_normmod_bf(const Ctx& C, const bf16* xsrc, int layer, int row_lo, int row_hi, bf16* dst) {
    const int gw = C.vcu * 8 + C.wave, NGW = C.G * 8;
    const float* g = C.in(IN_NMG) + layer * DM;
    for (int r = row_lo + gw; r < row_hi; r += NGW) { const int b = r / SEQ;
        normmod_row_bf(xsrc + (size_t)r * DM, g, C.mods(layer, 1) + (size_t)b * 6144, C.mods(layer, 0) + (size_t)b * 6144, dst + (size_t)(r - row_lo) * DM, C.lane); }
}
__device__ __forceinline__ void p_normmod(const Ctx& C, const float* xsrc, int layer, int row_lo, int row_hi, bf16* dst) {
    const int gw = C.vcu * 8 + C.wave, NGW = C.G * 8;
    const float* g = C.in(IN_NMG) + layer * DM;
    for (int r = row_lo + gw; r < row_hi; r += NGW) { const int b = r / SEQ;
        normmod_row(xsrc + (size_t)r * DM, g, C.mods(layer, 1) + (size_t)b * 6144, C.mods(layer, 0) + (size_t)b * 6144, dst + (size_t)(r - row_lo) * DM, C.lane); }
}

constexpr int AT_KS = 144, AT_VS = 144;
constexpr int AT_K_BYTES = 2 * 64 * AT_KS, AT_V_BYTES = 128 * AT_VS, AT_BUF = AT_K_BYTES + AT_V_BYTES;
constexpr int AT_TAB_OFF = 3 * AT_BUF;
constexpr int AT_EX_OFF = 0, AT_EX_PITCH = 132;
static_assert(AT_BUF % 16 == 0 && AT_TAB_OFF + 16384 <= RING_BYTES && 4 * 32 * AT_EX_PITCH * 4 <= AT_TAB_OFF, "attention LDS");
template <int ABL> __device__ __forceinline__ void attn_unit(const Ctx& C, int b, int h, int qt, bool load_tab) {
    LAS unsigned char* lds = C.lds;
    const int tid = C.tid, lane = C.lane, wid = C.wave, mp = wid >> 2, rb = wid & 3, r32 = lane & 31, hi = lane >> 5;
    const bf16* QK = C.w<bf16>(WS_QK); const bf16* VT = C.w<bf16>(WS_VT);
    const size_t tok0 = (size_t)b * SEQ; const int q0 = qt * 128, qa = q0 + 32 * rb;
    LAS float* tab = (LAS float*)(lds + AT_TAB_OFF);
    __syncthreads();
    if (load_tab) { const float* t2 = C.w<float>(WS_TAB2) + h * 4096; for (int i = tid; i < 4096; i += 512) tab[i] = t2[i]; }
    const float c_neg = C.w<float>(WS_TAB2)[h * 4096 + 1000], c_pos = C.w<float>(WS_TAB2)[h * 4096 + 3000];
    bf16x8 qf[4];
    { const bf16* qrow = QK + (tok0 + qa + r32) * 2048 + h * 128 + mp * 64 + hi * 8;
#pragma unroll
      for (int ks = 0; ks < 4; ++ks) qf[ks] = *(const bf16x8*)(qrow + ks * 16);
      asm volatile("" : "+v"(qf[0]), "+v"(qf[1]), "+v"(qf[2]), "+v"(qf[3])); }
    const int kkey = tid >> 4, kcc = tid & 15, vdv = tid >> 3, vkc = tid & 7;
    const bf16* ksrc = QK + (tok0 + kkey) * 2048 + 1024 + h * 128 + kcc * 8;
    const bf16* vsrc = VT + (size_t)(h * 128 + vdv) * NT + tok0 + vkc * 8;
    const int kdst = ((kcc >> 3) * 64 + kkey) * AT_KS + (kcc & 7) * 16;
    const int vdst = AT_K_BYTES + vdv * AT_VS + (vkc >> 1) * 32 + (vkc & 1) * 8;
    u32x4 kst[2], vst[2];
#define AT_LOAD(t) do { const int k0_ = (t) * 64; kst[0] = *(const u32x4*)(ksrc + (size_t)k0_ * 2048); kst[1] = *(const u32x4*)(ksrc + (size_t)(k0_ + 32) * 2048); \
        vst[0] = *(const u32x4*)(vsrc + k0_); vst[1] = *(const u32x4*)(vsrc + (size_t)64 * NT + k0_); } while (0)
#define AT_WRITE(bufo) do { _Pragma("unroll") for (int i_ = 0; i_ < 2; ++i_) { *(LAS u32x4*)(lds + (bufo) + kdst + 32 * i_ * AT_KS) = kst[i_]; \
        LAS u32x2* vd_ = (LAS u32x2*)(lds + (bufo) + vdst + 64 * i_ * AT_VS); vd_[0] = (u32x2){vst[i_].x, vst[i_].y}; vd_[2] = (u32x2){vst[i_].z, vst[i_].w}; } } while (0)
    const int kfo = (mp * 64 + r32) * AT_KS + hi * 16;
    const int vfo = AT_K_BYTES + r32 * AT_VS + hi * 16;
    f32x16 o[4];
#pragma unroll
    for (int i = 0; i < 4; ++i) o[i] = (f32x16){0.f, 0.f, 0.f, 0.f, 0.f, 0.f, 0.f, 0.f, 0.f, 0.f, 0.f, 0.f, 0.f, 0.f, 0.f, 0.f};
    f32x2 lacc = (f32x2){0.f, 0.f};
    bf16x8 pf[4];

#define AT_SOFT(t, bo) do { const int k0_ = (t) * 64; const int dlo_ = k0_ - qa - 31, dhi_ = k0_ + 63 - qa; \
        const bool cst_ = (dhi_ <= -91) || (dlo_ >= 91); const float ini_ = (dhi_ <= -91) ? c_neg : ((dlo_ >= 91) ? c_pos : 0.f); \
        bf16x8 kf_[2][4]; \
        _Pragma("unroll") for (int kb_ = 0; kb_ < 2; ++kb_) _Pragma("unroll") for (int ks_ = 0; ks_ < 4; ++ks_) kf_[kb_][ks_] = *(const LAS bf16x8*)(lds + (bo) + kfo + kb_ * 32 * AT_KS + ks_ * 32); \
        f32x16 s0_, s1_; \
        _Pragma("unroll") for (int r_ = 0; r_ < 16; ++r_) { s0_[r_] = ini_; s1_[r_] = ini_; } \
        if (!(ABL & 16)) { _Pragma("unroll") for (int ks_ = 0; ks_ < 4; ++ks_) { s0_ = __builtin_amdgcn_mfma_f32_32x32x16_bf16(kf_[0][ks_], qf[ks_], s0_, 0, 0, 0); s1_ = __builtin_amdgcn_mfma_f32_32x32x16_bf16(kf_[1][ks_], qf[ks_], s1_, 0, 0, 0); } } \
        else { _Pragma("unroll") for (int ks_ = 0; ks_ < 4; ++ks_) { s0_[ks_] += __builtin_bit_cast(float, kf_[0][ks_][0] + kf_[0][ks_][1]); s1_[ks_] += __builtin_bit_cast(float, kf_[1][ks_][0] + kf_[1][ks_][1]); } } \
        _Pragma("unroll") for (int kb_ = 0; kb_ < 2; ++kb_) { f32x16 s_ = kb_ ? s1_ : s0_; \
            if (!cst_) { const LAS float* tp_ = tab + (k0_ + 32 * kb_ + 4 * hi - (qa + r32) + 2047); _Pragma("unroll") for (int r_ = 0; r_ < 16; ++r_) s_[r_] += tp_[(r_ & 3) + 8 * (r_ >> 2)]; } \
            float p_[16]; \
            _Pragma("unroll") for (int r_ = 0; r_ < 16; ++r_) p_[r_] = (ABL & 1) ? s_[r_] : __builtin_amdgcn_exp2f(s_[r_]); \
            _Pragma("unroll") for (int r_ = 0; r_ < 16; r_ += 2) lacc += (f32x2){p_[r_], p_[r_ + 1]}; \
            _Pragma("unroll") for (int sh_ = 0; sh_ < 2; ++sh_) { u32x4 w_; w_.x = pk2(p_[8 * sh_ + 0], p_[8 * sh_ + 1]); w_.y = pk2(p_[8 * sh_ + 2], p_[8 * sh_ + 3]); w_.z = pk2(p_[8 * sh_ + 4], p_[8 * sh_ + 5]); w_.w = pk2(p_[8 * sh_ + 6], p_[8 * sh_ + 7]); \
                pf[2 * kb_ + sh_] = __builtin_bit_cast(bf16x8, w_); } } } while (0)
#define AT_PV(bo) do { _Pragma("unroll") for (int hb_ = 0; hb_ < 2; ++hb_) { u32x4 vf_[8]; \
        _Pragma("unroll") for (int i_ = 0; i_ < 8; ++i_) { const int dvb_ = 2 * hb_ + (i_ >> 2), s4_ = i_ & 3; vf_[i_] = *(const LAS u32x4*)(lds + (bo) + vfo + dvb_ * 32 * AT_VS + s4_ * 32); } \
        if (!(ABL & 2)) { _Pragma("unroll") for (int i_ = 0; i_ < 8; ++i_) o[2 * hb_ + (i_ >> 2)] = __builtin_amdgcn_mfma_f32_32x32x16_bf16(__builtin_bit_cast(bf16x8, vf_[i_]), pf[i_ & 3], o[2 * hb_ + (i_ >> 2)], 0, 0, 0); } \
        else { _Pragma("unroll") for (int i_ = 0; i_ < 8; ++i_) o[2 * hb_ + (i_ >> 2)][i_] += __builtin_bit_cast(float, vf_[i_].x ^ vf_[i_].y ^ vf_[i_].z ^ vf_[i_].w) + __builtin_bit_cast(float, __builtin_bit_cast(u32x4, pf[i_ & 3]).x); } } } while (0)
    AT_LOAD(0); AT_WRITE(0); AT_LOAD(1);
    __syncthreads();
    int b_prv = 2 * AT_BUF, b_cur = 0, b_nxt = AT_BUF;
#pragma nounroll
    for (int t = 0; t <= 32; ++t) {
        if (t + 1 < 32 && (!(ABL & 4) || t < 2)) AT_WRITE(b_nxt);
        if (t + 2 < 32 && (!(ABL & 4) || t < 2)) AT_LOAD(t + 2);
        if (mp == 0) { if (t < 32) AT_SOFT(t, b_cur); }
        else { if (t >= 1) AT_PV(b_prv); }
        if (!(ABL & 8)) __syncthreads();
        if (mp == 0) { if (t < 32) AT_PV(b_cur); }
        else { if (t < 32) AT_SOFT(t, b_cur); }
        { const int tmp = b_prv; b_prv = b_cur; b_cur = b_nxt; b_nxt = tmp; }
        if (!(ABL & 8)) __syncthreads();
    }
#undef AT_LOAD
#undef AT_WRITE
#undef AT_SOFT
#undef AT_PV
    float lsum = lacc.x + lacc.y;
    lsum += __shfl_xor(lsum, 32);
    const float lam = C.w<float>(WS_SCAL)[0];
    const float sc = (mp == 0 ? 1.0f : lam) / lsum;
    LAS float* ex = (LAS float*)(lds + AT_EX_OFF) + (rb * 32 + r32) * AT_EX_PITCH;
    if (mp == 1) {
#pragma unroll
        for (int dvb = 0; dvb < 4; ++dvb)
#pragma unroll
            for (int g = 0; g < 4; ++g) *(LAS f32x4*)(ex + dvb * 32 + 8 * g + 4 * hi) = (f32x4){o[dvb][4 * g] * sc, o[dvb][4 * g + 1] * sc, o[dvb][4 * g + 2] * sc, o[dvb][4 * g + 3] * sc};
    }
    __syncthreads();
    if (mp == 0) {
        float ss = 0.f;
#pragma unroll
        for (int dvb = 0; dvb < 4; ++dvb)
#pragma unroll
            for (int g = 0; g < 4; ++g) { const f32x4 e = *(const LAS f32x4*)(ex + dvb * 32 + 8 * g + 4 * hi);
#pragma unroll
                for (int i = 0; i < 4; ++i) { const float v = o[dvb][4 * g + i] * sc - e[i]; o[dvb][4 * g + i] = v; ss += v * v; } }
        ss += __shfl_xor(ss, 32);
        const float rs = (1.0f / sqrtf(ss * (1.0f / 128.0f) + EPS)) * 0.8f;
        bf16* orow = C.w<bf16>(ABL ? WS_HM : WS_O) + (tok0 + qa + r32) * DM + h * 128;
        const float* sg = C.in(IN_SUBLN);
#pragma unroll
        for (int dvb = 0; dvb < 4; ++dvb)
#pragma unroll
            for (int g = 0; g < 4; ++g) { const int dv = dvb * 32 + 8 * g + 4 * hi; const f32x4 gv = *(const f32x4*)(sg + dv);
                u32x2 w; w.x = pk2(o[dvb][4 * g] * rs * gv.x, o[dvb][4 * g + 1] * rs * gv.y); w.y = pk2(o[dvb][4 * g + 2] * rs * gv.z, o[dvb][4 * g + 3] * rs * gv.w);
                *(u32x2*)(orow + dv) = w; }
    }
}
template <int ABL> __device__ __forceinline__ void p_attention(const Ctx& C) {
    int last_h = -1;
    for (int w = C.vcu; w < NB * DA_H * 2; w += C.G) { const int bh = w >> 1, half = w & 1, h = bh & 7;
        for (int i = 0; i < 8; ++i) { attn_unit<ABL>(C, bh >> 3, h, half * 8 + i, h != last_h); last_h = h; } }
    __syncthreads();
}

constexpr int RT_CH = 128, RT_IMG = RT_CH * 16 * 16;
__device__ __forceinline__ void p_route(const Ctx& C, int layer, const bf16* x, bool commit = true) {
    const int lane = C.lane, tid = C.tid, tok = lane & 15, kq = lane >> 4;
    const float* g = C.in(IN_NFG) + layer * DM;
    const float* wr_ = C.in(IN_WRT) + (size_t)layer * DM * 32; const float* wg_ = C.in(IN_WGRP) + (size_t)layer * DM * 4;
    unsigned* cnt = C.w<unsigned>(WS_CTL) + CW_CNT + layer * 64;
    LAS float* lg = (LAS float*)(C.lds + 2 * RT_IMG) + C.wave * (16 * 48);
    bf16* HF = C.w<bf16>(WS_HF);
    const int sk = tid >> 2, sn = (tid & 3) * 4;
    f32x4 st0, st1, st2;
#define RT_LOAD(c) do { const int k_ = (c) * RT_CH + sk; st0 = *(const f32x4*)(wr_ + k_ * 32 + sn); st1 = *(const f32x4*)(wr_ + k_ * 32 + 16 + sn); st2 = (sn == 0) ? *(const f32x4*)(wg_ + k_ * 4) : (f32x4){0.f, 0.f, 0.f, 0.f}; } while (0)
#define RT_WRITE(bo) do { LAS f32x4* d_ = (LAS f32x4*)(C.lds + (bo)) + sk * 16 + sn; d_[0] = (f32x4){st0[0], st1[0], st2[0], 0.f}; d_[1] = (f32x4){st0[1], st1[1], st2[1], 0.f}; d_[2] = (f32x4){st0[2], st1[2], st2[2], 0.f}; d_[3] = (f32x4){st0[3], st1[3], st2[3], 0.f}; } while (0)
    for (int ts = C.vcu; ts < NT / 128; ts += C.G) {
        const int t0 = ts * 128 + C.wave * 16, b = t0 / SEQ;
        const bf16* xrow = x + (size_t)(t0 + tok) * DM + 4 * kq;
        __syncthreads();
        RT_LOAD(0);
        float ss = 0.f;
#pragma unroll 8
        for (int kk = 0; kk < 64; ++kk) { const u32x2 w = *(const u32x2*)(xrow + 16 * kk); const f32x4 v = (f32x4){bflo(w.x), bfhi(w.x), bflo(w.y), bfhi(w.y)}; ss += (v.x * v.x + v.y * v.y) + (v.z * v.z + v.w * v.w); }
        ss += __shfl_xor(ss, 16); ss += __shfl_xor(ss, 32);
        const float rstd = 1.0f / sqrtf(ss * (1.0f / DM) + EPS);
        const float* sc = C.mods(layer, 4) + (size_t)b * 6144 + 4 * kq; const float* sh = C.mods(layer, 3) + (size_t)b * 6144 + 4 * kq;
        f32x4 a0 = (f32x4){0.f, 0.f, 0.f, 0.f}, a1 = a0, a2 = a0;
        bf16* hrow = HF + (size_t)(t0 + tok) * DM + 4 * kq;
        RT_WRITE(0);
        for (int c = 0; c < DM / RT_CH; ++c) {
            const int bo = (c & 1) * RT_IMG;
            __syncthreads();
            if (c + 1 < DM / RT_CH) RT_LOAD(c + 1);
            const LAS f32x4* bimg = (const LAS f32x4*)(C.lds + bo) + (4 * kq) * 16 + tok;
#pragma unroll
            for (int half = 0; half < 2; ++half) {
                f32x4 hfv[4];
#pragma unroll
                for (int q = 0; q < 4; ++q) { const int kk = c * 8 + half * 4 + q;
                    const u32x2 xw2 = *(const u32x2*)(xrow + 16 * kk); const f32x4 v = (f32x4){bflo(xw2.x), bfhi(xw2.x), bflo(xw2.y), bfhi(xw2.y)};
                    const f32x4 gv = *(const f32x4*)(g + 16 * kk + 4 * kq), scv = *(const f32x4*)(sc + 16 * kk), shv = *(const f32x4*)(sh + 16 * kk);
                    hfv[q] = (v * rstd * gv) * (scv + 1.0f) + shv;
                    u32x2 w; w.x = pk2(hfv[q].x, hfv[q].y); w.y = pk2(hfv[q].z, hfv[q].w); *(u32x2*)(hrow + 16 * kk) = w; }
#pragma unroll
                for (int q = 0; q < 4; ++q)
#pragma unroll
                    for (int i = 0; i < 4; ++i) { const f32x4 bv = bimg[((half * 4 + q) * 16 + i) * 16];
                        a0 = __builtin_amdgcn_mfma_f32_16x16x4f32(hfv[q][i], bv[0], a0, 0, 0, 0); a1 = __builtin_amdgcn_mfma_f32_16x16x4f32(hfv[q][i], bv[1], a1, 0, 0, 0); a2 = __builtin_amdgcn_mfma_f32_16x16x4f32(hfv[q][i], bv[2], a2, 0, 0, 0); }
            }
            if (c + 1 < DM / RT_CH) RT_WRITE(RT_IMG - bo);
        }
#pragma unroll
        for (int r = 0; r < 4; ++r) { lg[(4 * kq + r) * 48 + tok] = a0[r]; lg[(4 * kq + r) * 48 + 16 + tok] = a1[r]; lg[(4 * kq + r) * 48 + 32 + tok] = a2[r]; }
        LDS_WAIT(); asm volatile("" ::: "memory");
        if (lane < 16 && commit) {
            const LAS float* L = lg + lane * 48;
            int gs = 0; float gm = L[32];
#pragma unroll
            for (int j = 1; j < 4; ++j) { const float v = L[32 + j]; if (v > gm) { gm = v; gs = j; } }
            float gsum = 0.f;
#pragma unroll
            for (int j = 0; j < 4; ++j) gsum += __expf(L[32 + j] - gm);
            const float pg = 1.0f / gsum;
            int ia = 0; float la = L[gs * 8];
#pragma unroll
            for (int j = 1; j < 8; ++j) { const float v = L[gs * 8 + j]; if (v > la) { la = v; ia = j; } }
            int ib = -1; float lb = -3.0e38f;
#pragma unroll
            for (int j = 0; j < 8; ++j) { const float v = L[gs * 8 + j]; if (j != ia && v > lb) { lb = v; ib = j; } }
            const float wa = pg / (1.0f + __expf(lb - la)), wb = pg - wa;
            const int ea = gs * 8 + ia, eb = gs * 8 + ib, t = t0 + lane;
            const unsigned pa = atomicAdd(cnt + ea, 1u), pb = atomicAdd(cnt + eb, 1u);
            C.w<int>(WS_RE)[2 * t] = ea; C.w<int>(WS_RE)[2 * t + 1] = eb; C.w<float>(WS_RW)[2 * t] = wa; C.w<float>(WS_RW)[2 * t + 1] = wb;
            C.w<int>(WS_RP)[2 * t] = (int)pa; C.w<int>(WS_RP)[2 * t + 1] = (int)pb;
            C.w<int>(WS_TL)[(size_t)ea * NT + pa] = t; C.w<int>(WS_TL)[(size_t)eb * NT + pb] = t;
        }
        LDS_WAIT(); asm volatile("" ::: "memory");
    }
#undef RT_LOAD
#undef RT_WRITE
}
struct MoeTab { LAS int* off; LAS int* tile_e; LAS int* ntile; LAS int* cnt; LAS int* tile_p0; };
__device__ __forceinline__ MoeTab moe_tables(const Ctx& C, int layer) {
    MoeTab T; T.off = (LAS int*)(C.lds + MISC_OFF + 256); T.tile_e = T.off + 128; T.ntile = T.off + 48; T.cnt = T.off + 64; T.tile_p0 = T.off + 128 + 320;
    __syncthreads();
    if (C.tid == 0) { const unsigned* cnt = C.w<unsigned>(WS_CTL) + CW_CNT + layer * 64; int o = 0, nt = 0;
        for (int e = 0; e < NEXP; ++e) { const int c = (int)__hip_atomic_load(cnt + e, __ATOMIC_RELAXED, __HIP_MEMORY_SCOPE_AGENT); T.off[e] = o; T.cnt[e] = c; const int tiles = (c + 255) >> 8; for (int j = 0; j < tiles; ++j) { T.tile_e[nt + j] = e; T.tile_p0[nt + j] = j * 256; } nt += tiles; o += tiles * 256; }
        T.off[32] = o; T.ntile[0] = nt; }
    __syncthreads();
    return T;
}
__device__ __forceinline__ void p_permute(const Ctx& C, int layer) {
    const MoeTab T = moe_tables(C, layer);
    const bf16* HF = C.w<bf16>(WS_HF); bf16* HS = C.w<bf16>(WS_HS);
    const int* RP = C.w<int>(WS_RP); const int* RE = C.w<int>(WS_RE);
    for (int p = C.vcu * 8 + C.wave; p < 2 * NT; p += C.G * 8) {
        const int e = RE[p], pos = RP[p], slot = T.off[e] + pos, t = p >> 1;
        const u32x4* s = (const u32x4*)(HF + (size_t)t * DM) + C.lane; u32x4* d = (u32x4*)(HS + (size_t)slot * DM) + C.lane;
        const u32x4 v0 = s[0], v1 = s[64]; d[0] = v0; d[64] = v1;
        asm volatile("" ::: "memory");
        if (C.lane == 0) C.w<int>(WS_RS)[p] = slot;
    }
}
template <int NPN, bool GATH> struct MoeOrder {
    const int* tl; MoeTab T; const char* A; const char* B; int lda_bytes; size_t b_expert_bytes; int b_tile_bytes; int G, c, nt;
    __device__ __forceinline__ bool next(int i, pg8::Unit& u) const {
        const int L = i * G + c; const int rt = L / NPN, pn = L - rt * NPN; if (rt >= T.ntile[0]) return false;
        const int e = T.tile_e[rt];
        u.A = GATH ? A : A + (size_t)rt * 256 * lda_bytes; u.B = B + (size_t)e * b_expert_bytes + (size_t)pn * b_tile_bytes; u.r0 = rt * 256; u.c0 = GATH ? T.tile_p0[rt] : pn * 256; u.a0 = e; u.a1 = pn; u.nt = nt; u.flags = GATH ? T.cnt[e] : 3; return true;
    }
    __device__ __forceinline__ int kb(const pg8::Unit&, int t) const { return t; }
    __device__ __forceinline__ unsigned arow(const pg8::Unit& u, int r) const { const int pos = u.c0 + r; const int tok = pos < u.flags ? tl[(size_t)u.a0 * NT + pos] : 0; return (unsigned)tok * (unsigned)(DM * 2); }
};
struct EpiSwiGLU {
    static constexpr bool PERM = true;
    bf16* H;
    __device__ __forceinline__ void operator()(const f32x4 (&acc)[2][2][4][2], const pg8::Unit& u, int wr, int wc, int fr_, int fq_) const {
        (void)fr_; (void)fq_; const int ln_ = opaque_v(lane_id()); const int fr = ln_ & 15, fq = ln_ >> 4;
        const int row0 = u.r0 + wr * 64 + fr, col0 = u.a1 * 128 + wc * 32 + 8 * fq;
#pragma unroll
        for (int ai = 0; ai < 2; ++ai)
#pragma unroll
            for (int m = 0; m < 4; ++m) { float r[8];
#pragma unroll
                for (int n = 0; n < 2; ++n)
#pragma unroll
                    for (int i = 0; i < 4; ++i) { const float a = acc[ai][0][m][n][i], b = acc[ai][1][m][n][i]; r[4 * n + i] = silu_f(a) * b; }
                u32x4 w; w.x = pk2(r[0], r[1]); w.y = pk2(r[2], r[3]); w.z = pk2(r[4], r[5]); w.w = pk2(r[6], r[7]);
                *(u32x4*)(H + (size_t)(row0 + ai * 128 + m * 16) * DEXP + col0) = w; }
    }
};
template <bool OUT_F32> __device__ __forceinline__ void p_combine(const Ctx& C, int layer, const bf16* xsrc, void* xdst, int norm_rows = 0, bf16* hm = nullptr) {
    const MoeTab T = moe_tables(C, layer);
    const bf16* YS = C.w<bf16>(WS_YS); const int* RP = C.w<int>(WS_RP); const int* RE = C.w<int>(WS_RE); const float* RW = C.w<float>(WS_RW);
    const float* ng = C.in(IN_NMG) + (layer + 1 < 2 ? layer + 1 : 1) * DM;
    for (int t = C.vcu * 8 + C.wave; t < NT; t += C.G * 8) {
        const int s0 = T.off[RE[2 * t]] + RP[2 * t], s1 = T.off[RE[2 * t + 1]] + RP[2 * t + 1]; const float w0 = RW[2 * t], w1 = RW[2 * t + 1];
        const int b = t / SEQ;
        const float* g2 = C.mods(layer, 5) + (size_t)b * 6144;
        const u32x4* y0 = (const u32x4*)(YS + (size_t)s0 * DM) + C.lane; const u32x4* y1 = (const u32x4*)(YS + (size_t)s1 * DM) + C.lane;
        const u32x4* xr = (const u32x4*)(xsrc + (size_t)t * DM) + C.lane;
        f32x4 xa[2], xb[2]; float ss = 0.f;
#pragma unroll
        for (int j = 0; j < 2; ++j) { const u32x4 a = y0[64 * j], bq = y1[64 * j], xw = xr[64 * j]; const f32x4 ga = *(const f32x4*)(g2 + 512 * j + 8 * C.lane), gb = *(const f32x4*)(g2 + 512 * j + 8 * C.lane + 4);
            xa[j] = (f32x4){bflo(xw.x), bfhi(xw.x), bflo(xw.y), bfhi(xw.y)}; xb[j] = (f32x4){bflo(xw.z), bfhi(xw.z), bflo(xw.w), bfhi(xw.w)};
            xa[j].x += ga.x * (w0 * bflo(a.x) + w1 * bflo(bq.x)); xa[j].y += ga.y * (w0 * bfhi(a.x) + w1 * bfhi(bq.x)); xa[j].z += ga.z * (w0 * bflo(a.y) + w1 * bflo(bq.y)); xa[j].w += ga.w * (w0 * bfhi(a.y) + w1 * bfhi(bq.y));
            xb[j].x += gb.x * (w0 * bflo(a.z) + w1 * bflo(bq.z)); xb[j].y += gb.y * (w0 * bfhi(a.z) + w1 * bfhi(bq.z)); xb[j].z += gb.z * (w0 * bflo(a.w) + w1 * bflo(bq.w)); xb[j].w += gb.w * (w0 * bfhi(a.w) + w1 * bfhi(bq.w));
            if (OUT_F32) { float* o = (float*)xdst + (size_t)t * DM + 512 * j + 8 * C.lane; *(f32x4*)o = xa[j]; *(f32x4*)(o + 4) = xb[j]; }
            else { u32x4 w; w.x = pk2(xa[j].x, xa[j].y); w.y = pk2(xa[j].z, xa[j].w); w.z = pk2(xb[j].x, xb[j].y); w.w = pk2(xb[j].z, xb[j].w); *((u32x4*)((bf16*)xdst + (size_t)t * DM + 512 * j) + C.lane) = w; }
            ss += (xa[j].x * xa[j].x + xa[j].y * xa[j].y) + (xa[j].z * xa[j].z + xa[j].w * xa[j].w) + (xb[j].x * xb[j].x + xb[j].y * xb[j].y) + (xb[j].z * xb[j].z + xb[j].w * xb[j].w); }
        if (t < norm_rows) {
            const float rstd = 1.0f / sqrtf(wave_sum(ss) * (1.0f / DM) + EPS);
            const float* sc = C.mods(layer + 1, 1) + (size_t)b * 6144; const float* sh = C.mods(layer + 1, 0) + (size_t)b * 6144;
#pragma unroll
            for (int j = 0; j < 2; ++j) { const int c = 512 * j + 8 * C.lane;
                const f32x4 g0 = *(const f32x4*)(ng + c), g1 = *(const f32x4*)(ng + c + 4), c0 = *(const f32x4*)(sc + c), c1 = *(const f32x4*)(sc + c + 4), h0 = *(const f32x4*)(sh + c), h1 = *(const f32x4*)(sh + c + 4);
                const f32x4 ya = (xa[j] * rstd * g0) * (c0 + 1.0f) + h0, yb = (xb[j] * rstd * g1) * (c1 + 1.0f) + h1;
                u32x4 w; w.x = pk2(ya.x, ya.y); w.y = pk2(ya.z, ya.w); w.z = pk2(yb.x, yb.y); w.w = pk2(yb.z, yb.w);
                *(u32x4*)(hm + (size_t)t * DM + c) = w; }
        }
    }
}

constexpr int CV_XM = 0;
constexpr int CV_QKV = 18432;
constexpr int CV_QKV_P = 1552;
constexpr int CV_VT = CV_QKV + 32 * CV_QKV_P;
constexpr int CV_RED = CV_VT + 256 * 80;
static_assert(CV_RED + 16384 <= RING_BYTES && CV_VT % 16 == 0 && CV_RED % 16 == 0, "conv LDS");
__device__ __forceinline__ void conv_unit(const Ctx& C, int round, int bl, int ti) {
    LAS unsigned char* lds = C.lds; const int tid = C.tid, lane = C.lane, wid = C.wave;
    const int s0 = ti * 32; const size_t rrow0 = (size_t)bl * SEQ;
    const bf16* XM = C.w<bf16>(WS_XMH); bf16* XC = C.w<bf16>(WS_XC); bf16* K = C.w<bf16>(WS_K); bf16* VTR = C.w<bf16>(WS_VTR);
    const bf16* GWT = C.w<bf16>(WS_GWT);
    f32x4 gacc[2]; gacc[0] = (f32x4){0.f, 0.f, 0.f, 0.f}; gacc[1] = gacc[0];
    const int nblk = tid & 63, tg = tid >> 6;
    u32x4 xs[3];
#define CV_LOAD(chn) do { _Pragma("unroll") for (int q_ = 0; q_ < 3; ++q_) { const int i_ = tid + 512 * q_; const int r_ = i_ >> 5, cc_ = i_ & 31, s_ = s0 - 2 + r_; xs[q_] = (u32x4){0u, 0u, 0u, 0u}; \
        if (i_ < 36 * 32 && s_ >= 0 && s_ < SEQ) xs[q_] = *(const u32x4*)(XM + (rrow0 + s_) * ML_IN + (chn) * 256 + cc_ * 8); } } while (0)
    CV_LOAD(0);
    for (int ch = 0; ch < 8; ++ch) {
        const int c0 = ch * 256;
        LDS_BARRIER();
#pragma unroll
        for (int q = 0; q < 3; ++q) { const int i = tid + 512 * q; if (i < 36 * 32) *(LAS u32x4*)(lds + CV_XM + (i >> 5) * 512 + (i & 31) * 16) = xs[q]; }
        if (ch + 1 < 8) CV_LOAD(ch + 1);
        LDS_BARRIER();
        {
            const int c = c0 + 4 * nblk;
            float cw[5][4], cb[4], wq[4][4], wk[4][4], wv[4][4];
            const float* convw = C.in(IN_CONVW); const float* convb = C.in(IN_CONVB);
#pragma unroll
            for (int j = 0; j < 5; ++j) { const f32x4 v = *(const f32x4*)(convw + j * ML_IN + c); cw[j][0] = v.x; cw[j][1] = v.y; cw[j][2] = v.z; cw[j][3] = v.w; }
            { const f32x4 v = *(const f32x4*)(convb + c); cb[0] = v.x; cb[1] = v.y; cb[2] = v.z; cb[3] = v.w; }
            const int nb = c >> 2;
#pragma unroll
            for (int i = 0; i < 4; ++i) { const f32x4 a = *(const f32x4*)(C.in(IN_WQ) + nb * 16 + i * 4), b = *(const f32x4*)(C.in(IN_WK) + nb * 16 + i * 4), d = *(const f32x4*)(C.in(IN_WV) + nb * 16 + i * 4);
                wq[i][0] = a.x; wq[i][1] = a.y; wq[i][2] = a.z; wq[i][3] = a.w; wk[i][0] = b.x; wk[i][1] = b.y; wk[i][2] = b.z; wk[i][3] = b.w; wv[i][0] = d.x; wv[i][1] = d.y; wv[i][2] = d.z; wv[i][3] = d.w; }
            float xw[8][4];
#pragma unroll
            for (int r = 0; r < 8; ++r) { const u32x2 v = *(const LAS u32x2*)(lds + CV_XM + (4 * tg + r) * 512 + nblk * 8); xw[r][0] = bflo(v.x); xw[r][1] = bfhi(v.x); xw[r][2] = bflo(v.y); xw[r][3] = bfhi(v.y); }
#pragma unroll
            for (int tt = 0; tt < 4; ++tt) {
                const int tl = 4 * tg + tt;
                float xc[4], qv[4], kv[4], vv[4];
#pragma unroll
                for (int i = 0; i < 4; ++i) { float a = cb[i];
#pragma unroll
                    for (int j = 0; j < 5; ++j) a += cw[j][i] * xw[tt + j][i];
                    xc[i] = silu_f(a); }
#pragma unroll
                for (int o = 0; o < 4; ++o) { float a = 0.f, b = 0.f, d = 0.f;
#pragma unroll
                    for (int i = 0; i < 4; ++i) { a += xc[i] * wq[i][o]; b += xc[i] * wk[i][o]; d += xw[tt + 2][i] * wv[i][o]; }
                    qv[o] = a; kv[o] = b; vv[o] = d; }
                const size_t grow = (rrow0 + s0 + tl) * ML_IN + c;
                float k2[4];
#pragma unroll
                for (int i = 0; i < 4; ++i) { float a = 0.f;
#pragma unroll
                    for (int o = 0; o < 4; ++o) a += kv[o] * wq[i][o];
                    k2[i] = a; }
                const u32x2 xcw = (u32x2){pk2(xc[0], xc[1]), pk2(xc[2], xc[3])}, qw = (u32x2){pk2(qv[0], qv[1]), pk2(qv[2], qv[3])}, kw = (u32x2){pk2(kv[0], kv[1]), pk2(kv[2], kv[3])}, vw = (u32x2){pk2(vv[0], vv[1]), pk2(vv[2], vv[3])};
                *(u32x2*)(XC + grow) = xcw; *(u32x2*)(K + grow) = (u32x2){pk2(k2[0], k2[1]), pk2(k2[2], k2[3])};
                LAS unsigned char* qrow = lds + CV_QKV + tl * CV_QKV_P + nblk * 8;
                *(LAS u32x2*)(qrow) = qw; *(LAS u32x2*)(qrow + 512) = kw; *(LAS u32x2*)(qrow + 1024) = vw;
            }
        }
        LDS_BARRIER();
        for (int i = tid; i < 256 * 4; i += 512) { const int cr = i >> 2, cc = i & 3; const int cg = c0 + cr, head = cg >> 9, dv = cg & 511;
            const LAS unsigned short* s = (const LAS unsigned short*)(lds + CV_QKV + (8 * cc) * CV_QKV_P + 1024) + cr; unsigned short v[8];
#pragma unroll
            for (int j = 0; j < 8; ++j) v[j] = s[j * (CV_QKV_P / 2)];
            *(u32x4*)(VTR + ((size_t)(bl * 4 + head) * 512 + dv) * SEQ + s0 + cc * 8) = (u32x4){(unsigned)v[0] | ((unsigned)v[1] << 16), (unsigned)v[2] | ((unsigned)v[3] << 16), (unsigned)v[4] | ((unsigned)v[5] << 16), (unsigned)v[6] | ((unsigned)v[7] << 16)}; }
#pragma unroll
        for (int ks = 0; ks < 3; ++ks) { const int kk = 96 * wid + 32 * ks + 8 * (lane >> 4);
            const int m = kk >> 8, cl = kk & 255;
            const bf16x8 bfr = *(const bf16x8*)(GWT + (size_t)(lane & 15) * 6144 + m * 2048 + c0 + cl);
#pragma unroll
            for (int tgp = 0; tgp < 2; ++tgp) { const bf16x8 afr = *(const LAS bf16x8*)(lds + CV_QKV + (16 * tgp + (lane & 15)) * CV_QKV_P + kk * 2);
                gacc[tgp] = __builtin_amdgcn_mfma_f32_16x16x32_bf16(afr, bfr, gacc[tgp], 0, 0, 0); } }
    }
    LDS_BARRIER();
    LAS float* red = (LAS float*)(lds + CV_RED);
#pragma unroll
    for (int tgp = 0; tgp < 2; ++tgp)
#pragma unroll
        for (int r = 0; r < 4; ++r) red[(wid * 32 + 16 * tgp + 4 * (lane >> 4) + r) * 16 + (lane & 15)] = gacc[tgp][r];
    LDS_BARRIER();
    { const int tkn = tid >> 4, n = tid & 15; float s = C.in(IN_GATEB)[n];
#pragma unroll
        for (int w = 0; w < 8; ++w) s += red[(w * 32 + tkn) * 16 + n];
        C.w<float>(WS_PRE)[(rrow0 + s0 + tkn) * 16 + n] = s; }
    (void)round;
#undef CV_LOAD
}
__device__ __forceinline__ void p_conv(const Ctx& C, int round) {
    { float* DEN = C.w<float>(WS_DEN); for (int i = C.vcu * 512 + C.tid; i < 2 * 16 * 2048; i += C.G * 512) DEN[i] = 0.f; }
    for (int u = C.vcu; u < RB * 64; u += C.G) conv_unit(C, round, u >> 6, u & 63);
    __syncthreads();
}
__device__ __forceinline__ void cumsum_seq(const Ctx& C, int sq) {
    float* FG = C.w<float>(WS_FG); const float* PRE = C.w<float>(WS_PRE);
    LAS float* wtot = (LAS float*)(C.lds);
    const int dir = sq & 1, bh = sq >> 1, bl = bh >> 2, hd = bh & 3, lane = C.lane, tid = C.tid;
    const float* p = PRE + (size_t)bl * SEQ * 16 + dir * 8;
    float lf[4], ii[4]; float tot = 0.f;
#pragma unroll
    for (int j = 0; j < 4; ++j) { const int s = tid * 4 + j; const float f = p[(size_t)s * 16 + 4 + hd]; ii[j] = p[(size_t)s * 16 + hd];
        lf[j] = fminf(f, 0.f) - log1pf(__expf(-fabsf(f))); tot += lf[j]; }
    float inc = tot;
#pragma unroll
    for (int o = 1; o < 64; o <<= 1) { const float v = __shfl_up(inc, o); if (lane >= o) inc += v; }
    __syncthreads();
    if (lane == 63) wtot[C.wave] = inc;
    __syncthreads();
    float before = 0.f, all = 0.f;
#pragma unroll
    for (int w = 0; w < 8; ++w) { const float v = wtot[w]; all += v; if (w < C.wave) before += v; }
    const float excl = before + inc - tot;
    float* F = FG + (size_t)(dir * 2) * 16 * 2048 + (size_t)bh * 2048; float* Gp = F + 16 * 2048;
    f32x4 fo, go;
    if (dir == 0) { float run = excl;
#pragma unroll
        for (int j = 0; j < 4; ++j) { run += lf[j]; fo[j] = run * LOG2E; go[j] = (ii[j] - run) * LOG2E - 4.5f; } }
    else { float run = all - excl;
#pragma unroll
        for (int j = 0; j < 4; ++j) { fo[j] = run * LOG2E; go[j] = (ii[j] - run) * LOG2E - 4.5f; run -= lf[j]; } }
    *(f32x4*)(F + tid * 4) = fo; *(f32x4*)(Gp + tid * 4) = go;
}
struct DecayOrder {
    const char* Qb; const char* Kb; int G, c;
    __device__ __forceinline__ bool next(int ii, pg8::Unit& u) const {
        const int grp = (ii >> 2) * G + c; if (grp >= 256) return false;
        const int bh = grp >> 4, i = (grp >> 1) & 7, j = 4 * (grp & 1) + (ii & 3), bl = bh >> 2, hd = bh & 3;
        u.A = Qb + ((size_t)(bl * SEQ + 256 * i) * ML_IN + hd * 512) * 2; u.B = Kb + ((size_t)(bl * SEQ + 256 * j) * ML_IN + hd * 512) * 2; u.r0 = 256 * i; u.c0 = 256 * j; u.a0 = bh; u.a1 = (i << 4) | j; u.nt = ML_DH / 64; u.flags = 3; return true;
    }
    __device__ __forceinline__ int kb(const pg8::Unit&, int t) const { return t; }
};
struct EpiDecay {
    static constexpr bool PERM = true;
    bf16* W; const float* FG; float* DEN; int den_on; bf16* DUMMY;
    template <bool MASK>
    __device__ __forceinline__ void pass(const f32x4 (&acc)[2][2][4][2], const pg8::Unit& u, int wr, int wc, int fr, int fq, int dir, int dmin, int dmax, int cblk) const {
        const int bh = u.a0; const float* F = FG + (size_t)(dir * 2) * 16 * 2048 + (size_t)bh * 2048; const float* Gp = F + 16 * 2048;
        const int rl0 = opaque_v(wr * 64 + fr), cl0 = opaque_v(wc * 32 + 8 * fq);
        const float* Fr = F + u.r0;
        const bool fake_ = (REP_ABL & 256) && !den_on;
        const float ref = fake_ ? 0.5f : (dir ? Fr[255] : Fr[0]);
        f32x4 gv[2][2];
#pragma unroll
        for (int bj = 0; bj < 2; ++bj)
#pragma unroll
            for (int n = 0; n < 2; ++n) { const f32x4 g = fake_ ? (f32x4){0.1f * fq, 0.2f, 0.3f * fr, 0.4f} : *(const f32x4*)(Gp + u.c0 + cl0 + bj * 128 + 4 * n);
#pragma unroll
                for (int i = 0; i < 4; ++i) gv[bj][n][i] = __builtin_amdgcn_exp2f(fminf(g[i] + ref, 120.0f)); }
        float fa[2][4];
#pragma unroll
        for (int ai = 0; ai < 2; ++ai)
#pragma unroll
            for (int m = 0; m < 4; ++m) fa[ai][m] = __builtin_amdgcn_exp2f(fmaxf((fake_ ? 0.01f * (fr + m) : Fr[rl0 + ai * 128 + m * 16]) - ref, -126.0f));
        bf16* wbase = W + ((size_t)bh * SEQ + u.r0) * WLD + cblk * 256 + cl0;
        float* den = DEN + (size_t)dir * 16 * 2048 + (size_t)bh * 2048 + u.r0;
#pragma unroll
        for (int ai = 0; ai < 2; ++ai)
#pragma unroll
            for (int m = 0; m < 4; ++m) { const int rl = rl0 + ai * 128 + m * 16; const float fv = fa[ai][m]; f32x4 rsv = (f32x4){0.f, 0.f, 0.f, 0.f};
#pragma unroll
                for (int bj = 0; bj < 2; ++bj) { f32x4 t0 = acc[ai][bj][m][0] * gv[bj][0], t1 = acc[ai][bj][m][1] * gv[bj][1];
                    if (MASK) {
#pragma unroll
                        for (int i = 0; i < 4; ++i) { const int d0 = cl0 + bj * 128 + i - rl, d1 = d0 + 4; t0[i] = (d0 >= dmin && d0 <= dmax) ? t0[i] : 0.f; t1[i] = (d1 >= dmin && d1 <= dmax) ? t1[i] : 0.f; } }
                    rsv += t0; rsv += t1; t0 = t0 * fv; t1 = t1 * fv;
                    u32x4 w; w.x = pk2(t0[0], t0[1]); w.y = pk2(t0[2], t0[3]); w.z = pk2(t1[0], t1[1]); w.w = pk2(t1[2], t1[3]);
                    if (!((REP_ABL & 64) && !den_on)) *(u32x4*)(wbase + (size_t)rl * WLD + bj * 128) = w; else rsv[0] += __builtin_bit_cast(float, w.x ^ w.y ^ w.z ^ w.w); }
                float rs = ((rsv[0] + rsv[1]) + (rsv[2] + rsv[3])) * fv;
                rs += __shfl_xor(rs, 16); rs += __shfl_xor(rs, 32);
                if (fq == 0 && den_on) atomicAdd(den + rl, rs); else if ((REP_ABL & 64) && rs == 12345.678f) den[rl] = rs; }
    }
    __device__ __forceinline__ void operator()(const f32x4 (&acc)[2][2][4][2], const pg8::Unit& u, int wr, int wc, int fr_, int fq_) const {
        (void)fr_; (void)fq_; const int ln_ = opaque_v(lane_id()); const int fr = ln_ & 15, fq = ln_ >> 4;
        if ((REP_ABL & 32) && !den_on) { if (acc[0][0][0][0][0] == 12345.678f) W[0] = 1; return; }
        if ((REP_ABL & 512) && !den_on) {
            bf16* wb = DUMMY + ((size_t)(u.a0 & 1) * SEQ + u.r0) * 2048 + (u.a1 & 7) * 256 + wc * 32 + 8 * fq;
#pragma unroll
            for (int ai = 0; ai < 2; ++ai)
#pragma unroll
                for (int m = 0; m < 4; ++m) { const int rl = wr * 64 + fr + ai * 128 + m * 16;
#pragma unroll
                    for (int bj = 0; bj < 2; ++bj) { const f32x4 v0 = acc[ai][bj][m][0], v1 = acc[ai][bj][m][1];
                        u32x4 w; w.x = pk2(v0[0], v0[1]); w.y = pk2(v0[2], v0[3]); w.z = pk2(v1[0], v1[1]); w.w = pk2(v1[2], v1[3]);
                        *(u32x4*)(wb + (size_t)rl * 2048 + bj * 128) = w; } }
            return; }
        const int i = u.a1 >> 4, j = u.a1 & 15;
        if (j != i) pass<false>(acc, u, wr, wc, fr, fq, j > i ? 1 : 0, 0, 0, j > i ? j + 1 : j);
        else { for (int p = 0; p < 2; ++p) pass<true>(acc, u, wr, wc, fr, fq, p, p ? 0 : -100000, p ? 100000 : 0, i + p); }
    }
};
struct HOrder {
    const char* Wb; const char* Vb; const float* DEN; int G, c;
    __device__ __forceinline__ bool next(int ii, pg8::Unit& u) const {
        const int L = (ii >> 1) * G + c, part = ii & 1; if (L >= 16 * 16) return false;
        const int bh = L >> 4, i = (L >> 1) & 7, jn = L & 1;
        const int kt0 = part ? 4 * (i + 1) : 0;
        u.A = Wb + (((size_t)bh * SEQ + 256 * i) * WLD + (size_t)kt0 * 64) * 2;
        u.B = Vb + (((size_t)bh * 512 + 256 * jn) * SEQ + (size_t)(part ? 4 * i : 0) * 64) * 2;
        u.r0 = 256 * i; u.c0 = 256 * jn; u.a0 = bh; u.a1 = part; u.nt = part ? 36 - 4 * (i + 1) : 4 * (i + 1); u.flags = 3; return true;
    }
    __device__ __forceinline__ int kb(const pg8::Unit&, int t) const { return t; }
    __device__ __forceinline__ void between(const pg8::Unit& u, f32x4 (&acc)[2][2][4][2], int wr) const {
        const int fr = opaque_v(lane_id()) & 15;
        const float* df = DEN + (size_t)u.a0 * 2048 + u.r0; const float* db = df + 16 * 2048;
#pragma unroll
        for (int ai = 0; ai < 2; ++ai)
#pragma unroll
            for (int m = 0; m < 4; ++m) { const int rl = ai * 128 + wr * 64 + m * 16 + fr; const float f = fmaxf(fabsf(db[rl]), 1.0f) / fmaxf(fabsf(df[rl]), 1.0f);
#pragma unroll
                for (int bj = 0; bj < 2; ++bj)
#pragma unroll
                    for (int n = 0; n < 2; ++n) acc[ai][bj][m][n] *= f; }
    }
};
struct EpiH {
    static constexpr bool PERM = true;
    bf16* HF; bf16* HB; const float* DEN;
    __device__ __forceinline__ void operator()(const f32x4 (&acc)[2][2][4][2], const pg8::Unit& u, int wr, int wc, int fr_, int fq_) const {
        (void)fr_; (void)fq_; const int ln_ = opaque_v(lane_id()); const int fr = ln_ & 15, fq = ln_ >> 4;
        const int bh = u.a0, bl = bh >> 2, hd = bh & 3, part = u.a1; const float* dn = DEN + (size_t)part * 16 * 2048 + (size_t)bh * 2048 + u.r0;
        const int rl0 = wr * 64 + fr, col0 = hd * 512 + u.c0 + wc * 32 + 8 * fq;
        bf16* Hh = HF; (void)HB;
#pragma unroll
        for (int ai = 0; ai < 2; ++ai)
#pragma unroll
            for (int m = 0; m < 4; ++m) { const int rl = rl0 + ai * 128 + m * 16; const float rv = 1.0f / fmaxf(fabsf(dn[rl]), 1.0f);
                bf16* rowp = Hh + ((size_t)bl * SEQ + u.r0 + rl) * ML_IN + col0;
#pragma unroll
                for (int bj = 0; bj < 2; ++bj) { f32x4 v0 = acc[ai][bj][m][0] * rv, v1 = acc[ai][bj][m][1] * rv;
                    u32x4 w; w.x = pk2(v0[0], v0[1]); w.y = pk2(v0[2], v0[3]); w.z = pk2(v1[0], v1[1]); w.w = pk2(v1[2], v1[3]);
                    *(u32x4*)(rowp + bj * 128) = w; } }
    }
};
__device__ __forceinline__ void p_ynorm(const Ctx& C, int round, bool dummy = false) {
    const bf16* HF = C.w<bf16>(WS_Q); const bf16* XC = C.w<bf16>(WS_XC); bf16* Y = C.w<bf16>(WS_Y) + (size_t)round * RT * ML_IN;
    const float* og = C.in(IN_ONG); const float* skip = C.in(IN_SKIP);
    bf16* Yd = dummy ? C.w<bf16>(WS_XMH) : Y;
    for (int r = C.vcu * 8 + C.wave; r < RT; r += C.G * 8) {
        const size_t off = (size_t)r * ML_IN + 8 * C.lane;
#pragma unroll
        for (int hd = 0; hd < 4; ++hd) {
            const u32x4 hw = *(const u32x4*)(HF + off + hd * 512), xw = *(const u32x4*)(XC + off + hd * 512), zw = *(const u32x4*)(Y + off + hd * 512);
            float hv[8] = {bflo(hw.x), bfhi(hw.x), bflo(hw.y), bfhi(hw.y), bflo(hw.z), bfhi(hw.z), bflo(hw.w), bfhi(hw.w)};
            const float xv[8] = {bflo(xw.x), bfhi(xw.x), bflo(xw.y), bfhi(xw.y), bflo(xw.z), bfhi(xw.z), bflo(xw.w), bfhi(xw.w)};
            const float zv[8] = {bflo(zw.x), bfhi(zw.x), bflo(zw.y), bfhi(zw.y), bflo(zw.z), bfhi(zw.z), bflo(zw.w), bfhi(zw.w)};
            float ss = 0.f;
#pragma unroll
            for (int j = 0; j < 8; ++j) ss += hv[j] * hv[j];
            const float rs = 1.0f / sqrtf(wave_sum(ss) * (1.0f / 512.0f) + EPS);
            const float* gg = og + hd * 512 + 8 * C.lane; const float* sk = skip + hd * 512 + 8 * C.lane; float yv[8];
#pragma unroll
            for (int j = 0; j < 8; ++j) yv[j] = (hv[j] * rs * gg[j] + sk[j] * xv[j]) * silu_f(zv[j]);
            u32x4 w; w.x = pk2(yv[0], yv[1]); w.y = pk2(yv[2], yv[3]); w.z = pk2(yv[4], yv[5]); w.w = pk2(yv[6], yv[7]);
            *(u32x4*)(Yd + off + hd * 512) = w;
        }
    }
}

constexpr int PH_PRO = 0, PH_NORM0 = 1, PH_QKV = 2, PH_ATTN = 3, PH_OUT0 = 4, PH_ROUTE0 = 5, PH_UP0 = 6, PH_DOWN0 = 7, PH_COMB0 = 8,
              PH_INPROJ0 = 9, PH_RND = 10  , PH_OUT1 = PH_RND + 4 * NROUND, PH_ROUTE1 = PH_OUT1 + 1,
              PH_UP1 = PH_OUT1 + 2, PH_DOWN1 = PH_OUT1 + 3, PH_COMB1 = PH_OUT1 + 4, N_PHASES = PH_OUT1 + 5;

__device__ __forceinline__ void moe_up(const Ctx& C, int layer) {
    const MoeTab T = moe_tables(C, layer);
    MoeOrder<2, true> S; S.tl = C.w<int>(WS_TL); S.T = T; S.A = (const char*)C.w<bf16>(WS_HF); S.B = (const char*)C.w<bf16>(WS_W13T); S.lda_bytes = DM * 2; S.b_expert_bytes = (size_t)512 * DM * 2; S.b_tile_bytes = 256 * DM * 2; S.G = C.G; S.c = C.vcu; S.nt = DM / 64;
    EpiSwiGLU E{C.w<bf16>(WS_HH)};
    pg8::gemm_phase<EpiSwiGLU, MoeOrder<2, true>, true, true>(C.lds, C.tid, DM, DM, S, E);
}
__device__ __forceinline__ void moe_down(const Ctx& C, int layer) {
    const MoeTab T = moe_tables(C, layer);
    MoeOrder<4, false> S; S.tl = nullptr; S.T = T; S.A = (const char*)C.w<bf16>(WS_HH); S.B = (const char*)C.w<bf16>(WS_W2T); S.lda_bytes = DEXP * 2; S.b_expert_bytes = (size_t)DM * DEXP * 2; S.b_tile_bytes = 256 * DEXP * 2; S.G = C.G; S.c = C.vcu; S.nt = DEXP / 64;
    pg8::EpiBf16 E{C.w<bf16>(WS_YS), DM, 0, nullptr, 0};
    pg8::gemm_phase<pg8::EpiBf16, MoeOrder<4, false>, true>(C.lds, C.tid, DEXP, DEXP, S, E);
}

__global__ void __launch_bounds__(512, 2) fwd_kernel(Args args) {
    extern __shared__ __attribute__((aligned(16))) unsigned char lds_raw[];
    Ctx C; C.a = &args; C.ws = (GAS unsigned char*)args.ws; C.lds = (LAS unsigned char*)lds_raw; C.tid = threadIdx.x; C.lane = C.tid & 63; C.wave = __builtin_amdgcn_readfirstlane(C.tid >> 6);
    C.G = gridDim.x; { const int bx = blockIdx.x; C.vcu = (C.G % 8 == 0) ? (bx % 8) * (C.G / 8) + bx / 8 : bx; }
    volatile LAS unsigned* MISC = (volatile LAS unsigned*)(C.lds + MISC_OFF);
    if (C.tid < 64) MISC[C.tid] = 0u;
    __syncthreads();
    const int lo = args.ph_lo, hi = args.ph_hi;
    XcdBarrier bar; bar.bar = C.w<unsigned>(WS_CTL) + CW_BAR; bar.x = 0; bar.st = nullptr;
    if (hi - lo > 1) bar = xcd_barrier_post(C.w<unsigned>(WS_CTL) + CW_BAR, MISC + 8);
#ifndef PHSEL
#define PHSEL(k) true
#endif
#define IN(k) (PHSEL(k) && lo <= (k) && (k) < hi)
#ifndef REP_PH
#define REP_PH (-1)
#endif
#ifndef REP_J
#define REP_J (-1)
#endif
#ifndef REP_N
#define REP_N 0
#endif
#define NREP(k) (1 + (((k) == REP_PH) ? REP_N : 0))
#define NREPJ(j) (1 + (((j) == REP_J) ? REP_N : 0))
#define SEAM(k) do { if (IN(k) && IN((k) + 1)) xcd_barrier(bar); } while (0)
    float* xout = (float*)(GAS float*)args.out;
    bf16* hmall = (bf16*)xout + (size_t)NT * DM;
    bf16* xb = (bf16*)xout;

    if (IN(PH_PRO)) for (int rep_ = 0; rep_ < NREP(PH_PRO); ++rep_) { const Ctx P = fresh(C); p_prologue(P); } SEAM(PH_PRO);
#ifdef XTRA_BARRIERS
    for (int xb_ = 0; xb_ < XTRA_BARRIERS; ++xb_) xcd_barrier(bar);
#endif
    if (IN(PH_NORM0)) for (int rep_ = 0; rep_ < NREP(PH_NORM0); ++rep_) { const Ctx P = fresh(C); p_normmod(P, P.in(IN_X), 0, 0, NT, P.w<bf16>(WS_HM)); } SEAM(PH_NORM0);
    if (IN(PH_QKV)) for (int rep_ = 0; rep_ < NREP(PH_QKV); ++rep_) { const Ctx P = fresh(C);
        { pg8::PlainOrder S{(const char*)P.w<bf16>(WS_HM), (const char*)P.w<bf16>(WS_WINT), DM, DM, NT / 256, 2048 / 256, P.G, P.vcu, DM / 64};
          pg8::EpiQKNorm E{P.w<bf16>(WS_QK), P.in(IN_QG), P.in(IN_KG)};
          pg8::gemm_phase<pg8::EpiQKNorm, pg8::PlainOrder, true, false, false, true>(P.lds, P.tid, DM, DM, S, E); }
        { pg8::PlainOrder S{(const char*)(P.w<bf16>(WS_WINT) + (size_t)2048 * DM), (const char*)P.w<bf16>(WS_HM), DM, DM, 1024 / 256, NT / 256, P.G, P.vcu, DM / 64};
          pg8::EpiBf16 E{P.w<bf16>(WS_VT), NT, 0, nullptr, 0};
          pg8::gemm_phase<pg8::EpiBf16, pg8::PlainOrder, true>(P.lds, P.tid, DM, DM, S, E); }
    } SEAM(PH_QKV);
    if (IN(PH_ATTN)) for (int rep_ = 0; rep_ < NREP(PH_ATTN); ++rep_) { const Ctx P = fresh(C); if (rep_ == 0) p_attention<0>(P); else p_attention<REP_ABL>(P); } SEAM(PH_ATTN);
    if (IN(PH_OUT0)) for (int rep_ = 0; rep_ < NREP(PH_OUT0); ++rep_) { const Ctx P = fresh(C);
        pg8::PlainOrder S{(const char*)P.w<bf16>(WS_O), (const char*)P.w<bf16>(WS_WOT), DM, DM, NT / 256, DM / 256, P.G, P.vcu, DM / 64};
        pg8::EpiResid<true> E{P.in(IN_X), xb, P.mods(0, 2)};
        pg8::gemm_phase<pg8::EpiResid<true>, pg8::PlainOrder, true>(P.lds, P.tid, DM, DM, S, E);
    } SEAM(PH_OUT0);
    if (IN(PH_ROUTE0)) for (int rep_ = 0; rep_ < NREP(PH_ROUTE0); ++rep_) { const Ctx P = fresh(C); p_route(P, 0, xb, rep_ == 0); } SEAM(PH_ROUTE0);
    if (IN(PH_UP0)) for (int rep_ = 0; rep_ < NREP(PH_UP0); ++rep_) { const Ctx P = fresh(C); moe_up(P, 0); } SEAM(PH_UP0);
    if (IN(PH_DOWN0)) for (int rep_ = 0; rep_ < NREP(PH_DOWN0); ++rep_) { const Ctx P = fresh(C); moe_down(P, 0); } SEAM(PH_DOWN0);
    if (IN(PH_COMB0)) for (int rep_ = 0; rep_ < NREP(PH_COMB0); ++rep_) { const Ctx P = fresh(C); p_combine<false>(P, 0, xb, rep_ == 0 ? (void*)xb : (void*)P.w<bf16>(WS_HS + 8 * MiB), rep_ == 0 ? NT : 0, hmall); LAS float* scr = (LAS float*)(P.lds + P.wave * 16384); moe_weight_items(P, 1, scr); } SEAM(PH_COMB0);

#define INPROJ(P_, rnd_, skip_) do { \
        pg8::PlainOrder S_{(const char*)(hmall + (size_t)(rnd_) * RT * DM), (const char*)(P_).w<bf16>(WS_MLWINT), DM, DM, RT / 256, 4096 / 256, (P_).G, (P_).vcu, DM / 64}; \
        pg8::EpiBf16 E_{(P_).w<bf16>(WS_XMH), ML_IN, ML_IN, (P_).w<bf16>(WS_Y) + (size_t)(rnd_) * RT * ML_IN, ML_IN, skip_}; \
        pg8::gemm_phase<pg8::EpiBf16, pg8::PlainOrder, true>((P_).lds, (P_).tid, DM, DM, S_, E_); } while (0)
    if (IN(PH_INPROJ0)) for (int rep_ = 0; rep_ < NREP(PH_INPROJ0); ++rep_) { const Ctx P = fresh(C); INPROJ(P, 0, rep_); } SEAM(PH_INPROJ0);
    for (int round = 0; round < NROUND; ++round) {
        const int pb = PH_RND + 4 * round;
        if (IN(pb + 0)) for (int rep_ = 0; rep_ < NREPJ(0); ++rep_) { const Ctx P = fresh(C); p_conv(P, round); } SEAM(pb + 0);
        if (IN(pb + 1)) for (int rep_ = 0; rep_ < NREPJ(1); ++rep_) { const Ctx P = fresh(C);
            { int last_bh = -1; for (int grp = P.vcu; grp < 256; grp += P.G) { const int bh = grp >> 4; if (bh != last_bh) { cumsum_seq(P, 2 * bh); cumsum_seq(P, 2 * bh + 1); last_bh = bh; } }
              asm volatile("s_waitcnt vmcnt(0)" ::: "memory"); __syncthreads(); }
            DecayOrder S{(const char*)P.w<bf16>(WS_XC), (const char*)P.w<bf16>(WS_K), P.G, P.vcu};
            EpiDecay E{P.w<bf16>(WS_W), P.w<float>(WS_FG), P.w<float>(WS_DEN), rep_ == 0 ? 1 : 0, P.w<bf16>(WS_XMH)};
            pg8::gemm_phase<EpiDecay, DecayOrder, GEMM1_ALIGN>(P.lds, P.tid, ML_IN, ML_IN, S, E);
        } SEAM(pb + 1);
        if (IN(pb + 2)) for (int rep_ = 0; rep_ < NREPJ(2); ++rep_) { const Ctx P = fresh(C);
            { HOrder S{(const char*)P.w<bf16>(WS_W), (const char*)P.w<bf16>(WS_VTR), P.w<float>(WS_DEN), P.G, P.vcu};
              EpiH E{P.w<bf16>(WS_Q), P.w<bf16>(WS_K), P.w<float>(WS_DEN)};
              pg8::gemm_phase<EpiH, HOrder, true, false, true>(P.lds, P.tid, WLD, SEQ, S, E); }
            if (round + 1 < NROUND) { const Ctx P2 = fresh(C); INPROJ(P2, round + 1, rep_); }
        } SEAM(pb + 2);
        if (IN(pb + 3)) for (int rep_ = 0; rep_ < NREPJ(3); ++rep_) { const Ctx P = fresh(C); p_ynorm(P, round, rep_ != 0); } SEAM(pb + 3);
    }
#undef INPROJ
    if (IN(PH_OUT1)) for (int rep_ = 0; rep_ < NREP(PH_OUT1); ++rep_) { const Ctx P = fresh(C);
        pg8::PlainOrder S{(const char*)P.w<bf16>(WS_Y), (const char*)P.w<bf16>(WS_MLWOUTT), ML_IN, ML_IN, NT / 256, DM / 256, P.G, P.vcu, ML_IN / 64};
        pg8::EpiResid<false> E{xb, P.w<bf16>(WS_XB3), P.mods(1, 2)};
        pg8::gemm_phase<pg8::EpiResid<false>, pg8::PlainOrder, true>(P.lds, P.tid, ML_IN, ML_IN, S, E);
    } SEAM(PH_OUT1);
    if (IN(PH_ROUTE1)) for (int rep_ = 0; rep_ < NREP(PH_ROUTE1); ++rep_) { const Ctx P = fresh(C); p_route(P, 1, P.w<bf16>(WS_XB3), rep_ == 0); } SEAM(PH_ROUTE1);
    if (IN(PH_UP1)) for (int rep_ = 0; rep_ < NREP(PH_UP1); ++rep_) { const Ctx P = fresh(C); moe_up(P, 1); } SEAM(PH_UP1);
    if (IN(PH_DOWN1)) for (int rep_ = 0; rep_ < NREP(PH_DOWN1); ++rep_) { const Ctx P = fresh(C); moe_down(P, 1); } SEAM(PH_DOWN1);
    if (IN(PH_COMB1)) for (int rep_ = 0; rep_ < NREP(PH_COMB1); ++rep_) { const Ctx P = fresh(C); p_combine<true>(P, 1, P.w<bf16>(WS_XB3), rep_ == 0 ? (void*)xout : (void*)P.w<float>(WS_HS + 8 * MiB)); }
#undef IN
#undef SEAM
}

extern "C" void kernel_launch(void* const* d_in, const int* in_sizes, int n_in, void* d_out, int out_size, void* d_ws, size_t ws_size, hipStream_t stream) {
    static int grid = 0;
    if (grid == 0) {
        if (n_in != 32 || in_sizes[0] != NT * DM || out_size != NT * DM || ws_size < WS_END) { fprintf(stderr, "kernel_launch: unexpected shapes (n_in %d, in0 %d, out %d, ws %zu)\n", n_in, n_in > 0 ? in_sizes[0] : -1, out_size, ws_size); grid = -1; return; }
        int dev = 0, cus = 0, per_cu = 0;
        if (hipGetDevice(&dev) != hipSuccess || hipDeviceGetAttribute(&cus, hipDeviceAttributeMultiprocessorCount, dev) != hipSuccess) { grid = -1; return; }
        if (hipFuncSetAttribute((const void*)fwd_kernel, hipFuncAttributeMaxDynamicSharedMemorySize, LDS_BYTES) != hipSuccess) { fprintf(stderr, "kernel_launch: hipFuncSetAttribute failed\n"); grid = -1; return; }
        if (hipOccupancyMaxActiveBlocksPerMultiprocessor(&per_cu, (const void*)fwd_kernel, 512, LDS_BYTES) != hipSuccess || per_cu < 1) fprintf(stderr, "kernel_launch: occupancy query reports %d\n", per_cu);
        (void)hipGetLastError();
        grid = cus;
    }
    if (grid < 0) return;
    (void)hipMemsetAsync((char*)d_ws + WS_CTL, 0, CTL_ZERO_BYTES, stream);
    Args a{};
    for (int i = 0; i < 32; ++i) a.in[i] = (const float*)d_in[i];
    a.out = (float*)d_out; a.ws = (unsigned char*)d_ws;
#if MK_ONE_LAUNCH
    a.ph_lo = 0; a.ph_hi = N_PHASES;
    hipLaunchKernelGGL(fwd_kernel, dim3(grid), dim3(512), LDS_BYTES, stream, a);
#else
    for (int p = 0; p < N_PHASES; ++p) { a.ph_lo = p; a.ph_hi = p + 1; hipLaunchKernelGGL(fwd_kernel, dim3(grid), dim3(512), LDS_BYTES, stream, a); }
#endif
}
```

```cpp
#include <hip/hip_runtime.h>
#include <cstdio>
#include <cstdint>

#ifndef REP_ABL
#define REP_ABL 0
#endif
#ifndef GEMM1_STAGGER
#define GEMM1_STAGGER 0ull
#endif
#ifndef GEMM1_ALIGN
#define GEMM1_ALIGN true
#endif
#ifndef MK_ONE_LAUNCH
#define MK_ONE_LAUNCH 1
#endif

#define GAS __attribute__((address_space(1)))
#define LAS __attribute__((address_space(3)))
typedef unsigned short bf16;
typedef short bf16x8 __attribute__((ext_vector_type(8)));
typedef float f32x4 __attribute__((ext_vector_type(4)));
typedef float f32x16 __attribute__((ext_vector_type(16)));
typedef float f32x2 __attribute__((ext_vector_type(2)));
typedef unsigned u32x4 __attribute__((ext_vector_type(4)));
typedef unsigned u32x2 __attribute__((ext_vector_type(2)));

constexpr int NB = 16, SEQ = 2048, DM = 1024, NT = NB * SEQ;
constexpr int DA_H = 8;
constexpr int ML_IN = 2048, ML_H = 4, ML_DH = 512;
constexpr int NEXP = 32, DEXP = 256;
constexpr float EPS = 1e-6f;
constexpr float LOG2E = 1.4426950408889634f;
constexpr int RB = 4;
constexpr int NROUND = NB / RB;
constexpr int RT = RB * SEQ;
constexpr int WLD = 2304;
constexpr int MAXSLOT = 2 * NT + NEXP * 256;

constexpr size_t MiB = 1u << 20;
constexpr size_t WS_CTL = 0, CTL_ZERO_BYTES = 1 * MiB;
constexpr size_t WS_MODS = 2 * MiB;
constexpr size_t WS_TAB2 = 3 * MiB;
constexpr size_t WS_SCAL = 3 * MiB + 128 * 1024;
constexpr size_t WS_GWT = 3 * MiB + 256 * 1024;
constexpr size_t WS_RE = 4 * MiB;
constexpr size_t WS_RW = 4 * MiB + 256 * 1024;
constexpr size_t WS_RP = 4 * MiB + 512 * 1024;
constexpr size_t WS_RS = 4 * MiB + 768 * 1024;
constexpr size_t WS_PRE = 5 * MiB;
constexpr size_t WS_FG = 5 * MiB + 512 * 1024;
constexpr size_t WS_DEN = 6 * MiB;
constexpr size_t WS_WINT = 8 * MiB;
constexpr size_t WS_WOT = 14 * MiB;
constexpr size_t WS_MLWINT = 16 * MiB;
constexpr size_t WS_MLWOUTT = 24 * MiB;
constexpr size_t WS_W13T = 28 * MiB;
constexpr size_t WS_W2T = 60 * MiB;
constexpr size_t WS_BIG = 76 * MiB;
constexpr size_t WS_HM = WS_BIG + 0 * MiB;
constexpr size_t WS_QK = WS_BIG + 64 * MiB;
constexpr size_t WS_VT = WS_BIG + 192 * MiB;
constexpr size_t WS_O = WS_BIG + 256 * MiB;
constexpr size_t WS_HF = WS_BIG + 0 * MiB;
constexpr size_t WS_HS = WS_BIG + 64 * MiB;
constexpr size_t WS_TL = WS_BIG + 64 * MiB;
constexpr size_t WS_HH = WS_BIG + 208 * MiB;
constexpr size_t WS_YS = WS_BIG + 244 * MiB;
constexpr size_t WS_Y = WS_BIG + 0 * MiB;
constexpr size_t WS_W = WS_BIG + 128 * MiB;
constexpr size_t WS_HMR = WS_BIG + 128 * MiB;
constexpr size_t WS_XMH = WS_BIG + 272 * MiB;
constexpr size_t WS_XC = WS_BIG + 304 * MiB;
constexpr size_t WS_Q = WS_BIG + 336 * MiB;
constexpr size_t WS_K = WS_BIG + 368 * MiB;
constexpr size_t WS_VTR = WS_BIG + 400 * MiB;
constexpr size_t WS_XB3 = WS_BIG + 128 * MiB;
constexpr size_t WS_END = WS_BIG + 432 * MiB;
static_assert(WS_END <= 512 * MiB, "ws map");
static_assert((size_t)MAXSLOT * 1024 * 2 <= 144 * MiB && (size_t)MAXSLOT * 256 * 2 <= 36 * MiB, "slot buffers");
constexpr int CW_CNT = 64;
constexpr int CW_BAR = 4096;

constexpr int RING_BYTES = 131072;
constexpr int MISC_OFF = RING_BYTES;
constexpr int LDS_BYTES = RING_BYTES + 16384;

__device__ __forceinline__ unsigned f2bf(float f) { unsigned u = __builtin_bit_cast(unsigned, f); return (u + 0x7fffu + ((u >> 16) & 1u)) >> 16; }
__device__ __forceinline__ unsigned pk2(float lo, float hi) { unsigned r; asm("v_cvt_pk_bf16_f32 %0, %1, %2" : "=v"(r) : "v"(lo), "v"(hi)); return r; }
__device__ __forceinline__ float bf2f(unsigned short b) { return __builtin_bit_cast(float, ((unsigned)b) << 16); }
__device__ __forceinline__ float bflo(unsigned w) { return __builtin_bit_cast(float, w << 16); }
__device__ __forceinline__ float bfhi(unsigned w) { return __builtin_bit_cast(float, w & 0xffff0000u); }
__device__ __forceinline__ float wave_sum(float v) {
#pragma unroll
    for (int o = 1; o < 64; o <<= 1) v += __shfl_xor(v, o);
    return v;
}
__device__ __forceinline__ float silu_f(float v) { return v / (1.0f + __expf(-v)); }
#define LDS_WAIT() asm volatile("s_waitcnt lgkmcnt(0)" ::: "memory")
#define VM_WAIT() asm volatile("s_waitcnt vmcnt(0)" ::: "memory")
#define LDS_BARRIER() do { asm volatile("s_waitcnt lgkmcnt(0)" ::: "memory"); __builtin_amdgcn_s_barrier(); asm volatile("" ::: "memory"); } while (0)
__device__ __forceinline__ int opaque_v(int x) { asm volatile("" : "+v"(x)); return x; }
__device__ __forceinline__ int lane_id() { return (int)__builtin_amdgcn_mbcnt_hi(~0u, __builtin_amdgcn_mbcnt_lo(~0u, 0u)); }

namespace pg8 {
constexpr int BM = 256, BK = 64, HALF = 128, HTB = HALF * BK * 2, STAGE_BYTES = 8 * HTB;
static_assert(STAGE_BYTES == RING_BYTES, "stage region");
__host__ __device__ __forceinline__ int lds_byte(int r, int c) { const int st = (r >> 4) * 2 + (c >> 5), rr = r & 15, cc = c & 31, ob = rr * 64 + cc * 2; return st * 1024 + (ob ^ (((ob >> 9) & 1) << 5)); }
__host__ __device__ __forceinline__ void stage_rc(int b, int& R, int& C) { const int st = b / 1024, sb = b % 1024, swz = sb ^ (((sb >> 9) & 1) << 5); R = (st >> 1) * 16 + swz / 64; C = (st & 1) * 32 + (swz % 64) / 2; }
__host__ __device__ __forceinline__ int perm32(int rho) { const int n = rho >> 4, i = rho & 15; return 8 * (i >> 2) + 4 * n + (i & 3); }

struct Unit { const char* A; const char* B; int r0, c0, a0, a1, nt, flags; };

__device__ __forceinline__ unsigned cvt_pk_bf16(float lo, float hi) { unsigned r; asm volatile("v_cvt_pk_bf16_f32 %0, %1, %2" : "=v"(r) : "v"(lo), "v"(hi)); return r; }

template <class Epi, class Sched, bool ALIGN_EPI, bool GATHER = false, bool PAIR = false, bool BMAP = false>
__device__ __forceinline__ void gemm_phase(LAS unsigned char* lds, const int tid, const int lda, const int ldb, const Sched& S, const Epi& E) {
    const int wid = __builtin_amdgcn_readfirstlane(tid >> 6), lane = tid & 63, wr = wid >> 2, wc = wid & 3, fr = lane & 15, fq = lane >> 4;
    unsigned voffA[2], voffB[2]; int gR[2], gC[2];
#pragma unroll
    for (int i = 0; i < 2; ++i) { int R, C; stage_rc(tid * 16 + i * 8192, R, C); const int Rb = Epi::PERM ? ((R & ~31) + perm32(R & 31)) : R; gR[i] = R; gC[i] = C;
        voffA[i] = (unsigned)(R * lda + C) * 2u; voffB[i] = (unsigned)(Rb * ldb + C) * 2u; }
    unsigned vb[2][2];
    if constexpr (BMAP) {
#pragma unroll
        for (int h = 0; h < 2; ++h)
#pragma unroll
            for (int i = 0; i < 2; ++i) vb[h][i] = (unsigned)(S.brow(h, gR[i]) * ldb + gC[i]) * 2u; }
    unsigned cv[2][2], nv[2][2];
    const size_t kstep = (size_t)(BK * 2);
    const size_t hstepA = GATHER ? 0 : (size_t)HALF * lda * 2, hstepB = (size_t)HALF * ldb * 2;
    const unsigned ldsw = (unsigned)wid * 1024u;
    const int aoff = lds_byte(wr * 64 + fr, fq * 8), boff = lds_byte(wc * 32 + fr, fq * 8);
#define PG8_SA(b, h) (((b) * 2 + (h)) * HTB)
#define PG8_SB(b, h) ((4 + (b) * 2 + (h)) * HTB)
#define PG8_STAGE(bufoff, gbase, voff) do { _Pragma("unroll") for (int _i = 0; _i < 2; ++_i) \
        __builtin_amdgcn_global_load_lds((const unsigned*)((const char*)(gbase) + (voff)[_i]), (LAS unsigned*)(lds + (bufoff) + ldsw + _i * 8192), 16, 0, 0); } while (0)
#define PG8_STAGE_A(bufoff, gbase, h, nx) do { if constexpr (GATHER) { if (nx) PG8_STAGE(bufoff, gbase, nv[h]); else PG8_STAGE(bufoff, gbase, cv[h]); } else PG8_STAGE(bufoff, (gbase) + (h) * hstepA, voffA); } while (0)
#define PG8_STAGE_B(bufoff, gbase, h) do { if constexpr (BMAP) PG8_STAGE(bufoff, gbase, vb[h]); else PG8_STAGE(bufoff, (gbase) + (h) * hstepB, voffB); } while (0)
#define PG8_LDA(dst, b, h) do { _Pragma("unroll") for (int m = 0; m < 4; ++m) _Pragma("unroll") for (int k = 0; k < 2; ++k) dst[m][k] = *(const LAS bf16x8*)(lds + PG8_SA(b, h) + aoff + m * 2048 + k * 1024); } while (0)
#define PG8_LDB(dst, b, h) do { _Pragma("unroll") for (int n = 0; n < 2; ++n) _Pragma("unroll") for (int k = 0; k < 2; ++k) dst[n][k] = *(const LAS bf16x8*)(lds + PG8_SB(b, h) + boff + n * 2048 + k * 1024); } while (0)
#define PG8_MMA(ai, bj, At, Bt) do { __builtin_amdgcn_s_setprio(1); _Pragma("unroll") for (int m = 0; m < 4; ++m) _Pragma("unroll") for (int n = 0; n < 2; ++n) _Pragma("unroll") for (int k = 0; k < 2; ++k) \
        acc[ai][bj][m][n] = __builtin_amdgcn_mfma_f32_16x16x32_bf16(Bt[n][k], At[m][k], acc[ai][bj][m][n], 0, 0, 0); __builtin_amdgcn_s_setprio(0); } while (0)
#define PG8_WAIT_V(n) asm volatile("s_waitcnt vmcnt(" #n ")" ::: "memory")
#define PG8_WAIT_L(n) asm volatile("s_waitcnt lgkmcnt(" #n ")" ::: "memory")
#define PG8_BAR __builtin_amdgcn_s_barrier()
#define PG8_SCHED __builtin_amdgcn_sched_barrier(0)
    Unit cur, nxt; int ui = 0;
    if (!S.next(0, cur)) return;
    f32x4 acc[2][2][4][2];
#pragma unroll
    for (int a = 0; a < 2; ++a)
#pragma unroll
        for (int b = 0; b < 2; ++b)
#pragma unroll
            for (int m = 0; m < 4; ++m)
#pragma unroll
                for (int n = 0; n < 2; ++n) acc[a][b][m][n] = (f32x4){0.f, 0.f, 0.f, 0.f};
    bf16x8 At[4][2], B0[2][2], B1[2][2];
    const char* cA = cur.A; const char* cB = cur.B;
    if constexpr (GATHER) {
#pragma unroll
        for (int h = 0; h < 2; ++h)
#pragma unroll
            for (int i = 0; i < 2; ++i) cv[h][i] = S.arow(cur, h * HALF + gR[i]) + (unsigned)gC[i] * 2u; }
    {
        const char* b0 = cB + (size_t)S.kb(cur, 0) * kstep; const char* b1 = cB + (size_t)S.kb(cur, 1) * kstep;
        PG8_STAGE_B(PG8_SB(0, 0), b0, 0); PG8_STAGE_B(PG8_SB(0, 1), b0, 1); PG8_STAGE_A(PG8_SA(0, 0), cA, 0, false); PG8_STAGE_A(PG8_SA(0, 1), cA, 1, false);
        if (wr == 1) PG8_BAR;
        PG8_WAIT_V(2); PG8_BAR;
        PG8_STAGE_B(PG8_SB(1, 0), b1, 0); PG8_STAGE_A(PG8_SA(1, 0), cA + kstep, 0, false); PG8_STAGE_B(PG8_SB(1, 1), b1, 1);
        PG8_WAIT_V(6); PG8_BAR;
    }
    bool has_next; const char* nA; const char* nB;
#define PG8_UNIT_KLOOP() do { \
        has_next = S.next(ui + 1, nxt); \
        const Unit& nu = has_next ? nxt : cur; \
        if constexpr (GATHER) { \
            _Pragma("unroll") for (int h = 0; h < 2; ++h) _Pragma("unroll") for (int i = 0; i < 2; ++i) nv[h][i] = S.arow(nu, h * HALF + gR[i]) + (unsigned)gC[i] * 2u; } \
        nA = nu.A; nB = nu.B; \
        const int nt = cur.nt; \
        for (int t = 0; t < nt; t += 2) { \
            const bool last = (t == nt - 2); \
            const char* a1 = cA + (size_t)(t + 1) * kstep; \
            const char* a2 = last ? nA : cA + (size_t)(t + 2) * kstep; \
            const char* a3 = a2 + kstep; \
            const char* b2 = last ? nB + (size_t)S.kb(nu, 0) * kstep : cB + (size_t)S.kb(cur, t + 2) * kstep; \
            const char* b3 = last ? nB + (size_t)S.kb(nu, 1) * kstep : cB + (size_t)S.kb(cur, t + 3) * kstep; \
            PG8_LDB(B0, 0, 0); PG8_LDB(B1, 0, 1); PG8_SCHED; PG8_LDA(At, 0, 0); PG8_STAGE_A(PG8_SA(1, 1), a1, 1, false); \
            PG8_WAIT_V(8); PG8_WAIT_L(0); PG8_BAR; PG8_MMA(0, 0, At, B0); PG8_MMA(0, 1, At, B1); PG8_BAR; PG8_SCHED; \
            PG8_LDA(At, 0, 1); PG8_STAGE_B(PG8_SB(0, 0), b2, 0); PG8_STAGE_B(PG8_SB(0, 1), b2, 1); PG8_STAGE_A(PG8_SA(0, 0), a2, 0, last); \
            PG8_WAIT_V(8); PG8_WAIT_L(0); PG8_BAR; PG8_MMA(1, 0, At, B0); PG8_MMA(1, 1, At, B1); PG8_BAR; PG8_SCHED; \
            PG8_LDB(B0, 1, 0); PG8_LDB(B1, 1, 1); PG8_SCHED; PG8_LDA(At, 1, 0); PG8_STAGE_A(PG8_SA(0, 1), a2, 1, last); \
            PG8_WAIT_V(8); PG8_WAIT_L(0); PG8_BAR; PG8_MMA(0, 0, At, B0); PG8_MMA(0, 1, At, B1); PG8_BAR; PG8_SCHED; \
            PG8_LDA(At, 1, 1); PG8_STAGE_B(PG8_SB(1, 0), b3, 0); PG8_STAGE_B(PG8_SB(1, 1), b3, 1); PG8_STAGE_A(PG8_SA(1, 0), a3, 0, last); \
            PG8_WAIT_V(8); PG8_WAIT_L(0); PG8_BAR; PG8_MMA(1, 0, At, B0); PG8_MMA(1, 1, At, B1); PG8_BAR; PG8_SCHED; \
        } } while (0)
#define PG8_ADVANCE() do { cur = nxt; cA = nA; cB = nB; ++ui; \
        if constexpr (GATHER) { _Pragma("unroll") for (int h = 0; h < 2; ++h) _Pragma("unroll") for (int i = 0; i < 2; ++i) cv[h][i] = nv[h][i]; } } while (0)
    for (;;) {
        PG8_UNIT_KLOOP();
        if constexpr (PAIR) {
            S.between(cur, acc, wr);
            PG8_ADVANCE();
            PG8_UNIT_KLOOP();
        }
        if constexpr (ALIGN_EPI) { if (wr == 0) PG8_BAR; }
        E(acc, cur, wr, wc, fr, fq);
        if (!has_next) break;
#pragma unroll
        for (int a = 0; a < 2; ++a)
#pragma unroll
            for (int b = 0; b < 2; ++b)
#pragma unroll
                for (int m = 0; m < 4; ++m)
#pragma unroll
                    for (int n = 0; n < 2; ++n) acc[a][b][m][n] = (f32x4){0.f, 0.f, 0.f, 0.f};
        PG8_ADVANCE();
        if constexpr (ALIGN_EPI) { if (wr == 1) PG8_BAR; }
    }
#undef PG8_UNIT_KLOOP
#undef PG8_ADVANCE
    PG8_WAIT_V(0);
    if constexpr (!ALIGN_EPI) { if (wr == 0) PG8_BAR; }
    PG8_BAR;
#undef PG8_SA
#undef PG8_SB
#undef PG8_STAGE
#undef PG8_STAGE_A
#undef PG8_STAGE_B
#undef PG8_LDA
#undef PG8_LDB
#undef PG8_MMA
#undef PG8_WAIT_V
#undef PG8_WAIT_L
#undef PG8_BAR
#undef PG8_SCHED
}

struct PlainOrder {
    const char* A; const char* B; int lda, ldb, nM, nN, G, c, nt;
    __device__ __forceinline__ bool next(int i, Unit& u) const {
        const int L = i * G + c; if (L >= nM * nN) return false;
        const int pm = L / nN, pn = L - pm * nN;
        u.A = A + (size_t)pm * 256 * lda * 2; u.B = B + (size_t)pn * 256 * ldb * 2; u.r0 = pm * 256; u.c0 = pn * 256; u.a0 = 0; u.a1 = 0; u.nt = nt; u.flags = 3; return true;
    }
    __device__ __forceinline__ int kb(const Unit&, int t) const { return t; }
    __device__ __forceinline__ int brow(int h, int R) const { return 64 * (R >> 5) + 32 * h + perm32(R & 31); }
};
struct EpiBf16 {
    static constexpr bool PERM = true;
    bf16* O; int ldc; int split_cols; bf16* O2; int ldc2; int skip = 0;
    __device__ __forceinline__ void operator()(const f32x4 (&acc)[2][2][4][2], const Unit& u, int wr, int wc, int fr_, int fq_) const {
        (void)fr_; (void)fq_; const int ln_ = opaque_v(lane_id()); const int fr = ln_ & 15, fq = ln_ >> 4;
        bf16* base = O; int ld = ldc; int colt = u.c0;
        if (split_cols > 0 && colt >= split_cols) { base = O2; ld = ldc2; colt -= split_cols; }
        const int row0 = u.r0 + wr * 64 + fr, col0 = colt + wc * 32 + 8 * fq;
#pragma unroll
        for (int ai = 0; ai < 2; ++ai)
#pragma unroll
            for (int m = 0; m < 4; ++m) { bf16* rowp = base + (size_t)(row0 + ai * HALF + m * 16) * ld + col0;
#pragma unroll
                for (int bj = 0; bj < 2; ++bj) { const f32x4 v0 = acc[ai][bj][m][0], v1 = acc[ai][bj][m][1];
                    u32x4 w; w.x = cvt_pk_bf16(v0[0], v0[1]); w.y = cvt_pk_bf16(v0[2], v0[3]); w.z = cvt_pk_bf16(v1[0], v1[1]); w.w = cvt_pk_bf16(v1[2], v1[3]);
                    if (!((REP_ABL & 128) && skip)) *(u32x4*)(rowp + bj * HALF) = w; else if (w.x == 0x12345678u) *(u32x4*)(rowp) = w; } }
    }
};
template <bool XF32> struct EpiResid {
    static constexpr bool PERM = true;
    const void* xin; bf16* out; const float* gate;
    __device__ __forceinline__ void operator()(const f32x4 (&acc)[2][2][4][2], const Unit& u, int wr, int wc, int fr_, int fq_) const {
        (void)fr_; (void)fq_; const int ln_ = opaque_v(lane_id()); const int fr = ln_ & 15, fq = ln_ >> 4;
        const int row0 = u.r0 + wr * 64 + fr, col0 = u.c0 + wc * 32 + 8 * fq;
        const float* g = gate + (size_t)(u.r0 / SEQ) * 6144 + col0;
        f32x4 gv[2][2];
#pragma unroll
        for (int bj = 0; bj < 2; ++bj)
#pragma unroll
            for (int n = 0; n < 2; ++n) gv[bj][n] = *(const f32x4*)(g + bj * HALF + 4 * n);
#pragma unroll
        for (int ai = 0; ai < 2; ++ai)
#pragma unroll
            for (int m = 0; m < 4; ++m) { const size_t off = (size_t)(row0 + ai * HALF + m * 16) * DM + col0;
#pragma unroll
                for (int bj = 0; bj < 2; ++bj) { f32x4 x0, x1;
                    if (XF32) { x0 = *(const f32x4*)((const float*)xin + off + bj * HALF); x1 = *(const f32x4*)((const float*)xin + off + bj * HALF + 4); }
                    else { const u32x4 w = *(const u32x4*)((const bf16*)xin + off + bj * HALF); x0 = (f32x4){bflo(w.x), bfhi(w.x), bflo(w.y), bfhi(w.y)}; x1 = (f32x4){bflo(w.z), bfhi(w.z), bflo(w.w), bfhi(w.w)}; }
                    const f32x4 y0 = x0 + gv[bj][0] * acc[ai][bj][m][0], y1 = x1 + gv[bj][1] * acc[ai][bj][m][1];
                    u32x4 o; o.x = cvt_pk_bf16(y0[0], y0[1]); o.y = cvt_pk_bf16(y0[2], y0[3]); o.z = cvt_pk_bf16(y1[0], y1[1]); o.w = cvt_pk_bf16(y1[2], y1[3]);
                    *(u32x4*)(out + off + bj * HALF) = o; }
                if (m & 1) asm volatile("" ::: "memory"); }
    }
};
struct EpiQKNorm {
    static constexpr bool PERM = true;
    bf16* O; const float* qg; const float* kg;
    __device__ __forceinline__ void operator()(const f32x4 (&acc)[2][2][4][2], const Unit& u, int wr, int wc, int fr_, int fq_) const {
        (void)fr_; (void)fq_; const int ln_ = opaque_v(lane_id()); const int fr = ln_ & 15, fq = ln_ >> 4;
        const bool isq = u.c0 < 1024; const float* gain = (isq ? qg : kg) + 8 * fq; const float osc = isq ? 0.125f * LOG2E : 1.0f;
        f32x4 g[2][2];
#pragma unroll
        for (int bj = 0; bj < 2; ++bj)
#pragma unroll
            for (int n = 0; n < 2; ++n) g[bj][n] = *(const f32x4*)(gain + 32 * bj + 4 * n) * osc;
        const int row0 = u.r0 + wr * 64 + fr, col0 = u.c0 + wc * 64 + 8 * fq;
#pragma unroll
        for (int ai = 0; ai < 2; ++ai)
#pragma unroll
            for (int m = 0; m < 4; ++m) { f32x4 sv = (f32x4){0.f, 0.f, 0.f, 0.f};
#pragma unroll
                for (int bj = 0; bj < 2; ++bj) { sv += acc[ai][bj][m][0] * acc[ai][bj][m][0]; sv += acc[ai][bj][m][1] * acc[ai][bj][m][1]; }
                float s = (sv[0] + sv[1]) + (sv[2] + sv[3]);
                s += __shfl_xor(s, 16); s += __shfl_xor(s, 32);
                const float rs = 1.0f / sqrtf(s * (1.0f / 64.0f) + EPS);
                bf16* rowp = O + (size_t)(row0 + ai * HALF + m * 16) * 2048 + col0;
#pragma unroll
                for (int bj = 0; bj < 2; ++bj) { const f32x4 v0 = acc[ai][bj][m][0] * rs * g[bj][0], v1 = acc[ai][bj][m][1] * rs * g[bj][1];
                    u32x4 w; w.x = cvt_pk_bf16(v0[0], v0[1]); w.y = cvt_pk_bf16(v0[2], v0[3]); w.z = cvt_pk_bf16(v1[0], v1[1]); w.w = cvt_pk_bf16(v1[2], v1[3]);
                    *(u32x4*)(rowp + 32 * bj) = w; } }
    }
};
}

#define XB_TMO      128
#define XB_XCNT(j)  (256  + 64 * (j))
#define XB_XSUB(j)  (1280 + 64 * (j))
#define XB_XGEN(j)  (2304 + 64 * (j))
#define XB_TOP      3328
#define XB_TOPGEN   3392
#define XCD_BAR_WORDS 3456
#define XB_SPIN_CAP (1u << 18)
__device__ __forceinline__ unsigned xb_ld(unsigned* p)              { return __hip_atomic_load(p, __ATOMIC_RELAXED, __HIP_MEMORY_SCOPE_AGENT); }
__device__ __forceinline__ unsigned xb_add(unsigned* p, unsigned v) { return __hip_atomic_fetch_add(p, v, __ATOMIC_RELAXED, __HIP_MEMORY_SCOPE_AGENT); }
__device__ __forceinline__ unsigned xb_xcc_id() { return (unsigned)__builtin_amdgcn_s_getreg((3 << 11) | 20) & 0xFu; }
#define XB_SPIN(cond, bar) do { unsigned _sp = 0; while (cond) { __builtin_amdgcn_s_sleep(1); \
    if ((++_sp & 255u) == 0u) { if (xb_ld(&(bar)[XB_TMO])) break; if (_sp > XB_SPIN_CAP) { atomicAdd(&(bar)[XB_TMO], 1u); break; } } } } while (0)
struct XcdBarrier { unsigned* bar; unsigned x; volatile LAS unsigned* st; };
__device__ __forceinline__ XcdBarrier xcd_barrier_post(unsigned* bar, volatile LAS unsigned* st) {
    XcdBarrier b; b.bar = bar; b.x = xb_xcc_id(); b.st = st;
    if (threadIdx.x == 0) (void)xb_add(&bar[XB_XCNT(b.x)], 1u);
    return b;
}
__device__ __forceinline__ void xcd_barrier_complete(unsigned* bar, unsigned x, unsigned& nloc, unsigned& nx) {
    const unsigned G = gridDim.x * gridDim.y * gridDim.z;
    unsigned sum, cnt, mine, sp = 0u;
    for (;;) {
        sum = 0u; cnt = 0u; mine = 0u;
#pragma unroll
        for (unsigned j = 0; j < 16; ++j) { const unsigned c = xb_ld(&bar[XB_XCNT(j)]); sum += c; cnt += (c > 0u) ? 1u : 0u; mine = (j == x) ? c : mine; }
        if (sum == G) break;
        __builtin_amdgcn_s_sleep(1);
        if ((++sp & 255u) == 0u) { if (xb_ld(&bar[XB_TMO])) break; if (sp > XB_SPIN_CAP) { atomicAdd(&bar[XB_TMO], 1u); break; } }
    }
    nloc = mine > 0u ? mine : 1u; nx = cnt > 0u ? cnt : 1u;
}
__device__ __forceinline__ void xcd_barrier(const XcdBarrier& b) {
    asm volatile("s_waitcnt vmcnt(0)" ::: "memory");
    __syncthreads();
    if (threadIdx.x == 0) {
        unsigned* bar = b.bar;
        __builtin_amdgcn_s_waitcnt(0);
        unsigned nloc = b.st[0], nx = b.st[1];
        if (nloc == 0u) { xcd_barrier_complete(bar, b.x, nloc, nx); b.st[0] = nloc; b.st[1] = nx; }
        const unsigned old = xb_add(&bar[XB_XSUB(b.x)], 1u);
        const unsigned gen = old / nloc;
        if (old + 1u == (gen + 1u) * nloc) {
            __builtin_amdgcn_fence(__ATOMIC_RELEASE, "agent");
            asm volatile("s_waitcnt vmcnt(0)" ::: "memory");
            const unsigned og = xb_add(&bar[XB_TOP], 1u);
            const unsigned tg = og / nx;
            if (og + 1u == (tg + 1u) * nx) xb_add(&bar[XB_TOPGEN], 1u);
            else XB_SPIN(xb_ld(&bar[XB_TOPGEN]) == tg, bar);
            __builtin_amdgcn_fence(__ATOMIC_ACQUIRE, "agent");
            xb_add(&bar[XB_XGEN(b.x)], 1u);
            asm volatile("s_waitcnt vmcnt(0)" ::: "memory");
        } else {
            XB_SPIN(xb_ld(&bar[XB_XGEN(b.x)]) == gen, bar);
            __builtin_amdgcn_fence(__ATOMIC_ACQUIRE, "agent");
            asm volatile("s_waitcnt vmcnt(0)" ::: "memory");
        }
    }
    __syncthreads();
}

struct Args { const float* in[32]; float* out; unsigned char* ws; int ph_lo, ph_hi; };
enum { IN_X = 0, IN_C, IN_REL, IN_ADAW, IN_ADAB, IN_NMG, IN_NFG, IN_DAWIN, IN_DAWOUT, IN_QG, IN_KG, IN_LQ1, IN_LK1, IN_LQ2, IN_LK2, IN_SUBLN,
       IN_MLWIN, IN_CONVW, IN_CONVB, IN_WQ, IN_WK, IN_WV, IN_GATEW, IN_GATEB, IN_ONG, IN_SKIP, IN_MLWOUT, IN_WGRP, IN_WRT, IN_W1, IN_W3, IN_W2 };

struct Ctx {
    const Args* a; GAS unsigned char* ws; LAS unsigned char* lds; int tid, lane, wave, G, vcu;
    __device__ __forceinline__ const float* in(int i) const { return (const float*)(const GAS float*)a->in[i]; }
    template <class Tp> __device__ __forceinline__ Tp* w(size_t off) const { return (Tp*)(GAS Tp*)(ws + off); }
    __device__ __forceinline__ float* xout() const { return (float*)(GAS float*)a->out; }
    __device__ __forceinline__ const float* mods(int layer, int which) const { return (const float*)(ws + WS_MODS) + (size_t)layer * 16 * 6144 + which * 1024; }
};

__device__ __forceinline__ Ctx fresh(const Ctx& C) {
    Ctx P = C; int t = C.tid; asm volatile("" : "+v"(t)); P.tid = t; P.lane = t & 63; P.wave = __builtin_amdgcn_readfirstlane(t >> 6);
    GAS unsigned char* w = C.ws; asm volatile("" : "+s"(w)); P.ws = w; int g = __builtin_amdgcn_readfirstlane(C.G), v = __builtin_amdgcn_readfirstlane(C.vcu); asm volatile("" : "+s"(g), "+s"(v)); P.G = g; P.vcu = v;
    return P;
}
__device__ __forceinline__ void transpose_item(const float* W, int K, int N, bf16* WT, int ldt, int dst_row0, LAS float* scr, int kb, int nb, int lane) {
    const int k0 = 64 * kb, n0 = 32 * nb;
#pragma unroll 8
    for (int i = 0; i < 32; ++i) { const int kk = 2 * i + (lane >> 5); scr[kk * 33 + (lane & 31)] = W[(size_t)(k0 + kk) * N + n0 + (lane & 31)]; }
    LDS_WAIT(); asm volatile("" ::: "memory");
    const int c = lane & 7;
#pragma unroll
    for (int j = 0; j < 4; ++j) { const int n = (lane >> 3) + 8 * j; const LAS float* s = scr + (8 * c) * 33 + n;
        u32x4 o; o.x = pk2(s[0 * 33], s[1 * 33]); o.y = pk2(s[2 * 33], s[3 * 33]); o.z = pk2(s[4 * 33], s[5 * 33]); o.w = pk2(s[6 * 33], s[7 * 33]);
        *(u32x4*)(WT + (size_t)(dst_row0 + n) * ldt + k0 + 8 * c) = o; }
    LDS_WAIT(); asm volatile("" ::: "memory");
}
__device__ __forceinline__ void moe_weight_items(const Ctx& C, int layer, LAS float* scr) {
    const int gw = C.vcu * 8 + C.wave, NGW = C.G * 8;
    const float* w1 = C.in(IN_W1) + (size_t)layer * NEXP * DM * DEXP; const float* w3 = C.in(IN_W3) + (size_t)layer * NEXP * DM * DEXP; const float* w2 = C.in(IN_W2) + (size_t)layer * NEXP * DEXP * DM;
    bf16* W13T = C.w<bf16>(WS_W13T); bf16* W2T = C.w<bf16>(WS_W2T);
    constexpr int I13 = 16 * 8, I2 = 4 * 32;
    for (int it = gw; it < NEXP * (2 * I13 + I2); it += NGW) {
        const int e = it / (2 * I13 + I2); int r = it - e * (2 * I13 + I2);
        if (r < 2 * I13) { const int which = r / I13; r -= which * I13; const int kb = r / 8, nb = r % 8; const int n0 = 32 * nb;
            const int dst = (n0 / 128) * 256 + which * 128 + (n0 % 128);
            transpose_item((which ? w3 : w1) + (size_t)e * DM * DEXP, DM, DEXP, W13T + (size_t)e * 512 * DM, DM, dst, scr, kb, nb, C.lane); }
        else { r -= 2 * I13; const int kb = r / 32, nb = r % 32;
            transpose_item(w2 + (size_t)e * DEXP * DM, DEXP, DM, W2T + (size_t)e * DM * DEXP, DEXP, 32 * nb, scr, kb, nb, C.lane); }
    }
}
__device__ __forceinline__ void plain_weight_items(const Ctx& C, const float* W, int K, int N, bf16* WT, LAS float* scr) {
    const int gw = C.vcu * 8 + C.wave, NGW = C.G * 8; const int nblk = N / 32;
    for (int it = gw; it < (K / 64) * nblk; it += NGW) { const int kb = it / nblk, nb = it % nblk; transpose_item(W, K, N, WT, K, 32 * nb, scr, kb, nb, C.lane); }
}
__device__ __forceinline__ int t5_bucket(int rel) {
    const int n = rel < 0 ? -rel : rel; int b;
    if (n < 8) b = n; else b = 8 + (n >= 12) + (n >= 16) + (n >= 23) + (n >= 32) + (n >= 46) + (n >= 64) + (n >= 91);
    return b + (rel > 0 ? 16 : 0);
}
__device__ __forceinline__ void p_prologue(const Ctx& C) {
    __syncthreads();
    {
        LAS float* cact = (LAS float*)C.lds;
        LAS float* red = (LAS float*)(C.lds + 65536);
        const float* c = C.in(IN_C);
        for (int i = C.tid; i < 16 * 1024; i += 512) cact[i] = silu_f(c[i]);
        __syncthreads();
        for (int task = C.vcu; task < 192; task += C.G) {
            const int layer = task / 96, n0 = (task % 96) * 64, nl = C.tid & 63, kc = C.tid >> 6;
            const float* W = C.in(IN_ADAW) + (size_t)layer * DM * 6144 + n0 + nl;
            float acc[16];
#pragma unroll
            for (int b = 0; b < 16; ++b) acc[b] = 0.f;
            for (int k = kc * 128; k < kc * 128 + 128; ++k) { const float wv = W[(size_t)k * 6144];
#pragma unroll
                for (int b = 0; b < 16; ++b) acc[b] += cact[b * 1024 + k] * wv; }
#pragma unroll
            for (int b = 0; b < 16; ++b) red[(kc * 16 + b) * 64 + nl] = acc[b];
            __syncthreads();
            for (int o = C.tid; o < 16 * 64; o += 512) { const int b = o >> 6, n = o & 63; float s = 0.f;
#pragma unroll
                for (int q = 0; q < 8; ++q) s += red[(q * 16 + b) * 64 + n];
                C.w<float>(WS_MODS)[(size_t)layer * 16 * 6144 + (size_t)b * 6144 + n0 + n] = s + C.in(IN_ADAB)[layer * 6144 + n0 + n]; }
            __syncthreads();
        }
    }
    {
        const int gt = C.vcu * 512 + C.tid, NGT = C.G * 512;
        float mq = 0.f, mk = 0.f;
        for (int i = 0; i < 64; ++i) { mq = fmaxf(mq, fabsf(C.in(IN_QG)[i])); mk = fmaxf(mk, fabsf(C.in(IN_KG)[i])); }
        for (int i = gt; i < 8 * 4096; i += NGT) { const int h = i >> 12, idx = i & 4095; if (idx < 4095) {
            float mb = -1e30f; for (int b = 0; b < 32; ++b) mb = fmaxf(mb, C.in(IN_REL)[b * 8 + h]);
            const float cshift = 8.0f * mq * mk + mb;
            C.w<float>(WS_TAB2)[i] = (C.in(IN_REL)[t5_bucket(idx - 2047) * 8 + h] - cshift) * LOG2E; } else C.w<float>(WS_TAB2)[i] = 0.f; }
        if (gt == 0) { float s1 = 0.f, s2 = 0.f; for (int i = 0; i < 64; ++i) { s1 += C.in(IN_LQ1)[i] * C.in(IN_LK1)[i]; s2 += C.in(IN_LQ2)[i] * C.in(IN_LK2)[i]; }
            C.w<float>(WS_SCAL)[0] = __expf(s1) - __expf(s2) + 0.2f; }
        for (int i = gt; i < 16 * 6144; i += NGT) { const int n = i / 6144, k = i % 6144, d = n >> 3, g = n & 7, m = k / 2048, c = k % 2048;
            C.w<bf16>(WS_GWT)[i] = (bf16)f2bf(C.in(IN_GATEW)[(((size_t)d * 3 + m) * 2048 + c) * 8 + g]); }
    }
    LAS float* scr = (LAS float*)(C.lds + C.wave * 16384);
    plain_weight_items(C, C.in(IN_DAWIN), DM, 3 * DM, C.w<bf16>(WS_WINT), scr);
    plain_weight_items(C, C.in(IN_DAWOUT), DM, DM, C.w<bf16>(WS_WOT), scr);
    plain_weight_items(C, C.in(IN_MLWIN), DM, 2 * ML_IN, C.w<bf16>(WS_MLWINT), scr);
    plain_weight_items(C, C.in(IN_MLWOUT), ML_IN, DM, C.w<bf16>(WS_MLWOUTT), scr);
    moe_weight_items(C, 0, scr);
}

__device__ __forceinline__ void normmod_row(const float* xrow, const float* g, const float* sc, const float* sh, bf16* orow, int lane) {
    const f32x4* xr = (const f32x4*)xrow + lane; f32x4 v[4]; float s = 0.f;
#pragma unroll
    for (int j = 0; j < 4; ++j) { v[j] = xr[64 * j]; s += (v[j].x * v[j].x + v[j].y * v[j].y) + (v[j].z * v[j].z + v[j].w * v[j].w); }
    const float rstd = 1.0f / sqrtf(wave_sum(s) * (1.0f / DM) + EPS);
    u32x2* o8 = (u32x2*)orow + lane;
#pragma unroll
    for (int j = 0; j < 4; ++j) { const f32x4 gv = ((const f32x4*)g)[lane + 64 * j], scv = ((const f32x4*)sc)[lane + 64 * j], shv = ((const f32x4*)sh)[lane + 64 * j];
        const f32x4 y = (v[j] * rstd * gv) * (scv + 1.0f) + shv; u32x2 w; w.x = pk2(y.x, y.y); w.y = pk2(y.z, y.w); o8[64 * j] = w; }
}
__device__ __forceinline__ void normmod_row_bf(const bf16* xrow, const float* g, const float* sc, const float* sh, bf16* orow, int lane) {
    float v[2][8]; float s = 0.f;
#pragma unroll
    for (int j = 0; j < 2; ++j) { const u32x4 w = *((const u32x4*)(xrow + 512 * j) + lane);
        v[j][0] = bflo(w.x); v[j][1] = bfhi(w.x); v[j][2] = bflo(w.y); v[j][3] = bfhi(w.y); v[j][4] = bflo(w.z); v[j][5] = bfhi(w.z); v[j][6] = bflo(w.w); v[j][7] = bfhi(w.w);
#pragma unroll
        for (int i = 0; i < 8; ++i) s += v[j][i] * v[j][i]; }
    const float rstd = 1.0f / sqrtf(wave_sum(s) * (1.0f / DM) + EPS);
#pragma unroll
    for (int j = 0; j < 2; ++j) { const int c = 512 * j + 8 * lane; float y[8];
#pragma unroll
        for (int i = 0; i < 8; ++i) y[i] = (v[j][i] * rstd * g[c + i]) * (sc[c + i] + 1.0f) + sh[c + i];
        u32x4 w; w.x = pk2(y[0], y[1]); w.y = pk2(y[2], y[3]); w.z = pk2(y[4], y[5]); w.w = pk2(y[6], y[7]);
        *((u32x4*)(orow + 512 * j) + lane) = w; }
}
__device__ __forceinline__ void p_normmod_bf(const Ctx& C, const bf16* xsrc, int layer, int row_lo, int row_hi, bf16* dst) {
    const int gw = C.vcu * 8 + C.wave, NGW = C.G * 8;
    const float* g = C.in(IN_NMG) + layer * DM;
    for (int r = row_lo + gw; r < row_hi; r += NGW) { const int b = r / SEQ;
        normmod_row_bf(xsrc + (size_t)r * DM, g, C.mods(layer, 1) + (size_t)b * 6144, C.mods(layer, 0) + (size_t)b * 6144, dst + (size_t)(r - row_lo) * DM, C.lane); }
}
__device__ __forceinline__ void p_normmod(const Ctx& C, const float* xsrc, int layer, int row_lo, int row_hi, bf16* dst) {
    const int gw = C.vcu * 8 + C.wave, NGW = C.G * 8;
    const float* g = C.in(IN_NMG) + layer * DM;
    for (int r = row_lo + gw; r < row_hi; r += NGW) { const int b = r / SEQ;
        normmod_row(xsrc + (size_t)r * DM, g, C.mods(layer, 1) + (size_t)b * 6144, C.mods(layer, 0) + (size_t)b * 6144, dst + (size_t)(r - row_lo) * DM, C.lane); }
}

constexpr int AT_KS = 144, AT_VS = 144;
constexpr int AT_K_BYTES = 2 * 64 * AT_KS, AT_V_BYTES = 128 * AT_VS, AT_BUF = AT_K_BYTES + AT_V_BYTES;
constexpr int AT_TAB_OFF = 3 * AT_BUF;
constexpr int AT_EX_OFF = 0, AT_EX_PITCH = 132;
static_assert(AT_BUF % 16 == 0 && AT_TAB_OFF + 16384 <= RING_BYTES && 4 * 32 * AT_EX_PITCH * 4 <= AT_TAB_OFF, "attention LDS");
template <int ABL> __device__ __forceinline__ void attn_unit(const Ctx& C, int b, int h, int qt, bool load_tab, float lam) {
    LAS unsigned char* lds = C.lds;
    const int tid = C.tid, lane = C.lane, wid = C.wave, mp = wid >> 2, rb = wid & 3, r32 = lane & 31, hi = lane >> 5;
    const bf16* QK = C.w<bf16>(WS_QK); const bf16* VT = C.w<bf16>(WS_VT);
    const size_t tok0 = (size_t)b * SEQ; const int q0 = qt * 128, qa = q0 + 32 * rb;
    LAS float* tab = (LAS float*)(lds + AT_TAB_OFF);
    __syncthreads();
    if (load_tab) { const float* t2 = C.w<float>(WS_TAB2) + h * 4096; for (int i = tid; i < 4096; i += 512) tab[i] = t2[i]; }
    bf16x8 qf[4];
    { const bf16* qrow = QK + (tok0 + qa + r32) * 2048 + h * 128 + mp * 64 + hi * 8;
#pragma unroll
      for (int ks = 0; ks < 4; ++ks) qf[ks] = *(const bf16x8*)(qrow + ks * 16);
      asm volatile("" : "+v"(qf[0]), "+v"(qf[1]), "+v"(qf[2]), "+v"(qf[3])); }
    const int kkey = tid >> 4, kcc = tid & 15, vdv = tid >> 3, vkc = tid & 7;
    const bf16* ksrc = QK + (tok0 + kkey) * 2048 + 1024 + h * 128 + kcc * 8;
    const bf16* vsrc = VT + (size_t)(h * 128 + vdv) * NT + tok0 + vkc * 8;
    const int kdst = ((kcc >> 3) * 64 + kkey) * AT_KS + (kcc & 7) * 16;
    const int vdst = AT_K_BYTES + vdv * AT_VS + (vkc >> 1) * 32 + (vkc & 1) * 8;
    u32x4 kst[2], vst[2];
#define AT_LOAD(t) do { const int k0_ = (t) * 64; kst[0] = *(const u32x4*)(ksrc + (size_t)k0_ * 2048); kst[1] = *(const u32x4*)(ksrc + (size_t)(k0_ + 32) * 2048); \
        vst[0] = *(const u32x4*)(vsrc + k0_); vst[1] = *(const u32x4*)(vsrc + (size_t)64 * NT + k0_); } while (0)
#define AT_WRITE(bufo) do { _Pragma("unroll") for (int i_ = 0; i_ < 2; ++i_) { *(LAS u32x4*)(lds + (bufo) + kdst + 32 * i_ * AT_KS) = kst[i_]; \
        LAS u32x2* vd_ = (LAS u32x2*)(lds + (bufo) + vdst + 64 * i_ * AT_VS); vd_[0] = (u32x2){vst[i_].x, vst[i_].y}; vd_[2] = (u32x2){vst[i_].z, vst[i_].w}; } } while (0)
    const int kfo = (mp * 64 + r32) * AT_KS + hi * 16;
    const int vfo = AT_K_BYTES + r32 * AT_VS + hi * 16;
    f32x16 o[4];
#pragma unroll
    for (int i = 0; i < 4; ++i) o[i] = (f32x16){0.f, 0.f, 0.f, 0.f, 0.f, 0.f, 0.f, 0.f, 0.f, 0.f, 0.f, 0.f, 0.f, 0.f, 0.f, 0.f};
    f32x2 lacc = (f32x2){0.f, 0.f};
    bf16x8 pf[4];

#define AT_SOFT(t, bo) do { const int k0_ = (t) * 64; const int dlo_ = k0_ - qa - 31, dhi_ = k0_ + 63 - qa; \
        const bool cst_ = (dhi_ <= -91) || (dlo_ >= 91); const float ini_ = (dhi_ <= -91) ? c_neg : ((dlo_ >= 91) ? c_pos : 0.f); \
        bf16x8 kf_[2][4]; \
        _Pragma("unroll") for (int kb_ = 0; kb_ < 2; ++kb_) _Pragma("unroll") for (int ks_ = 0; ks_ < 4; ++ks_) kf_[kb_][ks_] = *(const LAS bf16x8*)(lds + (bo) + kfo + kb_ * 32 * AT_KS + ks_ * 32); \
        f32x16 s0_, s1_; \
        _Pragma("unroll") for (int r_ = 0; r_ < 16; ++r_) { s0_[r_] = ini_; s1_[r_] = ini_; } \
        if (!(ABL & 16)) { _Pragma("unroll") for (int ks_ = 0; ks_ < 4; ++ks_) { s0_ = __builtin_amdgcn_mfma_f32_32x32x16_bf16(kf_[0][ks_], qf[ks_], s0_, 0, 0, 0); s1_ = __builtin_amdgcn_mfma_f32_32x32x16_bf16(kf_[1][ks_], qf[ks_], s1_, 0, 0, 0); } } \
        else { _Pragma("unroll") for (int ks_ = 0; ks_ < 4; ++ks_) { s0_[ks_] += __builtin_bit_cast(float, kf_[0][ks_][0] + kf_[0][ks_][1]); s1_[ks_] += __builtin_bit_cast(float, kf_[1][ks_][0] + kf_[1][ks_][1]); } } \
        _Pragma("unroll") for (int kb_ = 0; kb_ < 2; ++kb_) { f32x16 s_ = kb_ ? s1_ : s0_; \
            if (!cst_) { const LAS float* tp_ = tab + (k0_ + 32 * kb_ + 4 * hi - (qa + r32) + 2047); _Pragma("unroll") for (int r_ = 0; r_ < 16; ++r_) s_[r_] += tp_[(r_ & 3) + 8 * (r_ >> 2)]; } \
            float p_[16]; \
            _Pragma("unroll") for (int r_ = 0; r_ < 16; ++r_) p_[r_] = (ABL & 1) ? s_[r_] : __builtin_amdgcn_exp2f(s_[r_]); \
            _Pragma("unroll") for (int r_ = 0; r_ < 16; r_ += 2) lacc += (f32x2){p_[r_], p_[r_ + 1]}; \
            _Pragma("unroll") for (int sh_ = 0; sh_ < 2; ++sh_) { u32x4 w_; w_.x = pk2(p_[8 * sh_ + 0], p_[8 * sh_ + 1]); w_.y = pk2(p_[8 * sh_ + 2], p_[8 * sh_ + 3]); w_.z = pk2(p_[8 * sh_ + 4], p_[8 * sh_ + 5]); w_.w = pk2(p_[8 * sh_ + 6], p_[8 * sh_ + 7]); \
                pf[2 * kb_ + sh_] = __builtin_bit_cast(bf16x8, w_); } } } while (0)
#define AT_PV(bo) do { _Pragma("unroll") for (int hb_ = 0; hb_ < 2; ++hb_) { u32x4 vf_[8]; \
        _Pragma("unroll") for (int i_ = 0; i_ < 8; ++i_) { const int dvb_ = 2 * hb_ + (i_ >> 2), s4_ = i_ & 3; vf_[i_] = *(const LAS u32x4*)(lds + (bo) + vfo + dvb_ * 32 * AT_VS + s4_ * 32); } \
        if (!(ABL & 2)) { _Pragma("unroll") for (int i_ = 0; i_ < 8; ++i_) o[2 * hb_ + (i_ >> 2)] = __builtin_amdgcn_mfma_f32_32x32x16_bf16(__builtin_bit_cast(bf16x8, vf_[i_]), pf[i_ & 3], o[2 * hb_ + (i_ >> 2)], 0, 0, 0); } \
        else { _Pragma("unroll") for (int i_ = 0; i_ < 8; ++i_) o[2 * hb_ + (i_ >> 2)][i_] += __builtin_bit_cast(float, vf_[i_].x ^ vf_[i_].y ^ vf_[i_].z ^ vf_[i_].w) + __builtin_bit_cast(float, __builtin_bit_cast(u32x4, pf[i_ & 3]).x); } } } while (0)
    AT_LOAD(0); AT_WRITE(0); AT_LOAD(1);
    __syncthreads();
    const float c_neg = tab[1000], c_pos = tab[3000];
    int b_prv = 2 * AT_BUF, b_cur = 0, b_nxt = AT_BUF;
#pragma nounroll
    for (int t = 0; t <= 32; ++t) {
        if (t + 1 < 32 && (!(ABL & 4) || t < 2)) AT_WRITE(b_nxt);
        if (t + 2 < 32 && (!(ABL & 4) || t < 2)) AT_LOAD(t + 2);
        if (mp == 0) { if (t < 32) AT_SOFT(t, b_cur); }
        else { if (t >= 1) AT_PV(b_prv); }
        if (!(ABL & 8)) __syncthreads();
        if (mp == 0) { if (t < 32) AT_PV(b_cur); }
        else { if (t < 32) AT_SOFT(t, b_cur); }
        { const int tmp = b_prv; b_prv = b_cur; b_cur = b_nxt; b_nxt = tmp; }
        if (!(ABL & 8)) __syncthreads();
    }
#undef AT_LOAD
#undef AT_WRITE
#undef AT_SOFT
#undef AT_PV
    float lsum = lacc.x + lacc.y;
    lsum += __shfl_xor(lsum, 32);
    const float sc = (mp == 0 ? 1.0f : lam) / lsum;
    LAS float* ex = (LAS float*)(lds + AT_EX_OFF) + (rb * 32 + r32) * AT_EX_PITCH;
    if (mp == 1) {
#pragma unroll
        for (int dvb = 0; dvb < 4; ++dvb)
#pragma unroll
            for (int g = 0; g < 4; ++g) *(LAS f32x4*)(ex + dvb * 32 + 8 * g + 4 * hi) = (f32x4){o[dvb][4 * g] * sc, o[dvb][4 * g + 1] * sc, o[dvb][4 * g + 2] * sc, o[dvb][4 * g + 3] * sc};
    }
    __syncthreads();
    if (mp == 0) {
        float ss = 0.f;
#pragma unroll
        for (int dvb = 0; dvb < 4; ++dvb)
#pragma unroll
            for (int g = 0; g < 4; ++g) { const f32x4 e = *(const LAS f32x4*)(ex + dvb * 32 + 8 * g + 4 * hi);
#pragma unroll
                for (int i = 0; i < 4; ++i) { const float v = o[dvb][4 * g + i] * sc - e[i]; o[dvb][4 * g + i] = v; ss += v * v; } }
        ss += __shfl_xor(ss, 32);
        const float rs = (1.0f / sqrtf(ss * (1.0f / 128.0f) + EPS)) * 0.8f;
        bf16* orow = C.w<bf16>(ABL ? WS_HM : WS_O) + (tok0 + qa + r32) * DM + h * 128;
        const float* sg = C.in(IN_SUBLN);
#pragma unroll
        for (int dvb = 0; dvb < 4; ++dvb)
#pragma unroll
            for (int g = 0; g < 4; ++g) { const int dv = dvb * 32 + 8 * g + 4 * hi; const f32x4 gv = *(const f32x4*)(sg + dv);
                u32x2 w; w.x = pk2(o[dvb][4 * g] * rs * gv.x, o[dvb][4 * g + 1] * rs * gv.y); w.y = pk2(o[dvb][4 * g + 2] * rs * gv.z, o[dvb][4 * g + 3] * rs * gv.w);
                *(u32x2*)(orow + dv) = w; }
    }
}
template <int ABL> __device__ __forceinline__ void p_attention(const Ctx& C) {
    int last_h = -1; const float lam = C.w<float>(WS_SCAL)[0];
    for (int w = C.vcu; w < NB * DA_H * 2; w += C.G) { const int bh = w >> 1, half = w & 1, h = bh & 7;
        for (int i = 0; i < 8; ++i) { attn_unit<ABL>(C, bh >> 3, h, half * 8 + i, h != last_h, lam); last_h = h; } }
    __syncthreads();
}

constexpr int RT_CH = 128, RT_IMG = RT_CH * 16 * 16;
__device__ __forceinline__ void p_route(const Ctx& C, int layer, const bf16* x, bool commit = true) {
    const int lane = C.lane, tid = C.tid, tok = lane & 15, kq = lane >> 4;
    const float* g = C.in(IN_NFG) + layer * DM;
    const float* wr_ = C.in(IN_WRT) + (size_t)layer * DM * 32; const float* wg_ = C.in(IN_WGRP) + (size_t)layer * DM * 4;
    unsigned* cnt = C.w<unsigned>(WS_CTL) + CW_CNT + layer * 64;
    LAS float* lg = (LAS float*)(C.lds + 2 * RT_IMG) + C.wave * (16 * 48);
    bf16* HF = C.w<bf16>(WS_HF);
    const int sk = tid >> 2, sn = (tid & 3) * 4;
    f32x4 st0, st1, st2;
#define RT_LOAD(c) do { const int k_ = (c) * RT_CH + sk; st0 = *(const f32x4*)(wr_ + k_ * 32 + sn); st1 = *(const f32x4*)(wr_ + k_ * 32 + 16 + sn); st2 = (sn == 0) ? *(const f32x4*)(wg_ + k_ * 4) : (f32x4){0.f, 0.f, 0.f, 0.f}; } while (0)
#define RT_WRITE(bo) do { LAS f32x4* d_ = (LAS f32x4*)(C.lds + (bo)) + sk * 16 + sn; d_[0] = (f32x4){st0[0], st1[0], st2[0], 0.f}; d_[1] = (f32x4){st0[1], st1[1], st2[1], 0.f}; d_[2] = (f32x4){st0[2], st1[2], st2[2], 0.f}; d_[3] = (f32x4){st0[3], st1[3], st2[3], 0.f}; } while (0)
    for (int ts = C.vcu; ts < NT / 128; ts += C.G) {
        const int t0 = ts * 128 + C.wave * 16, b = t0 / SEQ;
        const bf16* xrow = x + (size_t)(t0 + tok) * DM + 4 * kq;
        __syncthreads();
        RT_LOAD(0);
        float ss = 0.f;
#pragma unroll 8
        for (int kk = 0; kk < 64; ++kk) { const u32x2 w = *(const u32x2*)(xrow + 16 * kk); const f32x4 v = (f32x4){bflo(w.x), bfhi(w.x), bflo(w.y), bfhi(w.y)}; ss += (v.x * v.x + v.y * v.y) + (v.z * v.z + v.w * v.w); }
        ss += __shfl_xor(ss, 16); ss += __shfl_xor(ss, 32);
        const float rstd = 1.0f / sqrtf(ss * (1.0f / DM) + EPS);
        const float* sc = C.mods(layer, 4) + (size_t)b * 6144 + 4 * kq; const float* sh = C.mods(layer, 3) + (size_t)b * 6144 + 4 * kq;
        f32x4 a0 = (f32x4){0.f, 0.f, 0.f, 0.f}, a1 = a0, a2 = a0;
        bf16* hrow = HF + (size_t)(t0 + tok) * DM + 4 * kq;
        RT_WRITE(0);
        for (int c = 0; c < DM / RT_CH; ++c) {
            const int bo = (c & 1) * RT_IMG;
            __syncthreads();
            if (c + 1 < DM / RT_CH) RT_LOAD(c + 1);
            const LAS f32x4* bimg = (const LAS f32x4*)(C.lds + bo) + (4 * kq) * 16 + tok;
#pragma unroll
            for (int half = 0; half < 2; ++half) {
                f32x4 hfv[4];
#pragma unroll
                for (int q = 0; q < 4; ++q) { const int kk = c * 8 + half * 4 + q;
                    const u32x2 xw2 = *(const u32x2*)(xrow + 16 * kk); const f32x4 v = (f32x4){bflo(xw2.x), bfhi(xw2.x), bflo(xw2.y), bfhi(xw2.y)};
                    const f32x4 gv = *(const f32x4*)(g + 16 * kk + 4 * kq), scv = *(const f32x4*)(sc + 16 * kk), shv = *(const f32x4*)(sh + 16 * kk);
                    hfv[q] = (v * rstd * gv) * (scv + 1.0f) + shv;
                    u32x2 w; w.x = pk2(hfv[q].x, hfv[q].y); w.y = pk2(hfv[q].z, hfv[q].w); *(u32x2*)(hrow + 16 * kk) = w; }
#pragma unroll
                for (int q = 0; q < 4; ++q)
#pragma unroll
                    for (int i = 0; i < 4; ++i) { const f32x4 bv = bimg[((half * 4 + q) * 16 + i) * 16];
                        a0 = __builtin_amdgcn_mfma_f32_16x16x4f32(hfv[q][i], bv[0], a0, 0, 0, 0); a1 = __builtin_amdgcn_mfma_f32_16x16x4f32(hfv[q][i], bv[1], a1, 0, 0, 0); a2 = __builtin_amdgcn_mfma_f32_16x16x4f32(hfv[q][i], bv[2], a2, 0, 0, 0); }
            }
            if (c + 1 < DM / RT_CH) RT_WRITE(RT_IMG - bo);
        }
#pragma unroll
        for (int r = 0; r < 4; ++r) { lg[(4 * kq + r) * 48 + tok] = a0[r]; lg[(4 * kq + r) * 48 + 16 + tok] = a1[r]; lg[(4 * kq + r) * 48 + 32 + tok] = a2[r]; }
        LDS_WAIT(); asm volatile("" ::: "memory");
        if (lane < 16 && commit) {
            const LAS float* L = lg + lane * 48;
            int gs = 0; float gm = L[32];
#pragma unroll
            for (int j = 1; j < 4; ++j) { const float v = L[32 + j]; if (v > gm) { gm = v; gs = j; } }
            float gsum = 0.f;
#pragma unroll
            for (int j = 0; j < 4; ++j) gsum += __expf(L[32 + j] - gm);
            const float pg = 1.0f / gsum;
            int ia = 0; float la = L[gs * 8];
#pragma unroll
            for (int j = 1; j < 8; ++j) { const float v = L[gs * 8 + j]; if (v > la) { la = v; ia = j; } }
            int ib = -1; float lb = -3.0e38f;
#pragma unroll
            for (int j = 0; j < 8; ++j) { const float v = L[gs * 8 + j]; if (j != ia && v > lb) { lb = v; ib = j; } }
            const float wa = pg / (1.0f + __expf(lb - la)), wb = pg - wa;
            const int ea = gs * 8 + ia, eb = gs * 8 + ib, t = t0 + lane;
            const unsigned pa = atomicAdd(cnt + ea, 1u), pb = atomicAdd(cnt + eb, 1u);
            C.w<int>(WS_RE)[2 * t] = ea; C.w<int>(WS_RE)[2 * t + 1] = eb; C.w<float>(WS_RW)[2 * t] = wa; C.w<float>(WS_RW)[2 * t + 1] = wb;
            C.w<int>(WS_RP)[2 * t] = (int)pa; C.w<int>(WS_RP)[2 * t + 1] = (int)pb;
            C.w<int>(WS_TL)[(size_t)ea * NT + pa] = t; C.w<int>(WS_TL)[(size_t)eb * NT + pb] = t;
        }
        LDS_WAIT(); asm volatile("" ::: "memory");
    }
#undef RT_LOAD
#undef RT_WRITE
}
struct MoeTab { LAS int* off; LAS int* tile_e; LAS int* ntile; LAS int* cnt; LAS int* tile_p0; };
__device__ __forceinline__ MoeTab moe_tables(const Ctx& C, int layer) {
    MoeTab T; T.off = (LAS int*)(C.lds + MISC_OFF + 256); T.tile_e = T.off + 128; T.ntile = T.off + 48; T.cnt = T.off + 64; T.tile_p0 = T.off + 128 + 320;
    __syncthreads();
    if (C.tid < 64) {
        const unsigned* cnt = C.w<unsigned>(WS_CTL) + CW_CNT + layer * 64; const int e = C.lane;
        const int c = e < NEXP ? (int)__hip_atomic_load(cnt + e, __ATOMIC_RELAXED, __HIP_MEMORY_SCOPE_AGENT) : 0;
        const int tiles = (c + 255) >> 8; int inc = tiles;
#pragma unroll
        for (int o = 1; o < 32; o <<= 1) { const int v = __shfl_up(inc, o); if (e >= o) inc += v; }
        const int first = inc - tiles;
        if (e < NEXP) { T.off[e] = first * 256; T.cnt[e] = c; for (int j = 0; j < tiles; ++j) { T.tile_e[first + j] = e; T.tile_p0[first + j] = j * 256; } }
        if (e == NEXP - 1) { T.off[32] = inc * 256; T.ntile[0] = inc; } }
    __syncthreads();
    return T;
}
__device__ __forceinline__ void p_permute(const Ctx& C, int layer) {
    const MoeTab T = moe_tables(C, layer);
    const bf16* HF = C.w<bf16>(WS_HF); bf16* HS = C.w<bf16>(WS_HS);
    const int* RP = C.w<int>(WS_RP); const int* RE = C.w<int>(WS_RE);
    for (int p = C.vcu * 8 + C.wave; p < 2 * NT; p += C.G * 8) {
        const int e = RE[p], pos = RP[p], slot = T.off[e] + pos, t = p >> 1;
        const u32x4* s = (const u32x4*)(HF + (size_t)t * DM) + C.lane; u32x4* d = (u32x4*)(HS + (size_t)slot * DM) + C.lane;
        const u32x4 v0 = s[0], v1 = s[64]; d[0] = v0; d[64] = v1;
        asm volatile("" ::: "memory");
        if (C.lane == 0) C.w<int>(WS_RS)[p] = slot;
    }
}
template <int NPN, bool GATH> struct MoeOrder {
    const int* tl; MoeTab T; const char* A; const char* B; int lda_bytes; size_t b_expert_bytes; int b_tile_bytes; int G, c, nt;
    __device__ __forceinline__ bool next(int i, pg8::Unit& u) const {
        const int L = i * G + c; const int rt = L / NPN, pn = L - rt * NPN; if (rt >= T.ntile[0]) return false;
        const int e = T.tile_e[rt];
        u.A = GATH ? A : A + (size_t)rt * 256 * lda_bytes; u.B = B + (size_t)e * b_expert_bytes + (size_t)pn * b_tile_bytes; u.r0 = rt * 256; u.c0 = GATH ? T.tile_p0[rt] : pn * 256; u.a0 = e; u.a1 = pn; u.nt = nt; u.flags = GATH ? T.cnt[e] : 3; return true;
    }
    __device__ __forceinline__ int kb(const pg8::Unit&, int t) const { return t; }
    __device__ __forceinline__ unsigned arow(const pg8::Unit& u, int r) const { const int pos = u.c0 + r; const int tok = pos < u.flags ? tl[(size_t)u.a0 * NT + pos] : 0; return (unsigned)tok * (unsigned)(DM * 2); }
};
struct EpiSwiGLU {
    static constexpr bool PERM = true;
    bf16* H;
    __device__ __forceinline__ void operator()(const f32x4 (&acc)[2][2][4][2], const pg8::Unit& u, int wr, int wc, int fr_, int fq_) const {
        (void)fr_; (void)fq_; const int ln_ = opaque_v(lane_id()); const int fr = ln_ & 15, fq = ln_ >> 4;
        const int row0 = u.r0 + wr * 64 + fr, col0 = u.a1 * 128 + wc * 32 + 8 * fq;
#pragma unroll
        for (int ai = 0; ai < 2; ++ai)
#pragma unroll
            for (int m = 0; m < 4; ++m) { float r[8];
#pragma unroll
                for (int n = 0; n < 2; ++n)
#pragma unroll
                    for (int i = 0; i < 4; ++i) { const float a = acc[ai][0][m][n][i], b = acc[ai][1][m][n][i]; r[4 * n + i] = silu_f(a) * b; }
                u32x4 w; w.x = pk2(r[0], r[1]); w.y = pk2(r[2], r[3]); w.z = pk2(r[4], r[5]); w.w = pk2(r[6], r[7]);
                *(u32x4*)(H + (size_t)(row0 + ai * 128 + m * 16) * DEXP + col0) = w; }
    }
};
template <bool OUT_F32> __device__ __forceinline__ void p_combine(const Ctx& C, int layer, const bf16* xsrc, void* xdst, int norm_rows = 0, bf16* hm = nullptr) {
    const MoeTab T = moe_tables(C, layer);
    const bf16* YS = C.w<bf16>(WS_YS); const int* RP = C.w<int>(WS_RP); const int* RE = C.w<int>(WS_RE); const float* RW = C.w<float>(WS_RW);
    const float* ng = C.in(IN_NMG) + (layer + 1 < 2 ? layer + 1 : 1) * DM;
    for (int t = C.vcu * 8 + C.wave; t < NT; t += C.G * 8) {
        const int s0 = T.off[RE[2 * t]] + RP[2 * t], s1 = T.off[RE[2 * t + 1]] + RP[2 * t + 1]; const float w0 = RW[2 * t], w1 = RW[2 * t + 1];
        const int b = t / SEQ;
        const float* g2 = C.mods(layer, 5) + (size_t)b * 6144;
        const u32x4* y0 = (const u32x4*)(YS + (size_t)s0 * DM) + C.lane; const u32x4* y1 = (const u32x4*)(YS + (size_t)s1 * DM) + C.lane;
        const u32x4* xr = (const u32x4*)(xsrc + (size_t)t * DM) + C.lane;
        f32x4 xa[2], xb[2]; float ss = 0.f;
#pragma unroll
        for (int j = 0; j < 2; ++j) { const u32x4 a = y0[64 * j], bq = y1[64 * j], xw = xr[64 * j]; const f32x4 ga = *(const f32x4*)(g2 + 512 * j + 8 * C.lane), gb = *(const f32x4*)(g2 + 512 * j + 8 * C.lane + 4);
            xa[j] = (f32x4){bflo(xw.x), bfhi(xw.x), bflo(xw.y), bfhi(xw.y)}; xb[j] = (f32x4){bflo(xw.z), bfhi(xw.z), bflo(xw.w), bfhi(xw.w)};
            xa[j].x += ga.x * (w0 * bflo(a.x) + w1 * bflo(bq.x)); xa[j].y += ga.y * (w0 * bfhi(a.x) + w1 * bfhi(bq.x)); xa[j].z += ga.z * (w0 * bflo(a.y) + w1 * bflo(bq.y)); xa[j].w += ga.w * (w0 * bfhi(a.y) + w1 * bfhi(bq.y));
            xb[j].x += gb.x * (w0 * bflo(a.z) + w1 * bflo(bq.z)); xb[j].y += gb.y * (w0 * bfhi(a.z) + w1 * bfhi(bq.z)); xb[j].z += gb.z * (w0 * bflo(a.w) + w1 * bflo(bq.w)); xb[j].w += gb.w * (w0 * bfhi(a.w) + w1 * bfhi(bq.w));
            if (OUT_F32) { float* o = (float*)xdst + (size_t)t * DM + 512 * j + 8 * C.lane; *(f32x4*)o = xa[j]; *(f32x4*)(o + 4) = xb[j]; }
            else { u32x4 w; w.x = pk2(xa[j].x, xa[j].y); w.y = pk2(xa[j].z, xa[j].w); w.z = pk2(xb[j].x, xb[j].y); w.w = pk2(xb[j].z, xb[j].w); *((u32x4*)((bf16*)xdst + (size_t)t * DM + 512 * j) + C.lane) = w; }
            ss += (xa[j].x * xa[j].x + xa[j].y * xa[j].y) + (xa[j].z * xa[j].z + xa[j].w * xa[j].w) + (xb[j].x * xb[j].x + xb[j].y * xb[j].y) + (xb[j].z * xb[j].z + xb[j].w * xb[j].w); }
        if (t < norm_rows) {
            const float rstd = 1.0f / sqrtf(wave_sum(ss) * (1.0f / DM) + EPS);
            const float* sc = C.mods(layer + 1, 1) + (size_t)b * 6144; const float* sh = C.mods(layer + 1, 0) + (size_t)b * 6144;
#pragma unroll
            for (int j = 0; j < 2; ++j) { const int c = 512 * j + 8 * C.lane;
                const f32x4 g0 = *(const f32x4*)(ng + c), g1 = *(const f32x4*)(ng + c + 4), c0 = *(const f32x4*)(sc + c), c1 = *(const f32x4*)(sc + c + 4), h0 = *(const f32x4*)(sh + c), h1 = *(const f32x4*)(sh + c + 4);
                const f32x4 ya = (xa[j] * rstd * g0) * (c0 + 1.0f) + h0, yb = (xb[j] * rstd * g1) * (c1 + 1.0f) + h1;
                u32x4 w; w.x = pk2(ya.x, ya.y); w.y = pk2(ya.z, ya.w); w.z = pk2(yb.x, yb.y); w.w = pk2(yb.z, yb.w);
                *(u32x4*)(hm + (size_t)t * DM + c) = w; }
        }
    }
}

constexpr int CV_XM = 0;
constexpr int CV_QKV = 18432;
constexpr int CV_QKV_P = 1552;
constexpr int CV_VT = CV_QKV + 32 * CV_QKV_P;
constexpr int CV_RED = CV_VT + 256 * 80;
static_assert(CV_RED + 16384 <= RING_BYTES && CV_VT % 16 == 0 && CV_RED % 16 == 0, "conv LDS");
__device__ __forceinline__ void conv_unit(const Ctx& C, int round, int bl, int ti) {
    LAS unsigned char* lds = C.lds; const int tid = C.tid, lane = C.lane, wid = C.wave;
    const int s0 = ti * 32; const size_t rrow0 = (size_t)bl * SEQ;
    const bf16* XM = C.w<bf16>(WS_XMH); bf16* XC = C.w<bf16>(WS_XC); bf16* K = C.w<bf16>(WS_K); bf16* VTR = C.w<bf16>(WS_VTR);
    const bf16* GWT = C.w<bf16>(WS_GWT);
    f32x4 gacc[2]; gacc[0] = (f32x4){0.f, 0.f, 0.f, 0.f}; gacc[1] = gacc[0];
    const int nblk = tid & 63, tg = tid >> 6;
    u32x4 xs[3];
#define CV_LOAD(chn) do { _Pragma("unroll") for (int q_ = 0; q_ < 3; ++q_) { const int i_ = tid + 512 * q_; const int r_ = i_ >> 5, cc_ = i_ & 31, s_ = s0 - 2 + r_; xs[q_] = (u32x4){0u, 0u, 0u, 0u}; \
        if (i_ < 36 * 32 && s_ >= 0 && s_ < SEQ) xs[q_] = *(const u32x4*)(XM + (rrow0 + s_) * ML_IN + (chn) * 256 + cc_ * 8); } } while (0)
    CV_LOAD(0);
    for (int ch = 0; ch < 8; ++ch) {
        const int c0 = ch * 256;
        LDS_BARRIER();
#pragma unroll
        for (int q = 0; q < 3; ++q) { const int i = tid + 512 * q; if (i < 36 * 32) *(LAS u32x4*)(lds + CV_XM + (i >> 5) * 512 + (i & 31) * 16) = xs[q]; }
        if (ch + 1 < 8) CV_LOAD(ch + 1);
        LDS_BARRIER();
        {
            const int c = c0 + 4 * nblk;
            float cw[5][4], cb[4], wq[4][4], wk[4][4], wv[4][4];
            const float* convw = C.in(IN_CONVW); const float* convb = C.in(IN_CONVB);
#pragma unroll
            for (int j = 0; j < 5; ++j) { const f32x4 v = *(const f32x4*)(convw + j * ML_IN + c); cw[j][0] = v.x; cw[j][1] = v.y; cw[j][2] = v.z; cw[j][3] = v.w; }
            { const f32x4 v = *(const f32x4*)(convb + c); cb[0] = v.x; cb[1] = v.y; cb[2] = v.z; cb[3] = v.w; }
            const int nb = c >> 2;
#pragma unroll
            for (int i = 0; i < 4; ++i) { const f32x4 a = *(const f32x4*)(C.in(IN_WQ) + nb * 16 + i * 4), b = *(const f32x4*)(C.in(IN_WK) + nb * 16 + i * 4), d = *(const f32x4*)(C.in(IN_WV) + nb * 16 + i * 4);
                wq[i][0] = a.x; wq[i][1] = a.y; wq[i][2] = a.z; wq[i][3] = a.w; wk[i][0] = b.x; wk[i][1] = b.y; wk[i][2] = b.z; wk[i][3] = b.w; wv[i][0] = d.x; wv[i][1] = d.y; wv[i][2] = d.z; wv[i][3] = d.w; }
            float xw[8][4];
#pragma unroll
            for (int r = 0; r < 8; ++r) { const u32x2 v = *(const LAS u32x2*)(lds + CV_XM + (4 * tg + r) * 512 + nblk * 8); xw[r][0] = bflo(v.x); xw[r][1] = bfhi(v.x); xw[r][2] = bflo(v.y); xw[r][3] = bfhi(v.y); }
#pragma unroll
            for (int tt = 0; tt < 4; ++tt) {
                const int tl = 4 * tg + tt;
                float xc[4], qv[4], kv[4], vv[4];
#pragma unroll
                for (int i = 0; i < 4; ++i) { float a = cb[i];
#pragma unroll
                    for (int j = 0; j < 5; ++j) a += cw[j][i] * xw[tt + j][i];
                    xc[i] = silu_f(a); }
#pragma unroll
                for (int o = 0; o < 4; ++o) { float a = 0.f, b = 0.f, d = 0.f;
#pragma unroll
                    for (int i = 0; i < 4; ++i) { a += xc[i] * wq[i][o]; b += xc[i] * wk[i][o]; d += xw[tt + 2][i] * wv[i][o]; }
                    qv[o] = a; kv[o] = b; vv[o] = d; }
                const size_t grow = (rrow0 + s0 + tl) * ML_IN + c;
                float k2[4];
#pragma unroll
                for (int i = 0; i < 4; ++i) { float a = 0.f;
#pragma unroll
                    for (int o = 0; o < 4; ++o) a += kv[o] * wq[i][o];
                    k2[i] = a; }
                const u32x2 xcw = (u32x2){pk2(xc[0], xc[1]), pk2(xc[2], xc[3])}, qw = (u32x2){pk2(qv[0], qv[1]), pk2(qv[2], qv[3])}, kw = (u32x2){pk2(kv[0], kv[1]), pk2(kv[2], kv[3])}, vw = (u32x2){pk2(vv[0], vv[1]), pk2(vv[2], vv[3])};
                *(u32x2*)(XC + grow) = xcw; *(u32x2*)(K + grow) = (u32x2){pk2(k2[0], k2[1]), pk2(k2[2], k2[3])};
                LAS unsigned char* qrow = lds + CV_QKV + tl * CV_QKV_P + nblk * 8;
                *(LAS u32x2*)(qrow) = qw; *(LAS u32x2*)(qrow + 512) = kw; *(LAS u32x2*)(qrow + 1024) = vw;
            }
        }
        LDS_BARRIER();
        for (int i = tid; i < 256 * 4; i += 512) { const int cr = i >> 2, cc = i & 3; const int cg = c0 + cr, head = cg >> 9, dv = cg & 511;
            const LAS unsigned short* s = (const LAS unsigned short*)(lds + CV_QKV + (8 * cc) * CV_QKV_P + 1024) + cr; unsigned short v[8];
#pragma unroll
            for (int j = 0; j < 8; ++j) v[j] = s[j * (CV_QKV_P / 2)];
            *(u32x4*)(VTR + ((size_t)(bl * 4 + head) * 512 + dv) * SEQ + s0 + cc * 8) = (u32x4){(unsigned)v[0] | ((unsigned)v[1] << 16), (unsigned)v[2] | ((unsigned)v[3] << 16), (unsigned)v[4] | ((unsigned)v[5] << 16), (unsigned)v[6] | ((unsigned)v[7] << 16)}; }
#pragma unroll
        for (int ks = 0; ks < 3; ++ks) { const int kk = 96 * wid + 32 * ks + 8 * (lane >> 4);
            const int m = kk >> 8, cl = kk & 255;
            const bf16x8 bfr = *(const bf16x8*)(GWT + (size_t)(lane & 15) * 6144 + m * 2048 + c0 + cl);
#pragma unroll
            for (int tgp = 0; tgp < 2; ++tgp) { const bf16x8 afr = *(const LAS bf16x8*)(lds + CV_QKV + (16 * tgp + (lane & 15)) * CV_QKV_P + kk * 2);
                gacc[tgp] = __builtin_amdgcn_mfma_f32_16x16x32_bf16(afr, bfr, gacc[tgp], 0, 0, 0); } }
    }
    LDS_BARRIER();
    LAS float* red = (LAS float*)(lds + CV_RED);
#pragma unroll
    for (int tgp = 0; tgp < 2; ++tgp)
#pragma unroll
        for (int r = 0; r < 4; ++r) red[(wid * 32 + 16 * tgp + 4 * (lane >> 4) + r) * 16 + (lane & 15)] = gacc[tgp][r];
    LDS_BARRIER();
    { const int tkn = tid >> 4, n = tid & 15; float s = C.in(IN_GATEB)[n];
#pragma unroll
        for (int w = 0; w < 8; ++w) s += red[(w * 32 + tkn) * 16 + n];
        C.w<float>(WS_PRE)[(rrow0 + s0 + tkn) * 16 + n] = s; }
    (void)round;
#undef CV_LOAD
}
__device__ __forceinline__ void p_conv(const Ctx& C, int round) {
    { float* DEN = C.w<float>(WS_DEN); for (int i = C.vcu * 512 + C.tid; i < 2 * 16 * 2048; i += C.G * 512) DEN[i] = 0.f; }
    for (int u = C.vcu; u < RB * 64; u += C.G) conv_unit(C, round, u >> 6, u & 63);
    __syncthreads();
}
__device__ __forceinline__ void cumsum_bh(const Ctx& C, int bh) {
    float* FG = C.w<float>(WS_FG); const float* PRE = C.w<float>(WS_PRE);
    LAS float* wtot = (LAS float*)(C.lds);
    const int bl = bh >> 2, hd = bh & 3, lane = C.lane, tid = C.tid;
    const float* p = PRE + (size_t)bl * SEQ * 16;
    float lf[2][4], ii[2][4], tot[2] = {0.f, 0.f};
#pragma unroll
    for (int j = 0; j < 4; ++j) { const int s = tid * 4 + j;
#pragma unroll
        for (int d = 0; d < 2; ++d) { const float f = p[(size_t)s * 16 + d * 8 + 4 + hd]; ii[d][j] = p[(size_t)s * 16 + d * 8 + hd];
            lf[d][j] = fminf(f, 0.f) - __logf(1.0f + __expf(-fabsf(f))); tot[d] += lf[d][j]; } }
    float inc[2] = {tot[0], tot[1]};
#pragma unroll
    for (int o = 1; o < 64; o <<= 1) { const float v0 = __shfl_up(inc[0], o), v1 = __shfl_up(inc[1], o); if (lane >= o) { inc[0] += v0; inc[1] += v1; } }
    __syncthreads();
    if (lane == 63) { wtot[C.wave] = inc[0]; wtot[8 + C.wave] = inc[1]; }
    __syncthreads();
#pragma unroll
    for (int d = 0; d < 2; ++d) {
        float before = 0.f, all = 0.f;
#pragma unroll
        for (int w = 0; w < 8; ++w) { const float v = wtot[d * 8 + w]; all += v; if (w < C.wave) before += v; }
        const float excl = before + inc[d] - tot[d];
        float* F = FG + (size_t)(d * 2) * 16 * 2048 + (size_t)bh * 2048; float* Gp = F + 16 * 2048;
        f32x4 fo, go;
        if (d == 0) { float run = excl;
#pragma unroll
            for (int j = 0; j < 4; ++j) { run += lf[d][j]; fo[j] = run * LOG2E; go[j] = (ii[d][j] - run) * LOG2E - 4.5f; } }
        else { float run = all - excl;
#pragma unroll
            for (int j = 0; j < 4; ++j) { fo[j] = run * LOG2E; go[j] = (ii[d][j] - run) * LOG2E - 4.5f; run -= lf[d][j]; } }
        *(f32x4*)(F + tid * 4) = fo; *(f32x4*)(Gp + tid * 4) = go;
    }
}
struct DecayOrder {
    const char* Qb; const char* Kb; int G, c;
    __device__ __forceinline__ bool next(int ii, pg8::Unit& u) const {
        const int grp = (ii >> 2) * G + c; if (grp >= 256) return false;
        const int bh = grp >> 4, i = (grp >> 1) & 7, j = 4 * (grp & 1) + (ii & 3), bl = bh >> 2, hd = bh & 3;
        u.A = Qb + ((size_t)(bl * SEQ + 256 * i) * ML_IN + hd * 512) * 2; u.B = Kb + ((size_t)(bl * SEQ + 256 * j) * ML_IN + hd * 512) * 2; u.r0 = 256 * i; u.c0 = 256 * j; u.a0 = bh; u.a1 = (i << 4) | j; u.nt = ML_DH / 64; u.flags = 3; return true;
    }
    __device__ __forceinline__ int kb(const pg8::Unit&, int t) const { return t; }
};
struct EpiDecay {
    static constexpr bool PERM = true;
    bf16* W; const float* FG; float* DEN; int den_on; bf16* DUMMY;
    template <bool MASK>
    __device__ __forceinline__ void pass(const f32x4 (&acc)[2][2][4][2], const pg8::Unit& u, int wr, int wc, int fr, int fq, int dir, int dmin, int dmax, int cblk) const {
        const int bh = u.a0; const float* F = FG + (size_t)(dir * 2) * 16 * 2048 + (size_t)bh * 2048; const float* Gp = F + 16 * 2048;
        const int rl0 = opaque_v(wr * 64 + fr), cl0 = opaque_v(wc * 32 + 8 * fq);
        const float* Fr = F + u.r0;
        const bool fake_ = (REP_ABL & 256) && !den_on;
        const float ref = fake_ ? 0.5f : (dir ? Fr[255] : Fr[0]);
        f32x4 gv[2][2];
#pragma unroll
        for (int bj = 0; bj < 2; ++bj)
#pragma unroll
            for (int n = 0; n < 2; ++n) { const f32x4 g = fake_ ? (f32x4){0.1f * fq, 0.2f, 0.3f * fr, 0.4f} : *(const f32x4*)(Gp + u.c0 + cl0 + bj * 128 + 4 * n);
#pragma unroll
                for (int i = 0; i < 4; ++i) gv[bj][n][i] = __builtin_amdgcn_exp2f(fminf(g[i] + ref, 120.0f)); }
        float fa[2][4];
#pragma unroll
        for (int ai = 0; ai < 2; ++ai)
#pragma unroll
            for (int m = 0; m < 4; ++m) fa[ai][m] = __builtin_amdgcn_exp2f(fmaxf((fake_ ? 0.01f * (fr + m) : Fr[rl0 + ai * 128 + m * 16]) - ref, -126.0f));
        bf16* wbase = W + ((size_t)bh * SEQ + u.r0) * WLD + cblk * 256 + cl0;
        float* den = DEN + (size_t)dir * 16 * 2048 + (size_t)bh * 2048 + u.r0;
#pragma unroll
        for (int ai = 0; ai < 2; ++ai)
#pragma unroll
            for (int m = 0; m < 4; ++m) { const int rl = rl0 + ai * 128 + m * 16; const float fv = fa[ai][m]; f32x4 rsv = (f32x4){0.f, 0.f, 0.f, 0.f};
#pragma unroll
                for (int bj = 0; bj < 2; ++bj) { f32x4 t0 = acc[ai][bj][m][0] * gv[bj][0], t1 = acc[ai][bj][m][1] * gv[bj][1];
                    if (MASK) {
#pragma unroll
                        for (int i = 0; i < 4; ++i) { const int d0 = cl0 + bj * 128 + i - rl, d1 = d0 + 4; t0[i] = (d0 >= dmin && d0 <= dmax) ? t0[i] : 0.f; t1[i] = (d1 >= dmin && d1 <= dmax) ? t1[i] : 0.f; } }
                    rsv += t0; rsv += t1; t0 = t0 * fv; t1 = t1 * fv;
                    u32x4 w; w.x = pk2(t0[0], t0[1]); w.y = pk2(t0[2], t0[3]); w.z = pk2(t1[0], t1[1]); w.w = pk2(t1[2], t1[3]);
                    if (!((REP_ABL & 64) && !den_on)) *(u32x4*)(wbase + (size_t)rl * WLD + bj * 128) = w; else rsv[0] += __builtin_bit_cast(float, w.x ^ w.y ^ w.z ^ w.w); }
                float rs = ((rsv[0] + rsv[1]) + (rsv[2] + rsv[3])) * fv;
                rs += __shfl_xor(rs, 16); rs += __shfl_xor(rs, 32);
                if (fq == 0 && den_on) atomicAdd(den + rl, rs); else if ((REP_ABL & 64) && rs == 12345.678f) den[rl] = rs; }
    }
    __device__ __forceinline__ void operator()(const f32x4 (&acc)[2][2][4][2], const pg8::Unit& u, int wr, int wc, int fr_, int fq_) const {
        (void)fr_; (void)fq_; const int ln_ = opaque_v(lane_id()); const int fr = ln_ & 15, fq = ln_ >> 4;
        if ((REP_ABL & 32) && !den_on) { if (acc[0][0][0][0][0] == 12345.678f) W[0] = 1; return; }
        if ((REP_ABL & 512) && !den_on) {
            bf16* wb = DUMMY + ((size_t)(u.a0 & 1) * SEQ + u.r0) * 2048 + (u.a1 & 7) * 256 + wc * 32 + 8 * fq;
#pragma unroll
            for (int ai = 0; ai < 2; ++ai)
#pragma unroll
                for (int m = 0; m < 4; ++m) { const int rl = wr * 64 + fr + ai * 128 + m * 16;
#pragma unroll
                    for (int bj = 0; bj < 2; ++bj) { const f32x4 v0 = acc[ai][bj][m][0], v1 = acc[ai][bj][m][1];
                        u32x4 w; w.x = pk2(v0[0], v0[1]); w.y = pk2(v0[2], v0[3]); w.z = pk2(v1[0], v1[1]); w.w = pk2(v1[2], v1[3]);
                        *(u32x4*)(wb + (size_t)rl * 2048 + bj * 128) = w; } }
            return; }
        const int i = u.a1 >> 4, j = u.a1 & 15;
        if (j != i) pass<false>(acc, u, wr, wc, fr, fq, j > i ? 1 : 0, 0, 0, j > i ? j + 1 : j);
        else { for (int p = 0; p < 2; ++p) pass<true>(acc, u, wr, wc, fr, fq, p, p ? 0 : -100000, p ? 100000 : 0, i + p); }
    }
};
struct HOrder {
    const char* Wb; const char* Vb; const float* DEN; int G, c;
    __device__ __forceinline__ bool next(int ii, pg8::Unit& u) const {
        const int L = (ii >> 1) * G + c, part = ii & 1; if (L >= 16 * 16) return false;
        const int bh = L >> 4, i = (L >> 1) & 7, jn = L & 1;
        const int kt0 = part ? 4 * (i + 1) : 0;
        u.A = Wb + (((size_t)bh * SEQ + 256 * i) * WLD + (size_t)kt0 * 64) * 2;
        u.B = Vb + (((size_t)bh * 512 + 256 * jn) * SEQ + (size_t)(part ? 4 * i : 0) * 64) * 2;
        u.r0 = 256 * i; u.c0 = 256 * jn; u.a0 = bh; u.a1 = part; u.nt = part ? 36 - 4 * (i + 1) : 4 * (i + 1); u.flags = 3; return true;
    }
    __device__ __forceinline__ int kb(const pg8::Unit&, int t) const { return t; }
    __device__ __forceinline__ void between(const pg8::Unit& u, f32x4 (&acc)[2][2][4][2], int wr) const {
        const int fr = opaque_v(lane_id()) & 15;
        const float* df = DEN + (size_t)u.a0 * 2048 + u.r0; const float* db = df + 16 * 2048;
#pragma unroll
        for (int ai = 0; ai < 2; ++ai)
#pragma unroll
            for (int m = 0; m < 4; ++m) { const int rl = ai * 128 + wr * 64 + m * 16 + fr; const float f = fmaxf(fabsf(db[rl]), 1.0f) / fmaxf(fabsf(df[rl]), 1.0f);
#pragma unroll
                for (int bj = 0; bj < 2; ++bj)
#pragma unroll
                    for (int n = 0; n < 2; ++n) acc[ai][bj][m][n] *= f; }
    }
};
struct EpiH {
    static constexpr bool PERM = true;
    bf16* HF; bf16* HB; const float* DEN;
    __device__ __forceinline__ void operator()(const f32x4 (&acc)[2][2][4][2], const pg8::Unit& u, int wr, int wc, int fr_, int fq_) const {
        (void)fr_; (void)fq_; const int ln_ = opaque_v(lane_id()); const int fr = ln_ & 15, fq = ln_ >> 4;
        const int bh = u.a0, bl = bh >> 2, hd = bh & 3, part = u.a1; const float* dn = DEN + (size_t)part * 16 * 2048 + (size_t)bh * 2048 + u.r0;
        const int rl0 = wr * 64 + fr, col0 = hd * 512 + u.c0 + wc * 32 + 8 * fq;
        bf16* Hh = HF; (void)HB;
#pragma unroll
        for (int ai = 0; ai < 2; ++ai)
#pragma unroll
            for (int m = 0; m < 4; ++m) { const int rl = rl0 + ai * 128 + m * 16; const float rv = 1.0f / fmaxf(fabsf(dn[rl]), 1.0f);
                bf16* rowp = Hh + ((size_t)bl * SEQ + u.r0 + rl) * ML_IN + col0;
#pragma unroll
                for (int bj = 0; bj < 2; ++bj) { f32x4 v0 = acc[ai][bj][m][0] * rv, v1 = acc[ai][bj][m][1] * rv;
                    u32x4 w; w.x = pk2(v0[0], v0[1]); w.y = pk2(v0[2], v0[3]); w.z = pk2(v1[0], v1[1]); w.w = pk2(v1[2], v1[3]);
                    *(u32x4*)(rowp + bj * 128) = w; } }
    }
};
__device__ __forceinline__ void p_ynorm(const Ctx& C, int round, bool dummy = false) {
    const bf16* HF = C.w<bf16>(WS_Q); const bf16* XC = C.w<bf16>(WS_XC); bf16* Y = C.w<bf16>(WS_Y) + (size_t)round * RT * ML_IN;
    const float* og = C.in(IN_ONG); const float* skip = C.in(IN_SKIP);
    bf16* Yd = dummy ? C.w<bf16>(WS_XMH) : Y;
    for (int r = C.vcu * 8 + C.wave; r < RT; r += C.G * 8) {
        const size_t off = (size_t)r * ML_IN + 8 * C.lane;
#pragma unroll
        for (int hd = 0; hd < 4; ++hd) {
            const u32x4 hw = *(const u32x4*)(HF + off + hd * 512), xw = *(const u32x4*)(XC + off + hd * 512), zw = *(const u32x4*)(Y + off + hd * 512);
            float hv[8] = {bflo(hw.x), bfhi(hw.x), bflo(hw.y), bfhi(hw.y), bflo(hw.z), bfhi(hw.z), bflo(hw.w), bfhi(hw.w)};
            const float xv[8] = {bflo(xw.x), bfhi(xw.x), bflo(xw.y), bfhi(xw.y), bflo(xw.z), bfhi(xw.z), bflo(xw.w), bfhi(xw.w)};
            const float zv[8] = {bflo(zw.x), bfhi(zw.x), bflo(zw.y), bfhi(zw.y), bflo(zw.z), bfhi(zw.z), bflo(zw.w), bfhi(zw.w)};
            float ss = 0.f;
#pragma unroll
            for (int j = 0; j < 8; ++j) ss += hv[j] * hv[j];
            const float rs = 1.0f / sqrtf(wave_sum(ss) * (1.0f / 512.0f) + EPS);
            const float* gg = og + hd * 512 + 8 * C.lane; const float* sk = skip + hd * 512 + 8 * C.lane; float yv[8];
#pragma unroll
            for (int j = 0; j < 8; ++j) yv[j] = (hv[j] * rs * gg[j] + sk[j] * xv[j]) * silu_f(zv[j]);
            u32x4 w; w.x = pk2(yv[0], yv[1]); w.y = pk2(yv[2], yv[3]); w.z = pk2(yv[4], yv[5]); w.w = pk2(yv[6], yv[7]);
            *(u32x4*)(Yd + off + hd * 512) = w;
        }
    }
}

constexpr int PH_PRO = 0, PH_NORM0 = 1, PH_QKV = 2, PH_ATTN = 3, PH_OUT0 = 4, PH_ROUTE0 = 5, PH_UP0 = 6, PH_DOWN0 = 7, PH_COMB0 = 8,
              PH_INPROJ0 = 9, PH_RND = 10  , PH_OUT1 = PH_RND + 4 * NROUND, PH_ROUTE1 = PH_OUT1 + 1,
              PH_UP1 = PH_OUT1 + 2, PH_DOWN1 = PH_OUT1 + 3, PH_COMB1 = PH_OUT1 + 4, N_PHASES = PH_OUT1 + 5;

__device__ __forceinline__ void moe_up(const Ctx& C, int layer) {
    const MoeTab T = moe_tables(C, layer);
    MoeOrder<2, true> S; S.tl = C.w<int>(WS_TL); S.T = T; S.A = (const char*)C.w<bf16>(WS_HF); S.B = (const char*)C.w<bf16>(WS_W13T); S.lda_bytes = DM * 2; S.b_expert_bytes = (size_t)512 * DM * 2; S.b_tile_bytes = 256 * DM * 2; S.G = C.G; S.c = C.vcu; S.nt = DM / 64;
    EpiSwiGLU E{C.w<bf16>(WS_HH)};
    pg8::gemm_phase<EpiSwiGLU, MoeOrder<2, true>, true, true>(C.lds, C.tid, DM, DM, S, E);
}
__device__ __forceinline__ void moe_down(const Ctx& C, int layer) {
    const MoeTab T = moe_tables(C, layer);
    MoeOrder<4, false> S; S.tl = nullptr; S.T = T; S.A = (const char*)C.w<bf16>(WS_HH); S.B = (const char*)C.w<bf16>(WS_W2T); S.lda_bytes = DEXP * 2; S.b_expert_bytes = (size_t)DM * DEXP * 2; S.b_tile_bytes = 256 * DEXP * 2; S.G = C.G; S.c = C.vcu; S.nt = DEXP / 64;
    pg8::EpiBf16 E{C.w<bf16>(WS_YS), DM, 0, nullptr, 0};
    pg8::gemm_phase<pg8::EpiBf16, MoeOrder<4, false>, true>(C.lds, C.tid, DEXP, DEXP, S, E);
}

__global__ void __launch_bounds__(512, 2) fwd_kernel(Args args) {
    extern __shared__ __attribute__((aligned(16))) unsigned char lds_raw[];
    Ctx C; C.a = &args; C.ws = (GAS unsigned char*)args.ws; C.lds = (LAS unsigned char*)lds_raw; C.tid = threadIdx.x; C.lane = C.tid & 63; C.wave = __builtin_amdgcn_readfirstlane(C.tid >> 6);
    C.G = gridDim.x; { const int bx = blockIdx.x; C.vcu = (C.G % 8 == 0) ? (bx % 8) * (C.G / 8) + bx / 8 : bx; }
    volatile LAS unsigned* MISC = (volatile LAS unsigned*)(C.lds + MISC_OFF);
    if (C.tid < 64) MISC[C.tid] = 0u;
    __syncthreads();
    const int lo = args.ph_lo, hi = args.ph_hi;
    XcdBarrier bar; bar.bar = C.w<unsigned>(WS_CTL) + CW_BAR; bar.x = 0; bar.st = nullptr;
    if (hi - lo > 1) bar = xcd_barrier_post(C.w<unsigned>(WS_CTL) + CW_BAR, MISC + 8);
#ifndef PHSEL
#define PHSEL(k) true
#endif
#define IN(k) (PHSEL(k) && lo <= (k) && (k) < hi)
#ifndef REP_PH
#define REP_PH (-1)
#endif
#ifndef REP_J
#define REP_J (-1)
#endif
#ifndef REP_N
#define REP_N 0
#endif
#define NREP(k) (1 + (((k) == REP_PH) ? REP_N : 0))
#define NREPJ(j) (1 + (((j) == REP_J) ? REP_N : 0))
#define SEAM(k) do { if (IN(k) && IN((k) + 1)) xcd_barrier(bar); } while (0)
    float* xout = (float*)(GAS float*)args.out;
    bf16* hmall = (bf16*)xout + (size_t)NT * DM;
    bf16* xb = (bf16*)xout;

    if (IN(PH_PRO)) for (int rep_ = 0; rep_ < NREP(PH_PRO); ++rep_) { const Ctx P = fresh(C); p_prologue(P); } SEAM(PH_PRO);
#ifdef XTRA_BARRIERS
    for (int xb_ = 0; xb_ < XTRA_BARRIERS; ++xb_) xcd_barrier(bar);
#endif
    if (IN(PH_NORM0)) for (int rep_ = 0; rep_ < NREP(PH_NORM0); ++rep_) { const Ctx P = fresh(C); p_normmod(P, P.in(IN_X), 0, 0, NT, P.w<bf16>(WS_HM)); } SEAM(PH_NORM0);
    if (IN(PH_QKV)) for (int rep_ = 0; rep_ < NREP(PH_QKV); ++rep_) { const Ctx P = fresh(C);
        { pg8::PlainOrder S{(const char*)P.w<bf16>(WS_HM), (const char*)P.w<bf16>(WS_WINT), DM, DM, NT / 256, 2048 / 256, P.G, P.vcu, DM / 64};
          pg8::EpiQKNorm E{P.w<bf16>(WS_QK), P.in(IN_QG), P.in(IN_KG)};
          pg8::gemm_phase<pg8::EpiQKNorm, pg8::PlainOrder, true, false, false, true>(P.lds, P.tid, DM, DM, S, E); }
        { pg8::PlainOrder S{(const char*)(P.w<bf16>(WS_WINT) + (size_t)2048 * DM), (const char*)P.w<bf16>(WS_HM), DM, DM, 1024 / 256, NT / 256, P.G, P.vcu, DM / 64};
          pg8::EpiBf16 E{P.w<bf16>(WS_VT), NT, 0, nullptr, 0};
          pg8::gemm_phase<pg8::EpiBf16, pg8::PlainOrder, true>(P.lds, P.tid, DM, DM, S, E); }
    } SEAM(PH_QKV);
    if (IN(PH_ATTN)) for (int rep_ = 0; rep_ < NREP(PH_ATTN); ++rep_) { const Ctx P = fresh(C); if (rep_ == 0) p_attention<0>(P); else p_attention<REP_ABL>(P); } SEAM(PH_ATTN);
    if (IN(PH_OUT0)) for (int rep_ = 0; rep_ < NREP(PH_OUT0); ++rep_) { const Ctx P = fresh(C);
        pg8::PlainOrder S{(const char*)P.w<bf16>(WS_O), (const char*)P.w<bf16>(WS_WOT), DM, DM, NT / 256, DM / 256, P.G, P.vcu, DM / 64};
        pg8::EpiResid<true> E{P.in(IN_X), xb, P.mods(0, 2)};
        pg8::gemm_phase<pg8::EpiResid<true>, pg8::PlainOrder, true>(P.lds, P.tid, DM, DM, S, E);
    } SEAM(PH_OUT0);
    if (IN(PH_ROUTE0)) for (int rep_ = 0; rep_ < NREP(PH_ROUTE0); ++rep_) { const Ctx P = fresh(C); p_route(P, 0, xb, rep_ == 0); } SEAM(PH_ROUTE0);
    if (IN(PH_UP0)) for (int rep_ = 0; rep_ < NREP(PH_UP0); ++rep_) { const Ctx P = fresh(C); moe_up(P, 0); } SEAM(PH_UP0);
    if (IN(PH_DOWN0)) for (int rep_ = 0; rep_ < NREP(PH_DOWN0); ++rep_) { const Ctx P = fresh(C); moe_down(P, 0); } SEAM(PH_DOWN0);
    if (IN(PH_COMB0)) for (int rep_ = 0; rep_ < NREP(PH_COMB0); ++rep_) { const Ctx P = fresh(C); p_combine<false>(P, 0, xb, rep_ == 0 ? (void*)xb : (void*)P.w<bf16>(WS_HS + 8 * MiB), rep_ == 0 ? NT : 0, hmall); LAS float* scr = (LAS float*)(P.lds + P.wave * 16384); moe_weight_items(P, 1, scr); } SEAM(PH_COMB0);

#define INPROJ(P_, rnd_, skip_) do { \
        pg8::PlainOrder S_{(const char*)(hmall + (size_t)(rnd_) * RT * DM), (const char*)(P_).w<bf16>(WS_MLWINT), DM, DM, RT / 256, 4096 / 256, (P_).G, (P_).vcu, DM / 64}; \
        pg8::EpiBf16 E_{(P_).w<bf16>(WS_XMH), ML_IN, ML_IN, (P_).w<bf16>(WS_Y) + (size_t)(rnd_) * RT * ML_IN, ML_IN, skip_}; \
        pg8::gemm_phase<pg8::EpiBf16, pg8::PlainOrder, true>((P_).lds, (P_).tid, DM, DM, S_, E_); } while (0)
    if (IN(PH_INPROJ0)) for (int rep_ = 0; rep_ < NREP(PH_INPROJ0); ++rep_) { const Ctx P = fresh(C); INPROJ(P, 0, rep_); } SEAM(PH_INPROJ0);
    for (int round = 0; round < NROUND; ++round) {
        const int pb = PH_RND + 4 * round;
        if (IN(pb + 0)) for (int rep_ = 0; rep_ < NREPJ(0); ++rep_) { const Ctx P = fresh(C); p_conv(P, round); } SEAM(pb + 0);
        if (IN(pb + 1)) for (int rep_ = 0; rep_ < NREPJ(1); ++rep_) { const Ctx P = fresh(C);
            { int last_bh = -1; for (int grp = P.vcu; grp < 256; grp += P.G) { const int bh = grp >> 4; if (bh != last_bh) { cumsum_bh(P, bh); last_bh = bh; } }
              asm volatile("s_waitcnt vmcnt(0)" ::: "memory"); __syncthreads(); }
            DecayOrder S{(const char*)P.w<bf16>(WS_XC), (const char*)P.w<bf16>(WS_K), P.G, P.vcu};
            EpiDecay E{P.w<bf16>(WS_W), P.w<float>(WS_FG), P.w<float>(WS_DEN), rep_ == 0 ? 1 : 0, P.w<bf16>(WS_XMH)};
            pg8::gemm_phase<EpiDecay, DecayOrder, GEMM1_ALIGN>(P.lds, P.tid, ML_IN, ML_IN, S, E);
        } SEAM(pb + 1);
        if (IN(pb + 2)) for (int rep_ = 0; rep_ < NREPJ(2); ++rep_) { const Ctx P = fresh(C);
            { HOrder S{(const char*)P.w<bf16>(WS_W), (const char*)P.w<bf16>(WS_VTR), P.w<float>(WS_DEN), P.G, P.vcu};
              EpiH E{P.w<bf16>(WS_Q), P.w<bf16>(WS_K), P.w<float>(WS_DEN)};
              pg8::gemm_phase<EpiH, HOrder, true, false, true>(P.lds, P.tid, WLD, SEQ, S, E); }
            if (round + 1 < NROUND) { const Ctx P2 = fresh(C); INPROJ(P2, round + 1, rep_); }
        } SEAM(pb + 2);
        if (IN(pb + 3)) for (int rep_ = 0; rep_ < NREPJ(3); ++rep_) { const Ctx P = fresh(C); p_ynorm(P, round, rep_ != 0); } SEAM(pb + 3);
    }
#undef INPROJ
    if (IN(PH_OUT1)) for (int rep_ = 0; rep_ < NREP(PH_OUT1); ++rep_) { const Ctx P = fresh(C);
        pg8::PlainOrder S{(const char*)P.w<bf16>(WS_Y), (const char*)P.w<bf16>(WS_MLWOUTT), ML_IN, ML_IN, NT / 256, DM / 256, P.G, P.vcu, ML_IN / 64};
        pg8::EpiResid<false> E{xb, P.w<bf16>(WS_XB3), P.mods(1, 2)};
        pg8::gemm_phase<pg8::EpiResid<false>, pg8::PlainOrder, true>(P.lds, P.tid, ML_IN, ML_IN, S, E);
    } SEAM(PH_OUT1);
    if (IN(PH_ROUTE1)) for (int rep_ = 0; rep_ < NREP(PH_ROUTE1); ++rep_) { const Ctx P = fresh(C); p_route(P, 1, P.w<bf16>(WS_XB3), rep_ == 0); } SEAM(PH_ROUTE1);
    if (IN(PH_UP1)) for (int rep_ = 0; rep_ < NREP(PH_UP1); ++rep_) { const Ctx P = fresh(C); moe_up(P, 1); } SEAM(PH_UP1);
    if (IN(PH_DOWN1)) for (int rep_ = 0; rep_ < NREP(PH_DOWN1); ++rep_) { const Ctx P = fresh(C); moe_down(P, 1); } SEAM(PH_DOWN1);
    if (IN(PH_COMB1)) for (int rep_ = 0; rep_ < NREP(PH_COMB1); ++rep_) { const Ctx P = fresh(C); p_combine<true>(P, 1, P.w<bf16>(WS_XB3), rep_ == 0 ? (void*)xout : (void*)P.w<float>(WS_HS + 8 * MiB)); }
#undef IN
#undef SEAM
}

extern "C" void kernel_launch(void* const* d_in, const int* in_sizes, int n_in, void* d_out, int out_size, void* d_ws, size_t ws_size, hipStream_t stream) {
    static int grid = 0;
    if (grid == 0) {
        if (n_in != 32 || in_sizes[0] != NT * DM || out_size != NT * DM || ws_size < WS_END) { fprintf(stderr, "kernel_launch: unexpected shapes (n_in %d, in0 %d, out %d, ws %zu)\n", n_in, n_in > 0 ? in_sizes[0] : -1, out_size, ws_size); grid = -1; return; }
        int dev = 0, cus = 0, per_cu = 0;
        if (hipGetDevice(&dev) != hipSuccess || hipDeviceGetAttribute(&cus, hipDeviceAttributeMultiprocessorCount, dev) != hipSuccess) { grid = -1; return; }
        if (hipFuncSetAttribute((const void*)fwd_kernel, hipFuncAttributeMaxDynamicSharedMemorySize, LDS_BYTES) != hipSuccess) { fprintf(stderr, "kernel_launch: hipFuncSetAttribute failed\n"); grid = -1; return; }
        if (hipOccupancyMaxActiveBlocksPerMultiprocessor(&per_cu, (const void*)fwd_kernel, 512, LDS_BYTES) != hipSuccess || per_cu < 1) fprintf(stderr, "kernel_launch: occupancy query reports %d\n", per_cu);
        (void)hipGetLastError();
        grid = cus;
    }
    if (grid < 0) return;
    (void)hipMemsetAsync((char*)d_ws + WS_CTL, 0, CTL_ZERO_BYTES, stream);
    Args a{};
    for (int i = 0; i < 32; ++i) a.in[i] = (const float*)d_in[i];
    a.out = (float*)d_out; a.ws = (unsigned char*)d_ws;
#if MK_ONE_LAUNCH
    a.ph_lo = 0; a.ph_hi = N_PHASES;
    hipLaunchKernelGGL(fwd_kernel, dim3(grid), dim3(512), LDS_BYTES, stream, a);
#else
    for (int p = 0; p < N_PHASES; ++p) { a.ph_lo = p; a.ph_hi = p + 1; hipLaunchKernelGGL(fwd_kernel, dim3(grid), dim3(512), LDS_BYTES, stream, a); }
#endif
}
```

```cpp
#include <hip/hip_runtime.h>
#include <cstdio>
#include <cstdint>

#ifndef REP_ABL
#define REP_ABL 0
#endif
#ifndef GEMM1_STAGGER
#define GEMM1_STAGGER 0ull
#endif
#ifndef GEMM1_ALIGN
#define GEMM1_ALIGN true
#endif
#ifndef MK_ONE_LAUNCH
#define MK_ONE_LAUNCH 1
#endif

#define GAS __attribute__((address_space(1)))
#define LAS __attribute__((address_space(3)))
typedef unsigned short bf16;
typedef short bf16x8 __attribute__((ext_vector_type(8)));
typedef float f32x4 __attribute__((ext_vector_type(4)));
typedef float f32x16 __attribute__((ext_vector_type(16)));
typedef float f32x2 __attribute__((ext_vector_type(2)));
typedef unsigned u32x4 __attribute__((ext_vector_type(4)));
typedef unsigned u32x2 __attribute__((ext_vector_type(2)));

constexpr int NB = 16, SEQ = 2048, DM = 1024, NT = NB * SEQ;
constexpr int DA_H = 8;
constexpr int ML_IN = 2048, ML_H = 4, ML_DH = 512;
constexpr int NEXP = 32, DEXP = 256;
constexpr float EPS = 1e-6f;
constexpr float LOG2E = 1.4426950408889634f;
constexpr int RB = 4;
constexpr int NROUND = NB / RB;
constexpr int RT = RB * SEQ;
constexpr int WLD = 2304;
constexpr int MAXSLOT = 2 * NT + NEXP * 256;

constexpr size_t MiB = 1u << 20;
constexpr size_t WS_CTL = 0, CTL_ZERO_BYTES = 1 * MiB;
constexpr size_t WS_MODS = 2 * MiB;
constexpr size_t WS_TAB2 = 3 * MiB;
constexpr size_t WS_SCAL = 3 * MiB + 128 * 1024;
constexpr size_t WS_GWT = 3 * MiB + 256 * 1024;
constexpr size_t WS_RE = 4 * MiB;
constexpr size_t WS_RW = 4 * MiB + 256 * 1024;
constexpr size_t WS_RP = 4 * MiB + 512 * 1024;
constexpr size_t WS_RS = 4 * MiB + 768 * 1024;
constexpr size_t WS_PRE = 5 * MiB;
constexpr size_t WS_FG = 5 * MiB + 512 * 1024;
constexpr size_t WS_DEN = 6 * MiB;
constexpr size_t WS_WINT = 8 * MiB;
constexpr size_t WS_WOT = 14 * MiB;
constexpr size_t WS_MLWINT = 16 * MiB;
constexpr size_t WS_MLWOUTT = 24 * MiB;
constexpr size_t WS_W13T = 28 * MiB;
constexpr size_t WS_W2T = 60 * MiB;
constexpr size_t WS_BIG = 76 * MiB;
constexpr size_t WS_HM = WS_BIG + 0 * MiB;
constexpr size_t WS_QK = WS_BIG + 64 * MiB;
constexpr size_t WS_VT = WS_BIG + 192 * MiB;
constexpr size_t WS_O = WS_BIG + 256 * MiB;
constexpr size_t WS_HF = WS_BIG + 0 * MiB;
constexpr size_t WS_HS = WS_BIG + 64 * MiB;
constexpr size_t WS_TL = WS_BIG + 64 * MiB;
constexpr size_t WS_HH = WS_BIG + 208 * MiB;
constexpr size_t WS_YS = WS_BIG + 244 * MiB;
constexpr size_t WS_Y = WS_BIG + 0 * MiB;
constexpr size_t WS_W = WS_BIG + 128 * MiB;
constexpr size_t WS_HMR = WS_BIG + 128 * MiB;
constexpr size_t WS_XMH = WS_BIG + 272 * MiB;
constexpr size_t WS_XC = WS_BIG + 304 * MiB;
constexpr size_t WS_Q = WS_BIG + 336 * MiB;
constexpr size_t WS_K = WS_BIG + 368 * MiB;
constexpr size_t WS_VTR = WS_BIG + 400 * MiB;
constexpr size_t WS_XB3 = WS_BIG + 128 * MiB;
constexpr size_t WS_END = WS_BIG + 432 * MiB;
static_assert(WS_END <= 512 * MiB, "ws map");
static_assert((size_t)MAXSLOT * 1024 * 2 <= 144 * MiB && (size_t)MAXSLOT * 256 * 2 <= 36 * MiB, "slot buffers");
constexpr int CW_CNT = 64;
constexpr int CW_BAR = 4096;

constexpr int RING_BYTES = 131072;
constexpr int MISC_OFF = RING_BYTES;
constexpr int LDS_BYTES = RING_BYTES + 16384;

__device__ __forceinline__ unsigned f2bf(float f) { unsigned u = __builtin_bit_cast(unsigned, f); return (u + 0x7fffu + ((u >> 16) & 1u)) >> 16; }
__device__ __forceinline__ unsigned pk2(float lo, float hi) { unsigned r; asm("v_cvt_pk_bf16_f32 %0, %1, %2" : "=v"(r) : "v"(lo), "v"(hi)); return r; }
__device__ __forceinline__ float bf2f(unsigned short b) { return __builtin_bit_cast(float, ((unsigned)b) << 16); }
__device__ __forceinline__ float bflo(unsigned w) { return __builtin_bit_cast(float, w << 16); }
__device__ __forceinline__ float bfhi(unsigned w) { return __builtin_bit_cast(float, w & 0xffff0000u); }
__device__ __forceinline__ float wave_sum(float v) {
#pragma unroll
    for (int o = 1; o < 64; o <<= 1) v += __shfl_xor(v, o);
    return v;
}
__device__ __forceinline__ float silu_f(float v) { return v / (1.0f + __expf(-v)); }
#define LDS_WAIT() asm volatile("s_waitcnt lgkmcnt(0)" ::: "memory")
#define VM_WAIT() asm volatile("s_waitcnt vmcnt(0)" ::: "memory")
#define LDS_BARRIER() do { asm volatile("s_waitcnt lgkmcnt(0)" ::: "memory"); __builtin_amdgcn_s_barrier(); asm volatile("" ::: "memory"); } while (0)
__device__ __forceinline__ int opaque_v(int x) { asm volatile("" : "+v"(x)); return x; }
__device__ __forceinline__ int lane_id() { return (int)__builtin_amdgcn_mbcnt_hi(~0u, __builtin_amdgcn_mbcnt_lo(~0u, 0u)); }

namespace pg8 {
constexpr int BM = 256, BK = 64, HALF = 128, HTB = HALF * BK * 2, STAGE_BYTES = 8 * HTB;
static_assert(STAGE_BYTES == RING_BYTES, "stage region");
__host__ __device__ __forceinline__ int lds_byte(int r, int c) { const int st = (r >> 4) * 2 + (c >> 5), rr = r & 15, cc = c & 31, ob = rr * 64 + cc * 2; return st * 1024 + (ob ^ (((ob >> 9) & 1) << 5)); }
__host__ __device__ __forceinline__ void stage_rc(int b, int& R, int& C) { const int st = b / 1024, sb = b % 1024, swz = sb ^ (((sb >> 9) & 1) << 5); R = (st >> 1) * 16 + swz / 64; C = (st & 1) * 32 + (swz % 64) / 2; }
__host__ __device__ __forceinline__ int perm32(int rho) { const int n = rho >> 4, i = rho & 15; return 8 * (i >> 2) + 4 * n + (i & 3); }

struct Unit { const char* A; const char* B; int r0, c0, a0, a1, nt, flags; };

__device__ __forceinline__ unsigned cvt_pk_bf16(float lo, float hi) { unsigned r; asm volatile("v_cvt_pk_bf16_f32 %0, %1, %2" : "=v"(r) : "v"(lo), "v"(hi)); return r; }

template <class Epi, class Sched, bool ALIGN_EPI, bool GATHER = false, bool PAIR = false, bool BMAP = false>
__device__ __forceinline__ void gemm_phase(LAS unsigned char* lds, const int tid, const int lda, const int ldb, const Sched& S, const Epi& E) {
    const int wid = __builtin_amdgcn_readfirstlane(tid >> 6), lane = tid & 63, wr = wid >> 2, wc = wid & 3, fr = lane & 15, fq = lane >> 4;
    unsigned voffA[2], voffB[2]; int gR[2], gC[2];
#pragma unroll
    for (int i = 0; i < 2; ++i) { int R, C; stage_rc(tid * 16 + i * 8192, R, C); const int Rb = Epi::PERM ? ((R & ~31) + perm32(R & 31)) : R; gR[i] = R; gC[i] = C;
        voffA[i] = (unsigned)(R * lda + C) * 2u; voffB[i] = (unsigned)(Rb * ldb + C) * 2u; }
    unsigned vb[2][2];
    if constexpr (BMAP) {
#pragma unroll
        for (int h = 0; h < 2; ++h)
#pragma unroll
            for (int i = 0; i < 2; ++i) vb[h][i] = (unsigned)(S.brow(h, gR[i]) * ldb + gC[i]) * 2u; }
    unsigned cv[2][2], nv[2][2];
    const size_t kstep = (size_t)(BK * 2);
    const size_t hstepA = GATHER ? 0 : (size_t)HALF * lda * 2, hstepB = (size_t)HALF * ldb * 2;
    const unsigned ldsw = (unsigned)wid * 1024u;
    const int aoff = lds_byte(wr * 64 + fr, fq * 8), boff = lds_byte(wc * 32 + fr, fq * 8);
#define PG8_SA(b, h) (((b) * 2 + (h)) * HTB)
#define PG8_SB(b, h) ((4 + (b) * 2 + (h)) * HTB)
#define PG8_STAGE(bufoff, gbase, voff) do { _Pragma("unroll") for (int _i = 0; _i < 2; ++_i) \
        __builtin_amdgcn_global_load_lds((const unsigned*)((const char*)(gbase) + (voff)[_i]), (LAS unsigned*)(lds + (bufoff) + ldsw + _i * 8192), 16, 0, 0); } while (0)
#define PG8_STAGE_A(bufoff, gbase, h, nx) do { if constexpr (GATHER) { if (nx) PG8_STAGE(bufoff, gbase, nv[h]); else PG8_STAGE(bufoff, gbase, cv[h]); } else PG8_STAGE(bufoff, (gbase) + (h) * hstepA, voffA); } while (0)
#define PG8_STAGE_B(bufoff, gbase, h) do { if constexpr (BMAP) PG8_STAGE(bufoff, gbase, vb[h]); else PG8_STAGE(bufoff, (gbase) + (h) * hstepB, voffB); } while (0)
#define PG8_LDA(dst, b, h) do { _Pragma("unroll") for (int m = 0; m < 4; ++m) _Pragma("unroll") for (int k = 0; k < 2; ++k) dst[m][k] = *(const LAS bf16x8*)(lds + PG8_SA(b, h) + aoff + m * 2048 + k * 1024); } while (0)
#define PG8_LDB(dst, b, h) do { _Pragma("unroll") for (int n = 0; n < 2; ++n) _Pragma("unroll") for (int k = 0; k < 2; ++k) dst[n][k] = *(const LAS bf16x8*)(lds + PG8_SB(b, h) + boff + n * 2048 + k * 1024); } while (0)
#define PG8_MMA(ai, bj, At, Bt) do { __builtin_amdgcn_s_setprio(1); _Pragma("unroll") for (int m = 0; m < 4; ++m) _Pragma("unroll") for (int n = 0; n < 2; ++n) _Pragma("unroll") for (int k = 0; k < 2; ++k) \
        acc[ai][bj][m][n] = __builtin_amdgcn_mfma_f32_16x16x32_bf16(Bt[n][k], At[m][k], acc[ai][bj][m][n], 0, 0, 0); __builtin_amdgcn_s_setprio(0); } while (0)
#define PG8_WAIT_V(n) asm volatile("s_waitcnt vmcnt(" #n ")" ::: "memory")
#define PG8_WAIT_L(n) asm volatile("s_waitcnt lgkmcnt(" #n ")" ::: "memory")
#define PG8_BAR __builtin_amdgcn_s_barrier()
#define PG8_SCHED __builtin_amdgcn_sched_barrier(0)
    Unit cur, nxt; int ui = 0;
    if (!S.next(0, cur)) return;
    f32x4 acc[2][2][4][2];
#pragma unroll
    for (int a = 0; a < 2; ++a)
#pragma unroll
        for (int b = 0; b < 2; ++b)
#pragma unroll
            for (int m = 0; m < 4; ++m)
#pragma unroll
                for (int n = 0; n < 2; ++n) acc[a][b][m][n] = (f32x4){0.f, 0.f, 0.f, 0.f};
    bf16x8 At[4][2], B0[2][2], B1[2][2];
    const char* cA = cur.A; const char* cB = cur.B;
    if constexpr (GATHER) {
#pragma unroll
        for (int h = 0; h < 2; ++h)
#pragma unroll
            for (int i = 0; i < 2; ++i) cv[h][i] = S.arow(cur, h * HALF + gR[i]) + (unsigned)gC[i] * 2u; }
    {
        const char* b0 = cB + (size_t)S.kb(cur, 0) * kstep; const char* b1 = cB + (size_t)S.kb(cur, 1) * kstep;
        PG8_STAGE_B(PG8_SB(0, 0), b0, 0); PG8_STAGE_B(PG8_SB(0, 1), b0, 1); PG8_STAGE_A(PG8_SA(0, 0), cA, 0, false); PG8_STAGE_A(PG8_SA(0, 1), cA, 1, false);
        if (wr == 1) PG8_BAR;
        PG8_WAIT_V(2); PG8_BAR;
        PG8_STAGE_B(PG8_SB(1, 0), b1, 0); PG8_STAGE_A(PG8_SA(1, 0), cA + kstep, 0, false); PG8_STAGE_B(PG8_SB(1, 1), b1, 1);
        PG8_WAIT_V(6); PG8_BAR;
    }
    bool has_next; const char* nA; const char* nB;
#define PG8_UNIT_KLOOP() do { \
        has_next = S.next(ui + 1, nxt); \
        const Unit& nu = has_next ? nxt : cur; \
        if constexpr (GATHER) { \
            _Pragma("unroll") for (int h = 0; h < 2; ++h) _Pragma("unroll") for (int i = 0; i < 2; ++i) nv[h][i] = S.arow(nu, h * HALF + gR[i]) + (unsigned)gC[i] * 2u; } \
        nA = nu.A; nB = nu.B; \
        const int nt = cur.nt; \
        for (int t = 0; t < nt; t += 2) { \
            const bool last = (t == nt - 2); \
            const char* a1 = cA + (size_t)(t + 1) * kstep; \
            const char* a2 = last ? nA : cA + (size_t)(t + 2) * kstep; \
            const char* a3 = a2 + kstep; \
            const char* b2 = last ? nB + (size_t)S.kb(nu, 0) * kstep : cB + (size_t)S.kb(cur, t + 2) * kstep; \
            const char* b3 = last ? nB + (size_t)S.kb(nu, 1) * kstep : cB + (size_t)S.kb(cur, t + 3) * kstep; \
            PG8_LDB(B0, 0, 0); PG8_LDB(B1, 0, 1); PG8_SCHED; PG8_LDA(At, 0, 0); PG8_STAGE_A(PG8_SA(1, 1), a1, 1, false); \
            PG8_WAIT_V(8); PG8_WAIT_L(0); PG8_BAR; PG8_MMA(0, 0, At, B0); PG8_MMA(0, 1, At, B1); PG8_BAR; PG8_SCHED; \
            PG8_LDA(At, 0, 1); PG8_STAGE_B(PG8_SB(0, 0), b2, 0); PG8_STAGE_B(PG8_SB(0, 1), b2, 1); PG8_STAGE_A(PG8_SA(0, 0), a2, 0, last); \
            PG8_WAIT_V(8); PG8_WAIT_L(0); PG8_BAR; PG8_MMA(1, 0, At, B0); PG8_MMA(1, 1, At, B1); PG8_BAR; PG8_SCHED; \
            PG8_LDB(B0, 1, 0); PG8_LDB(B1, 1, 1); PG8_SCHED; PG8_LDA(At, 1, 0); PG8_STAGE_A(PG8_SA(0, 1), a2, 1, last); \
            PG8_WAIT_V(8); PG8_WAIT_L(0); PG8_BAR; PG8_MMA(0, 0, At, B0); PG8_MMA(0, 1, At, B1); PG8_BAR; PG8_SCHED; \
            PG8_LDA(At, 1, 1); PG8_STAGE_B(PG8_SB(1, 0), b3, 0); PG8_STAGE_B(PG8_SB(1, 1), b3, 1); PG8_STAGE_A(PG8_SA(1, 0), a3, 0, last); \
            PG8_WAIT_V(8); PG8_WAIT_L(0); PG8_BAR; PG8_MMA(1, 0, At, B0); PG8_MMA(1, 1, At, B1); PG8_BAR; PG8_SCHED; \
        } } while (0)
#define PG8_ADVANCE() do { cur = nxt; cA = nA; cB = nB; ++ui; \
        if constexpr (GATHER) { _Pragma("unroll") for (int h = 0; h < 2; ++h) _Pragma("unroll") for (int i = 0; i < 2; ++i) cv[h][i] = nv[h][i]; } } while (0)
    for (;;) {
        PG8_UNIT_KLOOP();
        if constexpr (PAIR) {
            S.between(cur, acc, wr);
            PG8_ADVANCE();
            PG8_UNIT_KLOOP();
        }
        if constexpr (ALIGN_EPI) { if (wr == 0) PG8_BAR; }
        E(acc, cur, wr, wc, fr, fq);
        if (!has_next) break;
#pragma unroll
        for (int a = 0; a < 2; ++a)
#pragma unroll
            for (int b = 0; b < 2; ++b)
#pragma unroll
                for (int m = 0; m < 4; ++m)
#pragma unroll
                    for (int n = 0; n < 2; ++n) acc[a][b][m][n] = (f32x4){0.f, 0.f, 0.f, 0.f};
        PG8_ADVANCE();
        if constexpr (ALIGN_EPI) { if (wr == 1) PG8_BAR; }
    }
#undef PG8_UNIT_KLOOP
#undef PG8_ADVANCE
    PG8_WAIT_V(0);
    if constexpr (!ALIGN_EPI) { if (wr == 0) PG8_BAR; }
    PG8_BAR;
#undef PG8_SA
#undef PG8_SB
#undef PG8_STAGE
#undef PG8_STAGE_A
#undef PG8_STAGE_B
#undef PG8_LDA
#undef PG8_LDB
#undef PG8_MMA
#undef PG8_WAIT_V
#undef PG8_WAIT_L
#undef PG8_BAR
#undef PG8_SCHED
}

struct PlainOrder {
    const char* A; const char* B; int lda, ldb, nM, nN, G, c, nt;
    __device__ __forceinline__ bool next(int i, Unit& u) const {
        const int L = i * G + c; if (L >= nM * nN) return false;
        const int pm = L / nN, pn = L - pm * nN;
        u.A = A + (size_t)pm * 256 * lda * 2; u.B = B + (size_t)pn * 256 * ldb * 2; u.r0 = pm * 256; u.c0 = pn * 256; u.a0 = 0; u.a1 = 0; u.nt = nt; u.flags = 3; return true;
    }
    __device__ __forceinline__ int kb(const Unit&, int t) const { return t; }
    __device__ __forceinline__ int brow(int h, int R) const { return 64 * (R >> 5) + 32 * h + perm32(R & 31); }
};
struct EpiBf16 {
    static constexpr bool PERM = true;
    bf16* O; int ldc; int split_cols; bf16* O2; int ldc2; int skip = 0;
    __device__ __forceinline__ void operator()(const f32x4 (&acc)[2][2][4][2], const Unit& u, int wr, int wc, int fr_, int fq_) const {
        (void)fr_; (void)fq_; const int ln_ = opaque_v(lane_id()); const int fr = ln_ & 15, fq = ln_ >> 4;
        bf16* base = O; int ld = ldc; int colt = u.c0;
        if (split_cols > 0 && colt >= split_cols) { base = O2; ld = ldc2; colt -= split_cols; }
        const int row0 = u.r0 + wr * 64 + fr, col0 = colt + wc * 32 + 8 * fq;
#pragma unroll
        for (int ai = 0; ai < 2; ++ai)
#pragma unroll
            for (int m = 0; m < 4; ++m) { bf16* rowp = base + (size_t)(row0 + ai * HALF + m * 16) * ld + col0;
#pragma unroll
                for (int bj = 0; bj < 2; ++bj) { const f32x4 v0 = acc[ai][bj][m][0], v1 = acc[ai][bj][m][1];
                    u32x4 w; w.x = cvt_pk_bf16(v0[0], v0[1]); w.y = cvt_pk_bf16(v0[2], v0[3]); w.z = cvt_pk_bf16(v1[0], v1[1]); w.w = cvt_pk_bf16(v1[2], v1[3]);
                    if (!((REP_ABL & 128) && skip)) *(u32x4*)(rowp + bj * HALF) = w; else if (w.x == 0x12345678u) *(u32x4*)(rowp) = w; } }
    }
};
template <bool XF32> struct EpiResid {
    static constexpr bool PERM = true;
    const void* xin; bf16* out; const float* gate;
    __device__ __forceinline__ void operator()(const f32x4 (&acc)[2][2][4][2], const Unit& u, int wr, int wc, int fr_, int fq_) const {
        (void)fr_; (void)fq_; const int ln_ = opaque_v(lane_id()); const int fr = ln_ & 15, fq = ln_ >> 4;
        const int row0 = u.r0 + wr * 64 + fr, col0 = u.c0 + wc * 32 + 8 * fq;
        const float* g = gate + (size_t)(u.r0 / SEQ) * 6144 + col0;
        f32x4 gv[2][2];
#pragma unroll
        for (int bj = 0; bj < 2; ++bj)
#pragma unroll
            for (int n = 0; n < 2; ++n) gv[bj][n] = *(const f32x4*)(g + bj * HALF + 4 * n);
#pragma unroll
        for (int ai = 0; ai < 2; ++ai)
#pragma unroll
            for (int m = 0; m < 4; ++m) { const size_t off = (size_t)(row0 + ai * HALF + m * 16) * DM + col0;
#pragma unroll
                for (int bj = 0; bj < 2; ++bj) { f32x4 x0, x1;
                    if (XF32) { x0 = *(const f32x4*)((const float*)xin + off + bj * HALF); x1 = *(const f32x4*)((const float*)xin + off + bj * HALF + 4); }
                    else { const u32x4 w = *(const u32x4*)((const bf16*)xin + off + bj * HALF); x0 = (f32x4){bflo(w.x), bfhi(w.x), bflo(w.y), bfhi(w.y)}; x1 = (f32x4){bflo(w.z), bfhi(w.z), bflo(w.w), bfhi(w.w)}; }
                    const f32x4 y0 = x0 + gv[bj][0] * acc[ai][bj][m][0], y1 = x1 + gv[bj][1] * acc[ai][bj][m][1];
                    u32x4 o; o.x = cvt_pk_bf16(y0[0], y0[1]); o.y = cvt_pk_bf16(y0[2], y0[3]); o.z = cvt_pk_bf16(y1[0], y1[1]); o.w = cvt_pk_bf16(y1[2], y1[3]);
                    *(u32x4*)(out + off + bj * HALF) = o; }
                if (m & 1) asm volatile("" ::: "memory"); }
    }
};
struct EpiQKNorm {
    static constexpr bool PERM = true;
    bf16* O; const float* qg; const float* kg;
    __device__ __forceinline__ void operator()(const f32x4 (&acc)[2][2][4][2], const Unit& u, int wr, int wc, int fr_, int fq_) const {
        (void)fr_; (void)fq_; const int ln_ = opaque_v(lane_id()); const int fr = ln_ & 15, fq = ln_ >> 4;
        const bool isq = u.c0 < 1024; const float* gain = (isq ? qg : kg) + 8 * fq; const float osc = isq ? 0.125f * LOG2E : 1.0f;
        f32x4 g[2][2];
#pragma unroll
        for (int bj = 0; bj < 2; ++bj)
#pragma unroll
            for (int n = 0; n < 2; ++n) g[bj][n] = *(const f32x4*)(gain + 32 * bj + 4 * n) * osc;
        const int row0 = u.r0 + wr * 64 + fr, col0 = u.c0 + wc * 64 + 8 * fq;
#pragma unroll
        for (int ai = 0; ai < 2; ++ai)
#pragma unroll
            for (int m = 0; m < 4; ++m) { f32x4 sv = (f32x4){0.f, 0.f, 0.f, 0.f};
#pragma unroll
                for (int bj = 0; bj < 2; ++bj) { sv += acc[ai][bj][m][0] * acc[ai][bj][m][0]; sv += acc[ai][bj][m][1] * acc[ai][bj][m][1]; }
                float s = (sv[0] + sv[1]) + (sv[2] + sv[3]);
                s += __shfl_xor(s, 16); s += __shfl_xor(s, 32);
                const float rs = 1.0f / sqrtf(s * (1.0f / 64.0f) + EPS);
                bf16* rowp = O + (size_t)(row0 + ai * HALF + m * 16) * 2048 + col0;
#pragma unroll
                for (int bj = 0; bj < 2; ++bj) { const f32x4 v0 = acc[ai][bj][m][0] * rs * g[bj][0], v1 = acc[ai][bj][m][1] * rs * g[bj][1];
                    u32x4 w; w.x = cvt_pk_bf16(v0[0], v0[1]); w.y = cvt_pk_bf16(v0[2], v0[3]); w.z = cvt_pk_bf16(v1[0], v1[1]); w.w = cvt_pk_bf16(v1[2], v1[3]);
                    *(u32x4*)(rowp + 32 * bj) = w; } }
    }
};
}

#define XB_TMO      128
#define XB_XCNT(j)  (256  + 64 * (j))
#define XB_XSUB(j)  (1280 + 64 * (j))
#define XB_XGEN(j)  (2304 + 64 * (j))
#define XB_TOP      3328
#define XB_TOPGEN   3392
#define XCD_BAR_WORDS 3456
#define XB_SPIN_CAP (1u << 18)
__device__ __forceinline__ unsigned xb_ld(unsigned* p)              { return __hip_atomic_load(p, __ATOMIC_RELAXED, __HIP_MEMORY_SCOPE_AGENT); }
__device__ __forceinline__ unsigned xb_add(unsigned* p, unsigned v) { return __hip_atomic_fetch_add(p, v, __ATOMIC_RELAXED, __HIP_MEMORY_SCOPE_AGENT); }
__device__ __forceinline__ unsigned xb_xcc_id() { return (unsigned)__builtin_amdgcn_s_getreg((3 << 11) | 20) & 0xFu; }
#define XB_SPIN(cond, bar) do { unsigned _sp = 0; while (cond) { __builtin_amdgcn_s_sleep(1); \
    if ((++_sp & 255u) == 0u) { if (xb_ld(&(bar)[XB_TMO])) break; if (_sp > XB_SPIN_CAP) { atomicAdd(&(bar)[XB_TMO], 1u); break; } } } } while (0)
struct XcdBarrier { unsigned* bar; unsigned x; volatile LAS unsigned* st; };
__device__ __forceinline__ XcdBarrier xcd_barrier_post(unsigned* bar, volatile LAS unsigned* st) {
    XcdBarrier b; b.bar = bar; b.x = xb_xcc_id(); b.st = st;
    if (threadIdx.x == 0) (void)xb_add(&bar[XB_XCNT(b.x)], 1u);
    return b;
}
__device__ __forceinline__ void xcd_barrier_complete(unsigned* bar, unsigned x, unsigned& nloc, unsigned& nx) {
    const unsigned G = gridDim.x * gridDim.y * gridDim.z;
    unsigned sum, cnt, mine, sp = 0u;
    for (;;) {
        sum = 0u; cnt = 0u; mine = 0u;
#pragma unroll
        for (unsigned j = 0; j < 16; ++j) { const unsigned c = xb_ld(&bar[XB_XCNT(j)]); sum += c; cnt += (c > 0u) ? 1u : 0u; mine = (j == x) ? c : mine; }
        if (sum == G) break;
        __builtin_amdgcn_s_sleep(1);
        if ((++sp & 255u) == 0u) { if (xb_ld(&bar[XB_TMO])) break; if (sp > XB_SPIN_CAP) { atomicAdd(&bar[XB_TMO], 1u); break; } }
    }
    nloc = mine > 0u ? mine : 1u; nx = cnt > 0u ? cnt : 1u;
}
__device__ __forceinline__ void xcd_barrier(const XcdBarrier& b) {
    asm volatile("s_waitcnt vmcnt(0)" ::: "memory");
    __syncthreads();
    if (threadIdx.x == 0) {
        unsigned* bar = b.bar;
        __builtin_amdgcn_s_waitcnt(0);
        unsigned nloc = b.st[0], nx = b.st[1];
        if (nloc == 0u) { xcd_barrier_complete(bar, b.x, nloc, nx); b.st[0] = nloc; b.st[1] = nx; }
        const unsigned old = xb_add(&bar[XB_XSUB(b.x)], 1u);
        const unsigned gen = old / nloc;
        if (old + 1u == (gen + 1u) * nloc) {
            __builtin_amdgcn_fence(__ATOMIC_RELEASE, "agent");
            asm volatile("s_waitcnt vmcnt(0)" ::: "memory");
            const unsigned og = xb_add(&bar[XB_TOP], 1u);
            const unsigned tg = og / nx;
            if (og + 1u == (tg + 1u) * nx) xb_add(&bar[XB_TOPGEN], 1u);
            else XB_SPIN(xb_ld(&bar[XB_TOPGEN]) == tg, bar);
            __builtin_amdgcn_fence(__ATOMIC_ACQUIRE, "agent");
            xb_add(&bar[XB_XGEN(b.x)], 1u);
            asm volatile("s_waitcnt vmcnt(0)" ::: "memory");
        } else {
            XB_SPIN(xb_ld(&bar[XB_XGEN(b.x)]) == gen, bar);
            __builtin_amdgcn_fence(__ATOMIC_ACQUIRE, "agent");
            asm volatile("s_waitcnt vmcnt(0)" ::: "memory");
        }
    }
    __syncthreads();
}

struct Args { const float* in[32]; float* out; unsigned char* ws; int ph_lo, ph_hi; };
enum { IN_X = 0, IN_C, IN_REL, IN_ADAW, IN_ADAB, IN_NMG, IN_NFG, IN_DAWIN, IN_DAWOUT, IN_QG, IN_KG, IN_LQ1, IN_LK1, IN_LQ2, IN_LK2, IN_SUBLN,
       IN_MLWIN, IN_CONVW, IN_CONVB, IN_WQ, IN_WK, IN_WV, IN_GATEW, IN_GATEB, IN_ONG, IN_SKIP, IN_MLWOUT, IN_WGRP, IN_WRT, IN_W1, IN_W3, IN_W2 };

struct Ctx {
    const Args* a; GAS unsigned char* ws; LAS unsigned char* lds; int tid, lane, wave, G, vcu;
    __device__ __forceinline__ const float* in(int i) const { return (const float*)(const GAS float*)a->in[i]; }
    template <class Tp> __device__ __forceinline__ Tp* w(size_t off) const { return (Tp*)(GAS Tp*)(ws + off); }
    __device__ __forceinline__ float* xout() const { return (float*)(GAS float*)a->out; }
    __device__ __forceinline__ const float* mods(int layer, int which) const { return (const float*)(ws + WS_MODS) + (size_t)layer * 16 * 6144 + which * 1024; }
};

__device__ __forceinline__ Ctx fresh(const Ctx& C) {
    Ctx P = C; int t = C.tid; asm volatile("" : "+v"(t)); P.tid = t; P.lane = t & 63; P.wave = __builtin_amdgcn_readfirstlane(t >> 6);
    GAS unsigned char* w = C.ws; asm volatile("" : "+s"(w)); P.ws = w; int g = __builtin_amdgcn_readfirstlane(C.G), v = __builtin_amdgcn_readfirstlane(C.vcu); asm volatile("" : "+s"(g), "+s"(v)); P.G = g; P.vcu = v;
    return P;
}
__device__ __forceinline__ void transpose_item(const float* W, int K, int N, bf16* WT, int ldt, int dst_row0, LAS float* scr, int kb, int nb, int lane) {
    const int k0 = 64 * kb, n0 = 32 * nb;
#pragma unroll 8
    for (int i = 0; i < 32; ++i) { const int kk = 2 * i + (lane >> 5); scr[kk * 33 + (lane & 31)] = W[(size_t)(k0 + kk) * N + n0 + (lane & 31)]; }
    LDS_WAIT(); asm volatile("" ::: "memory");
    const int c = lane & 7;
#pragma unroll
    for (int j = 0; j < 4; ++j) { const int n = (lane >> 3) + 8 * j; const LAS float* s = scr + (8 * c) * 33 + n;
        u32x4 o; o.x = pk2(s[0 * 33], s[1 * 33]); o.y = pk2(s[2 * 33], s[3 * 33]); o.z = pk2(s[4 * 33], s[5 * 33]); o.w = pk2(s[6 * 33], s[7 * 33]);
        *(u32x4*)(WT + (size_t)(dst_row0 + n) * ldt + k0 + 8 * c) = o; }
    LDS_WAIT(); asm volatile("" ::: "memory");
}
__device__ __forceinline__ void moe_weight_items(const Ctx& C, int layer, LAS float* scr) {
    const int gw = C.vcu * 8 + C.wave, NGW = C.G * 8;
    const float* w1 = C.in(IN_W1) + (size_t)layer * NEXP * DM * DEXP; const float* w3 = C.in(IN_W3) + (size_t)layer * NEXP * DM * DEXP; const float* w2 = C.in(IN_W2) + (size_t)layer * NEXP * DEXP * DM;
    bf16* W13T = C.w<bf16>(WS_W13T); bf16* W2T = C.w<bf16>(WS_W2T);
    constexpr int I13 = 16 * 8, I2 = 4 * 32;
    for (int it = gw; it < NEXP * (2 * I13 + I2); it += NGW) {
        const int e = it / (2 * I13 + I2); int r = it - e * (2 * I13 + I2);
        if (r < 2 * I13) { const int which = r / I13; r -= which * I13; const int kb = r / 8, nb = r % 8; const int n0 = 32 * nb;
            const int dst = (n0 / 128) * 256 + which * 128 + (n0 % 128);
            transpose_item((which ? w3 : w1) + (size_t)e * DM * DEXP, DM, DEXP, W13T + (size_t)e * 512 * DM, DM, dst, scr, kb, nb, C.lane); }
        else { r -= 2 * I13; const int kb = r / 32, nb = r % 32;
            transpose_item(w2 + (size_t)e * DEXP * DM, DEXP, DM, W2T + (size_t)e * DM * DEXP, DEXP, 32 * nb, scr, kb, nb, C.lane); }
    }
}
__device__ __forceinline__ void plain_weight_items(const Ctx& C, const float* W, int K, int N, bf16* WT, LAS float* scr) {
    const int gw = C.vcu * 8 + C.wave, NGW = C.G * 8; const int nblk = N / 32;
    for (int it = gw; it < (K / 64) * nblk; it += NGW) { const int kb = it / nblk, nb = it % nblk; transpose_item(W, K, N, WT, K, 32 * nb, scr, kb, nb, C.lane); }
}
__device__ __forceinline__ int t5_bucket(int rel) {
    const int n = rel < 0 ? -rel : rel; int b;
    if (n < 8) b = n; else b = 8 + (n >= 12) + (n >= 16) + (n >= 23) + (n >= 32) + (n >= 46) + (n >= 64) + (n >= 91);
    return b + (rel > 0 ? 16 : 0);
}
__device__ __forceinline__ void p_prologue(const Ctx& C) {
    __syncthreads();
    {
        LAS float* cact = (LAS float*)C.lds;
        LAS float* red = (LAS float*)(C.lds + 65536);
        const float* c = C.in(IN_C);
        for (int i = C.tid; i < 16 * 1024; i += 512) cact[i] = silu_f(c[i]);
        __syncthreads();
        for (int task = C.vcu; task < 192; task += C.G) {
            const int layer = task / 96, n0 = (task % 96) * 64, nl = C.tid & 63, kc = C.tid >> 6;
            const float* W = C.in(IN_ADAW) + (size_t)layer * DM * 6144 + n0 + nl;
            float acc[16];
#pragma unroll
            for (int b = 0; b < 16; ++b) acc[b] = 0.f;
            for (int k = kc * 128; k < kc * 128 + 128; ++k) { const float wv = W[(size_t)k * 6144];
#pragma unroll
                for (int b = 0; b < 16; ++b) acc[b] += cact[b * 1024 + k] * wv; }
#pragma unroll
            for (int b = 0; b < 16; ++b) red[(kc * 16 + b) * 64 + nl] = acc[b];
            __syncthreads();
            for (int o = C.tid; o < 16 * 64; o += 512) { const int b = o >> 6, n = o & 63; float s = 0.f;
#pragma unroll
                for (int q = 0; q < 8; ++q) s += red[(q * 16 + b) * 64 + n];
                C.w<float>(WS_MODS)[(size_t)layer * 16 * 6144 + (size_t)b * 6144 + n0 + n] = s + C.in(IN_ADAB)[layer * 6144 + n0 + n]; }
            __syncthreads();
        }
    }
    {
        const int gt = C.vcu * 512 + C.tid, NGT = C.G * 512;
        float mq = 0.f, mk = 0.f;
        for (int i = 0; i < 64; ++i) { mq = fmaxf(mq, fabsf(C.in(IN_QG)[i])); mk = fmaxf(mk, fabsf(C.in(IN_KG)[i])); }
        for (int i = gt; i < 8 * 4096; i += NGT) { const int h = i >> 12, idx = i & 4095; if (idx < 4095) {
            float mb = -1e30f; for (int b = 0; b < 32; ++b) mb = fmaxf(mb, C.in(IN_REL)[b * 8 + h]);
            const float cshift = 8.0f * mq * mk + mb;
            C.w<float>(WS_TAB2)[i] = (C.in(IN_REL)[t5_bucket(idx - 2047) * 8 + h] - cshift) * LOG2E; } else C.w<float>(WS_TAB2)[i] = 0.f; }
        if (gt == 0) { float s1 = 0.f, s2 = 0.f; for (int i = 0; i < 64; ++i) { s1 += C.in(IN_LQ1)[i] * C.in(IN_LK1)[i]; s2 += C.in(IN_LQ2)[i] * C.in(IN_LK2)[i]; }
            C.w<float>(WS_SCAL)[0] = __expf(s1) - __expf(s2) + 0.2f; }
        for (int i = gt; i < 16 * 6144; i += NGT) { const int n = i / 6144, k = i % 6144, d = n >> 3, g = n & 7, m = k / 2048, c = k % 2048;
            C.w<bf16>(WS_GWT)[i] = (bf16)f2bf(C.in(IN_GATEW)[(((size_t)d * 3 + m) * 2048 + c) * 8 + g]); }
    }
    LAS float* scr = (LAS float*)(C.lds + C.wave * 16384);
    plain_weight_items(C, C.in(IN_DAWIN), DM, 3 * DM, C.w<bf16>(WS_WINT), scr);
    plain_weight_items(C, C.in(IN_DAWOUT), DM, DM, C.w<bf16>(WS_WOT), scr);
    plain_weight_items(C, C.in(IN_MLWIN), DM, 2 * ML_IN, C.w<bf16>(WS_MLWINT), scr);
    plain_weight_items(C, C.in(IN_MLWOUT), ML_IN, DM, C.w<bf16>(WS_MLWOUTT), scr);
    moe_weight_items(C, 0, scr);
}

__device__ __forceinline__ void normmod_row(const float* xrow, const float* g, const float* sc, const float* sh, bf16* orow, int lane) {
    const f32x4* xr = (const f32x4*)xrow + lane; f32x4 v[4]; float s = 0.f;
#pragma unroll
    for (int j = 0; j < 4; ++j) { v[j] = xr[64 * j]; s += (v[j].x * v[j].x + v[j].y * v[j].y) + (v[j].z * v[j].z + v[j].w * v[j].w); }
    const float rstd = 1.0f / sqrtf(wave_sum(s) * (1.0f / DM) + EPS);
    u32x2* o8 = (u32x2*)orow + lane;
#pragma unroll
    for (int j = 0; j < 4; ++j) { const f32x4 gv = ((const f32x4*)g)[lane + 64 * j], scv = ((const f32x4*)sc)[lane + 64 * j], shv = ((const f32x4*)sh)[lane + 64 * j];
        const f32x4 y = (v[j] * rstd * gv) * (scv + 1.0f) + shv; u32x2 w; w.x = pk2(y.x, y.y); w.y = pk2(y.z, y.w); o8[64 * j] = w; }
}
__device__ __forceinline__ void normmod_row_bf(const bf16* xrow, const float* g, const float* sc, const float* sh, bf16* orow, int lane) {
    float v[2][8]; float s = 0.f;
#pragma unroll
    for (int j = 0; j < 2; ++j) { const u32x4 w = *((const u32x4*)(xrow + 512 * j) + lane);
        v[j][0] = bflo(w.x); v[j][1] = bfhi(w.x); v[j][2] = bflo(w.y); v[j][3] = bfhi(w.y); v[j][4] = bflo(w.z); v[j][5] = bfhi(w.z); v[j][6] = bflo(w.w); v[j][7] = bfhi(w.w);
#pragma unroll
        for (int i = 0; i < 8; ++i) s += v[j][i] * v[j][i]; }
    const float rstd = 1.0f / sqrtf(wave_sum(s) * (1.0f / DM) + EPS);
#pragma unroll
    for (int j = 0; j < 2; ++j) { const int c = 512 * j + 8 * lane; float y[8];
#pragma unroll
        for (int i = 0; i < 8; ++i) y[i] = (v[j][i] * rstd * g[c + i]) * (sc[c + i] + 1.0f) + sh[c + i];
        u32x4 w; w.x = pk2(y[0], y[1]); w.y = pk2(y[2], y[3]); w.z = pk2(y[4], y[5]); w.w = pk2(y[6], y[7]);
        *((u32x4*)(orow + 512 * j) + lane) = w; }
}
__device__ __forceinline__ void p_normmod_bf(const Ctx& C, const bf16* xsrc, int layer, int row_lo, int row_hi, bf16* dst) {
    const int gw = C.vcu * 8 + C.wave, NGW = C.G * 8;
    const float* g = C.in(IN_NMG) + layer * DM;
    for (int r = row_lo + gw; r < row_hi; r += NGW) { const int b = r / SEQ;
        normmod_row_bf(xsrc + (size_t)r * DM, g, C.mods(layer, 1) + (size_t)b * 6144, C.mods(layer, 0) + (size_t)b * 6144, dst + (size_t)(r - row_lo) * DM, C.lane); }
}
__device__ __forceinline__ void p_normmod(const Ctx& C, const float* xsrc, int layer, int row_lo, int row_hi, bf16* dst) {
    const int gw = C.vcu * 8 + C.wave, NGW = C.G * 8;
    const float* g = C.in(IN_NMG) + layer * DM;
    for (int r = row_lo + gw; r < row_hi; r += NGW) { const int b = r / SEQ;
        normmod_row(xsrc + (size_t)r * DM, g, C.mods(layer, 1) + (size_t)b * 6144, C.mods(layer, 0) + (size_t)b * 6144, dst + (size_t)(r - row_lo) * DM, C.lane); }
}

constexpr int AT_KS = 144, AT_VS = 144;
constexpr int AT_K_BYTES = 2 * 64 * AT_KS, AT_V_BYTES = 128 * AT_VS, AT_BUF = AT_K_BYTES + AT_V_BYTES;
constexpr int AT_TAB_OFF = 3 * AT_BUF;
constexpr int AT_EX_OFF = 0, AT_EX_PITCH = 132;
static_assert(AT_BUF % 16 == 0 && AT_TAB_OFF + 16384 <= RING_BYTES && 4 * 32 * AT_EX_PITCH * 4 <= AT_TAB_OFF, "attention LDS");
template <int ABL> __device__ __forceinline__ void attn_unit(const Ctx& C, int b, int h, int qt, bool load_tab, float lam) {
    LAS unsigned char* lds = C.lds;
    const int tid = C.tid, lane = C.lane, wid = C.wave, mp = wid >> 2, rb = wid & 3, r32 = lane & 31, hi = lane >> 5;
    const bf16* QK = C.w<bf16>(WS_QK); const bf16* VT = C.w<bf16>(WS_VT);
    const size_t tok0 = (size_t)b * SEQ; const int q0 = qt * 128, qa = q0 + 32 * rb;
    LAS float* tab = (LAS float*)(lds + AT_TAB_OFF);
    __syncthreads();
    if (load_tab) { const float* t2 = C.w<float>(WS_TAB2) + h * 4096; for (int i = tid; i < 4096; i += 512) tab[i] = t2[i]; }
    bf16x8 qf[4];
    { const bf16* qrow = QK + (tok0 + qa + r32) * 2048 + h * 128 + mp * 64 + hi * 8;
#pragma unroll
      for (int ks = 0; ks < 4; ++ks) qf[ks] = *(const bf16x8*)(qrow + ks * 16);
      asm volatile("" : "+v"(qf[0]), "+v"(qf[1]), "+v"(qf[2]), "+v"(qf[3])); }
    const int kkey = tid >> 4, kcc = tid & 15, vdv = tid >> 3, vkc = tid & 7;
    const bf16* ksrc = QK + (tok0 + kkey) * 2048 + 1024 + h * 128 + kcc * 8;
    const bf16* vsrc = VT + (size_t)(h * 128 + vdv) * NT + tok0 + vkc * 8;
    const int kdst = ((kcc >> 3) * 64 + kkey) * AT_KS + (kcc & 7) * 16;
    const int vdst = AT_K_BYTES + vdv * AT_VS + (vkc >> 1) * 32 + (vkc & 1) * 8;
    u32x4 kst[2], vst[2];
#define AT_LOAD(t) do { const int k0_ = (t) * 64; kst[0] = *(const u32x4*)(ksrc + (size_t)k0_ * 2048); kst[1] = *(const u32x4*)(ksrc + (size_t)(k0_ + 32) * 2048); \
        vst[0] = *(const u32x4*)(vsrc + k0_); vst[1] = *(const u32x4*)(vsrc + (size_t)64 * NT + k0_); } while (0)
#define AT_WRITE(bufo) do { _Pragma("unroll") for (int i_ = 0; i_ < 2; ++i_) { *(LAS u32x4*)(lds + (bufo) + kdst + 32 * i_ * AT_KS) = kst[i_]; \
        LAS u32x2* vd_ = (LAS u32x2*)(lds + (bufo) + vdst + 64 * i_ * AT_VS); vd_[0] = (u32x2){vst[i_].x, vst[i_].y}; vd_[2] = (u32x2){vst[i_].z, vst[i_].w}; } } while (0)
    const int kfo = (mp * 64 + r32) * AT_KS + hi * 16;
    const int vfo = AT_K_BYTES + r32 * AT_VS + hi * 16;
    f32x16 o[4];
#pragma unroll
    for (int i = 0; i < 4; ++i) o[i] = (f32x16){0.f, 0.f, 0.f, 0.f, 0.f, 0.f, 0.f, 0.f, 0.f, 0.f, 0.f, 0.f, 0.f, 0.f, 0.f, 0.f};
    f32x2 lacc = (f32x2){0.f, 0.f};
    bf16x8 pf[4];

#define AT_SOFT(t, bo) do { const int k0_ = (t) * 64; const int dlo_ = k0_ - qa - 31, dhi_ = k0_ + 63 - qa; \
        const bool cst_ = (dhi_ <= -91) || (dlo_ >= 91); const float ini_ = (dhi_ <= -91) ? c_neg : ((dlo_ >= 91) ? c_pos : 0.f); \
        bf16x8 kf_[2][4]; \
        _Pragma("unroll") for (int kb_ = 0; kb_ < 2; ++kb_) _Pragma("unroll") for (int ks_ = 0; ks_ < 4; ++ks_) kf_[kb_][ks_] = *(const LAS bf16x8*)(lds + (bo) + kfo + kb_ * 32 * AT_KS + ks_ * 32); \
        f32x16 s0_, s1_; \
        _Pragma("unroll") for (int r_ = 0; r_ < 16; ++r_) { s0_[r_] = ini_; s1_[r_] = ini_; } \
        if (!(ABL & 16)) { _Pragma("unroll") for (int ks_ = 0; ks_ < 4; ++ks_) { s0_ = __builtin_amdgcn_mfma_f32_32x32x16_bf16(kf_[0][ks_], qf[ks_], s0_, 0, 0, 0); s1_ = __builtin_amdgcn_mfma_f32_32x32x16_bf16(kf_[1][ks_], qf[ks_], s1_, 0, 0, 0); } } \
        else { _Pragma("unroll") for (int ks_ = 0; ks_ < 4; ++ks_) { s0_[ks_] += __builtin_bit_cast(float, kf_[0][ks_][0] + kf_[0][ks_][1]); s1_[ks_] += __builtin_bit_cast(float, kf_[1][ks_][0] + kf_[1][ks_][1]); } } \
        _Pragma("unroll") for (int kb_ = 0; kb_ < 2; ++kb_) { f32x16 s_ = kb_ ? s1_ : s0_; \
            if (!cst_) { const LAS float* tp_ = tab + (k0_ + 32 * kb_ + 4 * hi - (qa + r32) + 2047); _Pragma("unroll") for (int r_ = 0; r_ < 16; ++r_) s_[r_] += tp_[(r_ & 3) + 8 * (r_ >> 2)]; } \
            float p_[16]; \
            _Pragma("unroll") for (int r_ = 0; r_ < 16; ++r_) p_[r_] = (ABL & 1) ? s_[r_] : __builtin_amdgcn_exp2f(s_[r_]); \
            _Pragma("unroll") for (int r_ = 0; r_ < 16; r_ += 2) lacc += (f32x2){p_[r_], p_[r_ + 1]}; \
            _Pragma("unroll") for (int sh_ = 0; sh_ < 2; ++sh_) { u32x4 w_; w_.x = pk2(p_[8 * sh_ + 0], p_[8 * sh_ + 1]); w_.y = pk2(p_[8 * sh_ + 2], p_[8 * sh_ + 3]); w_.z = pk2(p_[8 * sh_ + 4], p_[8 * sh_ + 5]); w_.w = pk2(p_[8 * sh_ + 6], p_[8 * sh_ + 7]); \
                pf[2 * kb_ + sh_] = __builtin_bit_cast(bf16x8, w_); } } } while (0)
#define AT_PV(bo) do { _Pragma("unroll") for (int hb_ = 0; hb_ < 2; ++hb_) { u32x4 vf_[8]; \
        _Pragma("unroll") for (int i_ = 0; i_ < 8; ++i_) { const int dvb_ = 2 * hb_ + (i_ >> 2), s4_ = i_ & 3; vf_[i_] = *(const LAS u32x4*)(lds + (bo) + vfo + dvb_ * 32 * AT_VS + s4_ * 32); } \
        if (!(ABL & 2)) { _Pragma("unroll") for (int i_ = 0; i_ < 8; ++i_) o[2 * hb_ + (i_ >> 2)] = __builtin_amdgcn_mfma_f32_32x32x16_bf16(__builtin_bit_cast(bf16x8, vf_[i_]), pf[i_ & 3], o[2 * hb_ + (i_ >> 2)], 0, 0, 0); } \
        else { _Pragma("unroll") for (int i_ = 0; i_ < 8; ++i_) o[2 * hb_ + (i_ >> 2)][i_] += __builtin_bit_cast(float, vf_[i_].x ^ vf_[i_].y ^ vf_[i_].z ^ vf_[i_].w) + __builtin_bit_cast(float, __builtin_bit_cast(u32x4, pf[i_ & 3]).x); } } } while (0)
    AT_LOAD(0); AT_WRITE(0); AT_LOAD(1);
    __syncthreads();
    const float c_neg = tab[1000], c_pos = tab[3000];
    int b_prv = 2 * AT_BUF, b_cur = 0, b_nxt = AT_BUF;
#pragma nounroll
    for (int t = 0; t <= 32; ++t) {
        if (t + 1 < 32 && (!(ABL & 4) || t < 2)) AT_WRITE(b_nxt);
        if (t + 2 < 32 && (!(ABL & 4) || t < 2)) AT_LOAD(t + 2);
        if (mp == 0) { if (t < 32) AT_SOFT(t, b_cur); }
        else { if (t >= 1) AT_PV(b_prv); }
        if (!(ABL & 8)) __syncthreads();
        if (mp == 0) { if (t < 32) AT_PV(b_cur); }
        else { if (t < 32) AT_SOFT(t, b_cur); }
        { const int tmp = b_prv; b_prv = b_cur; b_cur = b_nxt; b_nxt = tmp; }
        if (!(ABL & 8)) __syncthreads();
    }
#undef AT_LOAD
#undef AT_WRITE
#undef AT_SOFT
#undef AT_PV
    float lsum = lacc.x + lacc.y;
    lsum += __shfl_xor(lsum, 32);
    const float sc = (mp == 0 ? 1.0f : lam) / lsum;
    LAS float* ex = (LAS float*)(lds + AT_EX_OFF) + (rb * 32 + r32) * AT_EX_PITCH;
    if (mp == 1) {
#pragma unroll
        for (int dvb = 0; dvb < 4; ++dvb)
#pragma unroll
            for (int g = 0; g < 4; ++g) *(LAS f32x4*)(ex + dvb * 32 + 8 * g + 4 * hi) = (f32x4){o[dvb][4 * g] * sc, o[dvb][4 * g + 1] * sc, o[dvb][4 * g + 2] * sc, o[dvb][4 * g + 3] * sc};
    }
    __syncthreads();
    if (mp == 0) {
        float ss = 0.f;
#pragma unroll
        for (int dvb = 0; dvb < 4; ++dvb)
#pragma unroll
            for (int g = 0; g < 4; ++g) { const f32x4 e = *(const LAS f32x4*)(ex + dvb * 32 + 8 * g + 4 * hi);
#pragma unroll
                for (int i = 0; i < 4; ++i) { const float v = o[dvb][4 * g + i] * sc - e[i]; o[dvb][4 * g + i] = v; ss += v * v; } }
        ss += __shfl_xor(ss, 32);
        const float rs = (1.0f / sqrtf(ss * (1.0f / 128.0f) + EPS)) * 0.8f;
        bf16* orow = C.w<bf16>(ABL ? WS_HM : WS_O) + (tok0 + qa + r32) * DM + h * 128;
        const float* sg = C.in(IN_SUBLN);
#pragma unroll
        for (int dvb = 0; dvb < 4; ++dvb)
#pragma unroll
            for (int g = 0; g < 4; ++g) { const int dv = dvb * 32 + 8 * g + 4 * hi; const f32x4 gv = *(const f32x4*)(sg + dv);
                u32x2 w; w.x = pk2(o[dvb][4 * g] * rs * gv.x, o[dvb][4 * g + 1] * rs * gv.y); w.y = pk2(o[dvb][4 * g + 2] * rs * gv.z, o[dvb][4 * g + 3] * rs * gv.w);
                *(u32x2*)(orow + dv) = w; }
    }
}
template <int ABL> __device__ __forceinline__ void p_attention(const Ctx& C) {
    int last_h = -1; const float lam = C.w<float>(WS_SCAL)[0];
    for (int w = C.vcu; w < NB * DA_H * 2; w += C.G) { const int bh = w >> 1, half = w & 1, h = bh & 7;
        for (int i = 0; i < 8; ++i) { attn_unit<ABL>(C, bh >> 3, h, half * 8 + i, h != last_h, lam); last_h = h; } }
    __syncthreads();
}

constexpr int RT_CH = 128, RT_IMG = RT_CH * 16 * 16;
__device__ __forceinline__ void p_route(const Ctx& C, int layer, const bf16* x, bool commit = true) {
    const int lane = C.lane, tid = C.tid, tok = lane & 15, kq = lane >> 4;
    const float* g = C.in(IN_NFG) + layer * DM;
    const float* wr_ = C.in(IN_WRT) + (size_t)layer * DM * 32; const float* wg_ = C.in(IN_WGRP) + (size_t)layer * DM * 4;
    unsigned* cnt = C.w<unsigned>(WS_CTL) + CW_CNT + layer * 64;
    LAS float* lg = (LAS float*)(C.lds + 2 * RT_IMG) + C.wave * (16 * 48);
    bf16* HF = C.w<bf16>(WS_HF);
    const int sk = tid >> 2, sn = (tid & 3) * 4;
    f32x4 st0, st1, st2;
#define RT_LOAD(c) do { const int k_ = (c) * RT_CH + sk; st0 = *(const f32x4*)(wr_ + k_ * 32 + sn); st1 = *(const f32x4*)(wr_ + k_ * 32 + 16 + sn); st2 = (sn == 0) ? *(const f32x4*)(wg_ + k_ * 4) : (f32x4){0.f, 0.f, 0.f, 0.f}; } while (0)
#define RT_WRITE(bo) do { LAS f32x4* d_ = (LAS f32x4*)(C.lds + (bo)) + sk * 16 + sn; d_[0] = (f32x4){st0[0], st1[0], st2[0], 0.f}; d_[1] = (f32x4){st0[1], st1[1], st2[1], 0.f}; d_[2] = (f32x4){st0[2], st1[2], st2[2], 0.f}; d_[3] = (f32x4){st0[3], st1[3], st2[3], 0.f}; } while (0)
    for (int ts = C.vcu; ts < NT / 128; ts += C.G) {
        const int t0 = ts * 128 + C.wave * 16, b = t0 / SEQ;
        const bf16* xrow = x + (size_t)(t0 + tok) * DM + 4 * kq;
        __syncthreads();
        RT_LOAD(0);
        float ss = 0.f;
#pragma unroll 8
        for (int kk = 0; kk < 64; ++kk) { const u32x2 w = *(const u32x2*)(xrow + 16 * kk); const f32x4 v = (f32x4){bflo(w.x), bfhi(w.x), bflo(w.y), bfhi(w.y)}; ss += (v.x * v.x + v.y * v.y) + (v.z * v.z + v.w * v.w); }
        ss += __shfl_xor(ss, 16); ss += __shfl_xor(ss, 32);
        const float rstd = 1.0f / sqrtf(ss * (1.0f / DM) + EPS);
        const float* sc = C.mods(layer, 4) + (size_t)b * 6144 + 4 * kq; const float* sh = C.mods(layer, 3) + (size_t)b * 6144 + 4 * kq;
        f32x4 a0 = (f32x4){0.f, 0.f, 0.f, 0.f}, a1 = a0, a2 = a0;
        bf16* hrow = HF + (size_t)(t0 + tok) * DM + 4 * kq;
        RT_WRITE(0);
        for (int c = 0; c < DM / RT_CH; ++c) {
            const int bo = (c & 1) * RT_IMG;
            __syncthreads();
            if (c + 1 < DM / RT_CH) RT_LOAD(c + 1);
            const LAS f32x4* bimg = (const LAS f32x4*)(C.lds + bo) + (4 * kq) * 16 + tok;
#pragma unroll
            for (int half = 0; half < 2; ++half) {
                f32x4 hfv[4];
#pragma unroll
                for (int q = 0; q < 4; ++q) { const int kk = c * 8 + half * 4 + q;
                    const u32x2 xw2 = *(const u32x2*)(xrow + 16 * kk); const f32x4 v = (f32x4){bflo(xw2.x), bfhi(xw2.x), bflo(xw2.y), bfhi(xw2.y)};
                    const f32x4 gv = *(const f32x4*)(g + 16 * kk + 4 * kq), scv = *(const f32x4*)(sc + 16 * kk), shv = *(const f32x4*)(sh + 16 * kk);
                    hfv[q] = (v * rstd * gv) * (scv + 1.0f) + shv;
                    u32x2 w; w.x = pk2(hfv[q].x, hfv[q].y); w.y = pk2(hfv[q].z, hfv[q].w); *(u32x2*)(hrow + 16 * kk) = w; }
#pragma unroll
                for (int q = 0; q < 4; ++q)
#pragma unroll
                    for (int i = 0; i < 4; ++i) { const f32x4 bv = bimg[((half * 4 + q) * 16 + i) * 16];
                        a0 = __builtin_amdgcn_mfma_f32_16x16x4f32(hfv[q][i], bv[0], a0, 0, 0, 0); a1 = __builtin_amdgcn_mfma_f32_16x16x4f32(hfv[q][i], bv[1], a1, 0, 0, 0); a2 = __builtin_amdgcn_mfma_f32_16x16x4f32(hfv[q][i], bv[2], a2, 0, 0, 0); }
            }
            if (c + 1 < DM / RT_CH) RT_WRITE(RT_IMG - bo);
        }
#pragma unroll
        for (int r = 0; r < 4; ++r) { lg[(4 * kq + r) * 48 + tok] = a0[r]; lg[(4 * kq + r) * 48 + 16 + tok] = a1[r]; lg[(4 * kq + r) * 48 + 32 + tok] = a2[r]; }
        LDS_WAIT(); asm volatile("" ::: "memory");
        if (lane < 16 && commit) {
            const LAS float* L = lg + lane * 48;
            int gs = 0; float gm = L[32];
#pragma unroll
            for (int j = 1; j < 4; ++j) { const float v = L[32 + j]; if (v > gm) { gm = v; gs = j; } }
            float gsum = 0.f;
#pragma unroll
            for (int j = 0; j < 4; ++j) gsum += __expf(L[32 + j] - gm);
            const float pg = 1.0f / gsum;
            int ia = 0; float la = L[gs * 8];
#pragma unroll
            for (int j = 1; j < 8; ++j) { const float v = L[gs * 8 + j]; if (v > la) { la = v; ia = j; } }
            int ib = -1; float lb = -3.0e38f;
#pragma unroll
            for (int j = 0; j < 8; ++j) { const float v = L[gs * 8 + j]; if (j != ia && v > lb) { lb = v; ib = j; } }
            const float wa = pg / (1.0f + __expf(lb - la)), wb = pg - wa;
            const int ea = gs * 8 + ia, eb = gs * 8 + ib, t = t0 + lane;
            const unsigned pa = atomicAdd(cnt + ea, 1u), pb = atomicAdd(cnt + eb, 1u);
            C.w<int>(WS_RE)[2 * t] = ea; C.w<int>(WS_RE)[2 * t + 1] = eb; C.w<float>(WS_RW)[2 * t] = wa; C.w<float>(WS_RW)[2 * t + 1] = wb;
            C.w<int>(WS_RP)[2 * t] = (int)pa; C.w<int>(WS_RP)[2 * t + 1] = (int)pb;
            C.w<int>(WS_TL)[(size_t)ea * NT + pa] = t; C.w<int>(WS_TL)[(size_t)eb * NT + pb] = t;
        }
        LDS_WAIT(); asm volatile("" ::: "memory");
    }
#undef RT_LOAD
#undef RT_WRITE
}
struct MoeTab { LAS int* off; LAS int* tile_e; LAS int* ntile; LAS int* cnt; LAS int* tile_p0; };
__device__ __forceinline__ MoeTab moe_tables(const Ctx& C, int layer) {
    MoeTab T; T.off = (LAS int*)(C.lds + MISC_OFF + 256); T.tile_e = T.off + 128; T.ntile = T.off + 48; T.cnt = T.off + 64; T.tile_p0 = T.off + 128 + 320;
    __syncthreads();
    if (C.tid < 64) {
        const unsigned* cnt = C.w<unsigned>(WS_CTL) + CW_CNT + layer * 64; const int e = C.lane;
        const int c = e < NEXP ? (int)__hip_atomic_load(cnt + e, __ATOMIC_RELAXED, __HIP_MEMORY_SCOPE_AGENT) : 0;
        const int tiles = (c + 255) >> 8; int inc = tiles;
#pragma unroll
        for (int o = 1; o < 32; o <<= 1) { const int v = __shfl_up(inc, o); if (e >= o) inc += v; }
        const int first = inc - tiles;
        if (e < NEXP) { T.off[e] = first * 256; T.cnt[e] = c; for (int j = 0; j < tiles; ++j) { T.tile_e[first + j] = e; T.tile_p0[first + j] = j * 256; } }
        if (e == NEXP - 1) { T.off[32] = inc * 256; T.ntile[0] = inc; } }
    __syncthreads();
    return T;
}
__device__ __forceinline__ void p_permute(const Ctx& C, int layer) {
    const MoeTab T = moe_tables(C, layer);
    const bf16* HF = C.w<bf16>(WS_HF); bf16* HS = C.w<bf16>(WS_HS);
    const int* RP = C.w<int>(WS_RP); const int* RE = C.w<int>(WS_RE);
    for (int p = C.vcu * 8 + C.wave; p < 2 * NT; p += C.G * 8) {
        const int e = RE[p], pos = RP[p], slot = T.off[e] + pos, t = p >> 1;
        const u32x4* s = (const u32x4*)(HF + (size_t)t * DM) + C.lane; u32x4* d = (u32x4*)(HS + (size_t)slot * DM) + C.lane;
        const u32x4 v0 = s[0], v1 = s[64]; d[0] = v0; d[64] = v1;
        asm volatile("" ::: "memory");
        if (C.lane == 0) C.w<int>(WS_RS)[p] = slot;
    }
}
template <int NPN, bool GATH> struct MoeOrder {
    const int* tl; MoeTab T; const char* A; const char* B; int lda_bytes; size_t b_expert_bytes; int b_tile_bytes; int G, c, nt;
    __device__ __forceinline__ bool next(int i, pg8::Unit& u) const {
        const int L = i * G + c; const int rt = L / NPN, pn = L - rt * NPN; if (rt >= T.ntile[0]) return false;
        const int e = T.tile_e[rt];
        u.A = GATH ? A : A + (size_t)rt * 256 * lda_bytes; u.B = B + (size_t)e * b_expert_bytes + (size_t)pn * b_tile_bytes; u.r0 = rt * 256; u.c0 = GATH ? T.tile_p0[rt] : pn * 256; u.a0 = e; u.a1 = pn; u.nt = nt; u.flags = GATH ? T.cnt[e] : 3; return true;
    }
    __device__ __forceinline__ int kb(const pg8::Unit&, int t) const { return t; }
    __device__ __forceinline__ unsigned arow(const pg8::Unit& u, int r) const { const int pos = u.c0 + r; const int tok = pos < u.flags ? tl[(size_t)u.a0 * NT + pos] : 0; return (unsigned)tok * (unsigned)(DM * 2); }
};
struct EpiSwiGLU {
    static constexpr bool PERM = true;
    bf16* H;
    __device__ __forceinline__ void operator()(const f32x4 (&acc)[2][2][4][2], const pg8::Unit& u, int wr, int wc, int fr_, int fq_) const {
        (void)fr_; (void)fq_; const int ln_ = opaque_v(lane_id()); const int fr = ln_ & 15, fq = ln_ >> 4;
        const int row0 = u.r0 + wr * 64 + fr, col0 = u.a1 * 128 + wc * 32 + 8 * fq;
#pragma unroll
        for (int ai = 0; ai < 2; ++ai)
#pragma unroll
            for (int m = 0; m < 4; ++m) { float r[8];
#pragma unroll
                for (int n = 0; n < 2; ++n)
#pragma unroll
                    for (int i = 0; i < 4; ++i) { const float a = acc[ai][0][m][n][i], b = acc[ai][1][m][n][i]; r[4 * n + i] = silu_f(a) * b; }
                u32x4 w; w.x = pk2(r[0], r[1]); w.y = pk2(r[2], r[3]); w.z = pk2(r[4], r[5]); w.w = pk2(r[6], r[7]);
                *(u32x4*)(H + (size_t)(row0 + ai * 128 + m * 16) * DEXP + col0) = w; }
    }
};
template <bool OUT_F32> __device__ __forceinline__ void p_combine(const Ctx& C, int layer, const bf16* xsrc, void* xdst, int norm_rows = 0, bf16* hm = nullptr) {
    const MoeTab T = moe_tables(C, layer);
    const bf16* YS = C.w<bf16>(WS_YS); const int* RP = C.w<int>(WS_RP); const int* RE = C.w<int>(WS_RE); const float* RW = C.w<float>(WS_RW);
    const float* ng = C.in(IN_NMG) + (layer + 1 < 2 ? layer + 1 : 1) * DM;
    for (int t = C.vcu * 8 + C.wave; t < NT; t += C.G * 8) {
        const int s0 = T.off[RE[2 * t]] + RP[2 * t], s1 = T.off[RE[2 * t + 1]] + RP[2 * t + 1]; const float w0 = RW[2 * t], w1 = RW[2 * t + 1];
        const int b = t / SEQ;
        const float* g2 = C.mods(layer, 5) + (size_t)b * 6144;
        const u32x4* y0 = (const u32x4*)(YS + (size_t)s0 * DM) + C.lane; const u32x4* y1 = (const u32x4*)(YS + (size_t)s1 * DM) + C.lane;
        const u32x4* xr = (const u32x4*)(xsrc + (size_t)t * DM) + C.lane;
        f32x4 xa[2], xb[2]; float ss = 0.f;
#pragma unroll
        for (int j = 0; j < 2; ++j) { const u32x4 a = y0[64 * j], bq = y1[64 * j], xw = xr[64 * j]; const f32x4 ga = *(const f32x4*)(g2 + 512 * j + 8 * C.lane), gb = *(const f32x4*)(g2 + 512 * j + 8 * C.lane + 4);
            xa[j] = (f32x4){bflo(xw.x), bfhi(xw.x), bflo(xw.y), bfhi(xw.y)}; xb[j] = (f32x4){bflo(xw.z), bfhi(xw.z), bflo(xw.w), bfhi(xw.w)};
            xa[j].x += ga.x * (w0 * bflo(a.x) + w1 * bflo(bq.x)); xa[j].y += ga.y * (w0 * bfhi(a.x) + w1 * bfhi(bq.x)); xa[j].z += ga.z * (w0 * bflo(a.y) + w1 * bflo(bq.y)); xa[j].w += ga.w * (w0 * bfhi(a.y) + w1 * bfhi(bq.y));
            xb[j].x += gb.x * (w0 * bflo(a.z) + w1 * bflo(bq.z)); xb[j].y += gb.y * (w0 * bfhi(a.z) + w1 * bfhi(bq.z)); xb[j].z += gb.z * (w0 * bflo(a.w) + w1 * bflo(bq.w)); xb[j].w += gb.w * (w0 * bfhi(a.w) + w1 * bfhi(bq.w));
            if (OUT_F32) { float* o = (float*)xdst + (size_t)t * DM + 512 * j + 8 * C.lane; *(f32x4*)o = xa[j]; *(f32x4*)(o + 4) = xb[j]; }
            else { u32x4 w; w.x = pk2(xa[j].x, xa[j].y); w.y = pk2(xa[j].z, xa[j].w); w.z = pk2(xb[j].x, xb[j].y); w.w = pk2(xb[j].z, xb[j].w); *((u32x4*)((bf16*)xdst + (size_t)t * DM + 512 * j) + C.lane) = w; }
            ss += (xa[j].x * xa[j].x + xa[j].y * xa[j].y) + (xa[j].z * xa[j].z + xa[j].w * xa[j].w) + (xb[j].x * xb[j].x + xb[j].y * xb[j].y) + (xb[j].z * xb[j].z + xb[j].w * xb[j].w); }
        if (t < norm_rows) {
            const float rstd = 1.0f / sqrtf(wave_sum(ss) * (1.0f / DM) + EPS);
            const float* sc = C.mods(layer + 1, 1) + (size_t)b * 6144; const float* sh = C.mods(layer + 1, 0) + (size_t)b * 6144;
#pragma unroll
            for (int j = 0; j < 2; ++j) { const int c = 512 * j + 8 * C.lane;
                const f32x4 g0 = *(const f32x4*)(ng + c), g1 = *(const f32x4*)(ng + c + 4), c0 = *(const f32x4*)(sc + c), c1 = *(const f32x4*)(sc + c + 4), h0 = *(const f32x4*)(sh + c), h1 = *(const f32x4*)(sh + c + 4);
                const f32x4 ya = (xa[j] * rstd * g0) * (c0 + 1.0f) + h0, yb = (xb[j] * rstd * g1) * (c1 + 1.0f) + h1;
                u32x4 w; w.x = pk2(ya.x, ya.y); w.y = pk2(ya.z, ya.w); w.z = pk2(yb.x, yb.y); w.w = pk2(yb.z, yb.w);
                *(u32x4*)(hm + (size_t)t * DM + c) = w; }
        }
    }
}

constexpr int CV_XM = 0;
constexpr int CV_QKV = 18432;
constexpr int CV_QKV_P = 1552;
constexpr int CV_VT = CV_QKV + 32 * CV_QKV_P;
constexpr int CV_RED = CV_VT + 256 * 80;
static_assert(CV_RED + 16384 <= RING_BYTES && CV_VT % 16 == 0 && CV_RED % 16 == 0, "conv LDS");
__device__ __forceinline__ void conv_unit(const Ctx& C, int round, int bl, int ti) {
    LAS unsigned char* lds = C.lds; const int tid = C.tid, lane = C.lane, wid = C.wave;
    const int s0 = ti * 32; const size_t rrow0 = (size_t)bl * SEQ;
    const bf16* XM = C.w<bf16>(WS_XMH); bf16* XC = C.w<bf16>(WS_XC); bf16* K = C.w<bf16>(WS_K); bf16* VTR = C.w<bf16>(WS_VTR);
    const bf16* GWT = C.w<bf16>(WS_GWT);
    f32x4 gacc[2]; gacc[0] = (f32x4){0.f, 0.f, 0.f, 0.f}; gacc[1] = gacc[0];
    const int nblk = tid & 63, tg = tid >> 6;
    u32x4 xs[3];
#define CV_LOAD(chn) do { _Pragma("unroll") for (int q_ = 0; q_ < 3; ++q_) { const int i_ = tid + 512 * q_; const int r_ = i_ >> 5, cc_ = i_ & 31, s_ = s0 - 2 + r_; xs[q_] = (u32x4){0u, 0u, 0u, 0u}; \
        if (i_ < 36 * 32 && s_ >= 0 && s_ < SEQ) xs[q_] = *(const u32x4*)(XM + (rrow0 + s_) * ML_IN + (chn) * 256 + cc_ * 8); } } while (0)
    CV_LOAD(0);
    for (int ch = 0; ch < 8; ++ch) {
        const int c0 = ch * 256;
        bf16x8 gwf[3];
#pragma unroll
        for (int ks = 0; ks < 3; ++ks) { const int kk = 96 * wid + 32 * ks + 8 * (lane >> 4); gwf[ks] = *(const bf16x8*)(GWT + (size_t)(lane & 15) * 6144 + (kk >> 8) * 2048 + c0 + (kk & 255)); }
        LDS_BARRIER();
#pragma unroll
        for (int q = 0; q < 3; ++q) { const int i = tid + 512 * q; if (i < 36 * 32) *(LAS u32x4*)(lds + CV_XM + (i >> 5) * 512 + (i & 31) * 16) = xs[q]; }
        if (ch + 1 < 8) CV_LOAD(ch + 1);
        LDS_BARRIER();
        {
            const int c = c0 + 4 * nblk;
            float cw[5][4], cb[4], wq[4][4], wk[4][4], wv[4][4];
            const float* convw = C.in(IN_CONVW); const float* convb = C.in(IN_CONVB);
#pragma unroll
            for (int j = 0; j < 5; ++j) { const f32x4 v = *(const f32x4*)(convw + j * ML_IN + c); cw[j][0] = v.x; cw[j][1] = v.y; cw[j][2] = v.z; cw[j][3] = v.w; }
            { const f32x4 v = *(const f32x4*)(convb + c); cb[0] = v.x; cb[1] = v.y; cb[2] = v.z; cb[3] = v.w; }
            const int nb = c >> 2;
#pragma unroll
            for (int i = 0; i < 4; ++i) { const f32x4 a = *(const f32x4*)(C.in(IN_WQ) + nb * 16 + i * 4), b = *(const f32x4*)(C.in(IN_WK) + nb * 16 + i * 4), d = *(const f32x4*)(C.in(IN_WV) + nb * 16 + i * 4);
                wq[i][0] = a.x; wq[i][1] = a.y; wq[i][2] = a.z; wq[i][3] = a.w; wk[i][0] = b.x; wk[i][1] = b.y; wk[i][2] = b.z; wk[i][3] = b.w; wv[i][0] = d.x; wv[i][1] = d.y; wv[i][2] = d.z; wv[i][3] = d.w; }
            float xw[8][4];
#pragma unroll
            for (int r = 0; r < 8; ++r) { const u32x2 v = *(const LAS u32x2*)(lds + CV_XM + (4 * tg + r) * 512 + nblk * 8); xw[r][0] = bflo(v.x); xw[r][1] = bfhi(v.x); xw[r][2] = bflo(v.y); xw[r][3] = bfhi(v.y); }
#pragma unroll
            for (int tt = 0; tt < 4; ++tt) {
                const int tl = 4 * tg + tt;
                float xc[4], qv[4], kv[4], vv[4];
#pragma unroll
                for (int i = 0; i < 4; ++i) { float a = cb[i];
#pragma unroll
                    for (int j = 0; j < 5; ++j) a += cw[j][i] * xw[tt + j][i];
                    xc[i] = silu_f(a); }
#pragma unroll
                for (int o = 0; o < 4; ++o) { float a = 0.f, b = 0.f, d = 0.f;
#pragma unroll
                    for (int i = 0; i < 4; ++i) { a += xc[i] * wq[i][o]; b += xc[i] * wk[i][o]; d += xw[tt + 2][i] * wv[i][o]; }
                    qv[o] = a; kv[o] = b; vv[o] = d; }
                const size_t grow = (rrow0 + s0 + tl) * ML_IN + c;
                float k2[4];
#pragma unroll
                for (int i = 0; i < 4; ++i) { float a = 0.f;
#pragma unroll
                    for (int o = 0; o < 4; ++o) a += kv[o] * wq[i][o];
                    k2[i] = a; }
                const u32x2 xcw = (u32x2){pk2(xc[0], xc[1]), pk2(xc[2], xc[3])}, qw = (u32x2){pk2(qv[0], qv[1]), pk2(qv[2], qv[3])}, kw = (u32x2){pk2(kv[0], kv[1]), pk2(kv[2], kv[3])}, vw = (u32x2){pk2(vv[0], vv[1]), pk2(vv[2], vv[3])};
                *(u32x2*)(XC + grow) = xcw; *(u32x2*)(K + grow) = (u32x2){pk2(k2[0], k2[1]), pk2(k2[2], k2[3])};
                LAS unsigned char* qrow = lds + CV_QKV + tl * CV_QKV_P + nblk * 8;
                *(LAS u32x2*)(qrow) = qw; *(LAS u32x2*)(qrow + 512) = kw; *(LAS u32x2*)(qrow + 1024) = vw;
            }
        }
        LDS_BARRIER();
        for (int i = tid; i < 256 * 4; i += 512) { const int cr = i >> 2, cc = i & 3; const int cg = c0 + cr, head = cg >> 9, dv = cg & 511;
            const LAS unsigned short* s = (const LAS unsigned short*)(lds + CV_QKV + (8 * cc) * CV_QKV_P + 1024) + cr; unsigned short v[8];
#pragma unroll
            for (int j = 0; j < 8; ++j) v[j] = s[j * (CV_QKV_P / 2)];
            *(u32x4*)(VTR + ((size_t)(bl * 4 + head) * 512 + dv) * SEQ + s0 + cc * 8) = (u32x4){(unsigned)v[0] | ((unsigned)v[1] << 16), (unsigned)v[2] | ((unsigned)v[3] << 16), (unsigned)v[4] | ((unsigned)v[5] << 16), (unsigned)v[6] | ((unsigned)v[7] << 16)}; }
#pragma unroll
        for (int ks = 0; ks < 3; ++ks) { const int kk = 96 * wid + 32 * ks + 8 * (lane >> 4);
            const bf16x8 bfr = gwf[ks];
#pragma unroll
            for (int tgp = 0; tgp < 2; ++tgp) { const bf16x8 afr = *(const LAS bf16x8*)(lds + CV_QKV + (16 * tgp + (lane & 15)) * CV_QKV_P + kk * 2);
                gacc[tgp] = __builtin_amdgcn_mfma_f32_16x16x32_bf16(afr, bfr, gacc[tgp], 0, 0, 0); } }
    }
    LDS_BARRIER();
    LAS float* red = (LAS float*)(lds + CV_RED);
#pragma unroll
    for (int tgp = 0; tgp < 2; ++tgp)
#pragma unroll
        for (int r = 0; r < 4; ++r) red[(wid * 32 + 16 * tgp + 4 * (lane >> 4) + r) * 16 + (lane & 15)] = gacc[tgp][r];
    LDS_BARRIER();
    { const int tkn = tid >> 4, n = tid & 15; float s = C.in(IN_GATEB)[n];
#pragma unroll
        for (int w = 0; w < 8; ++w) s += red[(w * 32 + tkn) * 16 + n];
        C.w<float>(WS_PRE)[(rrow0 + s0 + tkn) * 16 + n] = s; }
    (void)round;
#undef CV_LOAD
}
__device__ __forceinline__ void p_conv(const Ctx& C, int round) {
    { float* DEN = C.w<float>(WS_DEN); for (int i = C.vcu * 512 + C.tid; i < 2 * 16 * 2048; i += C.G * 512) DEN[i] = 0.f; }
    for (int u = C.vcu; u < RB * 64; u += C.G) conv_unit(C, round, u >> 6, u & 63);
    __syncthreads();
}
__device__ __forceinline__ void cumsum_bh(const Ctx& C, int bh) {
    float* FG = C.w<float>(WS_FG); const float* PRE = C.w<float>(WS_PRE);
    LAS float* wtot = (LAS float*)(C.lds);
    const int bl = bh >> 2, hd = bh & 3, lane = C.lane, tid = C.tid;
    const float* p = PRE + (size_t)bl * SEQ * 16;
    float lf[2][4], ii[2][4], tot[2] = {0.f, 0.f};
#pragma unroll
    for (int j = 0; j < 4; ++j) { const int s = tid * 4 + j;
#pragma unroll
        for (int d = 0; d < 2; ++d) { const float f = p[(size_t)s * 16 + d * 8 + 4 + hd]; ii[d][j] = p[(size_t)s * 16 + d * 8 + hd];
            lf[d][j] = fminf(f, 0.f) - __logf(1.0f + __expf(-fabsf(f))); tot[d] += lf[d][j]; } }
    float inc[2] = {tot[0], tot[1]};
#pragma unroll
    for (int o = 1; o < 64; o <<= 1) { const float v0 = __shfl_up(inc[0], o), v1 = __shfl_up(inc[1], o); if (lane >= o) { inc[0] += v0; inc[1] += v1; } }
    __syncthreads();
    if (lane == 63) { wtot[C.wave] = inc[0]; wtot[8 + C.wave] = inc[1]; }
    __syncthreads();
#pragma unroll
    for (int d = 0; d < 2; ++d) {
        float before = 0.f, all = 0.f;
#pragma unroll
        for (int w = 0; w < 8; ++w) { const float v = wtot[d * 8 + w]; all += v; if (w < C.wave) before += v; }
        const float excl = before + inc[d] - tot[d];
        float* F = FG + (size_t)(d * 2) * 16 * 2048 + (size_t)bh * 2048; float* Gp = F + 16 * 2048;
        f32x4 fo, go;
        if (d == 0) { float run = excl;
#pragma unroll
            for (int j = 0; j < 4; ++j) { run += lf[d][j]; fo[j] = run * LOG2E; go[j] = (ii[d][j] - run) * LOG2E - 4.5f; } }
        else { float run = all - excl;
#pragma unroll
            for (int j = 0; j < 4; ++j) { fo[j] = run * LOG2E; go[j] = (ii[d][j] - run) * LOG2E - 4.5f; run -= lf[d][j]; } }
        *(f32x4*)(F + tid * 4) = fo; *(f32x4*)(Gp + tid * 4) = go;
    }
}
struct DecayOrder {
    const char* Qb; const char* Kb; int G, c;
    __device__ __forceinline__ bool next(int ii, pg8::Unit& u) const {
        const int grp = (ii >> 2) * G + c; if (grp >= 256) return false;
        const int bh = grp >> 4, i = (grp >> 1) & 7, j = 4 * (grp & 1) + (ii & 3), bl = bh >> 2, hd = bh & 3;
        u.A = Qb + ((size_t)(bl * SEQ + 256 * i) * ML_IN + hd * 512) * 2; u.B = Kb + ((size_t)(bl * SEQ + 256 * j) * ML_IN + hd * 512) * 2; u.r0 = 256 * i; u.c0 = 256 * j; u.a0 = bh; u.a1 = (i << 4) | j; u.nt = ML_DH / 64; u.flags = 3; return true;
    }
    __device__ __forceinline__ int kb(const pg8::Unit&, int t) const { return t; }
};
struct EpiDecay {
    static constexpr bool PERM = true;
    bf16* W; const float* FG; float* DEN; int den_on; bf16* DUMMY;
    template <bool MASK>
    __device__ __forceinline__ void pass(const f32x4 (&acc)[2][2][4][2], const pg8::Unit& u, int wr, int wc, int fr, int fq, int dir, int dmin, int dmax, int cblk) const {
        const int bh = u.a0; const float* F = FG + (size_t)(dir * 2) * 16 * 2048 + (size_t)bh * 2048; const float* Gp = F + 16 * 2048;
        const int rl0 = opaque_v(wr * 64 + fr), cl0 = opaque_v(wc * 32 + 8 * fq);
        const float* Fr = F + u.r0;
        const bool fake_ = (REP_ABL & 256) && !den_on;
        const float ref = fake_ ? 0.5f : (dir ? Fr[255] : Fr[0]);
        f32x4 gv[2][2];
#pragma unroll
        for (int bj = 0; bj < 2; ++bj)
#pragma unroll
            for (int n = 0; n < 2; ++n) { const f32x4 g = fake_ ? (f32x4){0.1f * fq, 0.2f, 0.3f * fr, 0.4f} : *(const f32x4*)(Gp + u.c0 + cl0 + bj * 128 + 4 * n);
#pragma unroll
                for (int i = 0; i < 4; ++i) gv[bj][n][i] = __builtin_amdgcn_exp2f(fminf(g[i] + ref, 120.0f)); }
        float fa[2][4];
#pragma unroll
        for (int ai = 0; ai < 2; ++ai)
#pragma unroll
            for (int m = 0; m < 4; ++m) fa[ai][m] = __builtin_amdgcn_exp2f(fmaxf((fake_ ? 0.01f * (fr + m) : Fr[rl0 + ai * 128 + m * 16]) - ref, -126.0f));
        bf16* wbase = W + ((size_t)bh * SEQ + u.r0) * WLD + cblk * 256 + cl0;
        float* den = DEN + (size_t)dir * 16 * 2048 + (size_t)bh * 2048 + u.r0;
#pragma unroll
        for (int ai = 0; ai < 2; ++ai)
#pragma unroll
            for (int m = 0; m < 4; ++m) { const int rl = rl0 + ai * 128 + m * 16; const float fv = fa[ai][m]; f32x4 rsv = (f32x4){0.f, 0.f, 0.f, 0.f};
#pragma unroll
                for (int bj = 0; bj < 2; ++bj) { f32x4 t0 = acc[ai][bj][m][0] * gv[bj][0], t1 = acc[ai][bj][m][1] * gv[bj][1];
                    if (MASK) {
#pragma unroll
                        for (int i = 0; i < 4; ++i) { const int d0 = cl0 + bj * 128 + i - rl, d1 = d0 + 4; t0[i] = (d0 >= dmin && d0 <= dmax) ? t0[i] : 0.f; t1[i] = (d1 >= dmin && d1 <= dmax) ? t1[i] : 0.f; } }
                    rsv += t0; rsv += t1; t0 = t0 * fv; t1 = t1 * fv;
                    u32x4 w; w.x = pk2(t0[0], t0[1]); w.y = pk2(t0[2], t0[3]); w.z = pk2(t1[0], t1[1]); w.w = pk2(t1[2], t1[3]);
                    if (!((REP_ABL & 64) && !den_on)) *(u32x4*)(wbase + (size_t)rl * WLD + bj * 128) = w; else rsv[0] += __builtin_bit_cast(float, w.x ^ w.y ^ w.z ^ w.w); }
                float rs = ((rsv[0] + rsv[1]) + (rsv[2] + rsv[3])) * fv;
                rs += __shfl_xor(rs, 16); rs += __shfl_xor(rs, 32);
                if (fq == 0 && den_on) atomicAdd(den + rl, rs); else if ((REP_ABL & 64) && rs == 12345.678f) den[rl] = rs; }
    }
    __device__ __forceinline__ void operator()(const f32x4 (&acc)[2][2][4][2], const pg8::Unit& u, int wr, int wc, int fr_, int fq_) const {
        (void)fr_; (void)fq_; const int ln_ = opaque_v(lane_id()); const int fr = ln_ & 15, fq = ln_ >> 4;
        if ((REP_ABL & 32) && !den_on) { if (acc[0][0][0][0][0] == 12345.678f) W[0] = 1; return; }
        if ((REP_ABL & 512) && !den_on) {
            bf16* wb = DUMMY + ((size_t)(u.a0 & 1) * SEQ + u.r0) * 2048 + (u.a1 & 7) * 256 + wc * 32 + 8 * fq;
#pragma unroll
            for (int ai = 0; ai < 2; ++ai)
#pragma unroll
                for (int m = 0; m < 4; ++m) { const int rl = wr * 64 + fr + ai * 128 + m * 16;
#pragma unroll
                    for (int bj = 0; bj < 2; ++bj) { const f32x4 v0 = acc[ai][bj][m][0], v1 = acc[ai][bj][m][1];
                        u32x4 w; w.x = pk2(v0[0], v0[1]); w.y = pk2(v0[2], v0[3]); w.z = pk2(v1[0], v1[1]); w.w = pk2(v1[2], v1[3]);
                        *(u32x4*)(wb + (size_t)rl * 2048 + bj * 128) = w; } }
            return; }
        const int i = u.a1 >> 4, j = u.a1 & 15;
        if (j != i) pass<false>(acc, u, wr, wc, fr, fq, j > i ? 1 : 0, 0, 0, j > i ? j + 1 : j);
        else { for (int p = 0; p < 2; ++p) pass<true>(acc, u, wr, wc, fr, fq, p, p ? 0 : -100000, p ? 100000 : 0, i + p); }
    }
};
struct HOrder {
    const char* Wb; const char* Vb; const float* DEN; int G, c;
    __device__ __forceinline__ bool next(int ii, pg8::Unit& u) const {
        const int L = (ii >> 1) * G + c, part = ii & 1; if (L >= 16 * 16) return false;
        const int bh = L >> 4, i = (L >> 1) & 7, jn = L & 1;
        const int kt0 = part ? 4 * (i + 1) : 0;
        u.A = Wb + (((size_t)bh * SEQ + 256 * i) * WLD + (size_t)kt0 * 64) * 2;
        u.B = Vb + (((size_t)bh * 512 + 256 * jn) * SEQ + (size_t)(part ? 4 * i : 0) * 64) * 2;
        u.r0 = 256 * i; u.c0 = 256 * jn; u.a0 = bh; u.a1 = part; u.nt = part ? 36 - 4 * (i + 1) : 4 * (i + 1); u.flags = 3; return true;
    }
    __device__ __forceinline__ int kb(const pg8::Unit&, int t) const { return t; }
    __device__ __forceinline__ void between(const pg8::Unit& u, f32x4 (&acc)[2][2][4][2], int wr) const {
        const int fr = opaque_v(lane_id()) & 15;
        const float* df = DEN + (size_t)u.a0 * 2048 + u.r0; const float* db = df + 16 * 2048;
#pragma unroll
        for (int ai = 0; ai < 2; ++ai)
#pragma unroll
            for (int m = 0; m < 4; ++m) { const int rl = ai * 128 + wr * 64 + m * 16 + fr; const float f = fmaxf(fabsf(db[rl]), 1.0f) / fmaxf(fabsf(df[rl]), 1.0f);
#pragma unroll
                for (int bj = 0; bj < 2; ++bj)
#pragma unroll
                    for (int n = 0; n < 2; ++n) acc[ai][bj][m][n] *= f; }
    }
};
struct EpiH {
    static constexpr bool PERM = true;
    bf16* HF; bf16* HB; const float* DEN;
    __device__ __forceinline__ void operator()(const f32x4 (&acc)[2][2][4][2], const pg8::Unit& u, int wr, int wc, int fr_, int fq_) const {
        (void)fr_; (void)fq_; const int ln_ = opaque_v(lane_id()); const int fr = ln_ & 15, fq = ln_ >> 4;
        const int bh = u.a0, bl = bh >> 2, hd = bh & 3, part = u.a1; const float* dn = DEN + (size_t)part * 16 * 2048 + (size_t)bh * 2048 + u.r0;
        const int rl0 = wr * 64 + fr, col0 = hd * 512 + u.c0 + wc * 32 + 8 * fq;
        bf16* Hh = HF; (void)HB;
#pragma unroll
        for (int ai = 0; ai < 2; ++ai)
#pragma unroll
            for (int m = 0; m < 4; ++m) { const int rl = rl0 + ai * 128 + m * 16; const float rv = 1.0f / fmaxf(fabsf(dn[rl]), 1.0f);
                bf16* rowp = Hh + ((size_t)bl * SEQ + u.r0 + rl) * ML_IN + col0;
#pragma unroll
                for (int bj = 0; bj < 2; ++bj) { f32x4 v0 = acc[ai][bj][m][0] * rv, v1 = acc[ai][bj][m][1] * rv;
                    u32x4 w; w.x = pk2(v0[0], v0[1]); w.y = pk2(v0[2], v0[3]); w.z = pk2(v1[0], v1[1]); w.w = pk2(v1[2], v1[3]);
                    *(u32x4*)(rowp + bj * 128) = w; } }
    }
};
__device__ __forceinline__ void p_ynorm(const Ctx& C, int round, bool dummy = false) {
    const bf16* HF = C.w<bf16>(WS_Q); const bf16* XC = C.w<bf16>(WS_XC); bf16* Y = C.w<bf16>(WS_Y) + (size_t)round * RT * ML_IN;
    const float* og = C.in(IN_ONG); const float* skip = C.in(IN_SKIP);
    bf16* Yd = dummy ? C.w<bf16>(WS_XMH) : Y;
    for (int r = C.vcu * 8 + C.wave; r < RT; r += C.G * 8) {
        const size_t off = (size_t)r * ML_IN + 8 * C.lane;
#pragma unroll
        for (int hd = 0; hd < 4; ++hd) {
            const u32x4 hw = *(const u32x4*)(HF + off + hd * 512), xw = *(const u32x4*)(XC + off + hd * 512), zw = *(const u32x4*)(Y + off + hd * 512);
            float hv[8] = {bflo(hw.x), bfhi(hw.x), bflo(hw.y), bfhi(hw.y), bflo(hw.z), bfhi(hw.z), bflo(hw.w), bfhi(hw.w)};
            const float xv[8] = {bflo(xw.x), bfhi(xw.x), bflo(xw.y), bfhi(xw.y), bflo(xw.z), bfhi(xw.z), bflo(xw.w), bfhi(xw.w)};
            const float zv[8] = {bflo(zw.x), bfhi(zw.x), bflo(zw.y), bfhi(zw.y), bflo(zw.z), bfhi(zw.z), bflo(zw.w), bfhi(zw.w)};
            float ss = 0.f;
#pragma unroll
            for (int j = 0; j < 8; ++j) ss += hv[j] * hv[j];
            const float rs = 1.0f / sqrtf(wave_sum(ss) * (1.0f / 512.0f) + EPS);
            const float* gg = og + hd * 512 + 8 * C.lane; const float* sk = skip + hd * 512 + 8 * C.lane; float yv[8];
#pragma unroll
            for (int j = 0; j < 8; ++j) yv[j] = (hv[j] * rs * gg[j] + sk[j] * xv[j]) * silu_f(zv[j]);
            u32x4 w; w.x = pk2(yv[0], yv[1]); w.y = pk2(yv[2], yv[3]); w.z = pk2(yv[4], yv[5]); w.w = pk2(yv[6], yv[7]);
            *(u32x4*)(Yd + off + hd * 512) = w;
        }
    }
}

constexpr int PH_PRO = 0, PH_NORM0 = 1, PH_QKV = 2, PH_ATTN = 3, PH_OUT0 = 4, PH_ROUTE0 = 5, PH_UP0 = 6, PH_DOWN0 = 7, PH_COMB0 = 8,
              PH_INPROJ0 = 9, PH_RND = 10  , PH_OUT1 = PH_RND + 4 * NROUND, PH_ROUTE1 = PH_OUT1 + 1,
              PH_UP1 = PH_OUT1 + 2, PH_DOWN1 = PH_OUT1 + 3, PH_COMB1 = PH_OUT1 + 4, N_PHASES = PH_OUT1 + 5;

__device__ __forceinline__ void moe_up(const Ctx& C, int layer) {
    const MoeTab T = moe_tables(C, layer);
    MoeOrder<2, true> S; S.tl = C.w<int>(WS_TL); S.T = T; S.A = (const char*)C.w<bf16>(WS_HF); S.B = (const char*)C.w<bf16>(WS_W13T); S.lda_bytes = DM * 2; S.b_expert_bytes = (size_t)512 * DM * 2; S.b_tile_bytes = 256 * DM * 2; S.G = C.G; S.c = C.vcu; S.nt = DM / 64;
    EpiSwiGLU E{C.w<bf16>(WS_HH)};
    pg8::gemm_phase<EpiSwiGLU, MoeOrder<2, true>, true, true>(C.lds, C.tid, DM, DM, S, E);
}
__device__ __forceinline__ void moe_down(const Ctx& C, int layer) {
    const MoeTab T = moe_tables(C, layer);
    MoeOrder<4, false> S; S.tl = nullptr; S.T = T; S.A = (const char*)C.w<bf16>(WS_HH); S.B = (const char*)C.w<bf16>(WS_W2T); S.lda_bytes = DEXP * 2; S.b_expert_bytes = (size_t)DM * DEXP * 2; S.b_tile_bytes = 256 * DEXP * 2; S.G = C.G; S.c = C.vcu; S.nt = DEXP / 64;
    pg8::EpiBf16 E{C.w<bf16>(WS_YS), DM, 0, nullptr, 0};
    pg8::gemm_phase<pg8::EpiBf16, MoeOrder<4, false>, true>(C.lds, C.tid, DEXP, DEXP, S, E);
}

__global__ void __launch_bounds__(512, 2) fwd_kernel(Args args) {
    extern __shared__ __attribute__((aligned(16))) unsigned char lds_raw[];
    Ctx C; C.a = &args; C.ws = (GAS unsigned char*)args.ws; C.lds = (LAS unsigned char*)lds_raw; C.tid = threadIdx.x; C.lane = C.tid & 63; C.wave = __builtin_amdgcn_readfirstlane(C.tid >> 6);
    C.G = gridDim.x; { const int bx = blockIdx.x; C.vcu = (C.G % 8 == 0) ? (bx % 8) * (C.G / 8) + bx / 8 : bx; }
    volatile LAS unsigned* MISC = (volatile LAS unsigned*)(C.lds + MISC_OFF);
    if (C.tid < 64) MISC[C.tid] = 0u;
    __syncthreads();
    const int lo = args.ph_lo, hi = args.ph_hi;
    XcdBarrier bar; bar.bar = C.w<unsigned>(WS_CTL) + CW_BAR; bar.x = 0; bar.st = nullptr;
    if (hi - lo > 1) bar = xcd_barrier_post(C.w<unsigned>(WS_CTL) + CW_BAR, MISC + 8);
#ifndef PHSEL
#define PHSEL(k) true
#endif
#define IN(k) (PHSEL(k) && lo <= (k) && (k) < hi)
#ifndef REP_PH
#define REP_PH (-1)
#endif
#ifndef REP_J
#define REP_J (-1)
#endif
#ifndef REP_N
#define REP_N 0
#endif
#define NREP(k) (1 + (((k) == REP_PH) ? REP_N : 0))
#define NREPJ(j) (1 + (((j) == REP_J) ? REP_N : 0))
#define SEAM(k) do { if (IN(k) && IN((k) + 1)) xcd_barrier(bar); } while (0)
    float* xout = (float*)(GAS float*)args.out;
    bf16* hmall = (bf16*)xout + (size_t)NT * DM;
    bf16* xb = (bf16*)xout;

    if (IN(PH_PRO)) for (int rep_ = 0; rep_ < NREP(PH_PRO); ++rep_) { const Ctx P = fresh(C); p_prologue(P); } SEAM(PH_PRO);
#ifdef XTRA_BARRIERS
    for (int xb_ = 0; xb_ < XTRA_BARRIERS; ++xb_) xcd_barrier(bar);
#endif
    if (IN(PH_NORM0)) for (int rep_ = 0; rep_ < NREP(PH_NORM0); ++rep_) { const Ctx P = fresh(C); p_normmod(P, P.in(IN_X), 0, 0, NT, P.w<bf16>(WS_HM)); } SEAM(PH_NORM0);
    if (IN(PH_QKV)) for (int rep_ = 0; rep_ < NREP(PH_QKV); ++rep_) { const Ctx P = fresh(C);
        { pg8::PlainOrder S{(const char*)P.w<bf16>(WS_HM), (const char*)P.w<bf16>(WS_WINT), DM, DM, NT / 256, 2048 / 256, P.G, P.vcu, DM / 64};
          pg8::EpiQKNorm E{P.w<bf16>(WS_QK), P.in(IN_QG), P.in(IN_KG)};
          pg8::gemm_phase<pg8::EpiQKNorm, pg8::PlainOrder, true, false, false, true>(P.lds, P.tid, DM, DM, S, E); }
        { pg8::PlainOrder S{(const char*)(P.w<bf16>(WS_WINT) + (size_t)2048 * DM), (const char*)P.w<bf16>(WS_HM), DM, DM, 1024 / 256, NT / 256, P.G, P.vcu, DM / 64};
          pg8::EpiBf16 E{P.w<bf16>(WS_VT), NT, 0, nullptr, 0};
          pg8::gemm_phase<pg8::EpiBf16, pg8::PlainOrder, true>(P.lds, P.tid, DM, DM, S, E); }
    } SEAM(PH_QKV);
    if (IN(PH_ATTN)) for (int rep_ = 0; rep_ < NREP(PH_ATTN); ++rep_) { const Ctx P = fresh(C); if (rep_ == 0) p_attention<0>(P); else p_attention<REP_ABL>(P); } SEAM(PH_ATTN);
    if (IN(PH_OUT0)) for (int rep_ = 0; rep_ < NREP(PH_OUT0); ++rep_) { const Ctx P = fresh(C);
        pg8::PlainOrder S{(const char*)P.w<bf16>(WS_O), (const char*)P.w<bf16>(WS_WOT), DM, DM, NT / 256, DM / 256, P.G, P.vcu, DM / 64};
        pg8::EpiResid<true> E{P.in(IN_X), xb, P.mods(0, 2)};
        pg8::gemm_phase<pg8::EpiResid<true>, pg8::PlainOrder, true>(P.lds, P.tid, DM, DM, S, E);
    } SEAM(PH_OUT0);
    if (IN(PH_ROUTE0)) for (int rep_ = 0; rep_ < NREP(PH_ROUTE0); ++rep_) { const Ctx P = fresh(C); p_route(P, 0, xb, rep_ == 0); } SEAM(PH_ROUTE0);
    if (IN(PH_UP0)) for (int rep_ = 0; rep_ < NREP(PH_UP0); ++rep_) { const Ctx P = fresh(C); moe_up(P, 0); } SEAM(PH_UP0);
    if (IN(PH_DOWN0)) for (int rep_ = 0; rep_ < NREP(PH_DOWN0); ++rep_) { const Ctx P = fresh(C); moe_down(P, 0); } SEAM(PH_DOWN0);
    if (IN(PH_COMB0)) for (int rep_ = 0; rep_ < NREP(PH_COMB0); ++rep_) { const Ctx P = fresh(C); p_combine<false>(P, 0, xb, rep_ == 0 ? (void*)xb : (void*)P.w<bf16>(WS_HS + 8 * MiB), rep_ == 0 ? NT : 0, hmall); LAS float* scr = (LAS float*)(P.lds + P.wave * 16384); moe_weight_items(P, 1, scr); } SEAM(PH_COMB0);

#define INPROJ(P_, rnd_, skip_) do { \
        pg8::PlainOrder S_{(const char*)(hmall + (size_t)(rnd_) * RT * DM), (const char*)(P_).w<bf16>(WS_MLWINT), DM, DM, RT / 256, 4096 / 256, (P_).G, (P_).vcu, DM / 64}; \
        pg8::EpiBf16 E_{(P_).w<bf16>(WS_XMH), ML_IN, ML_IN, (P_).w<bf16>(WS_Y) + (size_t)(rnd_) * RT * ML_IN, ML_IN, skip_}; \
        pg8::gemm_phase<pg8::EpiBf16, pg8::PlainOrder, true>((P_).lds, (P_).tid, DM, DM, S_, E_); } while (0)
    if (IN(PH_INPROJ0)) for (int rep_ = 0; rep_ < NREP(PH_INPROJ0); ++rep_) { const Ctx P = fresh(C); INPROJ(P, 0, rep_); } SEAM(PH_INPROJ0);
    for (int round = 0; round < NROUND; ++round) {
        const int pb = PH_RND + 4 * round;
        if (IN(pb + 0)) for (int rep_ = 0; rep_ < NREPJ(0); ++rep_) { const Ctx P = fresh(C); p_conv(P, round); } SEAM(pb + 0);
        if (IN(pb + 1)) for (int rep_ = 0; rep_ < NREPJ(1); ++rep_) { const Ctx P = fresh(C);
            { int last_bh = -1; for (int grp = P.vcu; grp < 256; grp += P.G) { const int bh = grp >> 4; if (bh != last_bh) { cumsum_bh(P, bh); last_bh = bh; } }
              asm volatile("s_waitcnt vmcnt(0)" ::: "memory"); __syncthreads(); }
            DecayOrder S{(const char*)P.w<bf16>(WS_XC), (const char*)P.w<bf16>(WS_K), P.G, P.vcu};
            EpiDecay E{P.w<bf16>(WS_W), P.w<float>(WS_FG), P.w<float>(WS_DEN), rep_ == 0 ? 1 : 0, P.w<bf16>(WS_XMH)};
            pg8::gemm_phase<EpiDecay, DecayOrder, GEMM1_ALIGN>(P.lds, P.tid, ML_IN, ML_IN, S, E);
        } SEAM(pb + 1);
        if (IN(pb + 2)) for (int rep_ = 0; rep_ < NREPJ(2); ++rep_) { const Ctx P = fresh(C);
            { HOrder S{(const char*)P.w<bf16>(WS_W), (const char*)P.w<bf16>(WS_VTR), P.w<float>(WS_DEN), P.G, P.vcu};
              EpiH E{P.w<bf16>(WS_Q), P.w<bf16>(WS_K), P.w<float>(WS_DEN)};
              pg8::gemm_phase<EpiH, HOrder, true, false, true>(P.lds, P.tid, WLD, SEQ, S, E); }
            if (round + 1 < NROUND) { const Ctx P2 = fresh(C); INPROJ(P2, round + 1, rep_); }
        } SEAM(pb + 2);
        if (IN(pb + 3)) for (int rep_ = 0; rep_ < NREPJ(3); ++rep_) { const Ctx P = fresh(C); p_ynorm(P, round, rep_ != 0); } SEAM(pb + 3);
    }
#undef INPROJ
    if (IN(PH_OUT1)) for (int rep_ = 0; rep_ < NREP(PH_OUT1); ++rep_) { const Ctx P = fresh(C);
        pg8::PlainOrder S{(const char*)P.w<bf16>(WS_Y), (const char*)P.w<bf16>(WS_MLWOUTT), ML_IN, ML_IN, NT / 256, DM / 256, P.G, P.vcu, ML_IN / 64};
        pg8::EpiResid<false> E{xb, P.w<bf16>(WS_XB3), P.mods(1, 2)};
        pg8::gemm_phase<pg8::EpiResid<false>, pg8::PlainOrder, true>(P.lds, P.tid, ML_IN, ML_IN, S, E);
    } SEAM(PH_OUT1);
    if (IN(PH_ROUTE1)) for (int rep_ = 0; rep_ < NREP(PH_ROUTE1); ++rep_) { const Ctx P = fresh(C); p_route(P, 1, P.w<bf16>(WS_XB3), rep_ == 0); } SEAM(PH_ROUTE1);
    if (IN(PH_UP1)) for (int rep_ = 0; rep_ < NREP(PH_UP1); ++rep_) { const Ctx P = fresh(C); moe_up(P, 1); } SEAM(PH_UP1);
    if (IN(PH_DOWN1)) for (int rep_ = 0; rep_ < NREP(PH_DOWN1); ++rep_) { const Ctx P = fresh(C); moe_down(P, 1); } SEAM(PH_DOWN1);
    if (IN(PH_COMB1)) for (int rep_ = 0; rep_ < NREP(PH_COMB1); ++rep_) { const Ctx P = fresh(C); p_combine<true>(P, 1, P.w<bf16>(WS_XB3), rep_ == 0 ? (void*)xout : (void*)P.w<float>(WS_HS + 8 * MiB)); }
#undef IN
#undef SEAM
}

extern "C" void kernel_launch(void* const* d_in, const int* in_sizes, int n_in, void* d_out, int out_size, void* d_ws, size_t ws_size, hipStream_t stream) {
    static int grid = 0;
    if (grid == 0) {
        if (n_in != 32 || in_sizes[0] != NT * DM || out_size != NT * DM || ws_size < WS_END) { fprintf(stderr, "kernel_launch: unexpected shapes (n_in %d, in0 %d, out %d, ws %zu)\n", n_in, n_in > 0 ? in_sizes[0] : -1, out_size, ws_size); grid = -1; return; }
        int dev = 0, cus = 0, per_cu = 0;
        if (hipGetDevice(&dev) != hipSuccess || hipDeviceGetAttribute(&cus, hipDeviceAttributeMultiprocessorCount, dev) != hipSuccess) { grid = -1; return; }
        if (hipFuncSetAttribute((const void*)fwd_kernel, hipFuncAttributeMaxDynamicSharedMemorySize, LDS_BYTES) != hipSuccess) { fprintf(stderr, "kernel_launch: hipFuncSetAttribute failed\n"); grid = -1; return; }
        if (hipOccupancyMaxActiveBlocksPerMultiprocessor(&per_cu, (const void*)fwd_kernel, 512, LDS_BYTES) != hipSuccess || per_cu < 1) fprintf(stderr, "kernel_launch: occupancy query reports %d\n", per_cu);
        (void)hipGetLastError();
        grid = cus;
    }
    if (grid < 0) return;
    (void)hipMemsetAsync((char*)d_ws + WS_CTL, 0, CTL_ZERO_BYTES, stream);
    Args a{};
    for (int i = 0; i < 32; ++i) a.in[i] = (const float*)d_in[i];
    a.out = (float*)d_out; a.ws = (unsigned char*)d_ws;
#if MK_ONE_LAUNCH
    a.ph_lo = 0; a.ph_hi = N_PHASES;
    hipLaunchKernelGGL(fwd_kernel, dim3(grid), dim3(512), LDS_BYTES, stream, a);
#else
    for (int p = 0; p < N_PHASES; ++p) { a.ph_lo = p; a.ph_hi = p + 1; hipLaunchKernelGGL(fwd_kernel, dim3(grid), dim3(512), LDS_BYTES, stream, a); }
#endif
}
```

```cpp
#include <hip/hip_runtime.h>
#include <cstdio>
#include <cstdint>

#ifndef REP_ABL
#define REP_ABL 0
#endif
#ifndef GEMM1_STAGGER
#define GEMM1_STAGGER 0ull
#endif
#ifndef GEMM1_ALIGN
#define GEMM1_ALIGN true
#endif
#ifndef MK_ONE_LAUNCH
#define MK_ONE_LAUNCH 1
#endif

#define GAS __attribute__((address_space(1)))
#define LAS __attribute__((address_space(3)))
typedef unsigned short bf16;
typedef short bf16x8 __attribute__((ext_vector_type(8)));
typedef float f32x4 __attribute__((ext_vector_type(4)));
typedef float f32x16 __attribute__((ext_vector_type(16)));
typedef float f32x2 __attribute__((ext_vector_type(2)));
typedef unsigned u32x4 __attribute__((ext_vector_type(4)));
typedef unsigned u32x2 __attribute__((ext_vector_type(2)));

constexpr int NB = 16, SEQ = 2048, DM = 1024, NT = NB * SEQ;
constexpr int DA_H = 8;
constexpr int ML_IN = 2048, ML_H = 4, ML_DH = 512;
constexpr int NEXP = 32, DEXP = 256;
constexpr float EPS = 1e-6f;
constexpr float LOG2E = 1.4426950408889634f;
constexpr int RB = 4;
constexpr int NROUND = NB / RB;
constexpr int RT = RB * SEQ;
constexpr int WLD = 2304;
constexpr int MAXSLOT = 2 * NT + NEXP * 256;

constexpr size_t MiB = 1u << 20;
constexpr size_t WS_CTL = 0, CTL_ZERO_BYTES = 1 * MiB;
constexpr size_t WS_MODS = 2 * MiB;
constexpr size_t WS_TAB2 = 3 * MiB;
constexpr size_t WS_SCAL = 3 * MiB + 128 * 1024;
constexpr size_t WS_GWT = 3 * MiB + 256 * 1024;
constexpr size_t WS_RE = 4 * MiB;
constexpr size_t WS_RW = 4 * MiB + 256 * 1024;
constexpr size_t WS_RP = 4 * MiB + 512 * 1024;
constexpr size_t WS_RS = 4 * MiB + 768 * 1024;
constexpr size_t WS_PRE = 5 * MiB;
constexpr size_t WS_FG = 5 * MiB + 512 * 1024;
constexpr size_t WS_DEN = 6 * MiB;
constexpr size_t WS_WINT = 8 * MiB;
constexpr size_t WS_WOT = 14 * MiB;
constexpr size_t WS_MLWINT = 16 * MiB;
constexpr size_t WS_MLWOUTT = 24 * MiB;
constexpr size_t WS_W13T = 28 * MiB;
constexpr size_t WS_W2T = 60 * MiB;
constexpr size_t WS_BIG = 76 * MiB;
constexpr size_t WS_HM = WS_BIG + 0 * MiB;
constexpr size_t WS_QK = WS_BIG + 64 * MiB;
constexpr size_t WS_VT = WS_BIG + 192 * MiB;
constexpr size_t WS_O = WS_BIG + 256 * MiB;
constexpr size_t WS_HF = WS_BIG + 0 * MiB;
constexpr size_t WS_HS = WS_BIG + 64 * MiB;
constexpr size_t WS_TL = WS_BIG + 64 * MiB;
constexpr size_t WS_HH = WS_BIG + 208 * MiB;
constexpr size_t WS_YS = WS_BIG + 244 * MiB;
constexpr size_t WS_Y = WS_BIG + 0 * MiB;
constexpr size_t WS_W = WS_BIG + 128 * MiB;
constexpr size_t WS_HMR = WS_BIG + 128 * MiB;
constexpr size_t WS_XMH = WS_BIG + 272 * MiB;
constexpr size_t WS_XC = WS_BIG + 304 * MiB;
constexpr size_t WS_Q = WS_BIG + 336 * MiB;
constexpr size_t WS_K = WS_BIG + 368 * MiB;
constexpr size_t WS_VTR = WS_BIG + 400 * MiB;
constexpr size_t WS_XB3 = WS_BIG + 128 * MiB;
constexpr size_t WS_END = WS_BIG + 432 * MiB;
static_assert(WS_END <= 512 * MiB, "ws map");
static_assert((size_t)MAXSLOT * 1024 * 2 <= 144 * MiB && (size_t)MAXSLOT * 256 * 2 <= 36 * MiB, "slot buffers");
constexpr int CW_CNT = 64;
constexpr int CW_BAR = 4096;

constexpr int RING_BYTES = 131072;
constexpr int MISC_OFF = RING_BYTES;
constexpr int LDS_BYTES = RING_BYTES + 16384;

__device__ __forceinline__ unsigned f2bf(float f) { unsigned u = __builtin_bit_cast(unsigned, f); return (u + 0x7fffu + ((u >> 16) & 1u)) >> 16; }
__device__ __forceinline__ unsigned pk2(float lo, float hi) { unsigned r; asm("v_cvt_pk_bf16_f32 %0, %1, %2" : "=v"(r) : "v"(lo), "v"(hi)); return r; }
__device__ __forceinline__ float bf2f(unsigned short b) { return __builtin_bit_cast(float, ((unsigned)b) << 16); }
__device__ __forceinline__ float bflo(unsigned w) { return __builtin_bit_cast(float, w << 16); }
__device__ __forceinline__ float bfhi(unsigned w) { return __builtin_bit_cast(float, w & 0xffff0000u); }
__device__ __forceinline__ float wave_sum(float v) {
#pragma unroll
    for (int o = 1; o < 64; o <<= 1) v += __shfl_xor(v, o);
    return v;
}
__device__ __forceinline__ float silu_f(float v) { return v / (1.0f + __expf(-v)); }
#define LDS_WAIT() asm volatile("s_waitcnt lgkmcnt(0)" ::: "memory")
#define VM_WAIT() asm volatile("s_waitcnt vmcnt(0)" ::: "memory")
#define LDS_BARRIER() do { asm volatile("s_waitcnt lgkmcnt(0)" ::: "memory"); __builtin_amdgcn_s_barrier(); asm volatile("" ::: "memory"); } while (0)
__device__ __forceinline__ int opaque_v(int x) { asm volatile("" : "+v"(x)); return x; }
__device__ __forceinline__ int lane_id() { return (int)__builtin_amdgcn_mbcnt_hi(~0u, __builtin_amdgcn_mbcnt_lo(~0u, 0u)); }

namespace pg8 {
constexpr int BM = 256, BK = 64, HALF = 128, HTB = HALF * BK * 2, STAGE_BYTES = 8 * HTB;
static_assert(STAGE_BYTES == RING_BYTES, "stage region");
__host__ __device__ __forceinline__ int lds_byte(int r, int c) { const int st = (r >> 4) * 2 + (c >> 5), rr = r & 15, cc = c & 31, ob = rr * 64 + cc * 2; return st * 1024 + (ob ^ (((ob >> 9) & 1) << 5)); }
__host__ __device__ __forceinline__ void stage_rc(int b, int& R, int& C) { const int st = b / 1024, sb = b % 1024, swz = sb ^ (((sb >> 9) & 1) << 5); R = (st >> 1) * 16 + swz / 64; C = (st & 1) * 32 + (swz % 64) / 2; }
__host__ __device__ __forceinline__ int perm32(int rho) { const int n = rho >> 4, i = rho & 15; return 8 * (i >> 2) + 4 * n + (i & 3); }

struct Unit { const char* A; const char* B; int r0, c0, a0, a1, nt, flags; };

__device__ __forceinline__ unsigned cvt_pk_bf16(float lo, float hi) { unsigned r; asm volatile("v_cvt_pk_bf16_f32 %0, %1, %2" : "=v"(r) : "v"(lo), "v"(hi)); return r; }

template <class Epi, class Sched, bool ALIGN_EPI, bool GATHER = false, bool PAIR = false, bool BMAP = false>
__device__ __forceinline__ void gemm_phase(LAS unsigned char* lds, const int tid, const int lda, const int ldb, const Sched& S, const Epi& E) {
    const int wid = __builtin_amdgcn_readfirstlane(tid >> 6), lane = tid & 63, wr = wid >> 2, wc = wid & 3, fr = lane & 15, fq = lane >> 4;
    unsigned voffA[2], voffB[2]; int gR[2], gC[2];
#pragma unroll
    for (int i = 0; i < 2; ++i) { int R, C; stage_rc(tid * 16 + i * 8192, R, C); const int Rb = Epi::PERM ? ((R & ~31) + perm32(R & 31)) : R; gR[i] = R; gC[i] = C;
        voffA[i] = (unsigned)(R * lda + C) * 2u; voffB[i] = (unsigned)(Rb * ldb + C) * 2u; }
    unsigned vb[2][2];
    if constexpr (BMAP) {
#pragma unroll
        for (int h = 0; h < 2; ++h)
#pragma unroll
            for (int i = 0; i < 2; ++i) vb[h][i] = (unsigned)(S.brow(h, gR[i]) * ldb + gC[i]) * 2u; }
    unsigned cv[2][2], nv[2][2];
    const size_t kstep = (size_t)(BK * 2);
    const size_t hstepA = GATHER ? 0 : (size_t)HALF * lda * 2, hstepB = (size_t)HALF * ldb * 2;
    const unsigned ldsw = (unsigned)wid * 1024u;
    const int aoff = lds_byte(wr * 64 + fr, fq * 8), boff = lds_byte(wc * 32 + fr, fq * 8);
#define PG8_SA(b, h) (((b) * 2 + (h)) * HTB)
#define PG8_SB(b, h) ((4 + (b) * 2 + (h)) * HTB)
#define PG8_STAGE(bufoff, gbase, voff) do { _Pragma("unroll") for (int _i = 0; _i < 2; ++_i) \
        __builtin_amdgcn_global_load_lds((const unsigned*)((const char*)(gbase) + (voff)[_i]), (LAS unsigned*)(lds + (bufoff) + ldsw + _i * 8192), 16, 0, 0); } while (0)
#define PG8_STAGE_A(bufoff, gbase, h, nx) do { if constexpr (GATHER) { if (nx) PG8_STAGE(bufoff, gbase, nv[h]); else PG8_STAGE(bufoff, gbase, cv[h]); } else PG8_STAGE(bufoff, (gbase) + (h) * hstepA, voffA); } while (0)
#define PG8_STAGE_B(bufoff, gbase, h) do { if constexpr (BMAP) PG8_STAGE(bufoff, gbase, vb[h]); else PG8_STAGE(bufoff, (gbase) + (h) * hstepB, voffB); } while (0)
#define PG8_LDA(dst, b, h) do { _Pragma("unroll") for (int m = 0; m < 4; ++m) _Pragma("unroll") for (int k = 0; k < 2; ++k) dst[m][k] = *(const LAS bf16x8*)(lds + PG8_SA(b, h) + aoff + m * 2048 + k * 1024); } while (0)
#define PG8_LDB(dst, b, h) do { _Pragma("unroll") for (int n = 0; n < 2; ++n) _Pragma("unroll") for (int k = 0; k < 2; ++k) dst[n][k] = *(const LAS bf16x8*)(lds + PG8_SB(b, h) + boff + n * 2048 + k * 1024); } while (0)
#define PG8_MMA(ai, bj, At, Bt) do { __builtin_amdgcn_s_setprio(1); _Pragma("unroll") for (int m = 0; m < 4; ++m) _Pragma("unroll") for (int n = 0; n < 2; ++n) _Pragma("unroll") for (int k = 0; k < 2; ++k) \
        acc[ai][bj][m][n] = __builtin_amdgcn_mfma_f32_16x16x32_bf16(Bt[n][k], At[m][k], acc[ai][bj][m][n], 0, 0, 0); __builtin_amdgcn_s_setprio(0); } while (0)
#define PG8_WAIT_V(n) asm volatile("s_waitcnt vmcnt(" #n ")" ::: "memory")
#define PG8_WAIT_L(n) asm volatile("s_waitcnt lgkmcnt(" #n ")" ::: "memory")
#define PG8_BAR __builtin_amdgcn_s_barrier()
#define PG8_SCHED __builtin_amdgcn_sched_barrier(0)
    Unit cur, nxt; int ui = 0;
    if (!S.next(0, cur)) return;
    f32x4 acc[2][2][4][2];
#pragma unroll
    for (int a = 0; a < 2; ++a)
#pragma unroll
        for (int b = 0; b < 2; ++b)
#pragma unroll
            for (int m = 0; m < 4; ++m)
#pragma unroll
                for (int n = 0; n < 2; ++n) acc[a][b][m][n] = (f32x4){0.f, 0.f, 0.f, 0.f};
    bf16x8 At[4][2], B0[2][2], B1[2][2];
    const char* cA = cur.A; const char* cB = cur.B;
    if constexpr (GATHER) {
#pragma unroll
        for (int h = 0; h < 2; ++h)
#pragma unroll
            for (int i = 0; i < 2; ++i) cv[h][i] = S.arow(cur, h * HALF + gR[i]) + (unsigned)gC[i] * 2u; }
    {
        const char* b0 = cB + (size_t)S.kb(cur, 0) * kstep; const char* b1 = cB + (size_t)S.kb(cur, 1) * kstep;
        PG8_STAGE_B(PG8_SB(0, 0), b0, 0); PG8_STAGE_B(PG8_SB(0, 1), b0, 1); PG8_STAGE_A(PG8_SA(0, 0), cA, 0, false); PG8_STAGE_A(PG8_SA(0, 1), cA, 1, false);
        if (wr == 1) PG8_BAR;
        PG8_WAIT_V(2); PG8_BAR;
        PG8_STAGE_B(PG8_SB(1, 0), b1, 0); PG8_STAGE_A(PG8_SA(1, 0), cA + kstep, 0, false); PG8_STAGE_B(PG8_SB(1, 1), b1, 1);
        PG8_WAIT_V(6); PG8_BAR;
    }
    bool has_next; const char* nA; const char* nB;
#define PG8_UNIT_KLOOP() do { \
        has_next = S.next(ui + 1, nxt); \
        const Unit& nu = has_next ? nxt : cur; \
        if constexpr (GATHER) { \
            _Pragma("unroll") for (int h = 0; h < 2; ++h) _Pragma("unroll") for (int i = 0; i < 2; ++i) nv[h][i] = S.arow(nu, h * HALF + gR[i]) + (unsigned)gC[i] * 2u; } \
        nA = nu.A; nB = nu.B; \
        const int nt = cur.nt; \
        for (int t = 0; t < nt; t += 2) { \
            const bool last = (t == nt - 2); \
            const char* a1 = cA + (size_t)(t + 1) * kstep; \
            const char* a2 = last ? nA : cA + (size_t)(t + 2) * kstep; \
            const char* a3 = a2 + kstep; \
            const char* b2 = last ? nB + (size_t)S.kb(nu, 0) * kstep : cB + (size_t)S.kb(cur, t + 2) * kstep; \
            const char* b3 = last ? nB + (size_t)S.kb(nu, 1) * kstep : cB + (size_t)S.kb(cur, t + 3) * kstep; \
            PG8_LDB(B0, 0, 0); PG8_LDB(B1, 0, 1); PG8_SCHED; PG8_LDA(At, 0, 0); PG8_STAGE_A(PG8_SA(1, 1), a1, 1, false); \
            PG8_WAIT_V(8); PG8_WAIT_L(0); PG8_BAR; PG8_MMA(0, 0, At, B0); PG8_MMA(0, 1, At, B1); PG8_BAR; PG8_SCHED; \
            PG8_LDA(At, 0, 1); PG8_STAGE_B(PG8_SB(0, 0), b2, 0); PG8_STAGE_B(PG8_SB(0, 1), b2, 1); PG8_STAGE_A(PG8_SA(0, 0), a2, 0, last); \
            PG8_WAIT_V(8); PG8_WAIT_L(0); PG8_BAR; PG8_MMA(1, 0, At, B0); PG8_MMA(1, 1, At, B1); PG8_BAR; PG8_SCHED; \
            PG8_LDB(B0, 1, 0); PG8_LDB(B1, 1, 1); PG8_SCHED; PG8_LDA(At, 1, 0); PG8_STAGE_A(PG8_SA(0, 1), a2, 1, last); \
            PG8_WAIT_V(8); PG8_WAIT_L(0); PG8_BAR; PG8_MMA(0, 0, At, B0); PG8_MMA(0, 1, At, B1); PG8_BAR; PG8_SCHED; \
            PG8_LDA(At, 1, 1); PG8_STAGE_B(PG8_SB(1, 0), b3, 0); PG8_STAGE_B(PG8_SB(1, 1), b3, 1); PG8_STAGE_A(PG8_SA(1, 0), a3, 0, last); \
            PG8_WAIT_V(8); PG8_WAIT_L(0); PG8_BAR; PG8_MMA(1, 0, At, B0); PG8_MMA(1, 1, At, B1); PG8_BAR; PG8_SCHED; \
        } } while (0)
#define PG8_ADVANCE() do { cur = nxt; cA = nA; cB = nB; ++ui; \
        if constexpr (GATHER) { _Pragma("unroll") for (int h = 0; h < 2; ++h) _Pragma("unroll") for (int i = 0; i < 2; ++i) cv[h][i] = nv[h][i]; } } while (0)
    for (;;) {
        PG8_UNIT_KLOOP();
        if constexpr (PAIR) {
            S.between(cur, acc, wr);
            PG8_ADVANCE();
            PG8_UNIT_KLOOP();
        }
        if constexpr (ALIGN_EPI) { if (wr == 0) PG8_BAR; }
        E(acc, cur, wr, wc, fr, fq);
        if (!has_next) break;
#pragma unroll
        for (int a = 0; a < 2; ++a)
#pragma unroll
            for (int b = 0; b < 2; ++b)
#pragma unroll
                for (int m = 0; m < 4; ++m)
#pragma unroll
                    for (int n = 0; n < 2; ++n) acc[a][b][m][n] = (f32x4){0.f, 0.f, 0.f, 0.f};
        PG8_ADVANCE();
        if constexpr (ALIGN_EPI) { if (wr == 1) PG8_BAR; }
    }
#undef PG8_UNIT_KLOOP
#undef PG8_ADVANCE
    PG8_WAIT_V(0);
    if constexpr (!ALIGN_EPI) { if (wr == 0) PG8_BAR; }
    PG8_BAR;
#undef PG8_SA
#undef PG8_SB
#undef PG8_STAGE
#undef PG8_STAGE_A
#undef PG8_STAGE_B
#undef PG8_LDA
#undef PG8_LDB
#undef PG8_MMA
#undef PG8_WAIT_V
#undef PG8_WAIT_L
#undef PG8_BAR
#undef PG8_SCHED
}

struct PlainOrder {
    const char* A; const char* B; int lda, ldb, nM, nN, G, c, nt;
    __device__ __forceinline__ bool next(int i, Unit& u) const {
        const int L = i * G + c; if (L >= nM * nN) return false;
        const int pm = L / nN, pn = L - pm * nN;
        u.A = A + (size_t)pm * 256 * lda * 2; u.B = B + (size_t)pn * 256 * ldb * 2; u.r0 = pm * 256; u.c0 = pn * 256; u.a0 = 0; u.a1 = 0; u.nt = nt; u.flags = 3; return true;
    }
    __device__ __forceinline__ int kb(const Unit&, int t) const { return t; }
    __device__ __forceinline__ int brow(int h, int R) const { return 64 * (R >> 5) + 32 * h + perm32(R & 31); }
};
struct EpiBf16 {
    static constexpr bool PERM = true;
    bf16* O; int ldc; int split_cols; bf16* O2; int ldc2; int skip = 0;
    __device__ __forceinline__ void operator()(const f32x4 (&acc)[2][2][4][2], const Unit& u, int wr, int wc, int fr_, int fq_) const {
        (void)fr_; (void)fq_; const int ln_ = opaque_v(lane_id()); const int fr = ln_ & 15, fq = ln_ >> 4;
        bf16* base = O; int ld = ldc; int colt = u.c0;
        if (split_cols > 0 && colt >= split_cols) { base = O2; ld = ldc2; colt -= split_cols; }
        const int row0 = u.r0 + wr * 64 + fr, col0 = colt + wc * 32 + 8 * fq;
#pragma unroll
        for (int ai = 0; ai < 2; ++ai)
#pragma unroll
            for (int m = 0; m < 4; ++m) { bf16* rowp = base + (size_t)(row0 + ai * HALF + m * 16) * ld + col0;
#pragma unroll
                for (int bj = 0; bj < 2; ++bj) { const f32x4 v0 = acc[ai][bj][m][0], v1 = acc[ai][bj][m][1];
                    u32x4 w; w.x = cvt_pk_bf16(v0[0], v0[1]); w.y = cvt_pk_bf16(v0[2], v0[3]); w.z = cvt_pk_bf16(v1[0], v1[1]); w.w = cvt_pk_bf16(v1[2], v1[3]);
                    if (!((REP_ABL & 128) && skip)) *(u32x4*)(rowp + bj * HALF) = w; else if (w.x == 0x12345678u) *(u32x4*)(rowp) = w; } }
    }
};
template <bool XF32> struct EpiResid {
    static constexpr bool PERM = true;
    const void* xin; bf16* out; const float* gate;
    __device__ __forceinline__ void operator()(const f32x4 (&acc)[2][2][4][2], const Unit& u, int wr, int wc, int fr_, int fq_) const {
        (void)fr_; (void)fq_; const int ln_ = opaque_v(lane_id()); const int fr = ln_ & 15, fq = ln_ >> 4;
        const int row0 = u.r0 + wr * 64 + fr, col0 = u.c0 + wc * 32 + 8 * fq;
        const float* g = gate + (size_t)(u.r0 / SEQ) * 6144 + col0;
        f32x4 gv[2][2];
#pragma unroll
        for (int bj = 0; bj < 2; ++bj)
#pragma unroll
            for (int n = 0; n < 2; ++n) gv[bj][n] = *(const f32x4*)(g + bj * HALF + 4 * n);
#pragma unroll
        for (int ai = 0; ai < 2; ++ai)
#pragma unroll
            for (int m = 0; m < 4; ++m) { const size_t off = (size_t)(row0 + ai * HALF + m * 16) * DM + col0;
#pragma unroll
                for (int bj = 0; bj < 2; ++bj) { f32x4 x0, x1;
                    if (XF32) { x0 = *(const f32x4*)((const float*)xin + off + bj * HALF); x1 = *(const f32x4*)((const float*)xin + off + bj * HALF + 4); }
                    else { const u32x4 w = *(const u32x4*)((const bf16*)xin + off + bj * HALF); x0 = (f32x4){bflo(w.x), bfhi(w.x), bflo(w.y), bfhi(w.y)}; x1 = (f32x4){bflo(w.z), bfhi(w.z), bflo(w.w), bfhi(w.w)}; }
                    const f32x4 y0 = x0 + gv[bj][0] * acc[ai][bj][m][0], y1 = x1 + gv[bj][1] * acc[ai][bj][m][1];
                    u32x4 o; o.x = cvt_pk_bf16(y0[0], y0[1]); o.y = cvt_pk_bf16(y0[2], y0[3]); o.z = cvt_pk_bf16(y1[0], y1[1]); o.w = cvt_pk_bf16(y1[2], y1[3]);
                    *(u32x4*)(out + off + bj * HALF) = o; }
                if (m & 1) asm volatile("" ::: "memory"); }
    }
};
struct EpiQKNorm {
    static constexpr bool PERM = true;
    bf16* O; const float* qg; const float* kg;
    __device__ __forceinline__ void operator()(const f32x4 (&acc)[2][2][4][2], const Unit& u, int wr, int wc, int fr_, int fq_) const {
        (void)fr_; (void)fq_; const int ln_ = opaque_v(lane_id()); const int fr = ln_ & 15, fq = ln_ >> 4;
        const bool isq = u.c0 < 1024; const float* gain = (isq ? qg : kg) + 8 * fq; const float osc = isq ? 0.125f * LOG2E : 1.0f;
        f32x4 g[2][2];
#pragma unroll
        for (int bj = 0; bj < 2; ++bj)
#pragma unroll
            for (int n = 0; n < 2; ++n) g[bj][n] = *(const f32x4*)(gain + 32 * bj + 4 * n) * osc;
        const int row0 = u.r0 + wr * 64 + fr, col0 = u.c0 + wc * 64 + 8 * fq;
#pragma unroll
        for (int ai = 0; ai < 2; ++ai)
#pragma unroll
            for (int m = 0; m < 4; ++m) { f32x4 sv = (f32x4){0.f, 0.f, 0.f, 0.f};
#pragma unroll
                for (int bj = 0; bj < 2; ++bj) { sv += acc[ai][bj][m][0] * acc[ai][bj][m][0]; sv += acc[ai][bj][m][1] * acc[ai][bj][m][1]; }
                float s = (sv[0] + sv[1]) + (sv[2] + sv[3]);
                s += __shfl_xor(s, 16); s += __shfl_xor(s, 32);
                const float rs = 1.0f / sqrtf(s * (1.0f / 64.0f) + EPS);
                bf16* rowp = O + (size_t)(row0 + ai * HALF + m * 16) * 2048 + col0;
#pragma unroll
                for (int bj = 0; bj < 2; ++bj) { const f32x4 v0 = acc[ai][bj][m][0] * rs * g[bj][0], v1 = acc[ai][bj][m][1] * rs * g[bj][1];
                    u32x4 w; w.x = cvt_pk_bf16(v0[0], v0[1]); w.y = cvt_pk_bf16(v0[2], v0[3]); w.z = cvt_pk_bf16(v1[0], v1[1]); w.w = cvt_pk_bf16(v1[2], v1[3]);
                    *(u32x4*)(rowp + 32 * bj) = w; } }
    }
};
}

#define XB_TMO      128
#define XB_XCNT(j)  (256  + 64 * (j))
#define XB_XSUB(j)  (1280 + 64 * (j))
#define XB_XGEN(j)  (2304 + 64 * (j))
#define XB_TOP      3328
#define XB_TOPGEN   3392
#define XCD_BAR_WORDS 3456
#define XB_SPIN_CAP (1u << 18)
__device__ __forceinline__ unsigned xb_ld(unsigned* p)              { return __hip_atomic_load(p, __ATOMIC_RELAXED, __HIP_MEMORY_SCOPE_AGENT); }
__device__ __forceinline__ unsigned xb_add(unsigned* p, unsigned v) { return __hip_atomic_fetch_add(p, v, __ATOMIC_RELAXED, __HIP_MEMORY_SCOPE_AGENT); }
__device__ __forceinline__ unsigned xb_xcc_id() { return (unsigned)__builtin_amdgcn_s_getreg((3 << 11) | 20) & 0xFu; }
#define XB_SPIN(cond, bar) do { unsigned _sp = 0; while (cond) { __builtin_amdgcn_s_sleep(1); \
    if ((++_sp & 255u) == 0u) { if (xb_ld(&(bar)[XB_TMO])) break; if (_sp > XB_SPIN_CAP) { atomicAdd(&(bar)[XB_TMO], 1u); break; } } } } while (0)
struct XcdBarrier { unsigned* bar; unsigned x; volatile LAS unsigned* st; };
__device__ __forceinline__ XcdBarrier xcd_barrier_post(unsigned* bar, volatile LAS unsigned* st) {
    XcdBarrier b; b.bar = bar; b.x = xb_xcc_id(); b.st = st;
    if (threadIdx.x == 0) (void)xb_add(&bar[XB_XCNT(b.x)], 1u);
    return b;
}
__device__ __forceinline__ void xcd_barrier_complete(unsigned* bar, unsigned x, unsigned& nloc, unsigned& nx) {
    const unsigned G = gridDim.x * gridDim.y * gridDim.z;
    unsigned sum, cnt, mine, sp = 0u;
    for (;;) {
        sum = 0u; cnt = 0u; mine = 0u;
#pragma unroll
        for (unsigned j = 0; j < 16; ++j) { const unsigned c = xb_ld(&bar[XB_XCNT(j)]); sum += c; cnt += (c > 0u) ? 1u : 0u; mine = (j == x) ? c : mine; }
        if (sum == G) break;
        __builtin_amdgcn_s_sleep(1);
        if ((++sp & 255u) == 0u) { if (xb_ld(&bar[XB_TMO])) break; if (sp > XB_SPIN_CAP) { atomicAdd(&bar[XB_TMO], 1u); break; } }
    }
    nloc = mine > 0u ? mine : 1u; nx = cnt > 0u ? cnt : 1u;
}
__device__ __forceinline__ void xcd_barrier(const XcdBarrier& b) {
    asm volatile("s_waitcnt vmcnt(0)" ::: "memory");
    __syncthreads();
    if (threadIdx.x == 0) {
        unsigned* bar = b.bar;
        __builtin_amdgcn_s_waitcnt(0);
        unsigned nloc = b.st[0], nx = b.st[1];
        if (nloc == 0u) { xcd_barrier_complete(bar, b.x, nloc, nx); b.st[0] = nloc; b.st[1] = nx; }
        const unsigned old = xb_add(&bar[XB_XSUB(b.x)], 1u);
        const unsigned gen = old / nloc;
        if (old + 1u == (gen + 1u) * nloc) {
            __builtin_amdgcn_fence(__ATOMIC_RELEASE, "agent");
            asm volatile("s_waitcnt vmcnt(0)" ::: "memory");
            const unsigned og = xb_add(&bar[XB_TOP], 1u);
            const unsigned tg = og / nx;
            if (og + 1u == (tg + 1u) * nx) xb_add(&bar[XB_TOPGEN], 1u);
            else XB_SPIN(xb_ld(&bar[XB_TOPGEN]) == tg, bar);
            __builtin_amdgcn_fence(__ATOMIC_ACQUIRE, "agent");
            xb_add(&bar[XB_XGEN(b.x)], 1u);
            asm volatile("s_waitcnt vmcnt(0)" ::: "memory");
        } else {
            XB_SPIN(xb_ld(&bar[XB_XGEN(b.x)]) == gen, bar);
            __builtin_amdgcn_fence(__ATOMIC_ACQUIRE, "agent");
            asm volatile("s_waitcnt vmcnt(0)" ::: "memory");
        }
    }
    __syncthreads();
}

struct Args { const float* in[32]; float* out; unsigned char* ws; int ph_lo, ph_hi; };
enum { IN_X = 0, IN_C, IN_REL, IN_ADAW, IN_ADAB, IN_NMG, IN_NFG, IN_DAWIN, IN_DAWOUT, IN_QG, IN_KG, IN_LQ1, IN_LK1, IN_LQ2, IN_LK2, IN_SUBLN,
       IN_MLWIN, IN_CONVW, IN_CONVB, IN_WQ, IN_WK, IN_WV, IN_GATEW, IN_GATEB, IN_ONG, IN_SKIP, IN_MLWOUT, IN_WGRP, IN_WRT, IN_W1, IN_W3, IN_W2 };

struct Ctx {
    const Args* a; GAS unsigned char* ws; LAS unsigned char* lds; int tid, lane, wave, G, vcu;
    __device__ __forceinline__ const float* in(int i) const { return (const float*)(const GAS float*)a->in[i]; }
    template <class Tp> __device__ __forceinline__ Tp* w(size_t off) const { return (Tp*)(GAS Tp*)(ws + off); }
    __device__ __forceinline__ float* xout() const { return (float*)(GAS float*)a->out; }
    __device__ __forceinline__ const float* mods(int layer, int which) const { return (const float*)(ws + WS_MODS) + (size_t)layer * 16 * 6144 + which * 1024; }
};

__device__ __forceinline__ Ctx fresh(const Ctx& C) {
    Ctx P = C; int t = C.tid; asm volatile("" : "+v"(t)); P.tid = t; P.lane = t & 63; P.wave = __builtin_amdgcn_readfirstlane(t >> 6);
    GAS unsigned char* w = C.ws; asm volatile("" : "+s"(w)); P.ws = w; int g = __builtin_amdgcn_readfirstlane(C.G), v = __builtin_amdgcn_readfirstlane(C.vcu); asm volatile("" : "+s"(g), "+s"(v)); P.G = g; P.vcu = v;
    return P;
}
__device__ __forceinline__ void transpose_item(const float* W, int K, int N, bf16* WT, int ldt, int dst_row0, LAS float* scr, int kb, int nb, int lane) {
    const int k0 = 64 * kb, n0 = 32 * nb;
#pragma unroll 8
    for (int i = 0; i < 32; ++i) { const int kk = 2 * i + (lane >> 5); scr[kk * 33 + (lane & 31)] = W[(size_t)(k0 + kk) * N + n0 + (lane & 31)]; }
    LDS_WAIT(); asm volatile("" ::: "memory");
    const int c = lane & 7;
#pragma unroll
    for (int j = 0; j < 4; ++j) { const int n = (lane >> 3) + 8 * j; const LAS float* s = scr + (8 * c) * 33 + n;
        u32x4 o; o.x = pk2(s[0 * 33], s[1 * 33]); o.y = pk2(s[2 * 33], s[3 * 33]); o.z = pk2(s[4 * 33], s[5 * 33]); o.w = pk2(s[6 * 33], s[7 * 33]);
        *(u32x4*)(WT + (size_t)(dst_row0 + n) * ldt + k0 + 8 * c) = o; }
    LDS_WAIT(); asm volatile("" ::: "memory");
}
__device__ __forceinline__ void moe_weight_items(const Ctx& C, int layer, LAS float* scr) {
    const int gw = C.vcu * 8 + C.wave, NGW = C.G * 8;
    const float* w1 = C.in(IN_W1) + (size_t)layer * NEXP * DM * DEXP; const float* w3 = C.in(IN_W3) + (size_t)layer * NEXP * DM * DEXP; const float* w2 = C.in(IN_W2) + (size_t)layer * NEXP * DEXP * DM;
    bf16* W13T = C.w<bf16>(WS_W13T); bf16* W2T = C.w<bf16>(WS_W2T);
    constexpr int I13 = 16 * 8, I2 = 4 * 32;
    for (int it = gw; it < NEXP * (2 * I13 + I2); it += NGW) {
        const int e = it / (2 * I13 + I2); int r = it - e * (2 * I13 + I2);
        if (r < 2 * I13) { const int which = r / I13; r -= which * I13; const int kb = r / 8, nb = r % 8; const int n0 = 32 * nb;
            const int dst = (n0 / 128) * 256 + which * 128 + (n0 % 128);
            transpose_item((which ? w3 : w1) + (size_t)e * DM * DEXP, DM, DEXP, W13T + (size_t)e * 512 * DM, DM, dst, scr, kb, nb, C.lane); }
        else { r -= 2 * I13; const int kb = r / 32, nb = r % 32;
            transpose_item(w2 + (size_t)e * DEXP * DM, DEXP, DM, W2T + (size_t)e * DM * DEXP, DEXP, 32 * nb, scr, kb, nb, C.lane); }
    }
}
__device__ __forceinline__ void plain_weight_items(const Ctx& C, const float* W, int K, int N, bf16* WT, LAS float* scr) {
    const int gw = C.vcu * 8 + C.wave, NGW = C.G * 8; const int nblk = N / 32;
    for (int it = gw; it < (K / 64) * nblk; it += NGW) { const int kb = it / nblk, nb = it % nblk; transpose_item(W, K, N, WT, K, 32 * nb, scr, kb, nb, C.lane); }
}
__device__ __forceinline__ int t5_bucket(int rel) {
    const int n = rel < 0 ? -rel : rel; int b;
    if (n < 8) b = n; else b = 8 + (n >= 12) + (n >= 16) + (n >= 23) + (n >= 32) + (n >= 46) + (n >= 64) + (n >= 91);
    return b + (rel > 0 ? 16 : 0);
}
__device__ __forceinline__ void p_prologue(const Ctx& C) {
    __syncthreads();
    {
        LAS float* cact = (LAS float*)C.lds;
        LAS float* red = (LAS float*)(C.lds + 65536);
        const float* c = C.in(IN_C);
        { float cv[32];
#pragma unroll
          for (int j = 0; j < 32; ++j) cv[j] = c[C.tid + 512 * j];
#pragma unroll
          for (int j = 0; j < 32; ++j) cact[C.tid + 512 * j] = silu_f(cv[j]); }
        __syncthreads();
        for (int task = C.vcu; task < 192; task += C.G) {
            const int layer = task / 96, n0 = (task % 96) * 64, nl = C.tid & 63, kc = C.tid >> 6;
            const float* W = C.in(IN_ADAW) + (size_t)layer * DM * 6144 + n0 + nl;
            float acc[16];
#pragma unroll
            for (int b = 0; b < 16; ++b) acc[b] = 0.f;
            for (int k0 = kc * 128; k0 < kc * 128 + 128; k0 += 16) { float wv[16];
#pragma unroll
                for (int j = 0; j < 16; ++j) wv[j] = W[(size_t)(k0 + j) * 6144];
#pragma unroll
                for (int j = 0; j < 16; ++j)
#pragma unroll
                    for (int b = 0; b < 16; ++b) acc[b] += cact[b * 1024 + k0 + j] * wv[j]; }
#pragma unroll
            for (int b = 0; b < 16; ++b) red[(kc * 16 + b) * 64 + nl] = acc[b];
            __syncthreads();
            for (int o = C.tid; o < 16 * 64; o += 512) { const int b = o >> 6, n = o & 63; float s = 0.f;
#pragma unroll
                for (int q = 0; q < 8; ++q) s += red[(q * 16 + b) * 64 + n];
                C.w<float>(WS_MODS)[(size_t)layer * 16 * 6144 + (size_t)b * 6144 + n0 + n] = s + C.in(IN_ADAB)[layer * 6144 + n0 + n]; }
            __syncthreads();
        }
    }
    {
        const int gt = C.vcu * 512 + C.tid, NGT = C.G * 512;
        float mq = 0.f, mk = 0.f;
        { f32x4 qv[16], kv[16];
#pragma unroll
          for (int i = 0; i < 16; ++i) { qv[i] = *(const f32x4*)(C.in(IN_QG) + 4 * i); kv[i] = *(const f32x4*)(C.in(IN_KG) + 4 * i); }
#pragma unroll
          for (int i = 0; i < 16; ++i) { mq = fmaxf(fmaxf(mq, fmaxf(fabsf(qv[i].x), fabsf(qv[i].y))), fmaxf(fabsf(qv[i].z), fabsf(qv[i].w))); mk = fmaxf(fmaxf(mk, fmaxf(fabsf(kv[i].x), fabsf(kv[i].y))), fmaxf(fabsf(kv[i].z), fabsf(kv[i].w))); } }
        for (int i = gt; i < 8 * 4096; i += NGT) { const int h = i >> 12, idx = i & 4095; if (idx < 4095) {
            float rv[32];
#pragma unroll
            for (int b = 0; b < 32; ++b) rv[b] = C.in(IN_REL)[b * 8 + h];
            float mb = -1e30f;
#pragma unroll
            for (int b = 0; b < 32; ++b) mb = fmaxf(mb, rv[b]);
            const float cshift = 8.0f * mq * mk + mb;
            C.w<float>(WS_TAB2)[i] = (C.in(IN_REL)[t5_bucket(idx - 2047) * 8 + h] - cshift) * LOG2E; } else C.w<float>(WS_TAB2)[i] = 0.f; }
        if (gt == 0) { f32x4 a1[16], b1[16], a2[16], b2[16];
#pragma unroll
            for (int i = 0; i < 16; ++i) { a1[i] = *(const f32x4*)(C.in(IN_LQ1) + 4 * i); b1[i] = *(const f32x4*)(C.in(IN_LK1) + 4 * i); a2[i] = *(const f32x4*)(C.in(IN_LQ2) + 4 * i); b2[i] = *(const f32x4*)(C.in(IN_LK2) + 4 * i); }
            float s1 = 0.f, s2 = 0.f;
#pragma unroll
            for (int i = 0; i < 16; ++i) { s1 += (a1[i].x * b1[i].x + a1[i].y * b1[i].y) + (a1[i].z * b1[i].z + a1[i].w * b1[i].w); s2 += (a2[i].x * b2[i].x + a2[i].y * b2[i].y) + (a2[i].z * b2[i].z + a2[i].w * b2[i].w); }
            C.w<float>(WS_SCAL)[0] = __expf(s1) - __expf(s2) + 0.2f; }
        for (int i = gt; i < 16 * 6144; i += NGT) { const int n = i / 6144, k = i % 6144, d = n >> 3, g = n & 7, m = k / 2048, c = k % 2048;
            C.w<bf16>(WS_GWT)[i] = (bf16)f2bf(C.in(IN_GATEW)[(((size_t)d * 3 + m) * 2048 + c) * 8 + g]); }
    }
    LAS float* scr = (LAS float*)(C.lds + C.wave * 16384);
    plain_weight_items(C, C.in(IN_DAWIN), DM, 3 * DM, C.w<bf16>(WS_WINT), scr);
    plain_weight_items(C, C.in(IN_DAWOUT), DM, DM, C.w<bf16>(WS_WOT), scr);
    plain_weight_items(C, C.in(IN_MLWIN), DM, 2 * ML_IN, C.w<bf16>(WS_MLWINT), scr);
    plain_weight_items(C, C.in(IN_MLWOUT), ML_IN, DM, C.w<bf16>(WS_MLWOUTT), scr);
    moe_weight_items(C, 0, scr);
}

__device__ __forceinline__ void normmod_row(const float* xrow, const float* g, const float* sc, const float* sh, bf16* orow, int lane) {
    const f32x4* xr = (const f32x4*)xrow + lane; f32x4 v[4]; float s = 0.f;
#pragma unroll
    for (int j = 0; j < 4; ++j) { v[j] = xr[64 * j]; s += (v[j].x * v[j].x + v[j].y * v[j].y) + (v[j].z * v[j].z + v[j].w * v[j].w); }
    const float rstd = 1.0f / sqrtf(wave_sum(s) * (1.0f / DM) + EPS);
    u32x2* o8 = (u32x2*)orow + lane;
#pragma unroll
    for (int j = 0; j < 4; ++j) { const f32x4 gv = ((const f32x4*)g)[lane + 64 * j], scv = ((const f32x4*)sc)[lane + 64 * j], shv = ((const f32x4*)sh)[lane + 64 * j];
        const f32x4 y = (v[j] * rstd * gv) * (scv + 1.0f) + shv; u32x2 w; w.x = pk2(y.x, y.y); w.y = pk2(y.z, y.w); o8[64 * j] = w; }
}
__device__ __forceinline__ void normmod_row_bf(const bf16* xrow, const float* g, const float* sc, const float* sh, bf16* orow, int lane) {
    float v[2][8]; float s = 0.f;
#pragma unroll
    for (int j = 0; j < 2; ++j) { const u32x4 w = *((const u32x4*)(xrow + 512 * j) + lane);
        v[j][0] = bflo(w.x); v[j][1] = bfhi(w.x); v[j][2] = bflo(w.y); v[j][3] = bfhi(w.y); v[j][4] = bflo(w.z); v[j][5] = bfhi(w.z); v[j][6] = bflo(w.w); v[j][7] = bfhi(w.w);
#pragma unroll
        for (int i = 0; i < 8; ++i) s += v[j][i] * v[j][i]; }
    const float rstd = 1.0f / sqrtf(wave_sum(s) * (1.0f / DM) + EPS);
#pragma unroll
    for (int j = 0; j < 2; ++j) { const int c = 512 * j + 8 * lane; float y[8];
#pragma unroll
        for (int i = 0; i < 8; ++i) y[i] = (v[j][i] * rstd * g[c + i]) * (sc[c + i] + 1.0f) + sh[c + i];
        u32x4 w; w.x = pk2(y[0], y[1]); w.y = pk2(y[2], y[3]); w.z = pk2(y[4], y[5]); w.w = pk2(y[6], y[7]);
        *((u32x4*)(orow + 512 * j) + lane) = w; }
}
__device__ __forceinline__ void p_normmod_bf(const Ctx& C, const bf16* xsrc, int layer, int row_lo, int row_hi, bf16* dst) {
    const int gw = C.vcu * 8 + C.wave, NGW = C.G * 8;
    const float* g = C.in(IN_NMG) + layer * DM;
    for (int r = row_lo + gw; r < row_hi; r += NGW) { const int b = r / SEQ;
        normmod_row_bf(xsrc + (size_t)r * DM, g, C.mods(layer, 1) + (size_t)b * 6144, C.mods(layer, 0) + (size_t)b * 6144, dst + (size_t)(r - row_lo) * DM, C.lane); }
}
__device__ __forceinline__ void p_normmod(const Ctx& C, const float* xsrc, int layer, int row_lo, int row_hi, bf16* dst) {
    const int gw = C.vcu * 8 + C.wave, NGW = C.G * 8;
    const float* g = C.in(IN_NMG) + layer * DM;
    for (int r = row_lo + gw; r < row_hi; r += NGW) { const int b = r / SEQ;
        normmod_row(xsrc + (size_t)r * DM, g, C.mods(layer, 1) + (size_t)b * 6144, C.mods(layer, 0) + (size_t)b * 6144, dst + (size_t)(r - row_lo) * DM, C.lane); }
}

constexpr int AT_KS = 144, AT_VS = 144;
constexpr int AT_K_BYTES = 2 * 64 * AT_KS, AT_V_BYTES = 128 * AT_VS, AT_BUF = AT_K_BYTES + AT_V_BYTES;
constexpr int AT_TAB_OFF = 3 * AT_BUF;
constexpr int AT_EX_OFF = 0, AT_EX_PITCH = 132;
static_assert(AT_BUF % 16 == 0 && AT_TAB_OFF + 16384 <= RING_BYTES && 4 * 32 * AT_EX_PITCH * 4 <= AT_TAB_OFF, "attention LDS");
template <int ABL> __device__ __forceinline__ void attn_unit(const Ctx& C, int b, int h, int qt, bool load_tab, float lam) {
    LAS unsigned char* lds = C.lds;
    const int tid = C.tid, lane = C.lane, wid = C.wave, mp = wid >> 2, rb = wid & 3, r32 = lane & 31, hi = lane >> 5;
    const bf16* QK = C.w<bf16>(WS_QK); const bf16* VT = C.w<bf16>(WS_VT);
    const size_t tok0 = (size_t)b * SEQ; const int q0 = qt * 128, qa = q0 + 32 * rb;
    LAS float* tab = (LAS float*)(lds + AT_TAB_OFF);
    __syncthreads();
    if (load_tab) { const float* t2 = C.w<float>(WS_TAB2) + h * 4096; for (int i = tid; i < 4096; i += 512) tab[i] = t2[i]; }
    bf16x8 qf[4];
    { const bf16* qrow = QK + (tok0 + qa + r32) * 2048 + h * 128 + mp * 64 + hi * 8;
#pragma unroll
      for (int ks = 0; ks < 4; ++ks) qf[ks] = *(const bf16x8*)(qrow + ks * 16);
      asm volatile("" : "+v"(qf[0]), "+v"(qf[1]), "+v"(qf[2]), "+v"(qf[3])); }
    const int kkey = tid >> 4, kcc = tid & 15, vdv = tid >> 3, vkc = tid & 7;
    const bf16* ksrc = QK + (tok0 + kkey) * 2048 + 1024 + h * 128 + kcc * 8;
    const bf16* vsrc = VT + (size_t)(h * 128 + vdv) * NT + tok0 + vkc * 8;
    const int kdst = ((kcc >> 3) * 64 + kkey) * AT_KS + (kcc & 7) * 16;
    const int vdst = AT_K_BYTES + vdv * AT_VS + (vkc >> 1) * 32 + (vkc & 1) * 8;
    u32x4 kst[2], vst[2];
#define AT_LOAD(t) do { const int k0_ = (t) * 64; kst[0] = *(const u32x4*)(ksrc + (size_t)k0_ * 2048); kst[1] = *(const u32x4*)(ksrc + (size_t)(k0_ + 32) * 2048); \
        vst[0] = *(const u32x4*)(vsrc + k0_); vst[1] = *(const u32x4*)(vsrc + (size_t)64 * NT + k0_); } while (0)
#define AT_WRITE(bufo) do { _Pragma("unroll") for (int i_ = 0; i_ < 2; ++i_) { *(LAS u32x4*)(lds + (bufo) + kdst + 32 * i_ * AT_KS) = kst[i_]; \
        LAS u32x2* vd_ = (LAS u32x2*)(lds + (bufo) + vdst + 64 * i_ * AT_VS); vd_[0] = (u32x2){vst[i_].x, vst[i_].y}; vd_[2] = (u32x2){vst[i_].z, vst[i_].w}; } } while (0)
    const int kfo = (mp * 64 + r32) * AT_KS + hi * 16;
    const int vfo = AT_K_BYTES + r32 * AT_VS + hi * 16;
    f32x16 o[4];
#pragma unroll
    for (int i = 0; i < 4; ++i) o[i] = (f32x16){0.f, 0.f, 0.f, 0.f, 0.f, 0.f, 0.f, 0.f, 0.f, 0.f, 0.f, 0.f, 0.f, 0.f, 0.f, 0.f};
    f32x2 lacc = (f32x2){0.f, 0.f};
    bf16x8 pf[4];

#define AT_SOFT(t, bo) do { const int k0_ = (t) * 64; const int dlo_ = k0_ - qa - 31, dhi_ = k0_ + 63 - qa; \
        const bool cst_ = (dhi_ <= -91) || (dlo_ >= 91); const float ini_ = (dhi_ <= -91) ? c_neg : ((dlo_ >= 91) ? c_pos : 0.f); \
        bf16x8 kf_[2][4]; \
        _Pragma("unroll") for (int kb_ = 0; kb_ < 2; ++kb_) _Pragma("unroll") for (int ks_ = 0; ks_ < 4; ++ks_) kf_[kb_][ks_] = *(const LAS bf16x8*)(lds + (bo) + kfo + kb_ * 32 * AT_KS + ks_ * 32); \
        f32x16 s0_, s1_; \
        _Pragma("unroll") for (int r_ = 0; r_ < 16; ++r_) { s0_[r_] = ini_; s1_[r_] = ini_; } \
        if (!(ABL & 16)) { _Pragma("unroll") for (int ks_ = 0; ks_ < 4; ++ks_) { s0_ = __builtin_amdgcn_mfma_f32_32x32x16_bf16(kf_[0][ks_], qf[ks_], s0_, 0, 0, 0); s1_ = __builtin_amdgcn_mfma_f32_32x32x16_bf16(kf_[1][ks_], qf[ks_], s1_, 0, 0, 0); } } \
        else { _Pragma("unroll") for (int ks_ = 0; ks_ < 4; ++ks_) { s0_[ks_] += __builtin_bit_cast(float, kf_[0][ks_][0] + kf_[0][ks_][1]); s1_[ks_] += __builtin_bit_cast(float, kf_[1][ks_][0] + kf_[1][ks_][1]); } } \
        _Pragma("unroll") for (int kb_ = 0; kb_ < 2; ++kb_) { f32x16 s_ = kb_ ? s1_ : s0_; \
            if (!cst_) { const LAS float* tp_ = tab + (k0_ + 32 * kb_ + 4 * hi - (qa + r32) + 2047); _Pragma("unroll") for (int r_ = 0; r_ < 16; ++r_) s_[r_] += tp_[(r_ & 3) + 8 * (r_ >> 2)]; } \
            float p_[16]; \
            _Pragma("unroll") for (int r_ = 0; r_ < 16; ++r_) p_[r_] = (ABL & 1) ? s_[r_] : __builtin_amdgcn_exp2f(s_[r_]); \
            _Pragma("unroll") for (int r_ = 0; r_ < 16; r_ += 2) lacc += (f32x2){p_[r_], p_[r_ + 1]}; \
            _Pragma("unroll") for (int sh_ = 0; sh_ < 2; ++sh_) { u32x4 w_; w_.x = pk2(p_[8 * sh_ + 0], p_[8 * sh_ + 1]); w_.y = pk2(p_[8 * sh_ + 2], p_[8 * sh_ + 3]); w_.z = pk2(p_[8 * sh_ + 4], p_[8 * sh_ + 5]); w_.w = pk2(p_[8 * sh_ + 6], p_[8 * sh_ + 7]); \
                pf[2 * kb_ + sh_] = __builtin_bit_cast(bf16x8, w_); } } } while (0)
#define AT_PV(bo) do { _Pragma("unroll") for (int hb_ = 0; hb_ < 2; ++hb_) { u32x4 vf_[8]; \
        _Pragma("unroll") for (int i_ = 0; i_ < 8; ++i_) { const int dvb_ = 2 * hb_ + (i_ >> 2), s4_ = i_ & 3; vf_[i_] = *(const LAS u32x4*)(lds + (bo) + vfo + dvb_ * 32 * AT_VS + s4_ * 32); } \
        if (!(ABL & 2)) { _Pragma("unroll") for (int i_ = 0; i_ < 8; ++i_) o[2 * hb_ + (i_ >> 2)] = __builtin_amdgcn_mfma_f32_32x32x16_bf16(__builtin_bit_cast(bf16x8, vf_[i_]), pf[i_ & 3], o[2 * hb_ + (i_ >> 2)], 0, 0, 0); } \
        else { _Pragma("unroll") for (int i_ = 0; i_ < 8; ++i_) o[2 * hb_ + (i_ >> 2)][i_] += __builtin_bit_cast(float, vf_[i_].x ^ vf_[i_].y ^ vf_[i_].z ^ vf_[i_].w) + __builtin_bit_cast(float, __builtin_bit_cast(u32x4, pf[i_ & 3]).x); } } } while (0)
    AT_LOAD(0); AT_WRITE(0); AT_LOAD(1);
    __syncthreads();
    const float c_neg = tab[1000], c_pos = tab[3000];
    int b_prv = 2 * AT_BUF, b_cur = 0, b_nxt = AT_BUF;
#pragma nounroll
    for (int t = 0; t <= 32; ++t) {
        if (t + 1 < 32 && (!(ABL & 4) || t < 2)) AT_WRITE(b_nxt);
        if (t + 2 < 32 && (!(ABL & 4) || t < 2)) AT_LOAD(t + 2);
        if (mp == 0) { if (t < 32) AT_SOFT(t, b_cur); }
        else { if (t >= 1) AT_PV(b_prv); }
        if (!(ABL & 8)) __syncthreads();
        if (mp == 0) { if (t < 32) AT_PV(b_cur); }
        else { if (t < 32) AT_SOFT(t, b_cur); }
        { const int tmp = b_prv; b_prv = b_cur; b_cur = b_nxt; b_nxt = tmp; }
        if (!(ABL & 8)) __syncthreads();
    }
#undef AT_LOAD
#undef AT_WRITE
#undef AT_SOFT
#undef AT_PV
    float lsum = lacc.x + lacc.y;
    lsum += __shfl_xor(lsum, 32);
    const float sc = (mp == 0 ? 1.0f : lam) / lsum;
    LAS float* ex = (LAS float*)(lds + AT_EX_OFF) + (rb * 32 + r32) * AT_EX_PITCH;
    if (mp == 1) {
#pragma unroll
        for (int dvb = 0; dvb < 4; ++dvb)
#pragma unroll
            for (int g = 0; g < 4; ++g) *(LAS f32x4*)(ex + dvb * 32 + 8 * g + 4 * hi) = (f32x4){o[dvb][4 * g] * sc, o[dvb][4 * g + 1] * sc, o[dvb][4 * g + 2] * sc, o[dvb][4 * g + 3] * sc};
    }
    __syncthreads();
    if (mp == 0) {
        float ss = 0.f;
#pragma unroll
        for (int dvb = 0; dvb < 4; ++dvb)
#pragma unroll
            for (int g = 0; g < 4; ++g) { const f32x4 e = *(const LAS f32x4*)(ex + dvb * 32 + 8 * g + 4 * hi);
#pragma unroll
                for (int i = 0; i < 4; ++i) { const float v = o[dvb][4 * g + i] * sc - e[i]; o[dvb][4 * g + i] = v; ss += v * v; } }
        ss += __shfl_xor(ss, 32);
        const float rs = (1.0f / sqrtf(ss * (1.0f / 128.0f) + EPS)) * 0.8f;
        bf16* orow = C.w<bf16>(ABL ? WS_HM : WS_O) + (tok0 + qa + r32) * DM + h * 128;
        const float* sg = C.in(IN_SUBLN);
#pragma unroll
        for (int dvb = 0; dvb < 4; ++dvb)
#pragma unroll
            for (int g = 0; g < 4; ++g) { const int dv = dvb * 32 + 8 * g + 4 * hi; const f32x4 gv = *(const f32x4*)(sg + dv);
                u32x2 w; w.x = pk2(o[dvb][4 * g] * rs * gv.x, o[dvb][4 * g + 1] * rs * gv.y); w.y = pk2(o[dvb][4 * g + 2] * rs * gv.z, o[dvb][4 * g + 3] * rs * gv.w);
                *(u32x2*)(orow + dv) = w; }
    }
}
template <int ABL> __device__ __forceinline__ void p_attention(const Ctx& C) {
    int last_h = -1; const float lam = C.w<float>(WS_SCAL)[0];
    for (int w = C.vcu; w < NB * DA_H * 2; w += C.G) { const int bh = w >> 1, half = w & 1, h = bh & 7;
        for (int i = 0; i < 8; ++i) { attn_unit<ABL>(C, bh >> 3, h, half * 8 + i, h != last_h, lam); last_h = h; } }
    __syncthreads();
}

constexpr int RT_CH = 128, RT_IMG = RT_CH * 16 * 16;
__device__ __forceinline__ void p_route(const Ctx& C, int layer, const bf16* x, bool commit = true) {
    const int lane = C.lane, tid = C.tid, tok = lane & 15, kq = lane >> 4;
    const float* g = C.in(IN_NFG) + layer * DM;
    const float* wr_ = C.in(IN_WRT) + (size_t)layer * DM * 32; const float* wg_ = C.in(IN_WGRP) + (size_t)layer * DM * 4;
    unsigned* cnt = C.w<unsigned>(WS_CTL) + CW_CNT + layer * 64;
    LAS float* lg = (LAS float*)(C.lds + 2 * RT_IMG) + C.wave * (16 * 48);
    bf16* HF = C.w<bf16>(WS_HF);
    const int sk = tid >> 2, sn = (tid & 3) * 4;
    f32x4 st0, st1, st2;
#define RT_LOAD(c) do { const int k_ = (c) * RT_CH + sk; st0 = *(const f32x4*)(wr_ + k_ * 32 + sn); st1 = *(const f32x4*)(wr_ + k_ * 32 + 16 + sn); st2 = (sn == 0) ? *(const f32x4*)(wg_ + k_ * 4) : (f32x4){0.f, 0.f, 0.f, 0.f}; } while (0)
#define RT_WRITE(bo) do { LAS f32x4* d_ = (LAS f32x4*)(C.lds + (bo)) + sk * 16 + sn; d_[0] = (f32x4){st0[0], st1[0], st2[0], 0.f}; d_[1] = (f32x4){st0[1], st1[1], st2[1], 0.f}; d_[2] = (f32x4){st0[2], st1[2], st2[2], 0.f}; d_[3] = (f32x4){st0[3], st1[3], st2[3], 0.f}; } while (0)
    for (int ts = C.vcu; ts < NT / 128; ts += C.G) {
        const int t0 = ts * 128 + C.wave * 16, b = t0 / SEQ;
        const bf16* xrow = x + (size_t)(t0 + tok) * DM + 8 * kq;
        __syncthreads();
        RT_LOAD(0);
        float ss = 0.f;
#pragma unroll 8
        for (int K = 0; K < 32; ++K) { const u32x4 w = *(const u32x4*)(xrow + 32 * K); const float v[8] = {bflo(w.x), bfhi(w.x), bflo(w.y), bfhi(w.y), bflo(w.z), bfhi(w.z), bflo(w.w), bfhi(w.w)};
#pragma unroll
            for (int i = 0; i < 8; ++i) ss += v[i] * v[i]; }
        ss += __shfl_xor(ss, 16); ss += __shfl_xor(ss, 32);
        const float rstd = 1.0f / sqrtf(ss * (1.0f / DM) + EPS);
        const float* gq = g + 8 * kq; const float* sc = C.mods(layer, 4) + (size_t)b * 6144 + 8 * kq; const float* sh = C.mods(layer, 3) + (size_t)b * 6144 + 8 * kq;
        f32x4 a0 = (f32x4){0.f, 0.f, 0.f, 0.f}, a1 = a0, a2 = a0;
        bf16* hrow = HF + (size_t)(t0 + tok) * DM + 8 * kq;
        RT_WRITE(0);
        for (int c = 0; c < DM / RT_CH; ++c) {
            const int bo = (c & 1) * RT_IMG;
            __syncthreads();
            if (c + 1 < DM / RT_CH) RT_LOAD(c + 1);
            const LAS f32x4* bimg = (const LAS f32x4*)(C.lds + bo) + (8 * kq) * 16 + tok;
#pragma unroll
            for (int half = 0; half < 2; ++half) {
                float hfv[2][8];
#pragma unroll
                for (int q = 0; q < 2; ++q) { const int K = c * 4 + half * 2 + q;
                    const u32x4 xw = *(const u32x4*)(xrow + 32 * K); const float v[8] = {bflo(xw.x), bfhi(xw.x), bflo(xw.y), bfhi(xw.y), bflo(xw.z), bfhi(xw.z), bflo(xw.w), bfhi(xw.w)};
                    const f32x4 g0 = *(const f32x4*)(gq + 32 * K), g1 = *(const f32x4*)(gq + 32 * K + 4), c0 = *(const f32x4*)(sc + 32 * K), c1 = *(const f32x4*)(sc + 32 * K + 4), h0 = *(const f32x4*)(sh + 32 * K), h1 = *(const f32x4*)(sh + 32 * K + 4);
#pragma unroll
                    for (int i = 0; i < 4; ++i) { hfv[q][i] = (v[i] * rstd * g0[i]) * (c0[i] + 1.0f) + h0[i]; hfv[q][4 + i] = (v[4 + i] * rstd * g1[i]) * (c1[i] + 1.0f) + h1[i]; }
                    u32x4 w; w.x = pk2(hfv[q][0], hfv[q][1]); w.y = pk2(hfv[q][2], hfv[q][3]); w.z = pk2(hfv[q][4], hfv[q][5]); w.w = pk2(hfv[q][6], hfv[q][7]); *(u32x4*)(hrow + 32 * K) = w; }
#pragma unroll
                for (int q = 0; q < 2; ++q)
#pragma unroll
                    for (int i = 0; i < 8; ++i) { const f32x4 bv = bimg[((half * 2 + q) * 32 + i) * 16];
                        a0 = __builtin_amdgcn_mfma_f32_16x16x4f32(hfv[q][i], bv[0], a0, 0, 0, 0); a1 = __builtin_amdgcn_mfma_f32_16x16x4f32(hfv[q][i], bv[1], a1, 0, 0, 0); a2 = __builtin_amdgcn_mfma_f32_16x16x4f32(hfv[q][i], bv[2], a2, 0, 0, 0); }
            }
            if (c + 1 < DM / RT_CH) RT_WRITE(RT_IMG - bo);
        }
#pragma unroll
        for (int r = 0; r < 4; ++r) { lg[(4 * kq + r) * 48 + tok] = a0[r]; lg[(4 * kq + r) * 48 + 16 + tok] = a1[r]; lg[(4 * kq + r) * 48 + 32 + tok] = a2[r]; }
        LDS_WAIT(); asm volatile("" ::: "memory");
        if (lane < 16 && commit) {
            const LAS float* L = lg + lane * 48;
            int gs = 0; float gm = L[32];
#pragma unroll
            for (int j = 1; j < 4; ++j) { const float v = L[32 + j]; if (v > gm) { gm = v; gs = j; } }
            float gsum = 0.f;
#pragma unroll
            for (int j = 0; j < 4; ++j) gsum += __expf(L[32 + j] - gm);
            const float pg = 1.0f / gsum;
            int ia = 0; float la = L[gs * 8];
#pragma unroll
            for (int j = 1; j < 8; ++j) { const float v = L[gs * 8 + j]; if (v > la) { la = v; ia = j; } }
            int ib = -1; float lb = -3.0e38f;
#pragma unroll
            for (int j = 0; j < 8; ++j) { const float v = L[gs * 8 + j]; if (j != ia && v > lb) { lb = v; ib = j; } }
            const float wa = pg / (1.0f + __expf(lb - la)), wb = pg - wa;
            const int ea = gs * 8 + ia, eb = gs * 8 + ib, t = t0 + lane;
            const unsigned pa = atomicAdd(cnt + ea, 1u), pb = atomicAdd(cnt + eb, 1u);
            C.w<int>(WS_RE)[2 * t] = ea; C.w<int>(WS_RE)[2 * t + 1] = eb; C.w<float>(WS_RW)[2 * t] = wa; C.w<float>(WS_RW)[2 * t + 1] = wb;
            C.w<int>(WS_RP)[2 * t] = (int)pa; C.w<int>(WS_RP)[2 * t + 1] = (int)pb;
            C.w<int>(WS_TL)[(size_t)ea * NT + pa] = t; C.w<int>(WS_TL)[(size_t)eb * NT + pb] = t;
        }
        LDS_WAIT(); asm volatile("" ::: "memory");
    }
#undef RT_LOAD
#undef RT_WRITE
}
struct MoeTab { LAS int* off; LAS int* tile_e; LAS int* ntile; LAS int* cnt; LAS int* tile_p0; };
__device__ __forceinline__ MoeTab moe_tables(const Ctx& C, int layer) {
    MoeTab T; T.off = (LAS int*)(C.lds + MISC_OFF + 256); T.tile_e = T.off + 128; T.ntile = T.off + 48; T.cnt = T.off + 64; T.tile_p0 = T.off + 128 + 320;
    __syncthreads();
    if (C.tid < 64) {
        const unsigned* cnt = C.w<unsigned>(WS_CTL) + CW_CNT + layer * 64; const int e = C.lane;
        const int c = e < NEXP ? (int)__hip_atomic_load(cnt + e, __ATOMIC_RELAXED, __HIP_MEMORY_SCOPE_AGENT) : 0;
        const int tiles = (c + 255) >> 8; int inc = tiles;
#pragma unroll
        for (int o = 1; o < 32; o <<= 1) { const int v = __shfl_up(inc, o); if (e >= o) inc += v; }
        const int first = inc - tiles;
        if (e < NEXP) { T.off[e] = first * 256; T.cnt[e] = c; for (int j = 0; j < tiles; ++j) { T.tile_e[first + j] = e; T.tile_p0[first + j] = j * 256; } }
        if (e == NEXP - 1) { T.off[32] = inc * 256; T.ntile[0] = inc; } }
    __syncthreads();
    return T;
}
__device__ __forceinline__ void p_permute(const Ctx& C, int layer) {
    const MoeTab T = moe_tables(C, layer);
    const bf16* HF = C.w<bf16>(WS_HF); bf16* HS = C.w<bf16>(WS_HS);
    const int* RP = C.w<int>(WS_RP); const int* RE = C.w<int>(WS_RE);
    for (int p = C.vcu * 8 + C.wave; p < 2 * NT; p += C.G * 8) {
        const int e = RE[p], pos = RP[p], slot = T.off[e] + pos, t = p >> 1;
        const u32x4* s = (const u32x4*)(HF + (size_t)t * DM) + C.lane; u32x4* d = (u32x4*)(HS + (size_t)slot * DM) + C.lane;
        const u32x4 v0 = s[0], v1 = s[64]; d[0] = v0; d[64] = v1;
        asm volatile("" ::: "memory");
        if (C.lane == 0) C.w<int>(WS_RS)[p] = slot;
    }
}
template <int NPN, bool GATH> struct MoeOrder {
    const int* tl; MoeTab T; const char* A; const char* B; int lda_bytes; size_t b_expert_bytes; int b_tile_bytes; int G, c, nt;
    __device__ __forceinline__ bool next(int i, pg8::Unit& u) const {
        const int L = i * G + c; const int rt = L / NPN, pn = L - rt * NPN; if (rt >= T.ntile[0]) return false;
        const int e = T.tile_e[rt];
        u.A = GATH ? A : A + (size_t)rt * 256 * lda_bytes; u.B = B + (size_t)e * b_expert_bytes + (size_t)pn * b_tile_bytes; u.r0 = rt * 256; u.c0 = GATH ? T.tile_p0[rt] : pn * 256; u.a0 = e; u.a1 = pn; u.nt = nt; u.flags = GATH ? T.cnt[e] : 3; return true;
    }
    __device__ __forceinline__ int kb(const pg8::Unit&, int t) const { return t; }
    __device__ __forceinline__ unsigned arow(const pg8::Unit& u, int r) const { const int pos = u.c0 + r; const int tok = pos < u.flags ? tl[(size_t)u.a0 * NT + pos] : 0; return (unsigned)tok * (unsigned)(DM * 2); }
};
struct EpiSwiGLU {
    static constexpr bool PERM = true;
    bf16* H;
    __device__ __forceinline__ void operator()(const f32x4 (&acc)[2][2][4][2], const pg8::Unit& u, int wr, int wc, int fr_, int fq_) const {
        (void)fr_; (void)fq_; const int ln_ = opaque_v(lane_id()); const int fr = ln_ & 15, fq = ln_ >> 4;
        const int row0 = u.r0 + wr * 64 + fr, col0 = u.a1 * 128 + wc * 32 + 8 * fq;
#pragma unroll
        for (int ai = 0; ai < 2; ++ai)
#pragma unroll
            for (int m = 0; m < 4; ++m) { float r[8];
#pragma unroll
                for (int n = 0; n < 2; ++n)
#pragma unroll
                    for (int i = 0; i < 4; ++i) { const float a = acc[ai][0][m][n][i], b = acc[ai][1][m][n][i]; r[4 * n + i] = silu_f(a) * b; }
                u32x4 w; w.x = pk2(r[0], r[1]); w.y = pk2(r[2], r[3]); w.z = pk2(r[4], r[5]); w.w = pk2(r[6], r[7]);
                *(u32x4*)(H + (size_t)(row0 + ai * 128 + m * 16) * DEXP + col0) = w; }
    }
};
template <bool OUT_F32> __device__ __forceinline__ void p_combine(const Ctx& C, int layer, const bf16* xsrc, void* xdst, int norm_rows = 0, bf16* hm = nullptr) {
    const MoeTab T = moe_tables(C, layer);
    const bf16* YS = C.w<bf16>(WS_YS); const int* RP = C.w<int>(WS_RP); const int* RE = C.w<int>(WS_RE); const float* RW = C.w<float>(WS_RW);
    const float* ng = C.in(IN_NMG) + (layer + 1 < 2 ? layer + 1 : 1) * DM;
    for (int t = C.vcu * 8 + C.wave; t < NT; t += C.G * 8) {
        const int s0 = T.off[RE[2 * t]] + RP[2 * t], s1 = T.off[RE[2 * t + 1]] + RP[2 * t + 1]; const float w0 = RW[2 * t], w1 = RW[2 * t + 1];
        const int b = t / SEQ;
        const float* g2 = C.mods(layer, 5) + (size_t)b * 6144;
        const u32x4* y0 = (const u32x4*)(YS + (size_t)s0 * DM) + C.lane; const u32x4* y1 = (const u32x4*)(YS + (size_t)s1 * DM) + C.lane;
        const u32x4* xr = (const u32x4*)(xsrc + (size_t)t * DM) + C.lane;
        f32x4 xa[2], xb[2]; float ss = 0.f;
#pragma unroll
        for (int j = 0; j < 2; ++j) { const u32x4 a = y0[64 * j], bq = y1[64 * j], xw = xr[64 * j]; const f32x4 ga = *(const f32x4*)(g2 + 512 * j + 8 * C.lane), gb = *(const f32x4*)(g2 + 512 * j + 8 * C.lane + 4);
            xa[j] = (f32x4){bflo(xw.x), bfhi(xw.x), bflo(xw.y), bfhi(xw.y)}; xb[j] = (f32x4){bflo(xw.z), bfhi(xw.z), bflo(xw.w), bfhi(xw.w)};
            xa[j].x += ga.x * (w0 * bflo(a.x) + w1 * bflo(bq.x)); xa[j].y += ga.y * (w0 * bfhi(a.x) + w1 * bfhi(bq.x)); xa[j].z += ga.z * (w0 * bflo(a.y) + w1 * bflo(bq.y)); xa[j].w += ga.w * (w0 * bfhi(a.y) + w1 * bfhi(bq.y));
            xb[j].x += gb.x * (w0 * bflo(a.z) + w1 * bflo(bq.z)); xb[j].y += gb.y * (w0 * bfhi(a.z) + w1 * bfhi(bq.z)); xb[j].z += gb.z * (w0 * bflo(a.w) + w1 * bflo(bq.w)); xb[j].w += gb.w * (w0 * bfhi(a.w) + w1 * bfhi(bq.w));
            if (OUT_F32) { float* o = (float*)xdst + (size_t)t * DM + 512 * j + 8 * C.lane; *(f32x4*)o = xa[j]; *(f32x4*)(o + 4) = xb[j]; }
            else { u32x4 w; w.x = pk2(xa[j].x, xa[j].y); w.y = pk2(xa[j].z, xa[j].w); w.z = pk2(xb[j].x, xb[j].y); w.w = pk2(xb[j].z, xb[j].w); *((u32x4*)((bf16*)xdst + (size_t)t * DM + 512 * j) + C.lane) = w; }
            ss += (xa[j].x * xa[j].x + xa[j].y * xa[j].y) + (xa[j].z * xa[j].z + xa[j].w * xa[j].w) + (xb[j].x * xb[j].x + xb[j].y * xb[j].y) + (xb[j].z * xb[j].z + xb[j].w * xb[j].w); }
        if (t < norm_rows) {
            const float rstd = 1.0f / sqrtf(wave_sum(ss) * (1.0f / DM) + EPS);
            const float* sc = C.mods(layer + 1, 1) + (size_t)b * 6144; const float* sh = C.mods(layer + 1, 0) + (size_t)b * 6144;
#pragma unroll
            for (int j = 0; j < 2; ++j) { const int c = 512 * j + 8 * C.lane;
                const f32x4 g0 = *(const f32x4*)(ng + c), g1 = *(const f32x4*)(ng + c + 4), c0 = *(const f32x4*)(sc + c), c1 = *(const f32x4*)(sc + c + 4), h0 = *(const f32x4*)(sh + c), h1 = *(const f32x4*)(sh + c + 4);
                const f32x4 ya = (xa[j] * rstd * g0) * (c0 + 1.0f) + h0, yb = (xb[j] * rstd * g1) * (c1 + 1.0f) + h1;
                u32x4 w; w.x = pk2(ya.x, ya.y); w.y = pk2(ya.z, ya.w); w.z = pk2(yb.x, yb.y); w.w = pk2(yb.z, yb.w);
                *(u32x4*)(hm + (size_t)t * DM + c) = w; }
        }
    }
}

constexpr int CV_XM = 0;
constexpr int CV_QKV = 18432;
constexpr int CV_QKV_P = 1552;
constexpr int CV_VT = CV_QKV + 32 * CV_QKV_P;
constexpr int CV_RED = CV_VT + 256 * 80;
static_assert(CV_RED + 16384 <= RING_BYTES && CV_VT % 16 == 0 && CV_RED % 16 == 0, "conv LDS");
__device__ __forceinline__ void conv_unit(const Ctx& C, int round, int bl, int ti) {
    LAS unsigned char* lds = C.lds; const int tid = C.tid, lane = C.lane, wid = C.wave;
    const int s0 = ti * 32; const size_t rrow0 = (size_t)bl * SEQ;
    const bf16* XM = C.w<bf16>(WS_XMH); bf16* XC = C.w<bf16>(WS_XC); bf16* K = C.w<bf16>(WS_K); bf16* VTR = C.w<bf16>(WS_VTR);
    const bf16* GWT = C.w<bf16>(WS_GWT);
    f32x4 gacc[2]; gacc[0] = (f32x4){0.f, 0.f, 0.f, 0.f}; gacc[1] = gacc[0];
    const int nblk = tid & 63, tg = tid >> 6;
    u32x4 xs[3];
#define CV_LOAD(chn) do { _Pragma("unroll") for (int q_ = 0; q_ < 3; ++q_) { const int i_ = tid + 512 * q_; const int r_ = i_ >> 5, cc_ = i_ & 31, s_ = s0 - 2 + r_; xs[q_] = (u32x4){0u, 0u, 0u, 0u}; \
        if (i_ < 36 * 32 && s_ >= 0 && s_ < SEQ) xs[q_] = *(const u32x4*)(XM + (rrow0 + s_) * ML_IN + (chn) * 256 + cc_ * 8); } } while (0)
    CV_LOAD(0);
    for (int ch = 0; ch < 8; ++ch) {
        const int c0 = ch * 256;
        bf16x8 gwf[3];
#pragma unroll
        for (int ks = 0; ks < 3; ++ks) { const int kk = 96 * wid + 32 * ks + 8 * (lane >> 4); gwf[ks] = *(const bf16x8*)(GWT + (size_t)(lane & 15) * 6144 + (kk >> 8) * 2048 + c0 + (kk & 255)); }
        LDS_BARRIER();
#pragma unroll
        for (int q = 0; q < 3; ++q) { const int i = tid + 512 * q; if (i < 36 * 32) *(LAS u32x4*)(lds + CV_XM + (i >> 5) * 512 + (i & 31) * 16) = xs[q]; }
        if (ch + 1 < 8) CV_LOAD(ch + 1);
        LDS_BARRIER();
        {
            const int c = c0 + 4 * nblk;
            float cw[5][4], cb[4], wq[4][4], wk[4][4], wv[4][4];
            const float* convw = C.in(IN_CONVW); const float* convb = C.in(IN_CONVB);
#pragma unroll
            for (int j = 0; j < 5; ++j) { const f32x4 v = *(const f32x4*)(convw + j * ML_IN + c); cw[j][0] = v.x; cw[j][1] = v.y; cw[j][2] = v.z; cw[j][3] = v.w; }
            { const f32x4 v = *(const f32x4*)(convb + c); cb[0] = v.x; cb[1] = v.y; cb[2] = v.z; cb[3] = v.w; }
            const int nb = c >> 2;
#pragma unroll
            for (int i = 0; i < 4; ++i) { const f32x4 a = *(const f32x4*)(C.in(IN_WQ) + nb * 16 + i * 4), b = *(const f32x4*)(C.in(IN_WK) + nb * 16 + i * 4), d = *(const f32x4*)(C.in(IN_WV) + nb * 16 + i * 4);
                wq[i][0] = a.x; wq[i][1] = a.y; wq[i][2] = a.z; wq[i][3] = a.w; wk[i][0] = b.x; wk[i][1] = b.y; wk[i][2] = b.z; wk[i][3] = b.w; wv[i][0] = d.x; wv[i][1] = d.y; wv[i][2] = d.z; wv[i][3] = d.w; }
            float xw[8][4];
#pragma unroll
            for (int r = 0; r < 8; ++r) { const u32x2 v = *(const LAS u32x2*)(lds + CV_XM + (4 * tg + r) * 512 + nblk * 8); xw[r][0] = bflo(v.x); xw[r][1] = bfhi(v.x); xw[r][2] = bflo(v.y); xw[r][3] = bfhi(v.y); }
#pragma unroll
            for (int tt = 0; tt < 4; ++tt) {
                const int tl = 4 * tg + tt;
                float xc[4], qv[4], kv[4], vv[4];
#pragma unroll
                for (int i = 0; i < 4; ++i) { float a = cb[i];
#pragma unroll
                    for (int j = 0; j < 5; ++j) a += cw[j][i] * xw[tt + j][i];
                    xc[i] = silu_f(a); }
#pragma unroll
                for (int o = 0; o < 4; ++o) { float a = 0.f, b = 0.f, d = 0.f;
#pragma unroll
                    for (int i = 0; i < 4; ++i) { a += xc[i] * wq[i][o]; b += xc[i] * wk[i][o]; d += xw[tt + 2][i] * wv[i][o]; }
                    qv[o] = a; kv[o] = b; vv[o] = d; }
                const size_t grow = (rrow0 + s0 + tl) * ML_IN + c;
                float k2[4];
#pragma unroll
                for (int i = 0; i < 4; ++i) { float a = 0.f;
#pragma unroll
                    for (int o = 0; o < 4; ++o) a += kv[o] * wq[i][o];
                    k2[i] = a; }
                const u32x2 xcw = (u32x2){pk2(xc[0], xc[1]), pk2(xc[2], xc[3])}, qw = (u32x2){pk2(qv[0], qv[1]), pk2(qv[2], qv[3])}, kw = (u32x2){pk2(kv[0], kv[1]), pk2(kv[2], kv[3])}, vw = (u32x2){pk2(vv[0], vv[1]), pk2(vv[2], vv[3])};
                *(u32x2*)(XC + grow) = xcw; *(u32x2*)(K + grow) = (u32x2){pk2(k2[0], k2[1]), pk2(k2[2], k2[3])};
                LAS unsigned char* qrow = lds + CV_QKV + tl * CV_QKV_P + nblk * 8;
                *(LAS u32x2*)(qrow) = qw; *(LAS u32x2*)(qrow + 512) = kw; *(LAS u32x2*)(qrow + 1024) = vw;
            }
        }
        LDS_BARRIER();
        for (int i = tid; i < 256 * 4; i += 512) { const int cr = i >> 2, cc = i & 3; const int cg = c0 + cr, head = cg >> 9, dv = cg & 511;
            const LAS unsigned short* s = (const LAS unsigned short*)(lds + CV_QKV + (8 * cc) * CV_QKV_P + 1024) + cr; unsigned short v[8];
#pragma unroll
            for (int j = 0; j < 8; ++j) v[j] = s[j * (CV_QKV_P / 2)];
            *(u32x4*)(VTR + ((size_t)(bl * 4 + head) * 512 + dv) * SEQ + s0 + cc * 8) = (u32x4){(unsigned)v[0] | ((unsigned)v[1] << 16), (unsigned)v[2] | ((unsigned)v[3] << 16), (unsigned)v[4] | ((unsigned)v[5] << 16), (unsigned)v[6] | ((unsigned)v[7] << 16)}; }
#pragma unroll
        for (int ks = 0; ks < 3; ++ks) { const int kk = 96 * wid + 32 * ks + 8 * (lane >> 4);
            const bf16x8 bfr = gwf[ks];
#pragma unroll
            for (int tgp = 0; tgp < 2; ++tgp) { const bf16x8 afr = *(const LAS bf16x8*)(lds + CV_QKV + (16 * tgp + (lane & 15)) * CV_QKV_P + kk * 2);
                gacc[tgp] = __builtin_amdgcn_mfma_f32_16x16x32_bf16(afr, bfr, gacc[tgp], 0, 0, 0); } }
    }
    LDS_BARRIER();
    LAS float* red = (LAS float*)(lds + CV_RED);
#pragma unroll
    for (int tgp = 0; tgp < 2; ++tgp)
#pragma unroll
        for (int r = 0; r < 4; ++r) red[(wid * 32 + 16 * tgp + 4 * (lane >> 4) + r) * 16 + (lane & 15)] = gacc[tgp][r];
    LDS_BARRIER();
    { const int tkn = tid >> 4, n = tid & 15; float s = C.in(IN_GATEB)[n];
#pragma unroll
        for (int w = 0; w < 8; ++w) s += red[(w * 32 + tkn) * 16 + n];
        C.w<float>(WS_PRE)[(rrow0 + s0 + tkn) * 16 + n] = s; }
    (void)round;
#undef CV_LOAD
}
__device__ __forceinline__ void p_conv(const Ctx& C, int round) {
    { float* DEN = C.w<float>(WS_DEN); for (int i = C.vcu * 512 + C.tid; i < 2 * 16 * 2048; i += C.G * 512) DEN[i] = 0.f; }
    for (int u = C.vcu; u < RB * 64; u += C.G) conv_unit(C, round, u >> 6, u & 63);
    __syncthreads();
}
__device__ __forceinline__ void cumsum_bh(const Ctx& C, int bh) {
    float* FG = C.w<float>(WS_FG); const float* PRE = C.w<float>(WS_PRE);
    LAS float* wtot = (LAS float*)(C.lds);
    const int bl = bh >> 2, hd = bh & 3, lane = C.lane, tid = C.tid;
    const float* p = PRE + (size_t)bl * SEQ * 16;
    float lf[2][4], ii[2][4], tot[2] = {0.f, 0.f};
#pragma unroll
    for (int j = 0; j < 4; ++j) { const int s = tid * 4 + j;
#pragma unroll
        for (int d = 0; d < 2; ++d) { const float f = p[(size_t)s * 16 + d * 8 + 4 + hd]; ii[d][j] = p[(size_t)s * 16 + d * 8 + hd];
            lf[d][j] = fminf(f, 0.f) - __logf(1.0f + __expf(-fabsf(f))); tot[d] += lf[d][j]; } }
    float inc[2] = {tot[0], tot[1]};
#pragma unroll
    for (int o = 1; o < 64; o <<= 1) { const float v0 = __shfl_up(inc[0], o), v1 = __shfl_up(inc[1], o); if (lane >= o) { inc[0] += v0; inc[1] += v1; } }
    __syncthreads();
    if (lane == 63) { wtot[C.wave] = inc[0]; wtot[8 + C.wave] = inc[1]; }
    __syncthreads();
#pragma unroll
    for (int d = 0; d < 2; ++d) {
        float before = 0.f, all = 0.f;
#pragma unroll
        for (int w = 0; w < 8; ++w) { const float v = wtot[d * 8 + w]; all += v; if (w < C.wave) before += v; }
        const float excl = before + inc[d] - tot[d];
        float* F = FG + (size_t)(d * 2) * 16 * 2048 + (size_t)bh * 2048; float* Gp = F + 16 * 2048;
        f32x4 fo, go;
        if (d == 0) { float run = excl;
#pragma unroll
            for (int j = 0; j < 4; ++j) { run += lf[d][j]; fo[j] = run * LOG2E; go[j] = (ii[d][j] - run) * LOG2E - 4.5f; } }
        else { float run = all - excl;
#pragma unroll
            for (int j = 0; j < 4; ++j) { fo[j] = run * LOG2E; go[j] = (ii[d][j] - run) * LOG2E - 4.5f; run -= lf[d][j]; } }
        *(f32x4*)(F + tid * 4) = fo; *(f32x4*)(Gp + tid * 4) = go;
    }
}
struct DecayOrder {
    const char* Qb; const char* Kb; int G, c;
    __device__ __forceinline__ bool next(int ii, pg8::Unit& u) const {
        const int grp = (ii >> 2) * G + c; if (grp >= 256) return false;
        const int bh = grp >> 4, i = (grp >> 1) & 7, j = 4 * (grp & 1) + (ii & 3), bl = bh >> 2, hd = bh & 3;
        u.A = Qb + ((size_t)(bl * SEQ + 256 * i) * ML_IN + hd * 512) * 2; u.B = Kb + ((size_t)(bl * SEQ + 256 * j) * ML_IN + hd * 512) * 2; u.r0 = 256 * i; u.c0 = 256 * j; u.a0 = bh; u.a1 = (i << 4) | j; u.nt = ML_DH / 64; u.flags = 3; return true;
    }
    __device__ __forceinline__ int kb(const pg8::Unit&, int t) const { return t; }
};
struct EpiDecay {
    static constexpr bool PERM = true;
    bf16* W; const float* FG; float* DEN; int den_on; bf16* DUMMY;
    template <bool MASK>
    __device__ __forceinline__ void pass(const f32x4 (&acc)[2][2][4][2], const pg8::Unit& u, int wr, int wc, int fr, int fq, int dir, int dmin, int dmax, int cblk) const {
        const int bh = u.a0; const float* F = FG + (size_t)(dir * 2) * 16 * 2048 + (size_t)bh * 2048; const float* Gp = F + 16 * 2048;
        const int rl0 = opaque_v(wr * 64 + fr), cl0 = opaque_v(wc * 32 + 8 * fq);
        const float* Fr = F + u.r0;
        const bool fake_ = (REP_ABL & 256) && !den_on;
        const float ref = fake_ ? 0.5f : (dir ? Fr[255] : Fr[0]);
        f32x4 gv[2][2];
#pragma unroll
        for (int bj = 0; bj < 2; ++bj)
#pragma unroll
            for (int n = 0; n < 2; ++n) { const f32x4 g = fake_ ? (f32x4){0.1f * fq, 0.2f, 0.3f * fr, 0.4f} : *(const f32x4*)(Gp + u.c0 + cl0 + bj * 128 + 4 * n);
#pragma unroll
                for (int i = 0; i < 4; ++i) gv[bj][n][i] = __builtin_amdgcn_exp2f(fminf(g[i] + ref, 120.0f)); }
        float fa[2][4];
#pragma unroll
        for (int ai = 0; ai < 2; ++ai)
#pragma unroll
            for (int m = 0; m < 4; ++m) fa[ai][m] = __builtin_amdgcn_exp2f(fmaxf((fake_ ? 0.01f * (fr + m) : Fr[rl0 + ai * 128 + m * 16]) - ref, -126.0f));
        bf16* wbase = W + ((size_t)bh * SEQ + u.r0) * WLD + cblk * 256 + cl0;
        float* den = DEN + (size_t)dir * 16 * 2048 + (size_t)bh * 2048 + u.r0;
#pragma unroll
        for (int ai = 0; ai < 2; ++ai)
#pragma unroll
            for (int m = 0; m < 4; ++m) { const int rl = rl0 + ai * 128 + m * 16; const float fv = fa[ai][m]; f32x4 rsv = (f32x4){0.f, 0.f, 0.f, 0.f};
#pragma unroll
                for (int bj = 0; bj < 2; ++bj) { f32x4 t0 = acc[ai][bj][m][0] * gv[bj][0], t1 = acc[ai][bj][m][1] * gv[bj][1];
                    if (MASK) {
#pragma unroll
                        for (int i = 0; i < 4; ++i) { const int d0 = cl0 + bj * 128 + i - rl, d1 = d0 + 4; t0[i] = (d0 >= dmin && d0 <= dmax) ? t0[i] : 0.f; t1[i] = (d1 >= dmin && d1 <= dmax) ? t1[i] : 0.f; } }
                    rsv += t0; rsv += t1; t0 = t0 * fv; t1 = t1 * fv;
                    u32x4 w; w.x = pk2(t0[0], t0[1]); w.y = pk2(t0[2], t0[3]); w.z = pk2(t1[0], t1[1]); w.w = pk2(t1[2], t1[3]);
                    if (!((REP_ABL & 64) && !den_on)) *(u32x4*)(wbase + (size_t)rl * WLD + bj * 128) = w; else rsv[0] += __builtin_bit_cast(float, w.x ^ w.y ^ w.z ^ w.w); }
                float rs = ((rsv[0] + rsv[1]) + (rsv[2] + rsv[3])) * fv;
                rs += __shfl_xor(rs, 16); rs += __shfl_xor(rs, 32);
                if (fq == 0 && den_on) atomicAdd(den + rl, rs); else if ((REP_ABL & 64) && rs == 12345.678f) den[rl] = rs; }
    }
    __device__ __forceinline__ void operator()(const f32x4 (&acc)[2][2][4][2], const pg8::Unit& u, int wr, int wc, int fr_, int fq_) const {
        (void)fr_; (void)fq_; const int ln_ = opaque_v(lane_id()); const int fr = ln_ & 15, fq = ln_ >> 4;
        if ((REP_ABL & 32) && !den_on) { if (acc[0][0][0][0][0] == 12345.678f) W[0] = 1; return; }
        if ((REP_ABL & 512) && !den_on) {
            bf16* wb = DUMMY + ((size_t)(u.a0 & 1) * SEQ + u.r0) * 2048 + (u.a1 & 7) * 256 + wc * 32 + 8 * fq;
#pragma unroll
            for (int ai = 0; ai < 2; ++ai)
#pragma unroll
                for (int m = 0; m < 4; ++m) { const int rl = wr * 64 + fr + ai * 128 + m * 16;
#pragma unroll
                    for (int bj = 0; bj < 2; ++bj) { const f32x4 v0 = acc[ai][bj][m][0], v1 = acc[ai][bj][m][1];
                        u32x4 w; w.x = pk2(v0[0], v0[1]); w.y = pk2(v0[2], v0[3]); w.z = pk2(v1[0], v1[1]); w.w = pk2(v1[2], v1[3]);
                        *(u32x4*)(wb + (size_t)rl * 2048 + bj * 128) = w; } }
            return; }
        const int i = u.a1 >> 4, j = u.a1 & 15;
        if (j != i) pass<false>(acc, u, wr, wc, fr, fq, j > i ? 1 : 0, 0, 0, j > i ? j + 1 : j);
        else { for (int p = 0; p < 2; ++p) pass<true>(acc, u, wr, wc, fr, fq, p, p ? 0 : -100000, p ? 100000 : 0, i + p); }
    }
};
struct HOrder {
    const char* Wb; const char* Vb; const float* DEN; int G, c;
    __device__ __forceinline__ bool next(int ii, pg8::Unit& u) const {
        const int L = (ii >> 1) * G + c, part = ii & 1; if (L >= 16 * 16) return false;
        const int bh = L >> 4, i = (L >> 1) & 7, jn = L & 1;
        const int kt0 = part ? 4 * (i + 1) : 0;
        u.A = Wb + (((size_t)bh * SEQ + 256 * i) * WLD + (size_t)kt0 * 64) * 2;
        u.B = Vb + (((size_t)bh * 512 + 256 * jn) * SEQ + (size_t)(part ? 4 * i : 0) * 64) * 2;
        u.r0 = 256 * i; u.c0 = 256 * jn; u.a0 = bh; u.a1 = part; u.nt = part ? 36 - 4 * (i + 1) : 4 * (i + 1); u.flags = 3; return true;
    }
    __device__ __forceinline__ int kb(const pg8::Unit&, int t) const { return t; }
    __device__ __forceinline__ void between(const pg8::Unit& u, f32x4 (&acc)[2][2][4][2], int wr) const {
        const int fr = opaque_v(lane_id()) & 15;
        const float* df = DEN + (size_t)u.a0 * 2048 + u.r0; const float* db = df + 16 * 2048;
#pragma unroll
        for (int ai = 0; ai < 2; ++ai)
#pragma unroll
            for (int m = 0; m < 4; ++m) { const int rl = ai * 128 + wr * 64 + m * 16 + fr; const float f = fmaxf(fabsf(db[rl]), 1.0f) / fmaxf(fabsf(df[rl]), 1.0f);
#pragma unroll
                for (int bj = 0; bj < 2; ++bj)
#pragma unroll
                    for (int n = 0; n < 2; ++n) acc[ai][bj][m][n] *= f; }
    }
};
struct EpiH {
    static constexpr bool PERM = true;
    bf16* HF; bf16* HB; const float* DEN;
    __device__ __forceinline__ void operator()(const f32x4 (&acc)[2][2][4][2], const pg8::Unit& u, int wr, int wc, int fr_, int fq_) const {
        (void)fr_; (void)fq_; const int ln_ = opaque_v(lane_id()); const int fr = ln_ & 15, fq = ln_ >> 4;
        const int bh = u.a0, bl = bh >> 2, hd = bh & 3, part = u.a1; const float* dn = DEN + (size_t)part * 16 * 2048 + (size_t)bh * 2048 + u.r0;
        const int rl0 = wr * 64 + fr, col0 = hd * 512 + u.c0 + wc * 32 + 8 * fq;
        bf16* Hh = HF; (void)HB;
#pragma unroll
        for (int ai = 0; ai < 2; ++ai)
#pragma unroll
            for (int m = 0; m < 4; ++m) { const int rl = rl0 + ai * 128 + m * 16; const float rv = 1.0f / fmaxf(fabsf(dn[rl]), 1.0f);
                bf16* rowp = Hh + ((size_t)bl * SEQ + u.r0 + rl) * ML_IN + col0;
#pragma unroll
                for (int bj = 0; bj < 2; ++bj) { f32x4 v0 = acc[ai][bj][m][0] * rv, v1 = acc[ai][bj][m][1] * rv;
                    u32x4 w; w.x = pk2(v0[0], v0[1]); w.y = pk2(v0[2], v0[3]); w.z = pk2(v1[0], v1[1]); w.w = pk2(v1[2], v1[3]);
                    *(u32x4*)(rowp + bj * 128) = w; } }
    }
};
__device__ __forceinline__ void p_ynorm(const Ctx& C, int round, bool dummy = false) {
    const bf16* HF = C.w<bf16>(WS_Q); const bf16* XC = C.w<bf16>(WS_XC); bf16* Y = C.w<bf16>(WS_Y) + (size_t)round * RT * ML_IN;
    const float* og = C.in(IN_ONG); const float* skip = C.in(IN_SKIP);
    bf16* Yd = dummy ? C.w<bf16>(WS_XMH) : Y;
    for (int r = C.vcu * 8 + C.wave; r < RT; r += C.G * 8) {
        const size_t off = (size_t)r * ML_IN + 8 * C.lane;
#pragma unroll
        for (int hd = 0; hd < 4; ++hd) {
            const u32x4 hw = *(const u32x4*)(HF + off + hd * 512), xw = *(const u32x4*)(XC + off + hd * 512), zw = *(const u32x4*)(Y + off + hd * 512);
            float hv[8] = {bflo(hw.x), bfhi(hw.x), bflo(hw.y), bfhi(hw.y), bflo(hw.z), bfhi(hw.z), bflo(hw.w), bfhi(hw.w)};
            const float xv[8] = {bflo(xw.x), bfhi(xw.x), bflo(xw.y), bfhi(xw.y), bflo(xw.z), bfhi(xw.z), bflo(xw.w), bfhi(xw.w)};
            const float zv[8] = {bflo(zw.x), bfhi(zw.x), bflo(zw.y), bfhi(zw.y), bflo(zw.z), bfhi(zw.z), bflo(zw.w), bfhi(zw.w)};
            float ss = 0.f;
#pragma unroll
            for (int j = 0; j < 8; ++j) ss += hv[j] * hv[j];
            const float rs = 1.0f / sqrtf(wave_sum(ss) * (1.0f / 512.0f) + EPS);
            const float* gg = og + hd * 512 + 8 * C.lane; const float* sk = skip + hd * 512 + 8 * C.lane; float yv[8];
#pragma unroll
            for (int j = 0; j < 8; ++j) yv[j] = (hv[j] * rs * gg[j] + sk[j] * xv[j]) * silu_f(zv[j]);
            u32x4 w; w.x = pk2(yv[0], yv[1]); w.y = pk2(yv[2], yv[3]); w.z = pk2(yv[4], yv[5]); w.w = pk2(yv[6], yv[7]);
            *(u32x4*)(Yd + off + hd * 512) = w;
        }
    }
}

constexpr int PH_PRO = 0, PH_NORM0 = 1, PH_QKV = 2, PH_ATTN = 3, PH_OUT0 = 4, PH_ROUTE0 = 5, PH_UP0 = 6, PH_DOWN0 = 7, PH_COMB0 = 8,
              PH_INPROJ0 = 9, PH_RND = 10  , PH_OUT1 = PH_RND + 4 * NROUND, PH_ROUTE1 = PH_OUT1 + 1,
              PH_UP1 = PH_OUT1 + 2, PH_DOWN1 = PH_OUT1 + 3, PH_COMB1 = PH_OUT1 + 4, N_PHASES = PH_OUT1 + 5;

__device__ __forceinline__ void moe_up(const Ctx& C, int layer) {
    const MoeTab T = moe_tables(C, layer);
    MoeOrder<2, true> S; S.tl = C.w<int>(WS_TL); S.T = T; S.A = (const char*)C.w<bf16>(WS_HF); S.B = (const char*)C.w<bf16>(WS_W13T); S.lda_bytes = DM * 2; S.b_expert_bytes = (size_t)512 * DM * 2; S.b_tile_bytes = 256 * DM * 2; S.G = C.G; S.c = C.vcu; S.nt = DM / 64;
    EpiSwiGLU E{C.w<bf16>(WS_HH)};
    pg8::gemm_phase<EpiSwiGLU, MoeOrder<2, true>, true, true>(C.lds, C.tid, DM, DM, S, E);
}
__device__ __forceinline__ void moe_down(const Ctx& C, int layer) {
    const MoeTab T = moe_tables(C, layer);
    MoeOrder<4, false> S; S.tl = nullptr; S.T = T; S.A = (const char*)C.w<bf16>(WS_HH); S.B = (const char*)C.w<bf16>(WS_W2T); S.lda_bytes = DEXP * 2; S.b_expert_bytes = (size_t)DM * DEXP * 2; S.b_tile_bytes = 256 * DEXP * 2; S.G = C.G; S.c = C.vcu; S.nt = DEXP / 64;
    pg8::EpiBf16 E{C.w<bf16>(WS_YS), DM, 0, nullptr, 0};
    pg8::gemm_phase<pg8::EpiBf16, MoeOrder<4, false>, true>(C.lds, C.tid, DEXP, DEXP, S, E);
}

__global__ void __launch_bounds__(512, 2) fwd_kernel(Args args) {
    extern __shared__ __attribute__((aligned(16))) unsigned char lds_raw[];
    Ctx C; C.a = &args; C.ws = (GAS unsigned char*)args.ws; C.lds = (LAS unsigned char*)lds_raw; C.tid = threadIdx.x; C.lane = C.tid & 63; C.wave = __builtin_amdgcn_readfirstlane(C.tid >> 6);
    C.G = gridDim.x; { const int bx = blockIdx.x; C.vcu = (C.G % 8 == 0) ? (bx % 8) * (C.G / 8) + bx / 8 : bx; }
    volatile LAS unsigned* MISC = (volatile LAS unsigned*)(C.lds + MISC_OFF);
    if (C.tid < 64) MISC[C.tid] = 0u;
    __syncthreads();
    const int lo = args.ph_lo, hi = args.ph_hi;
    XcdBarrier bar; bar.bar = C.w<unsigned>(WS_CTL) + CW_BAR; bar.x = 0; bar.st = nullptr;
    if (hi - lo > 1) bar = xcd_barrier_post(C.w<unsigned>(WS_CTL) + CW_BAR, MISC + 8);
#ifndef PHSEL
#define PHSEL(k) true
#endif
#define IN(k) (PHSEL(k) && lo <= (k) && (k) < hi)
#ifndef REP_PH
#define REP_PH (-1)
#endif
#ifndef REP_J
#define REP_J (-1)
#endif
#ifndef REP_N
#define REP_N 0
#endif
#define NREP(k) (1 + (((k) == REP_PH) ? REP_N : 0))
#define NREPJ(j) (1 + (((j) == REP_J) ? REP_N : 0))
#define SEAM(k) do { if (IN(k) && IN((k) + 1)) xcd_barrier(bar); } while (0)
    float* xout = (float*)(GAS float*)args.out;
    bf16* hmall = (bf16*)xout + (size_t)NT * DM;
    bf16* xb = (bf16*)xout;

    if (IN(PH_PRO)) for (int rep_ = 0; rep_ < NREP(PH_PRO); ++rep_) { const Ctx P = fresh(C); p_prologue(P); } SEAM(PH_PRO);
#ifdef XTRA_BARRIERS
    for (int xb_ = 0; xb_ < XTRA_BARRIERS; ++xb_) xcd_barrier(bar);
#endif
    if (IN(PH_NORM0)) for (int rep_ = 0; rep_ < NREP(PH_NORM0); ++rep_) { const Ctx P = fresh(C); p_normmod(P, P.in(IN_X), 0, 0, NT, P.w<bf16>(WS_HM)); } SEAM(PH_NORM0);
    if (IN(PH_QKV)) for (int rep_ = 0; rep_ < NREP(PH_QKV); ++rep_) { const Ctx P = fresh(C);
        { pg8::PlainOrder S{(const char*)P.w<bf16>(WS_HM), (const char*)P.w<bf16>(WS_WINT), DM, DM, NT / 256, 2048 / 256, P.G, P.vcu, DM / 64};
          pg8::EpiQKNorm E{P.w<bf16>(WS_QK), P.in(IN_QG), P.in(IN_KG)};
          pg8::gemm_phase<pg8::EpiQKNorm, pg8::PlainOrder, true, false, false, true>(P.lds, P.tid, DM, DM, S, E); }
        { pg8::PlainOrder S{(const char*)(P.w<bf16>(WS_WINT) + (size_t)2048 * DM), (const char*)P.w<bf16>(WS_HM), DM, DM, 1024 / 256, NT / 256, P.G, P.vcu, DM / 64};
          pg8::EpiBf16 E{P.w<bf16>(WS_VT), NT, 0, nullptr, 0};
          pg8::gemm_phase<pg8::EpiBf16, pg8::PlainOrder, true>(P.lds, P.tid, DM, DM, S, E); }
    } SEAM(PH_QKV);
    if (IN(PH_ATTN)) for (int rep_ = 0; rep_ < NREP(PH_ATTN); ++rep_) { const Ctx P = fresh(C); if (rep_ == 0) p_attention<0>(P); else p_attention<REP_ABL>(P); } SEAM(PH_ATTN);
    if (IN(PH_OUT0)) for (int rep_ = 0; rep_ < NREP(PH_OUT0); ++rep_) { const Ctx P = fresh(C);
        pg8::PlainOrder S{(const char*)P.w<bf16>(WS_O), (const char*)P.w<bf16>(WS_WOT), DM, DM, NT / 256, DM / 256, P.G, P.vcu, DM / 64};
        pg8::EpiResid<true> E{P.in(IN_X), xb, P.mods(0, 2)};
        pg8::gemm_phase<pg8::EpiResid<true>, pg8::PlainOrder, true>(P.lds, P.tid, DM, DM, S, E);
    } SEAM(PH_OUT0);
    if (IN(PH_ROUTE0)) for (int rep_ = 0; rep_ < NREP(PH_ROUTE0); ++rep_) { const Ctx P = fresh(C); p_route(P, 0, xb, rep_ == 0); } SEAM(PH_ROUTE0);
    if (IN(PH_UP0)) for (int rep_ = 0; rep_ < NREP(PH_UP0); ++rep_) { const Ctx P = fresh(C); moe_up(P, 0); } SEAM(PH_UP0);
    if (IN(PH_DOWN0)) for (int rep_ = 0; rep_ < NREP(PH_DOWN0); ++rep_) { const Ctx P = fresh(C); moe_down(P, 0); } SEAM(PH_DOWN0);
    if (IN(PH_COMB0)) for (int rep_ = 0; rep_ < NREP(PH_COMB0); ++rep_) { const Ctx P = fresh(C); p_combine<false>(P, 0, xb, rep_ == 0 ? (void*)xb : (void*)P.w<bf16>(WS_HS + 8 * MiB), rep_ == 0 ? NT : 0, hmall); LAS float* scr = (LAS float*)(P.lds + P.wave * 16384); moe_weight_items(P, 1, scr); } SEAM(PH_COMB0);

#define INPROJ(P_, rnd_, skip_) do { \
        pg8::PlainOrder S_{(const char*)(hmall + (size_t)(rnd_) * RT * DM), (const char*)(P_).w<bf16>(WS_MLWINT), DM, DM, RT / 256, 4096 / 256, (P_).G, (P_).vcu, DM / 64}; \
        pg8::EpiBf16 E_{(P_).w<bf16>(WS_XMH), ML_IN, ML_IN, (P_).w<bf16>(WS_Y) + (size_t)(rnd_) * RT * ML_IN, ML_IN, skip_}; \
        pg8::gemm_phase<pg8::EpiBf16, pg8::PlainOrder, true>((P_).lds, (P_).tid, DM, DM, S_, E_); } while (0)
    if (IN(PH_INPROJ0)) for (int rep_ = 0; rep_ < NREP(PH_INPROJ0); ++rep_) { const Ctx P = fresh(C); INPROJ(P, 0, rep_); } SEAM(PH_INPROJ0);
    for (int round = 0; round < NROUND; ++round) {
        const int pb = PH_RND + 4 * round;
        if (IN(pb + 0)) for (int rep_ = 0; rep_ < NREPJ(0); ++rep_) { const Ctx P = fresh(C); p_conv(P, round); } SEAM(pb + 0);
        if (IN(pb + 1)) for (int rep_ = 0; rep_ < NREPJ(1); ++rep_) { const Ctx P = fresh(C);
            { int last_bh = -1; for (int grp = P.vcu; grp < 256; grp += P.G) { const int bh = grp >> 4; if (bh != last_bh) { cumsum_bh(P, bh); last_bh = bh; } }
              asm volatile("s_waitcnt vmcnt(0)" ::: "memory"); __syncthreads(); }
            DecayOrder S{(const char*)P.w<bf16>(WS_XC), (const char*)P.w<bf16>(WS_K), P.G, P.vcu};
            EpiDecay E{P.w<bf16>(WS_W), P.w<float>(WS_FG), P.w<float>(WS_DEN), rep_ == 0 ? 1 : 0, P.w<bf16>(WS_XMH)};
            pg8::gemm_phase<EpiDecay, DecayOrder, GEMM1_ALIGN>(P.lds, P.tid, ML_IN, ML_IN, S, E);
        } SEAM(pb + 1);
        if (IN(pb + 2)) for (int rep_ = 0; rep_ < NREPJ(2); ++rep_) { const Ctx P = fresh(C);
            { HOrder S{(const char*)P.w<bf16>(WS_W), (const char*)P.w<bf16>(WS_VTR), P.w<float>(WS_DEN), P.G, P.vcu};
              EpiH E{P.w<bf16>(WS_Q), P.w<bf16>(WS_K), P.w<float>(WS_DEN)};
              pg8::gemm_phase<EpiH, HOrder, true, false, true>(P.lds, P.tid, WLD, SEQ, S, E); }
            if (round + 1 < NROUND) { const Ctx P2 = fresh(C); INPROJ(P2, round + 1, rep_); }
        } SEAM(pb + 2);
        if (IN(pb + 3)) for (int rep_ = 0; rep_ < NREPJ(3); ++rep_) { const Ctx P = fresh(C); p_ynorm(P, round, rep_ != 0); } SEAM(pb + 3);
    }
#undef INPROJ
    if (IN(PH_OUT1)) for (int rep_ = 0; rep_ < NREP(PH_OUT1); ++rep_) { const Ctx P = fresh(C);
        pg8::PlainOrder S{(const char*)P.w<bf16>(WS_Y), (const char*)P.w<bf16>(WS_MLWOUTT), ML_IN, ML_IN, NT / 256, DM / 256, P.G, P.vcu, ML_IN / 64};
        pg8::EpiResid<false> E{xb, P.w<bf16>(WS_XB3), P.mods(1, 2)};
        pg8::gemm_phase<pg8::EpiResid<false>, pg8::PlainOrder, true>(P.lds, P.tid, ML_IN, ML_IN, S, E);
    } SEAM(PH_OUT1);
    if (IN(PH_ROUTE1)) for (int rep_ = 0; rep_ < NREP(PH_ROUTE1); ++rep_) { const Ctx P = fresh(C); p_route(P, 1, P.w<bf16>(WS_XB3), rep_ == 0); } SEAM(PH_ROUTE1);
    if (IN(PH_UP1)) for (int rep_ = 0; rep_ < NREP(PH_UP1); ++rep_) { const Ctx P = fresh(C); moe_up(P, 1); } SEAM(PH_UP1);
    if (IN(PH_DOWN1)) for (int rep_ = 0; rep_ < NREP(PH_DOWN1); ++rep_) { const Ctx P = fresh(C); moe_down(P, 1); } SEAM(PH_DOWN1);
    if (IN(PH_COMB1)) for (int rep_ = 0; rep_ < NREP(PH_COMB1); ++rep_) { const Ctx P = fresh(C); p_combine<true>(P, 1, P.w<bf16>(WS_XB3), rep_ == 0 ? (void*)xout : (void*)P.w<float>(WS_HS + 8 * MiB)); }
#undef IN
#undef SEAM
}

extern "C" void kernel_launch(void* const* d_in, const int* in_sizes, int n_in, void* d_out, int out_size, void* d_ws, size_t ws_size, hipStream_t stream) {
    static int grid = 0;
    if (grid == 0) {
        if (n_in != 32 || in_sizes[0] != NT * DM || out_size != NT * DM || ws_size < WS_END) { fprintf(stderr, "kernel_launch: unexpected shapes (n_in %d, in0 %d, out %d, ws %zu)\n", n_in, n_in > 0 ? in_sizes[0] : -1, out_size, ws_size); grid = -1; return; }
        int dev = 0, cus = 0, per_cu = 0;
        if (hipGetDevice(&dev) != hipSuccess || hipDeviceGetAttribute(&cus, hipDeviceAttributeMultiprocessorCount, dev) != hipSuccess) { grid = -1; return; }
        if (hipFuncSetAttribute((const void*)fwd_kernel, hipFuncAttributeMaxDynamicSharedMemorySize, LDS_BYTES) != hipSuccess) { fprintf(stderr, "kernel_launch: hipFuncSetAttribute failed\n"); grid = -1; return; }
        if (hipOccupancyMaxActiveBlocksPerMultiprocessor(&per_cu, (const void*)fwd_kernel, 512, LDS_BYTES) != hipSuccess || per_cu < 1) fprintf(stderr, "kernel_launch: occupancy query reports %d\n", per_cu);
        (void)hipGetLastError();
        grid = cus;
    }
    if (grid < 0) return;
    (void)hipMemsetAsync((char*)d_ws + WS_CTL, 0, CTL_ZERO_BYTES, stream);
    Args a{};
    for (int i = 0; i < 32; ++i) a.in[i] = (const float*)d_in[i];
    a.out = (float*)d_out; a.ws = (unsigned char*)d_ws;
#if MK_ONE_LAUNCH
    a.ph_lo = 0; a.ph_hi = N_PHASES;
    hipLaunchKernelGGL(fwd_kernel, dim3(grid), dim3(512), LDS_BYTES, stream, a);
#else
    for (int p = 0; p < N_PHASES; ++p) { a.ph_lo = p; a.ph_hi = p + 1; hipLaunchKernelGGL(fwd_kernel, dim3(grid), dim3(512), LDS_BYTES, stream, a); }
#endif
}
```
